# Optimizing an MI355X kernel written in HIP

```python
import math
import jax, jax.numpy as jnp
from jax import lax
import numpy as np

D_MODEL = 1024
BATCH = 8
SEQ = 4096
DEPTH = 1

POOL_WINDOWS = (2, 4, 8, 16)
POOL_GROUPS = 4
POOL_WIDTH = D_MODEL // 2
POOL_GROUP_DIM = POOL_WIDTH // POOL_GROUPS
N_HEADS = 8
HEAD_DIM = 64
ATTN_WIDTH = N_HEADS * HEAD_DIM
KV_DIM = HEAD_DIM
IDX_HEADS = 8
IDX_DIM = 32
TOPK_MAX = 256
Q_BLOCK = 128
NEG_INF = -1e30
N_BRANCHES = 2
N_GROUPS = 4
EXPERTS_PER_GROUP = 8
N_EXPERTS = N_GROUPS * EXPERTS_PER_GROUP
EXPERT_FF = 256
ROUTE_TOPK = 2
LN_EPS = 1e-5
DEEPNORM_ALPHA = (2.0 * DEPTH) ** 0.25
DEEPNORM_BETA = (8.0 * DEPTH) ** -0.25
SPLITS = (POOL_WIDTH, ATTN_WIDTH, KV_DIM, KV_DIM, IDX_HEADS * IDX_DIM, IDX_DIM, IDX_HEADS, N_BRANCHES * D_MODEL)
IN_WIDTH = 3496

kernel_name = 'hybrid_pool_dsa_hmoe'


def layer_norm(x, g, b):
    x32 = x.astype(jnp.float32)
    mu = jnp.mean(x32, axis=-1, keepdims=True)
    xc = x32 - mu
    var = jnp.mean(xc * xc, axis=-1, keepdims=True)
    y = xc * lax.rsqrt(var + LN_EPS) * g.astype(jnp.float32) + b.astype(jnp.float32)
    return y.astype(x.dtype)


def causal_multiscale_pool(u, w_group, scale):
    B, L, _ = u.shape
    u32 = u.astype(jnp.float32).reshape(B, L, POOL_GROUPS, POOL_GROUP_DIM)
    csum = jnp.concatenate([jnp.zeros_like(u32[:, :1]), jnp.cumsum(u32, axis=1)], axis=1)
    pos = jnp.arange(L)
    deltas = []
    for g, w in enumerate(POOL_WINDOWS):
        start = jnp.maximum(pos + 1 - w, 0)
        win_sum = csum[:, 1:, g] - csum[:, start, g]
        count = (pos + 1 - start).astype(jnp.float32)
        deltas.append(win_sum / count[None, :, None] - u32[:, :, g])
    delta = jnp.stack(deltas, axis=2)
    mixed = jnp.einsum('blgd,gde->blge', delta, w_group.astype(jnp.float32))
    out = mixed.reshape(B, L, POOL_WIDTH) * scale.astype(jnp.float32)
    return out.astype(u.dtype)


def dsa_attention(q, k, v, iq, ik, iw):
    B, L, H, dh = q.shape
    n_sel = min(TOPK_MAX, L // 4)
    nb = L // Q_BLOCK
    sm_scale = 1.0 / math.sqrt(dh)
    key_pos = jnp.arange(L)
    ik32 = ik.astype(jnp.float32)

    def to_blocks(a):
        return a.reshape((B, nb, Q_BLOCK) + a.shape[2:]).swapaxes(0, 1)

    q_b, iq_b, iw_b = to_blocks(q), to_blocks(iq), to_blocks(iw)
    qpos_b = key_pos.reshape(nb, Q_BLOCK)

    def block(args):
        qb, iqb, iwb, qpos = args
        idx_logits = jnp.einsum('bqhd,bsd->bqhs', iqb.astype(jnp.float32), ik32)
        score = jnp.einsum('bqh,bqhs->bqs', iwb.astype(jnp.float32), jax.nn.relu(idx_logits))
        admissible = key_pos[None, :] <= qpos[:, None]
        score = jnp.where(admissible[None], score, NEG_INF)
        _, sel = lax.top_k(score, n_sel)
        valid = sel <= qpos[None, :, None]
        k_sel = jax.vmap(lambda kk, ii: kk[ii])(k, sel)
        v_sel = jax.vmap(lambda vv, ii: vv[ii])(v, sel)
        logits = jnp.einsum('bqhd,bqkd->bqhk', qb.astype(jnp.float32), k_sel.astype(jnp.float32)) * sm_scale
        logits = jnp.where(valid[:, :, None, :], logits, NEG_INF)
        p = jax.nn.softmax(logits, axis=-1)
        o = jnp.einsum('bqhk,bqkd->bqhd', p, v_sel.astype(jnp.float32))
        return o.astype(q.dtype)

    out = lax.map(block, (q_b, iq_b, iw_b, qpos_b))
    return out.swapaxes(0, 1).reshape(B, L, H * dh)


def hierarchical_moe(h, w_group, b_group, w_router, b_router, w_gate, w_up, w_down):
    B, L, D = h.shape
    t = h.reshape(B * L, D)
    t32 = t.astype(jnp.float32)
    group_logits = t32 @ w_group.astype(jnp.float32) + b_group.astype(jnp.float32)
    group_prob = jax.nn.softmax(group_logits, axis=-1)
    g_sel = jnp.argmax(group_logits, axis=-1)
    p_group = jnp.take_along_axis(group_prob, g_sel[:, None], axis=-1)
    exp_logits = (t32 @ w_router.astype(jnp.float32) + b_router.astype(jnp.float32)).reshape(-1, N_GROUPS, EXPERTS_PER_GROUP)
    exp_logits = jnp.take_along_axis(exp_logits, g_sel[:, None, None], axis=1)[:, 0]
    top_vals, top_idx = lax.top_k(exp_logits, ROUTE_TOPK)
    top_w = jax.nn.softmax(top_vals, axis=-1) * p_group
    expert_id = g_sel[:, None] * EXPERTS_PER_GROUP + top_idx
    gates = jnp.sum(jax.nn.one_hot(expert_id, N_EXPERTS, dtype=jnp.float32) * top_w[..., None], axis=1)
    out = jnp.zeros((B * L, D), jnp.float32)
    for e in range(N_EXPERTS):
        hid = jax.nn.silu(t @ w_gate[e]) * (t @ w_up[e])
        out = out + gates[:, e:e + 1] * (hid @ w_down[e]).astype(jnp.float32)
    return out.reshape(B, L, D).astype(h.dtype)


def setup_inputs(seed: int = 0) -> dict:
    key = jax.random.key(seed)
    ks = jax.random.split(key, 24)
    f32 = jnp.float32
    D = D_MODEL

    def nrm(k, shape, scale):
        return jax.random.normal(k, shape, f32) * scale

    col_scale = jnp.concatenate([
        jnp.ones((POOL_WIDTH + ATTN_WIDTH + KV_DIM,), f32),
        jnp.full((KV_DIM,), DEEPNORM_BETA, f32),
        jnp.ones((IDX_HEADS * IDX_DIM + IDX_DIM + IDX_HEADS + N_BRANCHES * D,), f32)])
    return {
        'x': jax.random.normal(ks[0], (BATCH, SEQ, D), f32),
        'ln_in_g': 1.0 + nrm(ks[1], (D,), 0.01),
        'ln_in_b': nrm(ks[2], (D,), 0.01),
        'w_in': nrm(ks[3], (DEPTH, D, IN_WIDTH), D ** -0.5) * col_scale,
        'b_gate': nrm(ks[4], (DEPTH, N_BRANCHES * D), 0.1),
        'pool_w': nrm(ks[5], (DEPTH, POOL_GROUPS, POOL_GROUP_DIM, POOL_GROUP_DIM), POOL_GROUP_DIM ** -0.5),
        'pool_scale': 1.0 + nrm(ks[6], (DEPTH, POOL_WIDTH), 0.01),
        'w_proj_pool': nrm(ks[7], (DEPTH, POOL_WIDTH, D), POOL_WIDTH ** -0.5),
        'w_proj_attn': nrm(ks[8], (DEPTH, ATTN_WIDTH, D), ATTN_WIDTH ** -0.5),
        'w_out': nrm(ks[9], (DEPTH, D, D), D ** -0.5 * DEEPNORM_BETA),
        'ln1_g': 1.0 + nrm(ks[10], (DEPTH, D), 0.01),
        'ln1_b': nrm(ks[11], (DEPTH, D), 0.01),
        'w_group': nrm(ks[12], (DEPTH, D, N_GROUPS), D ** -0.5),
        'b_group': nrm(ks[13], (DEPTH, N_GROUPS), 0.01),
        'w_router': nrm(ks[14], (DEPTH, D, N_EXPERTS), D ** -0.5),
        'b_router': nrm(ks[15], (DEPTH, N_EXPERTS), 0.01),
        'w_gate': nrm(ks[16], (DEPTH, N_EXPERTS, D, EXPERT_FF), D ** -0.5),
        'w_up': nrm(ks[17], (DEPTH, N_EXPERTS, D, EXPERT_FF), D ** -0.5),
        'w_down': nrm(ks[18], (DEPTH, N_EXPERTS, EXPERT_FF, D), EXPERT_FF ** -0.5 * DEEPNORM_BETA),
        'ln2_g': 1.0 + nrm(ks[19], (DEPTH, D), 0.01),
        'ln2_b': nrm(ks[20], (DEPTH, D), 0.01),
    }


def reference(x, ln_in_g, ln_in_b, w_in, b_gate, pool_w, pool_scale, w_proj_pool, w_proj_attn, w_out,
              ln1_g, ln1_b, w_group, b_group, w_router, b_router, w_gate, w_up, w_down, ln2_g, ln2_b):
    B, L, D = x.shape
    offsets = [int(o) for o in np.cumsum(SPLITS)[:-1]]
    h = layer_norm(x, ln_in_g, ln_in_b)
    for l in range(DEPTH):
        proj = h @ w_in[l]
        u_pool, q, k, v, iq, ik, iw, gate_pre = jnp.split(proj, offsets, axis=-1)
        pool_out = causal_multiscale_pool(u_pool, pool_w[l], pool_scale[l])
        attn_out = dsa_attention(q.reshape(B, L, N_HEADS, HEAD_DIM), k, v,
                                 iq.reshape(B, L, IDX_HEADS, IDX_DIM), ik, iw)
        gates = jax.nn.sigmoid(gate_pre.astype(jnp.float32) + b_gate[l].astype(jnp.float32)).reshape(B, L, N_BRANCHES, D)
        branch_pool = (pool_out @ w_proj_pool[l]).astype(jnp.float32)
        branch_attn = (attn_out @ w_proj_attn[l]).astype(jnp.float32)
        merged = gates[:, :, 0] * branch_pool + gates[:, :, 1] * branch_attn
        mix = merged.astype(h.dtype) @ w_out[l]
        h = layer_norm(DEEPNORM_ALPHA * h + mix, ln1_g[l], ln1_b[l])
        ffn = hierarchical_moe(h, w_group[l], b_group[l], w_router[l], b_router[l], w_gate[l], w_up[l], w_down[l])
        h = layer_norm(DEEPNORM_ALPHA * h + ffn, ln2_g[l], ln2_b[l])
    return h.astype(x.dtype)
```

```cpp
#include <hip/hip_runtime.h>
#include <hip/hip_fp16.h>
#include <stdint.h>
#include <stdio.h>

#define T_TOK 32768
#define DM 1024
#define SEQ 4096
#define PA_W 1448
#define IN_W 3496
#define C_Q 512
#define C_K 1024
#define C_V 1088
#define C_IQ 1152
#define C_IK 1408
#define C_IW 1440
#define ALPHA 1.189207115002721f
#define NEG_BIG (-1e30f)

#define OFF_H      ((size_t)0)
#define OFF_PROJA  ((size_t)134217728)
#define OFF_GATE   (OFF_PROJA + (size_t)T_TOK * PA_W * 4)
#define OFF_MISC   (OFF_GATE + (size_t)T_TOK * 2048 * 2)
#define OFF_ROUTE_E (OFF_MISC)
#define OFF_ROUTE_W (OFF_ROUTE_E + (size_t)T_TOK * 2 * 4)
#define OFF_COUNTS  (OFF_ROUTE_W + (size_t)T_TOK * 2 * 4)
#define OFF_LISTS   (OFF_COUNTS + 256)
#define WS_NEEDED   (OFF_LISTS + (size_t)32 * T_TOK * 4)

__device__ __forceinline__ float wave_sum(float v) {
#pragma unroll
  for (int o = 32; o > 0; o >>= 1) v += __shfl_xor(v, o, 64);
  return v;
}
__device__ __forceinline__ float wave_max(float v) {
#pragma unroll
  for (int o = 32; o > 0; o >>= 1) v = fmaxf(v, __shfl_xor(v, o, 64));
  return v;
}
__device__ __forceinline__ int wave_sum_i(int v) {
#pragma unroll
  for (int o = 32; o > 0; o >>= 1) v += __shfl_xor(v, o, 64);
  return v;
}

__global__ __launch_bounds__(256) void k_ln(const float* x, const float* __restrict__ ya,
                                            const float* __restrict__ g, const float* __restrict__ b,
                                            float* out, int mode, int* counts) {
  __shared__ float sred[8];
  const int tid = threadIdx.x, lane = tid & 63, wv = tid >> 6;
  if (counts && blockIdx.x == 0 && tid < 32) counts[tid] = 0;
  for (int t = blockIdx.x; t < T_TOK; t += gridDim.x) {
    float4 v = *(const float4*)(x + (size_t)t * DM + tid * 4);
    if (mode == 1) {
      float4 y0 = *(const float4*)(ya + (size_t)(2 * t) * DM + tid * 4);
      float4 y1 = *(const float4*)(ya + (size_t)(2 * t + 1) * DM + tid * 4);
      v.x = ALPHA * v.x + (y0.x + y1.x); v.y = ALPHA * v.y + (y0.y + y1.y);
      v.z = ALPHA * v.z + (y0.z + y1.z); v.w = ALPHA * v.w + (y0.w + y1.w);
    }
    float s = wave_sum(v.x + v.y + v.z + v.w);
    if (lane == 0) sred[wv] = s;
    __syncthreads();
    float mu = (sred[0] + sred[1] + sred[2] + sred[3]) * (1.0f / DM);
    float dx = v.x - mu, dy = v.y - mu, dz = v.z - mu, dw = v.w - mu;
    float q = wave_sum(dx * dx + dy * dy + dz * dz + dw * dw);
    if (lane == 0) sred[4 + wv] = q;
    __syncthreads();
    float var = (sred[4] + sred[5] + sred[6] + sred[7]) * (1.0f / DM);
    float rs = rsqrtf(var + 1e-5f);
    float4 gg = *(const float4*)(g + tid * 4), bb = *(const float4*)(b + tid * 4);
    float4 o;
    o.x = dx * rs * gg.x + bb.x; o.y = dy * rs * gg.y + bb.y;
    o.z = dz * rs * gg.z + bb.z; o.w = dw * rs * gg.w + bb.w;
    *(float4*)(out + (size_t)t * DM + tid * 4) = o;
    __syncthreads();
  }
}

#define SA_LD 68
__device__ __forceinline__ void gemm_tile_f32(const float* __restrict__ A, int lda, const float* __restrict__ B, int ldb,
                                              int K, int row0, int col0, int N, float acc[4][4], float* sA, float* sB) {
  const int tid = threadIdx.x, ty = tid >> 4, tx = tid & 15;
  for (int k0 = 0; k0 < K; k0 += 16) {
    {
      int r = tid >> 2, kk = (tid & 3) * 4;
      float4 v = *(const float4*)(A + (size_t)(row0 + r) * lda + k0 + kk);
      sA[(kk + 0) * SA_LD + r] = v.x; sA[(kk + 1) * SA_LD + r] = v.y;
      sA[(kk + 2) * SA_LD + r] = v.z; sA[(kk + 3) * SA_LD + r] = v.w;
    }
    {
      int kk = tid >> 4, c = (tid & 15) * 4;
      const float* bp = B + (size_t)(k0 + kk) * ldb + col0 + c;
      float4 v;
      if (col0 + c + 3 < N) v = *(const float4*)bp;
      else {
        v.x = (col0 + c + 0 < N) ? bp[0] : 0.f; v.y = (col0 + c + 1 < N) ? bp[1] : 0.f;
        v.z = (col0 + c + 2 < N) ? bp[2] : 0.f; v.w = (col0 + c + 3 < N) ? bp[3] : 0.f;
      }
      *(float4*)&sB[kk * 64 + c] = v;
    }
    __syncthreads();
#pragma unroll
    for (int kk = 0; kk < 16; ++kk) {
      float4 a = *(const float4*)&sA[kk * SA_LD + ty * 4];
      float4 b = *(const float4*)&sB[kk * 64 + tx * 4];
      float av[4] = {a.x, a.y, a.z, a.w}, bv[4] = {b.x, b.y, b.z, b.w};
#pragma unroll
      for (int i = 0; i < 4; ++i)
#pragma unroll
        for (int j = 0; j < 4; ++j) acc[i][j] += av[i] * bv[j];
    }
    __syncthreads();
  }
}

__global__ __launch_bounds__(256) void k_inproj(const float* __restrict__ h, const float* __restrict__ w_in,
                                                const float* __restrict__ b_gate, float* __restrict__ projA,
                                                __half* __restrict__ gate) {
  __shared__ float sA[16 * SA_LD];
  __shared__ float sB[16 * 64];
  const int tid = threadIdx.x, ty = tid >> 4, tx = tid & 15;
  const int NT = 55;
  for (int tile = blockIdx.x; tile < 512 * NT; tile += gridDim.x) {
    int rt = tile / NT, ct = tile % NT;
    float acc[4][4] = {};
    gemm_tile_f32(h, DM, w_in, IN_W, DM, rt * 64, ct * 64, IN_W, acc, sA, sB);
#pragma unroll
    for (int i = 0; i < 4; ++i)
#pragma unroll
      for (int j = 0; j < 4; ++j) {
        int r = rt * 64 + ty * 4 + i, c = ct * 64 + tx * 4 + j;
        if (c < PA_W) projA[(size_t)r * PA_W + c] = acc[i][j];
        else if (c < IN_W) {
          float z = acc[i][j] + b_gate[c - PA_W];
          gate[(size_t)r * 2048 + (c - PA_W)] = __float2half(1.0f / (1.0f + __expf(-z)));
        }
      }
  }
}

__global__ __launch_bounds__(256) void k_pool(const float* __restrict__ projA, const float* __restrict__ pool_w,
                                              const float* __restrict__ pool_scale, float* __restrict__ pa) {
  __shared__ float sd[8][512];
  const int tid = threadIdx.x;
  for (int tile = blockIdx.x; tile < T_TOK / 8; tile += gridDim.x) {
    int t0 = tile * 8;
    for (int c = tid; c < 512; c += 256) {
      int g = c >> 7, w = 2 << g;
      for (int i = 0; i < 8; ++i) {
        int t = t0 + i, l = t & (SEQ - 1);
        int start = max(l + 1 - w, 0), cnt = l + 1 - start;
        float s = 0.f;
        for (int j = start; j <= l; ++j) s += projA[(size_t)(t - l + j) * PA_W + c];
        sd[i][c] = s / (float)cnt - projA[(size_t)t * PA_W + c];
      }
    }
    __syncthreads();
    for (int c = tid; c < 512; c += 256) {
      int g = c >> 7, e = c & 127;
      float acc[8] = {};
      for (int d = 0; d < 128; ++d) {
        float w = pool_w[(g * 128 + d) * 128 + e];
#pragma unroll
        for (int i = 0; i < 8; ++i) acc[i] += sd[i][g * 128 + d] * w;
      }
      float sc = pool_scale[c];
#pragma unroll
      for (int i = 0; i < 8; ++i) pa[(size_t)(t0 + i) * DM + c] = acc[i] * sc;
    }
    __syncthreads();
  }
}

__device__ __forceinline__ unsigned f2key(float f) {
  if (f == 0.f) f = 0.f;
  unsigned u = __float_as_uint(f);
  return (u & 0x80000000u) ? ~u : (u | 0x80000000u);
}

__device__ __forceinline__ int block_scan_excl(int v, int* tot, int* sw) {
  const int tid = threadIdx.x, lane = tid & 63, wv = tid >> 6;
  int inc = v;
#pragma unroll
  for (int o = 1; o < 64; o <<= 1) {
    int n = __shfl_up(inc, o, 64);
    if (lane >= o) inc += n;
  }
  __syncthreads();
  if (lane == 63) sw[wv] = inc;
  __syncthreads();
  int base = 0, total = 0;
#pragma unroll
  for (int i = 0; i < 4; ++i) { int s = sw[i]; if (i < wv) base += s; total += s; }
  *tot = total;
  return base + inc - v;
}

__global__ __launch_bounds__(256) void k_attn(const float* __restrict__ projA, float* __restrict__ pa) {
  __shared__ unsigned skey[SEQ];
  __shared__ float siq[256];
  __shared__ float siw[8];
  __shared__ float sq[512];
  __shared__ int ssel[256];
  __shared__ float sp[8][256];
  __shared__ int sw[4];
  const int tid = threadIdx.x, lane = tid & 63, wv = tid >> 6;
  for (int t = blockIdx.x; t < T_TOK; t += gridDim.x) {
    const int l = t & (SEQ - 1), b0 = t - l, n = l + 1;
    const float* row = projA + (size_t)t * PA_W;
    siq[tid] = row[C_IQ + tid];
    if (tid < 8) siw[tid] = row[C_IW + tid];
    sq[tid] = row[C_Q + tid];
    sq[tid + 256] = row[C_Q + tid + 256];
    __syncthreads();
    for (int s = tid; s < n; s += 256) {
      const float4* ikp = (const float4*)(projA + (size_t)(b0 + s) * PA_W + C_IK);
      float4 kk[8];
#pragma unroll
      for (int j = 0; j < 8; ++j) kk[j] = ikp[j];
      float sc = 0.f;
#pragma unroll 1
      for (int hh = 0; hh < 8; ++hh) {
        float d = 0.f;
#pragma unroll
        for (int j = 0; j < 8; ++j) {
          d += siq[hh * 32 + j * 4 + 0] * kk[j].x; d += siq[hh * 32 + j * 4 + 1] * kk[j].y;
          d += siq[hh * 32 + j * 4 + 2] * kk[j].z; d += siq[hh * 32 + j * 4 + 3] * kk[j].w;
        }
        sc += siw[hh] * fmaxf(d, 0.f);
      }
      skey[s] = f2key(sc);
    }
    __syncthreads();
    int cnt;
    if (n <= 256) {
      if (tid < n) ssel[tid] = tid;
      cnt = n;
    } else {
      unsigned thr = 0;
      for (int bit = 31; bit >= 0; --bit) {
        unsigned cand = thr | (1u << bit);
        int c = 0;
        for (int s = tid; s < n; s += 256) c += (skey[s] >= cand) ? 1 : 0;
        c = wave_sum_i(c);
        __syncthreads();
        if (lane == 0) sw[wv] = c;
        __syncthreads();
        c = sw[0] + sw[1] + sw[2] + sw[3];
        if (c >= 256) thr = cand;
      }
      int cgt = 0, ceq = 0;
      for (int j = 0; j < 16; ++j) {
        int s = tid * 16 + j;
        if (s < n) { unsigned k = skey[s]; cgt += (k > thr); ceq += (k == thr); }
      }
      int tot_gt, tot_eq;
      int pre_eq = block_scan_excl(ceq, &tot_eq, sw);
      (void)block_scan_excl(cgt, &tot_gt, sw);
      int r = 256 - tot_gt;
      int csel = 0, eqr = pre_eq;
      for (int j = 0; j < 16; ++j) {
        int s = tid * 16 + j;
        if (s < n) {
          unsigned k = skey[s];
          if (k > thr) csel++;
          else if (k == thr) { if (eqr < r) csel++; eqr++; }
        }
      }
      int tot_sel;
      int pos = block_scan_excl(csel, &tot_sel, sw);
      eqr = pre_eq;
      for (int j = 0; j < 16; ++j) {
        int s = tid * 16 + j;
        if (s < n) {
          unsigned k = skey[s];
          bool take = false;
          if (k > thr) take = true;
          else if (k == thr) { take = (eqr < r); eqr++; }
          if (take) { if (pos < 256) ssel[pos] = s; pos++; }
        }
      }
      cnt = 256;
    }
    __syncthreads();
    {
      if (tid < cnt) {
        const float4* kp = (const float4*)(projA + (size_t)(b0 + ssel[tid]) * PA_W + C_K);
        float4 kr[16];
#pragma unroll
        for (int j = 0; j < 16; ++j) kr[j] = kp[j];
#pragma unroll 1
        for (int hh = 0; hh < 8; ++hh) {
          float d = 0.f;
#pragma unroll
          for (int j = 0; j < 16; ++j) {
            d += sq[hh * 64 + j * 4 + 0] * kr[j].x; d += sq[hh * 64 + j * 4 + 1] * kr[j].y;
            d += sq[hh * 64 + j * 4 + 2] * kr[j].z; d += sq[hh * 64 + j * 4 + 3] * kr[j].w;
          }
          sp[hh][tid] = d * 0.125f;
        }
      } else {
#pragma unroll
        for (int hh = 0; hh < 8; ++hh) sp[hh][tid] = NEG_BIG;
      }
    }
    __syncthreads();
    for (int hh = 2 * wv; hh < 2 * wv + 2; ++hh) {
      float v0 = sp[hh][lane], v1 = sp[hh][lane + 64], v2 = sp[hh][lane + 128], v3 = sp[hh][lane + 192];
      float m = wave_max(fmaxf(fmaxf(v0, v1), fmaxf(v2, v3)));
      float e0 = __expf(v0 - m), e1 = __expf(v1 - m), e2 = __expf(v2 - m), e3 = __expf(v3 - m);
      if (lane >= cnt) e0 = 0.f;
      if (lane + 64 >= cnt) e1 = 0.f;
      if (lane + 128 >= cnt) e2 = 0.f;
      if (lane + 192 >= cnt) e3 = 0.f;
      float ssum = wave_sum(e0 + e1 + e2 + e3);
      float inv = 1.0f / ssum;
      sp[hh][lane] = e0 * inv; sp[hh][lane + 64] = e1 * inv; sp[hh][lane + 128] = e2 * inv; sp[hh][lane + 192] = e3 * inv;
    }
    __syncthreads();
    {
      int hh = tid >> 5, d = (tid & 31) * 2;
      float o0 = 0.f, o1 = 0.f;
      for (int j = 0; j < cnt; ++j) {
        float p = sp[hh][j];
        const float2 vv = *(const float2*)(projA + (size_t)(b0 + ssel[j]) * PA_W + C_V + d);
        o0 += p * vv.x; o1 += p * vv.y;
      }
      float* op = pa + (size_t)t * DM + 512 + hh * 64 + d;
      op[0] = o0; op[1] = o1;
    }
    __syncthreads();
  }
}

__global__ __launch_bounds__(256) void k_merge(const float* __restrict__ pa, const float* __restrict__ wpp,
                                               const float* __restrict__ wpa, const __half* __restrict__ gate,
                                               float* __restrict__ merged) {
  __shared__ float sA[16 * SA_LD];
  __shared__ float sB[16 * 64];
  const int tid = threadIdx.x, ty = tid >> 4, tx = tid & 15;
  for (int tile = blockIdx.x; tile < 512 * 16; tile += gridDim.x) {
    int rt = tile >> 4, ct = tile & 15;
    float a0[4][4] = {}, a1[4][4] = {};
    gemm_tile_f32(pa, DM, wpp, DM, 512, rt * 64, ct * 64, DM, a0, sA, sB);
    gemm_tile_f32(pa + 512, DM, wpa, DM, 512, rt * 64, ct * 64, DM, a1, sA, sB);
#pragma unroll
    for (int i = 0; i < 4; ++i)
#pragma unroll
      for (int j = 0; j < 4; ++j) {
        int r = rt * 64 + ty * 4 + i, c = ct * 64 + tx * 4 + j;
        float g0 = __half2float(gate[(size_t)r * 2048 + c]);
        float g1 = __half2float(gate[(size_t)r * 2048 + 1024 + c]);
        merged[(size_t)r * DM + c] = g0 * a0[i][j] + g1 * a1[i][j];
      }
  }
}

__global__ __launch_bounds__(256) void k_resid(const float* __restrict__ merged, const float* __restrict__ w_out,
                                               float* __restrict__ h) {
  __shared__ float sA[16 * SA_LD];
  __shared__ float sB[16 * 64];
  const int tid = threadIdx.x, ty = tid >> 4, tx = tid & 15;
  for (int tile = blockIdx.x; tile < 512 * 16; tile += gridDim.x) {
    int rt = tile >> 4, ct = tile & 15;
    float acc[4][4] = {};
    gemm_tile_f32(merged, DM, w_out, DM, DM, rt * 64, ct * 64, DM, acc, sA, sB);
#pragma unroll
    for (int i = 0; i < 4; ++i)
#pragma unroll
      for (int j = 0; j < 4; ++j) {
        int r = rt * 64 + ty * 4 + i, c = ct * 64 + tx * 4 + j;
        size_t o = (size_t)r * DM + c;
        h[o] = ALPHA * h[o] + acc[i][j];
      }
  }
}

__global__ __launch_bounds__(256) void k_route(const float* __restrict__ h1, const float* __restrict__ w_group,
                                               const float* __restrict__ b_group, const float* __restrict__ w_router,
                                               const float* __restrict__ b_router, int* __restrict__ route_e,
                                               float* __restrict__ route_w, int* __restrict__ counts,
                                               int* __restrict__ lists) {
  __shared__ float slog[4][36];
  const int tid = threadIdx.x, lane = tid & 63, wv = tid >> 6;
  for (int t = blockIdx.x * 4 + wv; t < T_TOK; t += gridDim.x * 4) {
    float acc[36];
#pragma unroll
    for (int o = 0; o < 36; ++o) acc[o] = 0.f;
    for (int k = lane; k < DM; k += 64) {
      float hv = h1[(size_t)t * DM + k];
      float4 wg = *(const float4*)(w_group + k * 4);
      acc[0] += hv * wg.x; acc[1] += hv * wg.y; acc[2] += hv * wg.z; acc[3] += hv * wg.w;
#pragma unroll
      for (int o = 0; o < 8; ++o) {
        float4 wr = *(const float4*)(w_router + k * 32 + o * 4);
        acc[4 + o * 4 + 0] += hv * wr.x; acc[4 + o * 4 + 1] += hv * wr.y;
        acc[4 + o * 4 + 2] += hv * wr.z; acc[4 + o * 4 + 3] += hv * wr.w;
      }
    }
#pragma unroll
    for (int o = 0; o < 36; ++o) {
      float v = wave_sum(acc[o]);
      if (lane == 0) slog[wv][o] = v;
    }
    if (lane == 0) {
      float gl[4];
      int g = 0;
#pragma unroll
      for (int o = 0; o < 4; ++o) gl[o] = slog[wv][o] + b_group[o];
      float m = gl[0];
#pragma unroll
      for (int o = 1; o < 4; ++o) if (gl[o] > m) { m = gl[o]; g = o; }
      float se = 0.f;
#pragma unroll
      for (int o = 0; o < 4; ++o) se += __expf(gl[o] - m);
      float pg = 1.0f / se;
      float v1 = -3e38f, v2 = -3e38f;
      int i1 = 0, i2 = 0;
      for (int j = 0; j < 8; ++j) {
        float v = slog[wv][4 + g * 8 + j] + b_router[g * 8 + j];
        if (v > v1) { v2 = v1; i2 = i1; v1 = v; i1 = j; }
        else if (v > v2) { v2 = v; i2 = j; }
      }
      float e2 = __expf(v2 - v1);
      float w1 = pg / (1.0f + e2), w2 = pg * e2 / (1.0f + e2);
      int ea = g * 8 + i1, eb = g * 8 + i2;
      route_e[2 * t] = ea; route_e[2 * t + 1] = eb;
      route_w[2 * t] = w1; route_w[2 * t + 1] = w2;
      int pa_ = atomicAdd(&counts[ea], 1);
      lists[(size_t)ea * T_TOK + pa_] = 2 * t;
      int pb_ = atomicAdd(&counts[eb], 1);
      lists[(size_t)eb * T_TOK + pb_] = 2 * t + 1;
    }
  }
}

__global__ __launch_bounds__(256) void k_moe(const float* __restrict__ h1, const float* __restrict__ w_gate,
                                             const float* __restrict__ w_up, const float* __restrict__ w_down,
                                             const float* __restrict__ route_w, const int* __restrict__ counts,
                                             const int* __restrict__ lists, float* __restrict__ y) {
  __shared__ float sh[16][DM];
  __shared__ float shid[16][256];
  __shared__ int sent[16];
  const int tid = threadIdx.x;
  int pre[33];
  pre[0] = 0;
#pragma unroll
  for (int e = 0; e < 32; ++e) pre[e + 1] = pre[e] + ((counts[e] + 15) >> 4);
  const int total = pre[32];
  for (int item = blockIdx.x; item < total; item += gridDim.x) {
    int e = 0;
#pragma unroll
    for (int i = 1; i < 32; ++i) if (item >= pre[i]) e = i;
    int base = 0;
#pragma unroll
    for (int i = 0; i < 32; ++i) if (i == e) base = pre[i];
    int ti = item - base;
    int cnt_e = counts[e];
    if (tid < 16) {
      int idx = ti * 16 + tid;
      sent[tid] = (idx < cnt_e) ? lists[(size_t)e * T_TOK + idx] : -1;
    }
    __syncthreads();
    for (int i = 0; i < 16; ++i) {
      int en = sent[i];
      float4 v = make_float4(0.f, 0.f, 0.f, 0.f);
      if (en >= 0) v = *(const float4*)(h1 + (size_t)(en >> 1) * DM + tid * 4);
      *(float4*)&sh[i][tid * 4] = v;
    }
    __syncthreads();
    {
      float ag[16], au[16];
#pragma unroll
      for (int i = 0; i < 16; ++i) { ag[i] = 0.f; au[i] = 0.f; }
      const float* wg = w_gate + (size_t)e * DM * 256 + tid;
      const float* wu = w_up + (size_t)e * DM * 256 + tid;
      for (int k = 0; k < DM; ++k) {
        float g = wg[(size_t)k * 256], u = wu[(size_t)k * 256];
#pragma unroll
        for (int i = 0; i < 16; ++i) { float a = sh[i][k]; ag[i] += a * g; au[i] += a * u; }
      }
#pragma unroll
      for (int i = 0; i < 16; ++i) {
        float g = ag[i];
        shid[i][tid] = (g / (1.0f + __expf(-g))) * au[i];
      }
    }
    __syncthreads();
    {
      float acc[16][4];
#pragma unroll
      for (int i = 0; i < 16; ++i)
#pragma unroll
        for (int c = 0; c < 4; ++c) acc[i][c] = 0.f;
      const float* wd = w_down + (size_t)e * 256 * DM + tid;
      for (int f = 0; f < 256; ++f) {
        float w0 = wd[(size_t)f * DM], w1 = wd[(size_t)f * DM + 256], w2 = wd[(size_t)f * DM + 512], w3 = wd[(size_t)f * DM + 768];
#pragma unroll
        for (int i = 0; i < 16; ++i) {
          float hv = shid[i][f];
          acc[i][0] += hv * w0; acc[i][1] += hv * w1; acc[i][2] += hv * w2; acc[i][3] += hv * w3;
        }
      }
#pragma unroll
      for (int i = 0; i < 16; ++i) {
        int en = sent[i];
        if (en >= 0) {
          float rw = route_w[en];
          float* yp = y + (size_t)en * DM + tid;
          yp[0] = rw * acc[i][0]; yp[256] = rw * acc[i][1]; yp[512] = rw * acc[i][2]; yp[768] = rw * acc[i][3];
        }
      }
    }
    __syncthreads();
  }
}

extern "C" void kernel_launch(void* const* d_in, const int* in_sizes, int n_in, void* d_out, int out_size, void* d_ws,
                              size_t ws_size, hipStream_t stream) {
  if (ws_size < WS_NEEDED) { fprintf(stderr, "ws too small: %zu < %zu\n", ws_size, (size_t)WS_NEEDED); return; }
  const float* x = (const float*)d_in[0];
  const float* ln_in_g = (const float*)d_in[1];
  const float* ln_in_b = (const float*)d_in[2];
  const float* w_in = (const float*)d_in[3];
  const float* b_gate = (const float*)d_in[4];
  const float* pool_w = (const float*)d_in[5];
  const float* pool_scale = (const float*)d_in[6];
  const float* wpp = (const float*)d_in[7];
  const float* wpa = (const float*)d_in[8];
  const float* w_out = (const float*)d_in[9];
  const float* ln1_g = (const float*)d_in[10];
  const float* ln1_b = (const float*)d_in[11];
  const float* w_group = (const float*)d_in[12];
  const float* b_group = (const float*)d_in[13];
  const float* w_router = (const float*)d_in[14];
  const float* b_router = (const float*)d_in[15];
  const float* w_gate = (const float*)d_in[16];
  const float* w_up = (const float*)d_in[17];
  const float* w_down = (const float*)d_in[18];
  const float* ln2_g = (const float*)d_in[19];
  const float* ln2_b = (const float*)d_in[20];
  char* ws = (char*)d_ws;
  float* h = (float*)(ws + OFF_H);
  float* projA = (float*)(ws + OFF_PROJA);
  __half* gate = (__half*)(ws + OFF_GATE);
  int* route_e = (int*)(ws + OFF_ROUTE_E);
  float* route_w = (float*)(ws + OFF_ROUTE_W);
  int* counts = (int*)(ws + OFF_COUNTS);
  int* lists = (int*)(ws + OFF_LISTS);
  float* out = (float*)d_out;
  float* pa = out;
  float* merged = projA;
  float* y = projA;

  k_ln<<<2048, 256, 0, stream>>>(x, nullptr, ln_in_g, ln_in_b, h, 0, counts);
  k_inproj<<<2048, 256, 0, stream>>>(h, w_in, b_gate, projA, gate);
  k_pool<<<2048, 256, 0, stream>>>(projA, pool_w, pool_scale, pa);
  k_attn<<<4096, 256, 0, stream>>>(projA, pa);
  k_merge<<<2048, 256, 0, stream>>>(pa, wpp, wpa, gate, merged);
  k_resid<<<2048, 256, 0, stream>>>(merged, w_out, h);
  k_ln<<<2048, 256, 0, stream>>>(h, nullptr, ln1_g, ln1_b, h, 0, nullptr);
  k_route<<<1024, 256, 0, stream>>>(h, w_group, b_group, w_router, b_router, route_e, route_w, counts, lists);
  k_moe<<<1024, 256, 0, stream>>>(h, w_gate, w_up, w_down, route_w, counts, lists, y);
  k_ln<<<2048, 256, 0, stream>>>(h, y, ln2_g, ln2_b, out, 1, nullptr);
}
```

```cpp
#include <hip/hip_runtime.h>
#include <hip/hip_fp16.h>
#include <hip/hip_cooperative_groups.h>
namespace cg = cooperative_groups;
#include <stdint.h>
#include <stdio.h>

#define T_TOK 32768
#define DM 1024
#define SEQ 4096
#define PA_W 1448
#define IN_W 3496
#define C_Q 512
#define C_K 1024
#define C_V 1088
#define C_IQ 1152
#define C_IK 1408
#define C_IW 1440
#define ALPHA 1.189207115002721f
#define NEG_BIG (-1e30f)

#define OFF_H      ((size_t)0)
#define OFF_PROJA  ((size_t)134217728)
#define OFF_GATE   (OFF_PROJA + (size_t)T_TOK * PA_W * 4)
#define OFF_MISC   (OFF_GATE + (size_t)T_TOK * 2048 * 2)
#define OFF_ROUTE_E (OFF_MISC)
#define OFF_ROUTE_W (OFF_ROUTE_E + (size_t)T_TOK * 2 * 4)
#define OFF_COUNTS  (OFF_ROUTE_W + (size_t)T_TOK * 2 * 4)
#define OFF_LISTS   (OFF_COUNTS + 256)
#define WS_NEEDED   (OFF_LISTS + (size_t)32 * T_TOK * 4)

__device__ __forceinline__ float wave_sum(float v) {
#pragma unroll
  for (int o = 32; o > 0; o >>= 1) v += __shfl_xor(v, o, 64);
  return v;
}
__device__ __forceinline__ float wave_max(float v) {
#pragma unroll
  for (int o = 32; o > 0; o >>= 1) v = fmaxf(v, __shfl_xor(v, o, 64));
  return v;
}
__device__ __forceinline__ int wave_sum_i(int v) {
#pragma unroll
  for (int o = 32; o > 0; o >>= 1) v += __shfl_xor(v, o, 64);
  return v;
}

__device__ __forceinline__ void d_ln(const float* x, const float* __restrict__ ya,
                                            const float* __restrict__ g, const float* __restrict__ b,
                                            float* out, int mode, int* counts) {
  __shared__ float sred[8];
  const int tid = threadIdx.x, lane = tid & 63, wv = tid >> 6;
  if (counts && blockIdx.x == 0 && tid < 32) counts[tid] = 0;
  for (int t = blockIdx.x; t < T_TOK; t += gridDim.x) {
    float4 v = *(const float4*)(x + (size_t)t * DM + tid * 4);
    if (mode == 1) {
      float4 y0 = *(const float4*)(ya + (size_t)(2 * t) * DM + tid * 4);
      float4 y1 = *(const float4*)(ya + (size_t)(2 * t + 1) * DM + tid * 4);
      v.x = ALPHA * v.x + (y0.x + y1.x); v.y = ALPHA * v.y + (y0.y + y1.y);
      v.z = ALPHA * v.z + (y0.z + y1.z); v.w = ALPHA * v.w + (y0.w + y1.w);
    }
    float s = wave_sum(v.x + v.y + v.z + v.w);
    if (lane == 0) sred[wv] = s;
    __syncthreads();
    float mu = (sred[0] + sred[1] + sred[2] + sred[3]) * (1.0f / DM);
    float dx = v.x - mu, dy = v.y - mu, dz = v.z - mu, dw = v.w - mu;
    float q = wave_sum(dx * dx + dy * dy + dz * dz + dw * dw);
    if (lane == 0) sred[4 + wv] = q;
    __syncthreads();
    float var = (sred[4] + sred[5] + sred[6] + sred[7]) * (1.0f / DM);
    float rs = rsqrtf(var + 1e-5f);
    float4 gg = *(const float4*)(g + tid * 4), bb = *(const float4*)(b + tid * 4);
    float4 o;
    o.x = dx * rs * gg.x + bb.x; o.y = dy * rs * gg.y + bb.y;
    o.z = dz * rs * gg.z + bb.z; o.w = dw * rs * gg.w + bb.w;
    *(float4*)(out + (size_t)t * DM + tid * 4) = o;
    __syncthreads();
  }
}

#define SA_LD 68
__device__ __forceinline__ void gemm_tile_f32(const float* __restrict__ A, int lda, const float* __restrict__ B, int ldb,
                                              int K, int row0, int col0, int N, float acc[4][4], float* sA, float* sB) {
  const int tid = threadIdx.x, ty = tid >> 4, tx = tid & 15;
  for (int k0 = 0; k0 < K; k0 += 16) {
    {
      int r = tid >> 2, kk = (tid & 3) * 4;
      float4 v = *(const float4*)(A + (size_t)(row0 + r) * lda + k0 + kk);
      sA[(kk + 0) * SA_LD + r] = v.x; sA[(kk + 1) * SA_LD + r] = v.y;
      sA[(kk + 2) * SA_LD + r] = v.z; sA[(kk + 3) * SA_LD + r] = v.w;
    }
    {
      int kk = tid >> 4, c = (tid & 15) * 4;
      const float* bp = B + (size_t)(k0 + kk) * ldb + col0 + c;
      float4 v;
      if (col0 + c + 3 < N) v = *(const float4*)bp;
      else {
        v.x = (col0 + c + 0 < N) ? bp[0] : 0.f; v.y = (col0 + c + 1 < N) ? bp[1] : 0.f;
        v.z = (col0 + c + 2 < N) ? bp[2] : 0.f; v.w = (col0 + c + 3 < N) ? bp[3] : 0.f;
      }
      *(float4*)&sB[kk * 64 + c] = v;
    }
    __syncthreads();
#pragma unroll
    for (int kk = 0; kk < 16; ++kk) {
      float4 a = *(const float4*)&sA[kk * SA_LD + ty * 4];
      float4 b = *(const float4*)&sB[kk * 64 + tx * 4];
      float av[4] = {a.x, a.y, a.z, a.w}, bv[4] = {b.x, b.y, b.z, b.w};
#pragma unroll
      for (int i = 0; i < 4; ++i)
#pragma unroll
        for (int j = 0; j < 4; ++j) acc[i][j] += av[i] * bv[j];
    }
    __syncthreads();
  }
}

__device__ __forceinline__ void d_inproj(const float* __restrict__ h, const float* __restrict__ w_in,
                                                const float* __restrict__ b_gate, float* __restrict__ projA,
                                                __half* __restrict__ gate) {
  __shared__ float sA[16 * SA_LD];
  __shared__ float sB[16 * 64];
  const int tid = threadIdx.x, ty = tid >> 4, tx = tid & 15;
  const int NT = 55;
  for (int tile = blockIdx.x; tile < 512 * NT; tile += gridDim.x) {
    int rt = tile / NT, ct = tile % NT;
    float acc[4][4] = {};
    gemm_tile_f32(h, DM, w_in, IN_W, DM, rt * 64, ct * 64, IN_W, acc, sA, sB);
#pragma unroll
    for (int i = 0; i < 4; ++i)
#pragma unroll
      for (int j = 0; j < 4; ++j) {
        int r = rt * 64 + ty * 4 + i, c = ct * 64 + tx * 4 + j;
        if (c < PA_W) projA[(size_t)r * PA_W + c] = acc[i][j];
        else if (c < IN_W) {
          float z = acc[i][j] + b_gate[c - PA_W];
          gate[(size_t)r * 2048 + (c - PA_W)] = __float2half(1.0f / (1.0f + __expf(-z)));
        }
      }
  }
}

__device__ __forceinline__ void d_pool(const float* __restrict__ projA, const float* __restrict__ pool_w,
                                              const float* __restrict__ pool_scale, float* __restrict__ pa) {
  __shared__ float sd[8][512];
  const int tid = threadIdx.x;
  for (int tile = blockIdx.x; tile < T_TOK / 8; tile += gridDim.x) {
    int t0 = tile * 8;
    for (int c = tid; c < 512; c += 256) {
      int g = c >> 7, w = 2 << g;
      for (int i = 0; i < 8; ++i) {
        int t = t0 + i, l = t & (SEQ - 1);
        int start = max(l + 1 - w, 0), cnt = l + 1 - start;
        float s = 0.f;
        for (int j = start; j <= l; ++j) s += projA[(size_t)(t - l + j) * PA_W + c];
        sd[i][c] = s / (float)cnt - projA[(size_t)t * PA_W + c];
      }
    }
    __syncthreads();
    for (int c = tid; c < 512; c += 256) {
      int g = c >> 7, e = c & 127;
      float acc[8] = {};
      for (int d = 0; d < 128; ++d) {
        float w = pool_w[(g * 128 + d) * 128 + e];
#pragma unroll
        for (int i = 0; i < 8; ++i) acc[i] += sd[i][g * 128 + d] * w;
      }
      float sc = pool_scale[c];
#pragma unroll
      for (int i = 0; i < 8; ++i) pa[(size_t)(t0 + i) * DM + c] = acc[i] * sc;
    }
    __syncthreads();
  }
}

__device__ __forceinline__ unsigned f2key(float f) {
  if (f == 0.f) f = 0.f;
  unsigned u = __float_as_uint(f);
  return (u & 0x80000000u) ? ~u : (u | 0x80000000u);
}

__device__ __forceinline__ int block_scan_excl(int v, int* tot, int* sw) {
  const int tid = threadIdx.x, lane = tid & 63, wv = tid >> 6;
  int inc = v;
#pragma unroll
  for (int o = 1; o < 64; o <<= 1) {
    int n = __shfl_up(inc, o, 64);
    if (lane >= o) inc += n;
  }
  __syncthreads();
  if (lane == 63) sw[wv] = inc;
  __syncthreads();
  int base = 0, total = 0;
#pragma unroll
  for (int i = 0; i < 4; ++i) { int s = sw[i]; if (i < wv) base += s; total += s; }
  *tot = total;
  return base + inc - v;
}

__device__ __forceinline__ void d_attn(const float* __restrict__ projA, float* __restrict__ pa) {
  __shared__ unsigned skey[SEQ];
  __shared__ float siq[256];
  __shared__ float siw[8];
  __shared__ float sq[512];
  __shared__ int ssel[256];
  __shared__ float sp[8][256];
  __shared__ int sw[4];
  const int tid = threadIdx.x, lane = tid & 63, wv = tid >> 6;
  for (int t = blockIdx.x; t < T_TOK; t += gridDim.x) {
    const int l = t & (SEQ - 1), b0 = t - l, n = l + 1;
    const float* row = projA + (size_t)t * PA_W;
    siq[tid] = row[C_IQ + tid];
    if (tid < 8) siw[tid] = row[C_IW + tid];
    sq[tid] = row[C_Q + tid];
    sq[tid + 256] = row[C_Q + tid + 256];
    __syncthreads();
    for (int s = tid; s < n; s += 256) {
      const float4* ikp = (const float4*)(projA + (size_t)(b0 + s) * PA_W + C_IK);
      float4 kk[8];
#pragma unroll
      for (int j = 0; j < 8; ++j) kk[j] = ikp[j];
      float sc = 0.f;
#pragma unroll 1
      for (int hh = 0; hh < 8; ++hh) {
        float d = 0.f;
#pragma unroll
        for (int j = 0; j < 8; ++j) {
          d += siq[hh * 32 + j * 4 + 0] * kk[j].x; d += siq[hh * 32 + j * 4 + 1] * kk[j].y;
          d += siq[hh * 32 + j * 4 + 2] * kk[j].z; d += siq[hh * 32 + j * 4 + 3] * kk[j].w;
        }
        sc += siw[hh] * fmaxf(d, 0.f);
      }
      skey[s] = f2key(sc);
    }
    __syncthreads();
    int cnt;
    if (n <= 256) {
      if (tid < n) ssel[tid] = tid;
      cnt = n;
    } else {
      unsigned thr = 0;
      for (int bit = 31; bit >= 0; --bit) {
        unsigned cand = thr | (1u << bit);
        int c = 0;
        for (int s = tid; s < n; s += 256) c += (skey[s] >= cand) ? 1 : 0;
        c = wave_sum_i(c);
        __syncthreads();
        if (lane == 0) sw[wv] = c;
        __syncthreads();
        c = sw[0] + sw[1] + sw[2] + sw[3];
        if (c >= 256) thr = cand;
      }
      int cgt = 0, ceq = 0;
      for (int j = 0; j < 16; ++j) {
        int s = tid * 16 + j;
        if (s < n) { unsigned k = skey[s]; cgt += (k > thr); ceq += (k == thr); }
      }
      int tot_gt, tot_eq;
      int pre_eq = block_scan_excl(ceq, &tot_eq, sw);
      (void)block_scan_excl(cgt, &tot_gt, sw);
      int r = 256 - tot_gt;
      int csel = 0, eqr = pre_eq;
      for (int j = 0; j < 16; ++j) {
        int s = tid * 16 + j;
        if (s < n) {
          unsigned k = skey[s];
          if (k > thr) csel++;
          else if (k == thr) { if (eqr < r) csel++; eqr++; }
        }
      }
      int tot_sel;
      int pos = block_scan_excl(csel, &tot_sel, sw);
      eqr = pre_eq;
      for (int j = 0; j < 16; ++j) {
        int s = tid * 16 + j;
        if (s < n) {
          unsigned k = skey[s];
          bool take = false;
          if (k > thr) take = true;
          else if (k == thr) { take = (eqr < r); eqr++; }
          if (take) { if (pos < 256) ssel[pos] = s; pos++; }
        }
      }
      cnt = 256;
    }
    __syncthreads();
    {
      if (tid < cnt) {
        const float4* kp = (const float4*)(projA + (size_t)(b0 + ssel[tid]) * PA_W + C_K);
        float4 kr[16];
#pragma unroll
        for (int j = 0; j < 16; ++j) kr[j] = kp[j];
#pragma unroll 1
        for (int hh = 0; hh < 8; ++hh) {
          float d = 0.f;
#pragma unroll
          for (int j = 0; j < 16; ++j) {
            d += sq[hh * 64 + j * 4 + 0] * kr[j].x; d += sq[hh * 64 + j * 4 + 1] * kr[j].y;
            d += sq[hh * 64 + j * 4 + 2] * kr[j].z; d += sq[hh * 64 + j * 4 + 3] * kr[j].w;
          }
          sp[hh][tid] = d * 0.125f;
        }
      } else {
#pragma unroll
        for (int hh = 0; hh < 8; ++hh) sp[hh][tid] = NEG_BIG;
      }
    }
    __syncthreads();
    for (int hh = 2 * wv; hh < 2 * wv + 2; ++hh) {
      float v0 = sp[hh][lane], v1 = sp[hh][lane + 64], v2 = sp[hh][lane + 128], v3 = sp[hh][lane + 192];
      float m = wave_max(fmaxf(fmaxf(v0, v1), fmaxf(v2, v3)));
      float e0 = __expf(v0 - m), e1 = __expf(v1 - m), e2 = __expf(v2 - m), e3 = __expf(v3 - m);
      if (lane >= cnt) e0 = 0.f;
      if (lane + 64 >= cnt) e1 = 0.f;
      if (lane + 128 >= cnt) e2 = 0.f;
      if (lane + 192 >= cnt) e3 = 0.f;
      float ssum = wave_sum(e0 + e1 + e2 + e3);
      float inv = 1.0f / ssum;
      sp[hh][lane] = e0 * inv; sp[hh][lane + 64] = e1 * inv; sp[hh][lane + 128] = e2 * inv; sp[hh][lane + 192] = e3 * inv;
    }
    __syncthreads();
    {
      int hh = tid >> 5, d = (tid & 31) * 2;
      float o0 = 0.f, o1 = 0.f;
      for (int j = 0; j < cnt; ++j) {
        float p = sp[hh][j];
        const float2 vv = *(const float2*)(projA + (size_t)(b0 + ssel[j]) * PA_W + C_V + d);
        o0 += p * vv.x; o1 += p * vv.y;
      }
      float* op = pa + (size_t)t * DM + 512 + hh * 64 + d;
      op[0] = o0; op[1] = o1;
    }
    __syncthreads();
  }
}

__device__ __forceinline__ void d_merge(const float* __restrict__ pa, const float* __restrict__ wpp,
                                               const float* __restrict__ wpa, const __half* __restrict__ gate,
                                               float* __restrict__ merged) {
  __shared__ float sA[16 * SA_LD];
  __shared__ float sB[16 * 64];
  const int tid = threadIdx.x, ty = tid >> 4, tx = tid & 15;
  for (int tile = blockIdx.x; tile < 512 * 16; tile += gridDim.x) {
    int rt = tile >> 4, ct = tile & 15;
    float a0[4][4] = {}, a1[4][4] = {};
    gemm_tile_f32(pa, DM, wpp, DM, 512, rt * 64, ct * 64, DM, a0, sA, sB);
    gemm_tile_f32(pa + 512, DM, wpa, DM, 512, rt * 64, ct * 64, DM, a1, sA, sB);
#pragma unroll
    for (int i = 0; i < 4; ++i)
#pragma unroll
      for (int j = 0; j < 4; ++j) {
        int r = rt * 64 + ty * 4 + i, c = ct * 64 + tx * 4 + j;
        float g0 = __half2float(gate[(size_t)r * 2048 + c]);
        float g1 = __half2float(gate[(size_t)r * 2048 + 1024 + c]);
        merged[(size_t)r * DM + c] = g0 * a0[i][j] + g1 * a1[i][j];
      }
  }
}

__device__ __forceinline__ void d_resid(const float* __restrict__ merged, const float* __restrict__ w_out,
                                               float* __restrict__ h) {
  __shared__ float sA[16 * SA_LD];
  __shared__ float sB[16 * 64];
  const int tid = threadIdx.x, ty = tid >> 4, tx = tid & 15;
  for (int tile = blockIdx.x; tile < 512 * 16; tile += gridDim.x) {
    int rt = tile >> 4, ct = tile & 15;
    float acc[4][4] = {};
    gemm_tile_f32(merged, DM, w_out, DM, DM, rt * 64, ct * 64, DM, acc, sA, sB);
#pragma unroll
    for (int i = 0; i < 4; ++i)
#pragma unroll
      for (int j = 0; j < 4; ++j) {
        int r = rt * 64 + ty * 4 + i, c = ct * 64 + tx * 4 + j;
        size_t o = (size_t)r * DM + c;
        h[o] = ALPHA * h[o] + acc[i][j];
      }
  }
}

__device__ __forceinline__ void d_route(const float* __restrict__ h1, const float* __restrict__ w_group,
                                               const float* __restrict__ b_group, const float* __restrict__ w_router,
                                               const float* __restrict__ b_router, int* __restrict__ route_e,
                                               float* __restrict__ route_w, int* __restrict__ counts,
                                               int* __restrict__ lists) {
  __shared__ float slog[4][36];
  const int tid = threadIdx.x, lane = tid & 63, wv = tid >> 6;
  for (int t = blockIdx.x * 4 + wv; t < T_TOK; t += gridDim.x * 4) {
    float acc[36];
#pragma unroll
    for (int o = 0; o < 36; ++o) acc[o] = 0.f;
    for (int k = lane; k < DM; k += 64) {
      float hv = h1[(size_t)t * DM + k];
      float4 wg = *(const float4*)(w_group + k * 4);
      acc[0] += hv * wg.x; acc[1] += hv * wg.y; acc[2] += hv * wg.z; acc[3] += hv * wg.w;
#pragma unroll
      for (int o = 0; o < 8; ++o) {
        float4 wr = *(const float4*)(w_router + k * 32 + o * 4);
        acc[4 + o * 4 + 0] += hv * wr.x; acc[4 + o * 4 + 1] += hv * wr.y;
        acc[4 + o * 4 + 2] += hv * wr.z; acc[4 + o * 4 + 3] += hv * wr.w;
      }
    }
#pragma unroll
    for (int o = 0; o < 36; ++o) {
      float v = wave_sum(acc[o]);
      if (lane == 0) slog[wv][o] = v;
    }
    if (lane == 0) {
      float gl[4];
      int g = 0;
#pragma unroll
      for (int o = 0; o < 4; ++o) gl[o] = slog[wv][o] + b_group[o];
      float m = gl[0];
#pragma unroll
      for (int o = 1; o < 4; ++o) if (gl[o] > m) { m = gl[o]; g = o; }
      float se = 0.f;
#pragma unroll
      for (int o = 0; o < 4; ++o) se += __expf(gl[o] - m);
      float pg = 1.0f / se;
      float v1 = -3e38f, v2 = -3e38f;
      int i1 = 0, i2 = 0;
      for (int j = 0; j < 8; ++j) {
        float v = slog[wv][4 + g * 8 + j] + b_router[g * 8 + j];
        if (v > v1) { v2 = v1; i2 = i1; v1 = v; i1 = j; }
        else if (v > v2) { v2 = v; i2 = j; }
      }
      float e2 = __expf(v2 - v1);
      float w1 = pg / (1.0f + e2), w2 = pg * e2 / (1.0f + e2);
      int ea = g * 8 + i1, eb = g * 8 + i2;
      route_e[2 * t] = ea; route_e[2 * t + 1] = eb;
      route_w[2 * t] = w1; route_w[2 * t + 1] = w2;
      int pa_ = atomicAdd(&counts[ea], 1);
      lists[(size_t)ea * T_TOK + pa_] = 2 * t;
      int pb_ = atomicAdd(&counts[eb], 1);
      lists[(size_t)eb * T_TOK + pb_] = 2 * t + 1;
    }
  }
}

__device__ __forceinline__ void d_moe(const float* __restrict__ h1, const float* __restrict__ w_gate,
                                             const float* __restrict__ w_up, const float* __restrict__ w_down,
                                             const float* __restrict__ route_w, const int* __restrict__ counts,
                                             const int* __restrict__ lists, float* __restrict__ y) {
  __shared__ float sh[16][DM];
  __shared__ float shid[16][256];
  __shared__ int sent[16];
  const int tid = threadIdx.x;
  int pre[33];
  pre[0] = 0;
#pragma unroll
  for (int e = 0; e < 32; ++e) pre[e + 1] = pre[e] + ((counts[e] + 15) >> 4);
  const int total = pre[32];
  for (int item = blockIdx.x; item < total; item += gridDim.x) {
    int e = 0;
#pragma unroll
    for (int i = 1; i < 32; ++i) if (item >= pre[i]) e = i;
    int base = 0;
#pragma unroll
    for (int i = 0; i < 32; ++i) if (i == e) base = pre[i];
    int ti = item - base;
    int cnt_e = counts[e];
    if (tid < 16) {
      int idx = ti * 16 + tid;
      sent[tid] = (idx < cnt_e) ? lists[(size_t)e * T_TOK + idx] : -1;
    }
    __syncthreads();
    for (int i = 0; i < 16; ++i) {
      int en = sent[i];
      float4 v = make_float4(0.f, 0.f, 0.f, 0.f);
      if (en >= 0) v = *(const float4*)(h1 + (size_t)(en >> 1) * DM + tid * 4);
      *(float4*)&sh[i][tid * 4] = v;
    }
    __syncthreads();
    {
      float ag[16], au[16];
#pragma unroll
      for (int i = 0; i < 16; ++i) { ag[i] = 0.f; au[i] = 0.f; }
      const float* wg = w_gate + (size_t)e * DM * 256 + tid;
      const float* wu = w_up + (size_t)e * DM * 256 + tid;
      for (int k = 0; k < DM; ++k) {
        float g = wg[(size_t)k * 256], u = wu[(size_t)k * 256];
#pragma unroll
        for (int i = 0; i < 16; ++i) { float a = sh[i][k]; ag[i] += a * g; au[i] += a * u; }
      }
#pragma unroll
      for (int i = 0; i < 16; ++i) {
        float g = ag[i];
        shid[i][tid] = (g / (1.0f + __expf(-g))) * au[i];
      }
    }
    __syncthreads();
    {
      float acc[16][4];
#pragma unroll
      for (int i = 0; i < 16; ++i)
#pragma unroll
        for (int c = 0; c < 4; ++c) acc[i][c] = 0.f;
      const float* wd = w_down + (size_t)e * 256 * DM + tid;
      for (int f = 0; f < 256; ++f) {
        float w0 = wd[(size_t)f * DM], w1 = wd[(size_t)f * DM + 256], w2 = wd[(size_t)f * DM + 512], w3 = wd[(size_t)f * DM + 768];
#pragma unroll
        for (int i = 0; i < 16; ++i) {
          float hv = shid[i][f];
          acc[i][0] += hv * w0; acc[i][1] += hv * w1; acc[i][2] += hv * w2; acc[i][3] += hv * w3;
        }
      }
#pragma unroll
      for (int i = 0; i < 16; ++i) {
        int en = sent[i];
        if (en >= 0) {
          float rw = route_w[en];
          float* yp = y + (size_t)en * DM + tid;
          yp[0] = rw * acc[i][0]; yp[256] = rw * acc[i][1]; yp[512] = rw * acc[i][2]; yp[768] = rw * acc[i][3];
        }
      }
    }
    __syncthreads();
  }
}

struct Params {
  const float *x, *ln_in_g, *ln_in_b, *w_in, *b_gate, *pool_w, *pool_scale, *wpp, *wpa, *w_out, *ln1_g, *ln1_b, *w_group,
      *b_group, *w_router, *b_router, *w_gate, *w_up, *w_down, *ln2_g, *ln2_b;
  float* out;
  char* ws;
};

__global__ __launch_bounds__(256) void mega(Params p) {
  cg::grid_group grid = cg::this_grid();
  char* ws = p.ws;
  float* h = (float*)(ws + OFF_H);
  float* projA = (float*)(ws + OFF_PROJA);
  __half* gate = (__half*)(ws + OFF_GATE);
  int* route_e = (int*)(ws + OFF_ROUTE_E);
  float* route_w = (float*)(ws + OFF_ROUTE_W);
  int* counts = (int*)(ws + OFF_COUNTS);
  int* lists = (int*)(ws + OFF_LISTS);
  float* pa = p.out;
  float* merged = projA;
  float* y = projA;
  d_ln(p.x, nullptr, p.ln_in_g, p.ln_in_b, h, 0, counts);
  grid.sync();
  d_inproj(h, p.w_in, p.b_gate, projA, gate);
  grid.sync();
  d_pool(projA, p.pool_w, p.pool_scale, pa);
  d_attn(projA, pa);
  grid.sync();
  d_merge(pa, p.wpp, p.wpa, gate, merged);
  grid.sync();
  d_resid(merged, p.w_out, h);
  grid.sync();
  d_ln(h, nullptr, p.ln1_g, p.ln1_b, h, 0, nullptr);
  grid.sync();
  d_route(h, p.w_group, p.b_group, p.w_router, p.b_router, route_e, route_w, counts, lists);
  grid.sync();
  d_moe(h, p.w_gate, p.w_up, p.w_down, route_w, counts, lists, y);
  grid.sync();
  d_ln(h, y, p.ln2_g, p.ln2_b, p.out, 1, nullptr);
}

extern "C" void kernel_launch(void* const* d_in, const int* in_sizes, int n_in, void* d_out, int out_size, void* d_ws,
                              size_t ws_size, hipStream_t stream) {
  if (ws_size < WS_NEEDED) { fprintf(stderr, "ws too small: %zu < %zu\n", ws_size, (size_t)WS_NEEDED); return; }
  static int grid_blocks = 0;
  if (!grid_blocks) {
    int dev = 0, cus = 0, per_cu = 0;
    hipGetDevice(&dev);
    hipDeviceGetAttribute(&cus, hipDeviceAttributeMultiprocessorCount, dev);
    hipOccupancyMaxActiveBlocksPerMultiprocessor(&per_cu, mega, 256, 0);
    if (per_cu > 4) per_cu = 4;
    grid_blocks = cus * per_cu;
    fprintf(stderr, "mega: cus=%d per_cu=%d grid=%d\n", cus, per_cu, grid_blocks);
  }
  Params p{};
  const float** pp = (const float**)&p;
  for (int i = 0; i < 21; ++i) pp[i] = (const float*)d_in[i];
  p.out = (float*)d_out;
  p.ws = (char*)d_ws;
  void* args[] = {&p};
  hipError_t e = hipLaunchCooperativeKernel((void*)mega, dim3(grid_blocks), dim3(256), args, 0, stream);
  if (e != hipSuccess) fprintf(stderr, "cooperative launch failed: %s (grid %d)\n", hipGetErrorString(e), grid_blocks);
}
```

```cpp
#include <hip/hip_runtime.h>
#include <hip/hip_fp16.h>
#include <hip/hip_cooperative_groups.h>
#include <stdint.h>
#include <stdio.h>
namespace cg = cooperative_groups;

typedef _Float16 f16;
typedef f16 f16x8 __attribute__((ext_vector_type(8)));
typedef f16 f16x4 __attribute__((ext_vector_type(4)));
typedef f16 f16x2 __attribute__((ext_vector_type(2)));
typedef float f32x4 __attribute__((ext_vector_type(4)));
typedef int i32x4 __attribute__((ext_vector_type(4)));

#define T_TOK 32768
#define DM 1024
#define SEQ 4096
#define PJ_W 1536
#define PA_W 1448
#define IN_W 3496
#define IN_WP 3584
#define C_Q 512
#define C_K 1024
#define C_V 1088
#define C_IQ 1152
#define C_IK 1408
#define C_IW 1440
#define ALPHA 1.189207115002721f
#define NEG_BIG (-1e30f)

#define SZ_A   ((size_t)T_TOK * DM * 2)
#define SZ_B   ((size_t)T_TOK * PJ_W * 2)
#define SZ_C   ((size_t)T_TOK * 2048 * 2)
#define SZ_D   ((size_t)T_TOK * DM * 2)
#define OFF_A  ((size_t)0)
#define OFF_B  (OFF_A + SZ_A)
#define OFF_C  (OFF_B + SZ_B)
#define OFF_D  (OFF_C + SZ_C)
#define OFF_W  (OFF_D + SZ_D)
#define OFF_WIN   (OFF_W)
#define OFF_WPOOL (OFF_WIN + (size_t)IN_WP * 1024 * 2)
#define OFF_WPP   (OFF_WPOOL + (size_t)4 * 128 * 128 * 2)
#define OFF_WPA   (OFF_WPP + (size_t)1024 * 512 * 2)
#define OFF_WOUT  (OFF_WPA + (size_t)1024 * 512 * 2)
#define OFF_WGU   (OFF_WOUT + (size_t)1024 * 1024 * 2)
#define OFF_WDN   (OFF_WGU + (size_t)32 * 512 * 1024 * 2)
#define OFF_MISC  (OFF_WDN + (size_t)32 * 1024 * 256 * 2)
#define OFF_ROUTE_E (OFF_MISC)
#define OFF_ROUTE_W (OFF_ROUTE_E + (size_t)T_TOK * 2 * 4)
#define OFF_COUNTS  (OFF_ROUTE_W + (size_t)T_TOK * 2 * 4)
#define OFF_LISTS   (OFF_COUNTS + 256)
#define OFF_SEL     (OFF_LISTS + (size_t)32 * T_TOK * 4)
#define WS_NEEDED   (OFF_SEL + (size_t)T_TOK * 256 * 2)

struct Params {
  const float *x, *ln_in_g, *ln_in_b, *w_in, *b_gate, *pool_w, *pool_scale, *wpp, *wpa, *w_out, *ln1_g, *ln1_b, *w_group,
      *b_group, *w_router, *b_router, *w_gate, *w_up, *w_down, *ln2_g, *ln2_b;
  float* out;
  char* ws;
};

__device__ __forceinline__ float wave_sum(float v) {
#pragma unroll
  for (int o = 32; o > 0; o >>= 1) v += __shfl_xor(v, o, 64);
  return v;
}
__device__ __forceinline__ float wave_max(float v) {
#pragma unroll
  for (int o = 32; o > 0; o >>= 1) v = fmaxf(v, __shfl_xor(v, o, 64));
  return v;
}
__device__ __forceinline__ int wave_sum_i(int v) {
#pragma unroll
  for (int o = 32; o > 0; o >>= 1) v += __shfl_xor(v, o, 64);
  return v;
}
__device__ __forceinline__ int opaque_tid() { int t = threadIdx.x; asm volatile("" : "+v"(t)); return t; }
__device__ __forceinline__ float ldf(const float* p) { return *p; }
__device__ __forceinline__ float ldf(const f16* p) { return (float)*p; }

#define WAIT_V(n) asm volatile("s_waitcnt vmcnt(%0)" ::"n"(n) : "memory")
#define WAIT_L(n) asm volatile("s_waitcnt lgkmcnt(%0)" ::"n"(n) : "memory")

__device__ __forceinline__ int lds_byte(int r, int c) {
  int st = (r >> 4) * 2 + (c >> 5), ob = (r & 15) * 64 + (c & 31) * 2;
  return st * 1024 + (ob ^ (((ob >> 9) & 1) << 5));
}
__device__ __forceinline__ void stage_rc(int b, int& R, int& C) {
  int st = b >> 10, sb = b & 1023, swz = sb ^ (((sb >> 9) & 1) << 5);
  R = (st >> 1) * 16 + swz / 64;
  C = (st & 1) * 32 + (swz % 64) / 2;
}

#define TILE_B 32768
#define STAGE_B 65536
#define GEMM_LDS 135168
#define EPI_LD 528

__device__ __forceinline__ void gemm_core(const f16* __restrict__ Ab, const unsigned (&pa)[4], const f16* __restrict__ Bb,
                                          const unsigned (&pb)[4], int nt, f32x4 (&acc)[8][4], char* shm) {
  const int tid = opaque_tid(), wid = tid >> 6, lane = tid & 63, wr = wid >> 2, wc = wid & 3, fr = lane & 15, fq = lane >> 4;
#define SA(b) (shm + (b) * STAGE_B)
#define SB(b) (shm + (b) * STAGE_B + TILE_B)
#define GLDS_STAGE(buf, kt)                                                                                              \
  do {                                                                                                                   \
    _Pragma("unroll") for (int i = 0; i < 4; ++i) {                                                                     \
      __builtin_amdgcn_global_load_lds((const unsigned*)(Ab + pa[i] + (kt) * 64), (unsigned*)(SA(buf) + wid * 1024 + i * 8192), \
                                       16, 0, 0);                                                                        \
      __builtin_amdgcn_global_load_lds((const unsigned*)(Bb + pb[i] + (kt) * 64), (unsigned*)(SB(buf) + wid * 1024 + i * 8192), \
                                       16, 0, 0);                                                                        \
    }                                                                                                                    \
  } while (0)
  GLDS_STAGE(0, 0);
  WAIT_V(0);
  __syncthreads();
  for (int t = 0; t < nt; ++t) {
    const int cur = t & 1;
    if (t + 1 < nt) GLDS_STAGE(cur ^ 1, t + 1);
#pragma unroll
    for (int ks = 0; ks < 2; ++ks) {
      f16x8 At[8], Bf[4];
#pragma unroll
      for (int m = 0; m < 8; ++m) At[m] = *(const f16x8*)(SA(cur) + lds_byte(wr * 128 + m * 16 + fr, ks * 32 + fq * 8));
#pragma unroll
      for (int n = 0; n < 4; ++n) Bf[n] = *(const f16x8*)(SB(cur) + lds_byte(wc * 64 + n * 16 + fr, ks * 32 + fq * 8));
#pragma unroll
      for (int m = 0; m < 8; ++m)
#pragma unroll
        for (int n = 0; n < 4; ++n) acc[m][n] = __builtin_amdgcn_mfma_f32_16x16x32_f16(At[m], Bf[n], acc[m][n], 0, 0, 0);
      __builtin_amdgcn_sched_barrier(0);
    }
    WAIT_V(0);
    __syncthreads();
  }
#undef SA
#undef SB
#undef GLDS_STAGE
}

__device__ __forceinline__ void epi_store_f16(const f32x4 (&acc)[8][4], char* shm) {
  const int tid = opaque_tid(), wid = tid >> 6, lane = tid & 63, wr = wid >> 2, wc = wid & 3, fr = lane & 15, fq = lane >> 4;
#pragma unroll
  for (int m = 0; m < 8; ++m)
#pragma unroll
    for (int n = 0; n < 4; ++n) {
      f16x4 v;
      v[0] = (f16)acc[m][n][0]; v[1] = (f16)acc[m][n][1]; v[2] = (f16)acc[m][n][2]; v[3] = (f16)acc[m][n][3];
      *(f16x4*)(shm + (wc * 64 + n * 16 + fr) * EPI_LD + (wr * 128 + m * 16 + fq * 4) * 2) = v;
    }
}

__device__ __forceinline__ void p_ln_in(const Params& p) {
  f16* h16 = (f16*)(p.ws + OFF_A);
  const int tid = opaque_tid(), lane = tid & 63, wid = tid >> 6;
  const int nw = gridDim.x * 8;
  for (int t = blockIdx.x * 8 + wid; t < T_TOK; t += nw) {
    const float* xr = p.x + (size_t)t * DM;
    float4 v[4];
#pragma unroll
    for (int i = 0; i < 4; ++i) v[i] = *(const float4*)(xr + i * 256 + lane * 4);
    float s = 0.f;
#pragma unroll
    for (int i = 0; i < 4; ++i) s += v[i].x + v[i].y + v[i].z + v[i].w;
    float mu = wave_sum(s) * (1.0f / DM);
    float q = 0.f;
#pragma unroll
    for (int i = 0; i < 4; ++i) {
      v[i].x -= mu; v[i].y -= mu; v[i].z -= mu; v[i].w -= mu;
      q += v[i].x * v[i].x + v[i].y * v[i].y + v[i].z * v[i].z + v[i].w * v[i].w;
    }
    float rs = rsqrtf(wave_sum(q) * (1.0f / DM) + 1e-5f);
#pragma unroll
    for (int i = 0; i < 4; ++i) {
      float4 g = *(const float4*)(p.ln_in_g + i * 256 + lane * 4), b = *(const float4*)(p.ln_in_b + i * 256 + lane * 4);
      f16x4 o;
      o[0] = (f16)(v[i].x * rs * g.x + b.x); o[1] = (f16)(v[i].y * rs * g.y + b.y);
      o[2] = (f16)(v[i].z * rs * g.z + b.z); o[3] = (f16)(v[i].w * rs * g.w + b.w);
      *(f16x4*)(h16 + (size_t)t * DM + i * 256 + lane * 4) = o;
    }
  }
}

template <class RowMap>
__device__ __forceinline__ void conv_tile(const float* __restrict__ src, int ld_src, int nvalid, int k0, int n0, f16* __restrict__ dst,
                                          int ld_dst, RowMap rm, float* sT) {
  const int tid = opaque_tid();
  {
    int k = tid >> 3, n = (tid & 7) * 8;
    const float* sp = src + (size_t)(k0 + k) * ld_src + n0 + n;
#pragma unroll
    for (int j = 0; j < 8; ++j) sT[k * 65 + n + j] = (n0 + n + j < nvalid) ? sp[j] : 0.f;
  }
  __syncthreads();
  {
    int n = tid >> 3, k = (tid & 7) * 8;
    f16x8 o;
#pragma unroll
    for (int j = 0; j < 8; ++j) o[j] = (f16)sT[(k + j) * 65 + n];
    int drow = rm(n0 + n);
    if (drow >= 0) *(f16x8*)(dst + (size_t)drow * ld_dst + k0 + k) = o;
  }
  __syncthreads();
}

struct RowId { __device__ int operator()(int n) const { return n; } };
struct RowGU { int up; __device__ int operator()(int ff) const {
  int tile = ff >> 7, wr = (ff >> 6) & 1, l = ff & 63; return tile * 256 + wr * 128 + up * 64 + l; } };

__device__ __forceinline__ void p_convert(const Params& p, char* shm) {
  float* sT = (float*)shm;
  char* ws = p.ws;
  const int J0 = 16 * 56, J1 = J0 + 16, J2 = J1 + 128, J3 = J2 + 128, J4 = J3 + 256, J5 = J4 + 32 * 64, J6 = J5 + 32 * 64,
            J7 = J6 + 32 * 64;
  for (int job = blockIdx.x; job < J7; job += gridDim.x) {
    if (job < J0) {
      int kt = job / 56, nt = job % 56;
      conv_tile(p.w_in, IN_W, IN_W, kt * 64, nt * 64, (f16*)(ws + OFF_WIN), 1024, RowId(), sT);
    } else if (job < J1) {
      int j = job - J0, g = j >> 2, kt = (j >> 1) & 1, nt = j & 1;
      conv_tile(p.pool_w + g * 128 * 128, 128, 128, kt * 64, nt * 64, (f16*)(ws + OFF_WPOOL) + g * 128 * 128, 128, RowId(), sT);
    } else if (job < J2) {
      int j = job - J1, kt = j >> 4, nt = j & 15;
      conv_tile(p.wpp, 1024, 1024, kt * 64, nt * 64, (f16*)(ws + OFF_WPP), 512, RowId(), sT);
    } else if (job < J3) {
      int j = job - J2, kt = j >> 4, nt = j & 15;
      conv_tile(p.wpa, 1024, 1024, kt * 64, nt * 64, (f16*)(ws + OFF_WPA), 512, RowId(), sT);
    } else if (job < J4) {
      int j = job - J3, kt = j >> 4, nt = j & 15;
      conv_tile(p.w_out, 1024, 1024, kt * 64, nt * 64, (f16*)(ws + OFF_WOUT), 1024, RowId(), sT);
    } else if (job < J6) {
      int up = job >= J5;
      int j = job - (up ? J5 : J4), e = j >> 6, kt = (j >> 2) & 15, nt = j & 3;
      RowGU rm; rm.up = up;
      conv_tile((up ? p.w_up : p.w_gate) + (size_t)e * 1024 * 256, 256, 256, kt * 64, nt * 64,
                (f16*)(ws + OFF_WGU) + (size_t)e * 512 * 1024, 1024, rm, sT);
    } else {
      int j = job - J6, e = j >> 6, kt = (j >> 4) & 3, nt = j & 15;
      conv_tile(p.w_down + (size_t)e * 256 * 1024, 1024, 1024, kt * 64, nt * 64, (f16*)(ws + OFF_WDN) + (size_t)e * 1024 * 256,
                256, RowId(), sT);
    }
  }
}

__device__ __forceinline__ void p_inproj(const Params& p, char* shm) {
  const f16* h16 = (const f16*)(p.ws + OFF_A);
  const f16* wT = (const f16*)(p.ws + OFF_WIN);
  f16* proj16 = (f16*)(p.ws + OFF_B);
  f16* gate16 = (f16*)(p.ws + OFF_C);
  const int tid = opaque_tid(), wid = tid >> 6, lane = tid & 63;
  int sR[4], sC[4];
#pragma unroll
  for (int i = 0; i < 4; ++i) stage_rc(wid * 1024 + i * 8192 + lane * 16, sR[i], sC[i]);
  const int NTILES = 128 * 14;
  for (int tile = blockIdx.x; tile < NTILES; tile += gridDim.x) {
    int grp = tile / (8 * 14), rem = tile % (8 * 14);
    int ft = rem / 8, tt = grp * 8 + (rem % 8);
    unsigned pa[4], pb[4];
#pragma unroll
    for (int i = 0; i < 4; ++i) {
      pa[i] = (unsigned)((ft * 256 + sR[i]) * 1024 + sC[i]);
      pb[i] = (unsigned)((tt * 256 + sR[i]) * 1024 + sC[i]);
    }
    f32x4 acc[8][4];
#pragma unroll
    for (int m = 0; m < 8; ++m)
#pragma unroll
      for (int n = 0; n < 4; ++n) acc[m][n] = (f32x4){0.f, 0.f, 0.f, 0.f};
    gemm_core(wT, pa, h16, pb, 16, acc, shm);
    epi_store_f16(acc, shm);
    __syncthreads();
    {
      int ch = tid & 31, r0 = tid >> 5;
      int f0 = ft * 256 + ch * 8;
      float bg[8];
      if (f0 >= PA_W && f0 < IN_W) {
#pragma unroll
        for (int j = 0; j < 8; ++j) bg[j] = p.b_gate[f0 - PA_W + j];
      } else {
#pragma unroll
        for (int j = 0; j < 8; ++j) bg[j] = 0.f;
      }
#pragma unroll 4
      for (int ps = 0; ps < 16; ++ps) {
        int r = ps * 16 + r0;
        f16x8 v = *(const f16x8*)(shm + r * EPI_LD + ch * 16);
        size_t tok = (size_t)tt * 256 + r;
        if (f0 < PA_W) {
          *(f16x8*)(proj16 + tok * PJ_W + f0) = v;
        } else if (f0 < IN_W) {
          f16x8 o;
#pragma unroll
          for (int j = 0; j < 8; ++j) o[j] = (f16)(1.0f / (1.0f + __expf(-((float)v[j] + bg[j]))));
          *(f16x8*)(gate16 + tok * 2048 + (f0 - PA_W)) = o;
        }
      }
    }
    __syncthreads();
  }
}


__device__ __forceinline__ void zero_acc(f32x4 (&acc)[8][4]) {
#pragma unroll
  for (int m = 0; m < 8; ++m)
#pragma unroll
    for (int n = 0; n < 4; ++n) acc[m][n] = (f32x4){0.f, 0.f, 0.f, 0.f};
}

template <class RowPtr>
__device__ __forceinline__ void epi_rows_out(char* shm, RowPtr rp) {
  const int tid = opaque_tid(), ch = tid & 31, r0 = tid >> 5;
#pragma unroll 4
  for (int ps = 0; ps < 16; ++ps) {
    int r = ps * 16 + r0;
    f16x8 v = *(const f16x8*)(shm + r * EPI_LD + ch * 16);
    f16* d = rp(r);
    if (d) *(f16x8*)(d + ch * 8) = v;
  }
}

__device__ __forceinline__ void p_merge(const Params& p, char* shm) {
  const f16* pa16 = (const f16*)(p.ws + OFF_D);
  const f16* gate16 = (const f16*)(p.ws + OFF_C);
  const f16* wpp = (const f16*)(p.ws + OFF_WPP);
  const f16* wpa = (const f16*)(p.ws + OFF_WPA);
  f16* merged16 = (f16*)(p.ws + OFF_B);
  const int tid = opaque_tid(), wid = tid >> 6, lane = tid & 63, wr = wid >> 2, wc = wid & 3, fr = lane & 15, fq = lane >> 4;
  int sR[4], sC[4];
#pragma unroll
  for (int i = 0; i < 4; ++i) stage_rc(wid * 1024 + i * 8192 + lane * 16, sR[i], sC[i]);
  for (int tile = blockIdx.x; tile < 512; tile += gridDim.x) {
    int ft = tile & 3, tt = tile >> 2;
    unsigned pa[4], pb[4];
    f32x4 acc[8][4];
    zero_acc(acc);
#pragma unroll
    for (int i = 0; i < 4; ++i) {
      pa[i] = (unsigned)((ft * 256 + sR[i]) * 512 + sC[i]);
      pb[i] = (unsigned)((tt * 256 + sR[i]) * 1024 + sC[i]);
    }
    gemm_core(wpp, pa, pa16, pb, 8, acc, shm);
#pragma unroll
    for (int m = 0; m < 8; ++m)
#pragma unroll
      for (int n = 0; n < 4; ++n) {
        const f16* gp = gate16 + (size_t)(tt * 256 + wc * 64 + n * 16 + fr) * 2048 + ft * 256 + wr * 128 + m * 16 + fq * 4;
        f16x4 g0 = *(const f16x4*)gp, g1 = *(const f16x4*)(gp + 1024);
#pragma unroll
        for (int j = 0; j < 4; ++j) acc[m][n][j] *= (float)g0[j] / (float)g1[j];
        if (n == 3) __builtin_amdgcn_sched_barrier(0);
      }
    gemm_core(wpa, pa, pa16 + 512, pb, 8, acc, shm);
#pragma unroll
    for (int m = 0; m < 8; ++m)
#pragma unroll
      for (int n = 0; n < 4; ++n) {
        const f16* gp = gate16 + (size_t)(tt * 256 + wc * 64 + n * 16 + fr) * 2048 + 1024 + ft * 256 + wr * 128 + m * 16 + fq * 4;
        f16x4 g1 = *(const f16x4*)gp;
#pragma unroll
        for (int j = 0; j < 4; ++j) acc[m][n][j] *= (float)g1[j];
        if (n == 3) __builtin_amdgcn_sched_barrier(0);
      }
    epi_store_f16(acc, shm);
    __syncthreads();
    epi_rows_out(shm, [&](int r) { return merged16 + (size_t)(tt * 256 + r) * 1024 + ft * 256; });
    __syncthreads();
  }
}

__device__ __forceinline__ void p_resid(const Params& p, char* shm) {
  const f16* merged16 = (const f16*)(p.ws + OFF_B);
  const f16* h16 = (const f16*)(p.ws + OFF_A);
  const f16* wo = (const f16*)(p.ws + OFF_WOUT);
  float* z32 = (float*)(p.ws + OFF_C);
  const int tid = opaque_tid(), wid = tid >> 6, lane = tid & 63, wr = wid >> 2, wc = wid & 3, fr = lane & 15, fq = lane >> 4;
  int sR[4], sC[4];
#pragma unroll
  for (int i = 0; i < 4; ++i) stage_rc(wid * 1024 + i * 8192 + lane * 16, sR[i], sC[i]);
  for (int tile = blockIdx.x; tile < 512; tile += gridDim.x) {
    int ft = tile & 3, tt = tile >> 2;
    unsigned pa[4], pb[4];
    f32x4 acc[8][4];
    zero_acc(acc);
#pragma unroll
    for (int i = 0; i < 4; ++i) {
      pa[i] = (unsigned)((ft * 256 + sR[i]) * 1024 + sC[i]);
      pb[i] = (unsigned)((tt * 256 + sR[i]) * 1024 + sC[i]);
    }
    gemm_core(wo, pa, merged16, pb, 16, acc, shm);
#pragma unroll
    for (int m = 0; m < 8; ++m)
#pragma unroll
      for (int n = 0; n < 4; ++n) {
        size_t o = (size_t)(tt * 256 + wc * 64 + n * 16 + fr) * 1024 + ft * 256 + wr * 128 + m * 16 + fq * 4;
        f16x4 hv = *(const f16x4*)(h16 + o);
        f32x4 z;
#pragma unroll
        for (int j = 0; j < 4; ++j) z[j] = ALPHA * (float)hv[j] + acc[m][n][j];
        *(f32x4*)(z32 + o) = z;
      }
  }
}

#define HID_ROWS 73728
__device__ __forceinline__ void moe_tiles(const int* counts, int (&pre)[33]) {
  pre[0] = 0;
#pragma unroll
  for (int e = 0; e < 32; ++e) pre[e + 1] = pre[e] + ((counts[e] + 255) >> 8);
}
__device__ __forceinline__ void moe_find(const int (&pre)[33], int item, int& e, int& mt) {
  e = 0;
#pragma unroll
  for (int i = 1; i < 32; ++i) if (item >= pre[i]) e = i;
  int base = 0;
#pragma unroll
  for (int i = 0; i < 32; ++i) if (i == e) base = pre[i];
  mt = item - base;
}

__device__ __forceinline__ void p_moe_a(const Params& p, char* shm) {
  const f16* h1 = (const f16*)(p.ws + OFF_A);
  const f16* wgu = (const f16*)(p.ws + OFF_WGU);
  const int* counts = (const int*)(p.ws + OFF_COUNTS);
  const int* lists = (const int*)(p.ws + OFF_LISTS);
  f16* hid16 = (f16*)(p.ws + OFF_B);
  const int tid = opaque_tid(), wid = tid >> 6, lane = tid & 63, wr = wid >> 2, wc = wid & 3, fr = lane & 15, fq = lane >> 4;
  int sR[4], sC[4];
#pragma unroll
  for (int i = 0; i < 4; ++i) stage_rc(wid * 1024 + i * 8192 + lane * 16, sR[i], sC[i]);
  int pre[33];
  moe_tiles(counts, pre);
  const int total = pre[32] * 2;
  for (int item = blockIdx.x; item < total; item += gridDim.x) {
    int e, mt;
    moe_find(pre, item >> 1, e, mt);
    const int fh = item & 1;
    const int cnt_e = counts[e];
    int rowbase = 0;
#pragma unroll
    for (int i = 0; i < 32; ++i) if (i == e) rowbase = pre[i] * 256;
    unsigned pa[4], pb[4];
    f32x4 acc[8][4];
    zero_acc(acc);
#pragma unroll
    for (int i = 0; i < 4; ++i) {
      pa[i] = (unsigned)((e * 512 + fh * 256 + sR[i]) * 1024 + sC[i]);
      int idx = mt * 256 + sR[i];
      int tok = (idx < cnt_e) ? (lists[(size_t)e * T_TOK + idx] >> 1) : 0;
      pb[i] = (unsigned)(tok * 1024 + sC[i]);
    }
    gemm_core(wgu, pa, h1, pb, 16, acc, shm);
#pragma unroll
    for (int m = 0; m < 4; ++m)
#pragma unroll
      for (int n = 0; n < 4; ++n) {
        f16x4 o;
#pragma unroll
        for (int j = 0; j < 4; ++j) {
          float g = acc[m][n][j], u = acc[m + 4][n][j];
          o[j] = (f16)((g / (1.0f + __expf(-g))) * u);
        }
        size_t row = (size_t)rowbase + mt * 256 + wc * 64 + n * 16 + fr;
        *(f16x4*)(hid16 + row * 256 + fh * 128 + wr * 64 + m * 16 + fq * 4) = o;
      }
  }
}

__device__ __forceinline__ void p_moe_b(const Params& p, char* shm) {
  const f16* wdn = (const f16*)(p.ws + OFF_WDN);
  const f16* hid16 = (const f16*)(p.ws + OFF_B);
  const float* route_w = (const float*)(p.ws + OFF_ROUTE_W);
  const int* counts = (const int*)(p.ws + OFF_COUNTS);
  const int* lists = (const int*)(p.ws + OFF_LISTS);
  f16* y16 = (f16*)(p.ws + OFF_C);
  int* sent = (int*)(shm + 256 * EPI_LD);
  const int tid = opaque_tid(), wid = tid >> 6, lane = tid & 63, wc = wid & 3, fr = lane & 15;
  int sR[4], sC[4];
#pragma unroll
  for (int i = 0; i < 4; ++i) stage_rc(wid * 1024 + i * 8192 + lane * 16, sR[i], sC[i]);
  int pre[33];
  moe_tiles(counts, pre);
  const int total = pre[32] * 4;
  for (int item = blockIdx.x; item < total; item += gridDim.x) {
    int e, mt;
    moe_find(pre, item >> 2, e, mt);
    const int ft = item & 3;
    const int cnt_e = counts[e];
    int rowbase = 0;
#pragma unroll
    for (int i = 0; i < 32; ++i) if (i == e) rowbase = pre[i] * 256;
    if (tid < 256) {
      int idx = mt * 256 + tid;
      sent[tid] = (idx < cnt_e) ? lists[(size_t)e * T_TOK + idx] : -1;
    }
    unsigned pa[4], pb[4];
    f32x4 acc[8][4];
    zero_acc(acc);
#pragma unroll
    for (int i = 0; i < 4; ++i) {
      pa[i] = (unsigned)((e * 1024 + ft * 256 + sR[i]) * 256 + sC[i]);
      pb[i] = (unsigned)((rowbase + mt * 256 + sR[i]) * 256 + sC[i]);
    }
    gemm_core(wdn, pa, hid16, pb, 4, acc, shm);
#pragma unroll
    for (int n = 0; n < 4; ++n) {
      int en = sent[wc * 64 + n * 16 + fr];
      float rw = (en >= 0) ? route_w[en] : 0.f;
#pragma unroll
      for (int m = 0; m < 8; ++m)
#pragma unroll
        for (int j = 0; j < 4; ++j) acc[m][n][j] *= rw;
    }
    epi_store_f16(acc, shm);
    __syncthreads();
    epi_rows_out(shm, [&](int r) -> f16* { int en = sent[r]; return (en >= 0) ? (y16 + (size_t)en * 1024 + ft * 256) : (f16*)nullptr; });
    __syncthreads();
  }
}


__device__ __forceinline__ unsigned f2key_(float f) {
  if (f == 0.f) f = 0.f;
  unsigned u = __float_as_uint(f);
  return (u & 0x80000000u) ? ~u : (u | 0x80000000u);
}
__device__ __forceinline__ float key2f_(unsigned k) {
  return __uint_as_float((k & 0x80000000u) ? (k & 0x7fffffffu) : ~k);
}
__device__ __forceinline__ void find_bin(const unsigned* hrow, int need, int lane, int* out_bin, int* out_above) {
  uint4 c = *(const uint4*)(hrow + 4 * lane);
  int tot = (int)(c.x + c.y + c.z + c.w);
  int incl = tot;
#pragma unroll
  for (int o = 1; o < 64; o <<= 1) {
    int v = __shfl_down(incl, o, 64);
    if (lane + o < 64) incl += v;
  }
  int above = incl - tot;
  if (above < need && incl >= need) {
    int b;
    if (above + (int)c.w >= need) b = 3;
    else { above += c.w; if (above + (int)c.z >= need) b = 2;
      else { above += c.z; if (above + (int)c.y >= need) b = 1; else { above += c.y; b = 0; } } }
    *out_bin = 4 * lane + b;
    *out_above = above;
  }
}

__device__ __forceinline__ void p_index(const Params& p, char* shm) {
  const f16* proj16 = (const f16*)(p.ws + OFF_B);
  unsigned short* sel16 = (unsigned short*)(p.ws + OFF_SEL);
  unsigned* hist1 = (unsigned*)shm;
  unsigned* hist2 = hist1 + 4096;
  unsigned short* ssel = (unsigned short*)(hist2 + 4096);
  unsigned short* scand = ssel + 4096;
  unsigned* smm = (unsigned*)(scand + 1024);
  unsigned* scnt = smm + 32;
  int* sbin = (int*)(scnt + 32);
  const int tid = opaque_tid(), wid = tid >> 6, lane = tid & 63, fr = lane & 15, fq = lane >> 4;
  const float NINF = -__builtin_huge_valf();
  for (int rnd = 0;; ++rnd) {
    int idx = rnd * gridDim.x + ((rnd & 1) ? (gridDim.x - 1 - blockIdx.x) : blockIdx.x);
    if (idx >= 2048) break;
    const int b = idx & 7, j = 255 - (idx >> 3);
    const int l0 = j * 16, t0 = b * SEQ + l0;
    int sbase = wid * 16 + fq * 4, frq = fr, krow = wid * 16 + fr;
    int wids = __builtin_amdgcn_readfirstlane(wid);
    asm volatile("" : "+v"(sbase), "+v"(frq), "+v"(krow), "+s"(wids));
    if (j < 16) {
      for (int i = tid; i < 4096; i += 512) sel16[(size_t)t0 * 256 + i] = (unsigned short)(i & 255);
      continue;
    }
    for (int i = tid; i < 8192; i += 512) hist1[i] = 0;
    if (tid < 32) scnt[tid] = 0;
    if (tid < 16) { smm[tid] = 0xFFFFFFFFu; smm[16 + tid] = 0u; }
    f16x8 bq[8];
    float wq[8];
    {
      const f16* qrow = proj16 + (size_t)(t0 + fr) * PJ_W;
#pragma unroll
      for (int h = 0; h < 8; ++h) bq[h] = *(const f16x8*)(qrow + C_IQ + h * 32 + fq * 8);
      f16x8 wv = *(const f16x8*)(qrow + C_IW);
#pragma unroll
      for (int h = 0; h < 8; ++h) wq[h] = (float)wv[h];
    }
    __syncthreads();
    const int nkt = j + 1;
    float sc[32][4];
#pragma unroll
    for (int it = 0; it < 32; ++it) {
      const int kt = it * 8 + wids;
      if (kt < nkt) {
        f16x8 a = *(const f16x8*)(proj16 + (size_t)(b * SEQ + it * 128 + krow) * PJ_W + C_IK + fq * 8);
        f32x4 s = {0.f, 0.f, 0.f, 0.f};
#pragma unroll
        for (int h = 0; h < 8; ++h) {
          f32x4 L = __builtin_amdgcn_mfma_f32_16x16x32_f16(a, bq[h], (f32x4){0.f, 0.f, 0.f, 0.f}, 0, 0, 0);
#pragma unroll
          for (int jj = 0; jj < 4; ++jj) s[jj] += wq[h] * fmaxf(L[jj], 0.f);
        }
        if (kt == j) {
#pragma unroll
          for (int jj = 0; jj < 4; ++jj) if (fq * 4 + jj > fr) s[jj] = NINF;
        }
#pragma unroll
        for (int jj = 0; jj < 4; ++jj) sc[it][jj] = s[jj];
      } else {
#pragma unroll
        for (int jj = 0; jj < 4; ++jj) sc[it][jj] = NINF;
      }
      __builtin_amdgcn_sched_barrier(0);
    }
    {
      float mn = __builtin_huge_valf(), mx = NINF;
#pragma unroll
      for (int it = 0; it < 32; ++it)
#pragma unroll
        for (int jj = 0; jj < 4; ++jj) {
          float x = sc[it][jj];
          mx = fmaxf(mx, x);
          mn = fminf(mn, (x == NINF) ? __builtin_huge_valf() : x);
        }
      mn = fminf(mn, __shfl_xor(mn, 16, 64)); mn = fminf(mn, __shfl_xor(mn, 32, 64));
      mx = fmaxf(mx, __shfl_xor(mx, 16, 64)); mx = fmaxf(mx, __shfl_xor(mx, 32, 64));
      if (fq == 0) {
        if (mn != __builtin_huge_valf()) atomicMin(&smm[fr], f2key_(mn));
        if (mx != NINF) atomicMax(&smm[16 + fr], f2key_(mx));
      }
    }
    __syncthreads();
    const float lo = key2f_(smm[fr]), hi = key2f_(smm[16 + fr]);
    const float s1 = (hi > lo) ? 256.0f / (hi - lo) : 0.f;
#pragma unroll
    for (int it = 0; it < 32; ++it) {
      if (it * 8 + wids < nkt) {
#pragma unroll
        for (int jj = 0; jj < 4; ++jj) {
          float x = sc[it][jj];
          if (x != NINF) {
            int b1 = min((int)((x - lo) * s1), 255);
            atomicAdd(&hist1[frq * 256 + b1], 1u);
          }
        }
      }
    }
    __syncthreads();
    for (int qq = 0; qq < 2; ++qq) find_bin(hist1 + (2 * wid + qq) * 256, 256, lane, &sbin[2 * wid + qq], &sbin[16 + 2 * wid + qq]);
    __syncthreads();
    const int b1s = sbin[fr];
#pragma unroll
    for (int it = 0; it < 32; ++it) {
      if (it * 8 + wids < nkt) {
#pragma unroll
        for (int jj = 0; jj < 4; ++jj) {
          float x = sc[it][jj];
          if (x != NINF) {
            float u = (x - lo) * s1;
            int b1 = min((int)u, 255);
            if (b1 == b1s) {
              int b2 = min((int)((u - (float)b1) * 256.0f), 255);
              atomicAdd(&hist2[frq * 256 + b2], 1u);
            }
          }
        }
      }
    }
    __syncthreads();
    for (int qq = 0; qq < 2; ++qq) {
      int q = 2 * wid + qq;
      find_bin(hist2 + q * 256, 256 - sbin[16 + q], lane, &sbin[32 + q], &sbin[48 + q]);
    }
    __syncthreads();
    const int b2s = sbin[32 + fr];
#pragma unroll
    for (int it = 0; it < 32; ++it) {
      if (it * 8 + wids < nkt) {
#pragma unroll
        for (int jj = 0; jj < 4; ++jj) {
          float x = sc[it][jj];
          if (x != NINF) {
            float u = (x - lo) * s1;
            int b1 = min((int)u, 255);
            int cls = 0;
            if (b1 > b1s) cls = 1;
            else if (b1 == b1s) {
              int b2 = min((int)((u - (float)b1) * 256.0f), 255);
              cls = (b2 > b2s) ? 1 : ((b2 == b2s) ? 2 : 0);
            }
            unsigned short sidx = (unsigned short)(sbase + it * 128 + jj);
            if (cls == 1) {
              unsigned pos = atomicAdd(&scnt[frq], 1u);
              if (pos < 256) ssel[frq * 256 + pos] = sidx;
            } else if (cls == 2) {
              unsigned cp = atomicAdd(&scnt[16 + frq], 1u);
              if (cp < 64) scand[frq * 64 + cp] = sidx;
            }
          }
        }
      }
    }
    __syncthreads();
    for (int qq = 0; qq < 2; ++qq) {
      int q = 2 * wid + qq;
      int base = (int)scnt[q], c = min((int)scnt[16 + q], 64), r = 256 - base;
      if (lane < c) {
        unsigned short my = scand[q * 64 + lane];
        int rank = 0;
        for (int k = 0; k < c; ++k) rank += (scand[q * 64 + k] < my) ? 1 : 0;
        if (rank < r) ssel[q * 256 + base + rank] = my;
      }
    }
    __syncthreads();
    *(uint4*)(sel16 + (size_t)t0 * 256 + tid * 8) = *(const uint4*)(ssel + tid * 8);
    __syncthreads();
  }
}


typedef short s16x4 __attribute__((ext_vector_type(4)));
#define VROW 160
#define ATT_WAVE_LDS (64 * VROW + 512)
__device__ __forceinline__ f16x8 tr_pair(const char* a, const char* b) {
  s16x4 x = __builtin_amdgcn_ds_read_tr16_b64_v4i16((__attribute__((address_space(3))) s16x4*)(a));
  s16x4 y = __builtin_amdgcn_ds_read_tr16_b64_v4i16((__attribute__((address_space(3))) s16x4*)(b));
  typedef short s16x8 __attribute__((ext_vector_type(8)));
  s16x8 r = __builtin_shufflevector(x, y, 0, 1, 2, 3, 4, 5, 6, 7);
  return __builtin_bit_cast(f16x8, r);
}
__device__ __forceinline__ void p_attn(const Params& p, char* shm) {
  const f16* proj16 = (const f16*)(p.ws + OFF_B);
  const unsigned short* sel16 = (const unsigned short*)(p.ws + OFF_SEL);
  f16* pa16 = (f16*)(p.ws + OFF_D);
  const int tid = opaque_tid(), wid = tid >> 6, lane = tid & 63, fr = lane & 15, fq = lane >> 4;
  char* vimg = shm + wid * ATT_WAVE_LDS;
  unsigned short* ssel = (unsigned short*)(vimg + 64 * VROW);
  for (int t = blockIdx.x * 8 + wid; t < T_TOK; t += gridDim.x * 8) {
    const int l = t & (SEQ - 1), b0 = t - l, cnt = min(l + 1, 256);
    {
      uint2 sv = *(const uint2*)(sel16 + (size_t)t * 256 + lane * 4);
      unsigned short i0 = sv.x & 0xffff, i1 = sv.x >> 16, i2 = sv.y & 0xffff, i3 = sv.y >> 16;
      int s0 = lane * 4;
      ushort4 o;
      o.x = (s0 + 0 < cnt) ? (unsigned short)min((int)i0, l) : 0;
      o.y = (s0 + 1 < cnt) ? (unsigned short)min((int)i1, l) : 0;
      o.z = (s0 + 2 < cnt) ? (unsigned short)min((int)i2, l) : 0;
      o.w = (s0 + 3 < cnt) ? (unsigned short)min((int)i3, l) : 0;
      *(ushort4*)(ssel + s0) = o;
    }
    asm volatile("s_waitcnt lgkmcnt(0)" ::: "memory");
    f16x8 bq0, bq1;
    {
      const f16* qp = proj16 + (size_t)t * PJ_W + C_Q + (fr & 7) * 64 + fq * 8;
      bq0 = *(const f16x8*)qp;
      bq1 = *(const f16x8*)(qp + 32);
#pragma unroll
      for (int e = 0; e < 8; ++e) { bq0[e] = (fr < 8) ? bq0[e] * (f16)0.125f : (f16)0.f; bq1[e] = (fr < 8) ? bq1[e] * (f16)0.125f : (f16)0.f; }
    }
    const f16* kbase = proj16 + (size_t)b0 * PJ_W + C_K + fq * 8;
    const f16* vbase = proj16 + (size_t)b0 * PJ_W + C_V + (lane & 7) * 8;
    f32x4 S[16];
#pragma unroll
    for (int kt = 0; kt < 16; ++kt) {
      int kidx = ssel[kt * 16 + fr];
      const f16* kp = kbase + (size_t)kidx * PJ_W;
      f16x8 a0 = *(const f16x8*)kp, a1 = *(const f16x8*)(kp + 32);
      f32x4 z = {0.f, 0.f, 0.f, 0.f};
      z = __builtin_amdgcn_mfma_f32_16x16x32_f16(a0, bq0, z, 0, 0, 0);
      z = __builtin_amdgcn_mfma_f32_16x16x32_f16(a1, bq1, z, 0, 0, 0);
#pragma unroll
      for (int j = 0; j < 4; ++j) S[kt][j] = (kt * 16 + fq * 4 + j < cnt) ? z[j] : NEG_BIG;
    }
    float m = NEG_BIG;
#pragma unroll
    for (int kt = 0; kt < 16; ++kt)
#pragma unroll
      for (int j = 0; j < 4; ++j) m = fmaxf(m, S[kt][j]);
    m = fmaxf(m, __shfl_xor(m, 16, 64));
    m = fmaxf(m, __shfl_xor(m, 32, 64));
    float lsum = 0.f;
    f16x8 P[8];
#pragma unroll
    for (int c = 0; c < 8; ++c)
#pragma unroll
      for (int j = 0; j < 4; ++j) {
        float e0 = __expf(S[2 * c][j] - m), e1 = __expf(S[2 * c + 1][j] - m);
        lsum += e0 + e1;
        P[c][j] = (f16)e0;
        P[c][4 + j] = (f16)e1;
      }
    lsum += __shfl_xor(lsum, 16, 64);
    lsum += __shfl_xor(lsum, 32, 64);
    f32x4 O[4];
#pragma unroll
    for (int nt = 0; nt < 4; ++nt) O[nt] = (f32x4){0.f, 0.f, 0.f, 0.f};
#pragma unroll 1
    for (int rr = 0; rr < 4; ++rr) {
      f16x8 vv[8];
#pragma unroll
      for (int i = 0; i < 8; ++i) {
        int r = (lane >> 3) + 8 * i;
        int vidx = ssel[rr * 64 + r];
        vv[i] = *(const f16x8*)(vbase + (size_t)vidx * PJ_W);
      }
      asm volatile("s_waitcnt lgkmcnt(0)" ::: "memory");
#pragma unroll
      for (int i = 0; i < 8; ++i) {
        int r = (lane >> 3) + 8 * i;
        *(f16x8*)(vimg + r * VROW + (lane & 7) * 16) = vv[i];
      }
      asm volatile("s_waitcnt lgkmcnt(0)" ::: "memory");
#pragma unroll
      for (int cc = 0; cc < 2; ++cc) {
        const char* ra = vimg + (cc * 32 + fq * 4 + (fr >> 2)) * VROW + (fr & 3) * 8;
#pragma unroll
        for (int nt = 0; nt < 4; ++nt) {
          f16x8 B = tr_pair(ra + nt * 32, ra + 16 * VROW + nt * 32);
          f16x8 A = (rr == 0) ? P[cc] : (rr == 1) ? P[2 + cc] : (rr == 2) ? P[4 + cc] : P[6 + cc];
          O[nt] = __builtin_amdgcn_mfma_f32_16x16x32_f16(A, B, O[nt], 0, 0, 0);
        }
      }
    }
    asm volatile("s_waitcnt lgkmcnt(0)" ::: "memory");
#pragma unroll
    for (int j = 0; j < 4; ++j) {
      float ls = __shfl(lsum, (fq & 1) * 4 + j, 64);
      float inv = 1.0f / ls;
      if (fq < 2) {
        f16* op = pa16 + (size_t)t * DM + 512 + (fq * 4 + j) * 64 + fr;
#pragma unroll
        for (int nt = 0; nt < 4; ++nt) op[nt * 16] = (f16)(O[nt][j] * inv);
      }
    }
  }
}


#define DL_LD 1040
__device__ __forceinline__ void p_pool(const Params& p, char* shm) {
  const f16* proj16 = (const f16*)(p.ws + OFF_B);
  const f16* wpl = (const f16*)(p.ws + OFF_WPOOL);
  f16* pa16 = (f16*)(p.ws + OFF_D);
  const int tid = opaque_tid(), wid = tid >> 6, lane = tid & 63, fr = lane & 15, fq = lane >> 4;
  for (int item = blockIdx.x; item < T_TOK / 64; item += gridDim.x) {
    const int t0 = item * 64;
    {
      const int cp = tid & 255, th = tid >> 8;
      const int c = cp * 2, g = c >> 7, w = 2 << g;
      const int ts = t0 + th * 32, l_s = ts & (SEQ - 1);
      float s0 = 0.f, s1 = 0.f;
      for (int k = 1; k < w; ++k) {
        if (l_s - k >= 0) {
          f16x2 u = *(const f16x2*)(proj16 + (size_t)(ts - k) * PJ_W + c);
          s0 += (float)u[0]; s1 += (float)u[1];
        }
      }
      for (int i = 0; i < 32; ++i) {
        const int t = ts + i, l = l_s + i;
        f16x2 u = *(const f16x2*)(proj16 + (size_t)t * PJ_W + c);
        s0 += (float)u[0]; s1 += (float)u[1];
        float inv = 1.0f / (float)min(l + 1, w);
        f16x2 d;
        d[0] = (f16)(s0 * inv - (float)u[0]); d[1] = (f16)(s1 * inv - (float)u[1]);
        *(f16x2*)(shm + (th * 32 + i) * DL_LD + c * 2) = d;
        if (l - (w - 1) >= 0) {
          f16x2 uo = *(const f16x2*)(proj16 + (size_t)(t - (w - 1)) * PJ_W + c);
          s0 -= (float)uo[0]; s1 -= (float)uo[1];
        }
      }
    }
    __syncthreads();
    {
      const int g = wid >> 1, eh = wid & 1;
      f32x4 acc[4][4];
#pragma unroll
      for (int m = 0; m < 4; ++m)
#pragma unroll
        for (int n = 0; n < 4; ++n) acc[m][n] = (f32x4){0.f, 0.f, 0.f, 0.f};
#pragma unroll
      for (int ks = 0; ks < 4; ++ks) {
        f16x8 A[4], B[4];
#pragma unroll
        for (int m = 0; m < 4; ++m) A[m] = *(const f16x8*)(wpl + (size_t)(g * 128 + eh * 64 + m * 16 + fr) * 128 + ks * 32 + fq * 8);
#pragma unroll
        for (int n = 0; n < 4; ++n) B[n] = *(const f16x8*)(shm + (n * 16 + fr) * DL_LD + (g * 128 + ks * 32 + fq * 8) * 2);
#pragma unroll
        for (int m = 0; m < 4; ++m)
#pragma unroll
          for (int n = 0; n < 4; ++n) acc[m][n] = __builtin_amdgcn_mfma_f32_16x16x32_f16(A[m], B[n], acc[m][n], 0, 0, 0);
      }
#pragma unroll
      for (int m = 0; m < 4; ++m) {
        const int e0 = g * 128 + eh * 64 + m * 16 + fq * 4;
        float4 sc = *(const float4*)(p.pool_scale + e0);
#pragma unroll
        for (int n = 0; n < 4; ++n) {
          f16x4 o;
          o[0] = (f16)(acc[m][n][0] * sc.x); o[1] = (f16)(acc[m][n][1] * sc.y);
          o[2] = (f16)(acc[m][n][2] * sc.z); o[3] = (f16)(acc[m][n][3] * sc.w);
          *(f16x4*)(pa16 + (size_t)(t0 + n * 16 + fr) * DM + e0) = o;
        }
      }
    }
    __syncthreads();
  }
}

#define RT_LDS (36 * 1024 * 4)
__device__ __forceinline__ void p_ln1_route(const Params& p, char* shm) {
  const float* z32 = (const float*)(p.ws + OFF_C);
  f16* h1 = (f16*)(p.ws + OFF_A);
  int* route_e = (int*)(p.ws + OFF_ROUTE_E);
  float* route_w = (float*)(p.ws + OFF_ROUTE_W);
  int* counts = (int*)(p.ws + OFF_COUNTS);
  int* lists = (int*)(p.ws + OFF_LISTS);
  float* sW = (float*)shm;
  const int tid = opaque_tid(), wid = tid >> 6, lane = tid & 63;
  for (int i = tid; i < 36 * 1024; i += 512) {
    int o = i >> 10, k = i & 1023;
    sW[i] = (o < 4) ? p.w_group[k * 4 + o] : p.w_router[k * 32 + (o - 4)];
  }
  __syncthreads();
  const int nw = gridDim.x * 8;
  for (int pr = blockIdx.x * 8 + wid; pr < T_TOK / 2; pr += nw) {
    const int t = pr * 2;
    float v[2][16];
#pragma unroll
    for (int r = 0; r < 2; ++r)
#pragma unroll
      for (int i = 0; i < 4; ++i) {
        float4 x = *(const float4*)(z32 + (size_t)(t + r) * DM + i * 256 + lane * 4);
        v[r][i * 4 + 0] = x.x; v[r][i * 4 + 1] = x.y; v[r][i * 4 + 2] = x.z; v[r][i * 4 + 3] = x.w;
      }
#pragma unroll
    for (int r = 0; r < 2; ++r) {
      float s = 0.f;
#pragma unroll
      for (int i = 0; i < 16; ++i) s += v[r][i];
      float mu = wave_sum(s) * (1.0f / DM);
      float q = 0.f;
#pragma unroll
      for (int i = 0; i < 16; ++i) { v[r][i] -= mu; q += v[r][i] * v[r][i]; }
      float rs = rsqrtf(wave_sum(q) * (1.0f / DM) + 1e-5f);
#pragma unroll
      for (int i = 0; i < 4; ++i) {
        float4 g = *(const float4*)(p.ln1_g + i * 256 + lane * 4), b = *(const float4*)(p.ln1_b + i * 256 + lane * 4);
        v[r][i * 4 + 0] = v[r][i * 4 + 0] * rs * g.x + b.x; v[r][i * 4 + 1] = v[r][i * 4 + 1] * rs * g.y + b.y;
        v[r][i * 4 + 2] = v[r][i * 4 + 2] * rs * g.z + b.z; v[r][i * 4 + 3] = v[r][i * 4 + 3] * rs * g.w + b.w;
        f16x4 o;
        o[0] = (f16)v[r][i * 4 + 0]; o[1] = (f16)v[r][i * 4 + 1]; o[2] = (f16)v[r][i * 4 + 2]; o[3] = (f16)v[r][i * 4 + 3];
        *(f16x4*)(h1 + (size_t)(t + r) * DM + i * 256 + lane * 4) = o;
      }
    }
    float mine0 = 0.f, mine1 = 0.f;
#pragma unroll 2
    for (int o = 0; o < 36; ++o) {
      float a0 = 0.f, a1 = 0.f;
#pragma unroll
      for (int i = 0; i < 4; ++i) {
        float4 w = *(const float4*)(sW + o * 1024 + i * 256 + lane * 4);
        a0 += v[0][i * 4 + 0] * w.x + v[0][i * 4 + 1] * w.y + v[0][i * 4 + 2] * w.z + v[0][i * 4 + 3] * w.w;
        a1 += v[1][i * 4 + 0] * w.x + v[1][i * 4 + 1] * w.y + v[1][i * 4 + 2] * w.z + v[1][i * 4 + 3] * w.w;
      }
      a0 = wave_sum(a0); a1 = wave_sum(a1);
      if (lane == o) { mine0 = a0; mine1 = a1; }
    }
    {
      const int r = lane & 1;
      float gl[4];
#pragma unroll
      for (int o = 0; o < 4; ++o) {
        float x0 = __shfl(mine0, o, 64), x1 = __shfl(mine1, o, 64);
        gl[o] = (r ? x1 : x0) + p.b_group[o];
      }
      int g = 0;
      float m = gl[0];
#pragma unroll
      for (int o = 1; o < 4; ++o) if (gl[o] > m) { m = gl[o]; g = o; }
      float se = 0.f;
#pragma unroll
      for (int o = 0; o < 4; ++o) se += __expf(gl[o] - m);
      float pg = 1.0f / se;
      float v1 = -3e38f, v2 = -3e38f;
      int i1 = 0, i2 = 0;
#pragma unroll
      for (int jx = 0; jx < 8; ++jx) {
        float x0 = __shfl(mine0, 4 + g * 8 + jx, 64), x1 = __shfl(mine1, 4 + g * 8 + jx, 64);
        float x = (r ? x1 : x0) + p.b_router[g * 8 + jx];
        if (x > v1) { v2 = v1; i2 = i1; v1 = x; i1 = jx; }
        else if (x > v2) { v2 = x; i2 = jx; }
      }
      if (lane < 2) {
        const int tt = t + r;
        float e2 = __expf(v2 - v1);
        float w1 = pg / (1.0f + e2), w2 = pg * e2 / (1.0f + e2);
        int ea = g * 8 + i1, eb = g * 8 + i2;
        route_e[2 * tt] = ea; route_e[2 * tt + 1] = eb;
        route_w[2 * tt] = w1; route_w[2 * tt + 1] = w2;
        int pa_ = atomicAdd(&counts[ea], 1);
        lists[(size_t)ea * T_TOK + pa_] = 2 * tt;
        int pb_ = atomicAdd(&counts[eb], 1);
        lists[(size_t)eb * T_TOK + pb_] = 2 * tt + 1;
      }
    }
  }
}

__device__ __forceinline__ void p_final(const Params& p) {
  const f16* h1 = (const f16*)(p.ws + OFF_A);
  const f16* y16 = (const f16*)(p.ws + OFF_C);
  const int tid = opaque_tid(), wid = tid >> 6, lane = tid & 63;
  const int nw = gridDim.x * 8;
  for (int t = blockIdx.x * 8 + wid; t < T_TOK; t += nw) {
    float v[16];
#pragma unroll
    for (int i = 0; i < 2; ++i) {
      f16x8 hv = *(const f16x8*)(h1 + (size_t)t * DM + i * 512 + lane * 8);
      f16x8 y0 = *(const f16x8*)(y16 + (size_t)(2 * t) * DM + i * 512 + lane * 8);
      f16x8 y1 = *(const f16x8*)(y16 + (size_t)(2 * t + 1) * DM + i * 512 + lane * 8);
#pragma unroll
      for (int e = 0; e < 8; ++e) v[i * 8 + e] = ALPHA * (float)hv[e] + ((float)y0[e] + (float)y1[e]);
    }
    float s = 0.f;
#pragma unroll
    for (int i = 0; i < 16; ++i) s += v[i];
    float mu = wave_sum(s) * (1.0f / DM);
    float q = 0.f;
#pragma unroll
    for (int i = 0; i < 16; ++i) { v[i] -= mu; q += v[i] * v[i]; }
    float rs = rsqrtf(wave_sum(q) * (1.0f / DM) + 1e-5f);
#pragma unroll
    for (int i = 0; i < 2; ++i)
#pragma unroll
      for (int hf = 0; hf < 2; ++hf) {
        const int c = i * 512 + lane * 8 + hf * 4;
        float4 g = *(const float4*)(p.ln2_g + c), b = *(const float4*)(p.ln2_b + c);
        float4 o;
        o.x = v[i * 8 + hf * 4 + 0] * rs * g.x + b.x; o.y = v[i * 8 + hf * 4 + 1] * rs * g.y + b.y;
        o.z = v[i * 8 + hf * 4 + 2] * rs * g.z + b.z; o.w = v[i * 8 + hf * 4 + 3] * rs * g.w + b.w;
        *(float4*)(p.out + (size_t)t * DM + c) = o;
      }
  }
}

#define MEGA_LDS 148480


__global__ __launch_bounds__(512) void mega(Params p) {
  __shared__ __attribute__((aligned(1024))) char shm[MEGA_LDS];
  cg::grid_group grid = cg::this_grid();
  if (blockIdx.x == 0 && threadIdx.x < 32) ((int*)(p.ws + OFF_COUNTS))[threadIdx.x] = 0;
  p_ln_in(p);
  p_convert(p, shm);
  grid.sync();
  p_inproj(p, shm);
  grid.sync();
  p_pool(p, shm);
  p_index(p, shm);
  grid.sync();
  p_attn(p, shm);
  grid.sync();
  p_merge(p, shm);
  grid.sync();
  p_resid(p, shm);
  grid.sync();
  p_ln1_route(p, shm);
  grid.sync();
  p_moe_a(p, shm);
  grid.sync();
  p_moe_b(p, shm);
  grid.sync();
  p_final(p);
}

extern "C" void kernel_launch(void* const* d_in, const int* in_sizes, int n_in, void* d_out, int out_size, void* d_ws,
                              size_t ws_size, hipStream_t stream) {
  if (ws_size < WS_NEEDED) { fprintf(stderr, "ws too small: %zu < %zu\n", ws_size, (size_t)WS_NEEDED); return; }
  static int grid_blocks = 0;
  if (!grid_blocks) {
    int dev = 0, cus = 0, per_cu = 0;
    hipGetDevice(&dev);
    hipDeviceGetAttribute(&cus, hipDeviceAttributeMultiprocessorCount, dev);
    hipOccupancyMaxActiveBlocksPerMultiprocessor(&per_cu, mega, 512, 0);
    if (per_cu > 1) per_cu = 1;
    grid_blocks = cus * per_cu;
    fprintf(stderr, "mega: cus=%d per_cu=%d grid=%d\n", cus, per_cu, grid_blocks);
  }
  Params p{};
  const float** pp = (const float**)&p;
  for (int i = 0; i < 21; ++i) pp[i] = (const float*)d_in[i];
  p.out = (float*)d_out;
  p.ws = (char*)d_ws;
  void* args[] = {&p};
  hipError_t e = hipLaunchCooperativeKernel((void*)mega, dim3(grid_blocks), dim3(512), args, 0, stream);
  if (e != hipSuccess) fprintf(stderr, "cooperative launch failed: %s (grid %d)\n", hipGetErrorString(e), grid_blocks);
}
```

```cpp
#include <hip/hip_runtime.h>
#include <hip/hip_fp16.h>
#include <hip/hip_cooperative_groups.h>
#include <stdint.h>
#include <stdio.h>
namespace cg = cooperative_groups;

typedef _Float16 f16;
typedef f16 f16x8 __attribute__((ext_vector_type(8)));
typedef f16 f16x4 __attribute__((ext_vector_type(4)));
typedef f16 f16x2 __attribute__((ext_vector_type(2)));
typedef float f32x4 __attribute__((ext_vector_type(4)));
typedef int i32x4 __attribute__((ext_vector_type(4)));

#define T_TOK 32768
#define DM 1024
#define SEQ 4096
#define PJ_W 1536
#define PA_W 1448
#define IN_W 3496
#define IN_WP 3584
#define C_Q 512
#define C_K 1024
#define C_V 1088
#define C_IQ 1152
#define C_IK 1408
#define C_IW 1440
#define ALPHA 1.189207115002721f
#define NEG_BIG (-1e30f)

#define SZ_A   ((size_t)T_TOK * DM * 2)
#define SZ_B   ((size_t)T_TOK * PJ_W * 2)
#define SZ_C   ((size_t)T_TOK * 2048 * 2)
#define SZ_D   ((size_t)T_TOK * DM * 2)
#define OFF_A  ((size_t)0)
#define OFF_B  (OFF_A + SZ_A)
#define OFF_C  (OFF_B + SZ_B)
#define OFF_D  (OFF_C + SZ_C)
#define OFF_W  (OFF_D + SZ_D)
#define OFF_WIN   (OFF_W)
#define OFF_WPOOL (OFF_WIN + (size_t)IN_WP * 1024 * 2)
#define OFF_WPP   (OFF_WPOOL + (size_t)4 * 128 * 128 * 2)
#define OFF_WPA   (OFF_WPP + (size_t)1024 * 512 * 2)
#define OFF_WOUT  (OFF_WPA + (size_t)1024 * 512 * 2)
#define OFF_WGU   (OFF_WOUT + (size_t)1024 * 1024 * 2)
#define OFF_WDN   (OFF_WGU + (size_t)32 * 512 * 1024 * 2)
#define OFF_MISC  (OFF_WDN + (size_t)32 * 1024 * 256 * 2)
#define OFF_ROUTE_E (OFF_MISC)
#define OFF_ROUTE_W (OFF_ROUTE_E + (size_t)T_TOK * 2 * 4)
#define OFF_COUNTS  (OFF_ROUTE_W + (size_t)T_TOK * 2 * 4)
#define OFF_LISTS   (OFF_COUNTS + 256)
#define OFF_SEL     (OFF_LISTS + (size_t)32 * T_TOK * 4)
#define OFF_CNT      (OFF_SEL + (size_t)T_TOK * 256 * 2)
#define OFF_BAR      (OFF_CNT + 4096)
#define WS_NEEDED   (OFF_BAR + 16384)
#define CNT_STRIDE 32

struct Params {
  const float *x, *ln_in_g, *ln_in_b, *w_in, *b_gate, *pool_w, *pool_scale, *wpp, *wpa, *w_out, *ln1_g, *ln1_b, *w_group,
      *b_group, *w_router, *b_router, *w_gate, *w_up, *w_down, *ln2_g, *ln2_b;
  float* out;
  char* ws;
};

__device__ __forceinline__ float wave_sum(float v) {
#pragma unroll
  for (int o = 32; o > 0; o >>= 1) v += __shfl_xor(v, o, 64);
  return v;
}
__device__ __forceinline__ float wave_max(float v) {
#pragma unroll
  for (int o = 32; o > 0; o >>= 1) v = fmaxf(v, __shfl_xor(v, o, 64));
  return v;
}
__device__ __forceinline__ int wave_sum_i(int v) {
#pragma unroll
  for (int o = 32; o > 0; o >>= 1) v += __shfl_xor(v, o, 64);
  return v;
}
__device__ __forceinline__ int opaque_tid() { int t = threadIdx.x; asm volatile("" : "+v"(t)); return t; }
__device__ __forceinline__ float ldf(const float* p) { return *p; }
__device__ __forceinline__ float ldf(const f16* p) { return (float)*p; }

#define WAIT_V(n) asm volatile("s_waitcnt vmcnt(%0)" ::"n"(n) : "memory")
#define WAIT_L(n) asm volatile("s_waitcnt lgkmcnt(%0)" ::"n"(n) : "memory")

__device__ __forceinline__ int lds_byte(int r, int c) {
  int st = (r >> 4) * 2 + (c >> 5), ob = (r & 15) * 64 + (c & 31) * 2;
  return st * 1024 + (ob ^ (((ob >> 9) & 1) << 5));
}
__device__ __forceinline__ void stage_rc(int b, int& R, int& C) {
  int st = b >> 10, sb = b & 1023, swz = sb ^ (((sb >> 9) & 1) << 5);
  R = (st >> 1) * 16 + swz / 64;
  C = (st & 1) * 32 + (swz % 64) / 2;
}

#define TILE_B 32768
#define STAGE_B 65536
#define GEMM_LDS 135168
#define EPI_LD 528

__device__ __forceinline__ void gemm_core(const f16* __restrict__ Ab, const unsigned (&pa)[4], const f16* __restrict__ Bb,
                                          const unsigned (&pb)[4], int nt, f32x4 (&acc)[8][4], char* shm) {
  const int tid = opaque_tid(), wid = tid >> 6, lane = tid & 63, wr = wid >> 2, wc = wid & 3, fr = lane & 15, fq = lane >> 4;
#define SA(b) (shm + (b) * STAGE_B)
#define SB(b) (shm + (b) * STAGE_B + TILE_B)
#define GLDS_STAGE(buf, kt)                                                                                              \
  do {                                                                                                                   \
    _Pragma("unroll") for (int i = 0; i < 4; ++i) {                                                                     \
      __builtin_amdgcn_global_load_lds((const unsigned*)(Ab + pa[i] + (kt) * 64), (unsigned*)(SA(buf) + wid * 1024 + i * 8192), \
                                       16, 0, 0);                                                                        \
      __builtin_amdgcn_global_load_lds((const unsigned*)(Bb + pb[i] + (kt) * 64), (unsigned*)(SB(buf) + wid * 1024 + i * 8192), \
                                       16, 0, 0);                                                                        \
    }                                                                                                                    \
  } while (0)
  GLDS_STAGE(0, 0);
  WAIT_V(0);
  __syncthreads();
  for (int t = 0; t < nt; ++t) {
    const int cur = t & 1;
    if (t + 1 < nt) GLDS_STAGE(cur ^ 1, t + 1);
#pragma unroll
    for (int ks = 0; ks < 2; ++ks) {
      f16x8 At[8], Bf[4];
#pragma unroll
      for (int m = 0; m < 8; ++m) At[m] = *(const f16x8*)(SA(cur) + lds_byte(wr * 128 + m * 16 + fr, ks * 32 + fq * 8));
#pragma unroll
      for (int n = 0; n < 4; ++n) Bf[n] = *(const f16x8*)(SB(cur) + lds_byte(wc * 64 + n * 16 + fr, ks * 32 + fq * 8));
#pragma unroll
      for (int m = 0; m < 8; ++m)
#pragma unroll
        for (int n = 0; n < 4; ++n) acc[m][n] = __builtin_amdgcn_mfma_f32_16x16x32_f16(At[m], Bf[n], acc[m][n], 0, 0, 0);
      __builtin_amdgcn_sched_barrier(0);
    }
    WAIT_V(0);
    __syncthreads();
  }
#undef SA
#undef SB
#undef GLDS_STAGE
}

__device__ __forceinline__ void epi_store_f16(const f32x4 (&acc)[8][4], char* shm) {
  const int tid = opaque_tid(), wid = tid >> 6, lane = tid & 63, wr = wid >> 2, wc = wid & 3, fr = lane & 15, fq = lane >> 4;
#pragma unroll
  for (int m = 0; m < 8; ++m)
#pragma unroll
    for (int n = 0; n < 4; ++n) {
      f16x4 v;
      v[0] = (f16)acc[m][n][0]; v[1] = (f16)acc[m][n][1]; v[2] = (f16)acc[m][n][2]; v[3] = (f16)acc[m][n][3];
      *(f16x4*)(shm + (wc * 64 + n * 16 + fr) * EPI_LD + (wr * 128 + m * 16 + fq * 4) * 2) = v;
    }
}

__device__ __forceinline__ void p_ln_in(const Params& p) {
  f16* h16 = (f16*)(p.ws + OFF_A);
  const int tid = opaque_tid(), lane = tid & 63, wid = tid >> 6;
  const int nw = gridDim.x * 8;
  for (int t = blockIdx.x * 8 + wid; t < T_TOK; t += nw) {
    const float* xr = p.x + (size_t)t * DM;
    float4 v[4];
#pragma unroll
    for (int i = 0; i < 4; ++i) v[i] = *(const float4*)(xr + i * 256 + lane * 4);
    float s = 0.f;
#pragma unroll
    for (int i = 0; i < 4; ++i) s += v[i].x + v[i].y + v[i].z + v[i].w;
    float mu = wave_sum(s) * (1.0f / DM);
    float q = 0.f;
#pragma unroll
    for (int i = 0; i < 4; ++i) {
      v[i].x -= mu; v[i].y -= mu; v[i].z -= mu; v[i].w -= mu;
      q += v[i].x * v[i].x + v[i].y * v[i].y + v[i].z * v[i].z + v[i].w * v[i].w;
    }
    float rs = rsqrtf(wave_sum(q) * (1.0f / DM) + 1e-5f);
#pragma unroll
    for (int i = 0; i < 4; ++i) {
      float4 g = *(const float4*)(p.ln_in_g + i * 256 + lane * 4), b = *(const float4*)(p.ln_in_b + i * 256 + lane * 4);
      f16x4 o;
      o[0] = (f16)(v[i].x * rs * g.x + b.x); o[1] = (f16)(v[i].y * rs * g.y + b.y);
      o[2] = (f16)(v[i].z * rs * g.z + b.z); o[3] = (f16)(v[i].w * rs * g.w + b.w);
      *(f16x4*)(h16 + (size_t)t * DM + i * 256 + lane * 4) = o;
    }
  }
}

template <class RowMap>
__device__ __forceinline__ void conv_tile(const float* __restrict__ src, int ld_src, int nvalid, int k0, int n0, f16* __restrict__ dst,
                                          int ld_dst, RowMap rm, float* sT) {
  const int tid = opaque_tid();
  {
    int k = tid >> 3, n = (tid & 7) * 8;
    const float* sp = src + (size_t)(k0 + k) * ld_src + n0 + n;
#pragma unroll
    for (int j = 0; j < 8; ++j) sT[k * 65 + n + j] = (n0 + n + j < nvalid) ? sp[j] : 0.f;
  }
  __syncthreads();
  {
    int n = tid >> 3, k = (tid & 7) * 8;
    f16x8 o;
#pragma unroll
    for (int j = 0; j < 8; ++j) o[j] = (f16)sT[(k + j) * 65 + n];
    int drow = rm(n0 + n);
    if (drow >= 0) *(f16x8*)(dst + (size_t)drow * ld_dst + k0 + k) = o;
  }
  __syncthreads();
}

struct RowId { __device__ int operator()(int n) const { return n; } };
struct RowGU { int up; __device__ int operator()(int ff) const {
  int tile = ff >> 7, wr = (ff >> 6) & 1, l = ff & 63; return tile * 256 + wr * 128 + up * 64 + l; } };

__device__ __forceinline__ void p_convert(const Params& p, char* shm) {
  float* sT = (float*)shm;
  char* ws = p.ws;
  const int J0 = 16 * 56, J1 = J0 + 16, J2 = J1 + 128, J3 = J2 + 128, J4 = J3 + 256, J5 = J4 + 32 * 64, J6 = J5 + 32 * 64,
            J7 = J6 + 32 * 64;
  for (int job = blockIdx.x; job < J7; job += gridDim.x) {
    if (job < J0) {
      int kt = job / 56, nt = job % 56;
      conv_tile(p.w_in, IN_W, IN_W, kt * 64, nt * 64, (f16*)(ws + OFF_WIN), 1024, RowId(), sT);
    } else if (job < J1) {
      int j = job - J0, g = j >> 2, kt = (j >> 1) & 1, nt = j & 1;
      conv_tile(p.pool_w + g * 128 * 128, 128, 128, kt * 64, nt * 64, (f16*)(ws + OFF_WPOOL) + g * 128 * 128, 128, RowId(), sT);
    } else if (job < J2) {
      int j = job - J1, kt = j >> 4, nt = j & 15;
      conv_tile(p.wpp, 1024, 1024, kt * 64, nt * 64, (f16*)(ws + OFF_WPP), 512, RowId(), sT);
    } else if (job < J3) {
      int j = job - J2, kt = j >> 4, nt = j & 15;
      conv_tile(p.wpa, 1024, 1024, kt * 64, nt * 64, (f16*)(ws + OFF_WPA), 512, RowId(), sT);
    } else if (job < J4) {
      int j = job - J3, kt = j >> 4, nt = j & 15;
      conv_tile(p.w_out, 1024, 1024, kt * 64, nt * 64, (f16*)(ws + OFF_WOUT), 1024, RowId(), sT);
    } else if (job < J6) {
      int up = job >= J5;
      int j = job - (up ? J5 : J4), e = j >> 6, kt = (j >> 2) & 15, nt = j & 3;
      RowGU rm; rm.up = up;
      conv_tile((up ? p.w_up : p.w_gate) + (size_t)e * 1024 * 256, 256, 256, kt * 64, nt * 64,
                (f16*)(ws + OFF_WGU) + (size_t)e * 512 * 1024, 1024, rm, sT);
    } else {
      int j = job - J6, e = j >> 6, kt = (j >> 4) & 3, nt = j & 15;
      conv_tile(p.w_down + (size_t)e * 256 * 1024, 1024, 1024, kt * 64, nt * 64, (f16*)(ws + OFF_WDN) + (size_t)e * 1024 * 256,
                256, RowId(), sT);
    }
  }
}

__device__ __forceinline__ int xcd_item(int n_items, int r) {
  const int nx = 8, slots = gridDim.x >> 3;
  const int xcd = blockIdx.x & 7, slot = blockIdx.x >> 3;
  const int per = (n_items + nx - 1) / nx;
  const int local = slot + r * slots;
  if (local >= per) return -1;
  const int item = xcd * per + local;
  return (item < n_items) ? item : -2;
}

__device__ __forceinline__ void p_inproj(const Params& p, char* shm) {
  const f16* h16 = (const f16*)(p.ws + OFF_A);
  const f16* wT = (const f16*)(p.ws + OFF_WIN);
  f16* proj16 = (f16*)(p.ws + OFF_B);
  f16* gate16 = (f16*)(p.ws + OFF_C);
  const int tid = opaque_tid(), wid = tid >> 6, lane = tid & 63;
  int sR[4], sC[4];
#pragma unroll
  for (int i = 0; i < 4; ++i) stage_rc(wid * 1024 + i * 8192 + lane * 16, sR[i], sC[i]);
  const int NTILES = 128 * 14;
  for (int r = 0;; ++r) {
    int tile = xcd_item(NTILES, r);
    if (tile == -1) break;
    if (tile < 0) continue;
    int grp = tile / 56, rem = tile % 56;
    int ft = rem >> 2, tt = grp * 4 + (rem & 3);
    unsigned pa[4], pb[4];
#pragma unroll
    for (int i = 0; i < 4; ++i) {
      pa[i] = (unsigned)((ft * 256 + sR[i]) * 1024 + sC[i]);
      pb[i] = (unsigned)((tt * 256 + sR[i]) * 1024 + sC[i]);
    }
    f32x4 acc[8][4];
#pragma unroll
    for (int m = 0; m < 8; ++m)
#pragma unroll
      for (int n = 0; n < 4; ++n) acc[m][n] = (f32x4){0.f, 0.f, 0.f, 0.f};
    gemm_core(wT, pa, h16, pb, 16, acc, shm);
    epi_store_f16(acc, shm);
    __syncthreads();
    {
      int ch = tid & 31, r0 = tid >> 5;
      int f0 = ft * 256 + ch * 8;
      float bg[8];
      if (f0 >= PA_W && f0 < IN_W) {
#pragma unroll
        for (int j = 0; j < 8; ++j) bg[j] = p.b_gate[f0 - PA_W + j];
      } else {
#pragma unroll
        for (int j = 0; j < 8; ++j) bg[j] = 0.f;
      }
#pragma unroll 4
      for (int ps = 0; ps < 16; ++ps) {
        int r = ps * 16 + r0;
        f16x8 v = *(const f16x8*)(shm + r * EPI_LD + ch * 16);
        size_t tok = (size_t)tt * 256 + r;
        if (f0 < PA_W) {
          *(f16x8*)(proj16 + tok * PJ_W + f0) = v;
        } else if (f0 < IN_W) {
          f16x8 o;
#pragma unroll
          for (int j = 0; j < 8; ++j) o[j] = (f16)(1.0f / (1.0f + __expf(-((float)v[j] + bg[j]))));
          *(f16x8*)(gate16 + tok * 2048 + (f0 - PA_W)) = o;
        }
      }
    }
    __syncthreads();
  }
}


__device__ __forceinline__ void zero_acc(f32x4 (&acc)[8][4]) {
#pragma unroll
  for (int m = 0; m < 8; ++m)
#pragma unroll
    for (int n = 0; n < 4; ++n) acc[m][n] = (f32x4){0.f, 0.f, 0.f, 0.f};
}

template <class RowPtr>
__device__ __forceinline__ void epi_rows_out(char* shm, RowPtr rp) {
  const int tid = opaque_tid(), ch = tid & 31, r0 = tid >> 5;
#pragma unroll 4
  for (int ps = 0; ps < 16; ++ps) {
    int r = ps * 16 + r0;
    f16x8 v = *(const f16x8*)(shm + r * EPI_LD + ch * 16);
    f16* d = rp(r);
    if (d) *(f16x8*)(d + ch * 8) = v;
  }
}

__device__ __forceinline__ void p_merge(const Params& p, char* shm) {
  const f16* pa16 = (const f16*)(p.ws + OFF_D);
  const f16* gate16 = (const f16*)(p.ws + OFF_C);
  const f16* wpp = (const f16*)(p.ws + OFF_WPP);
  const f16* wpa = (const f16*)(p.ws + OFF_WPA);
  f16* merged16 = (f16*)(p.ws + OFF_B);
  const int tid = opaque_tid(), wid = tid >> 6, lane = tid & 63, wr = wid >> 2, wc = wid & 3, fr = lane & 15, fq = lane >> 4;
  int sR[4], sC[4];
#pragma unroll
  for (int i = 0; i < 4; ++i) stage_rc(wid * 1024 + i * 8192 + lane * 16, sR[i], sC[i]);
  for (int r = 0;; ++r) {
    int tile = xcd_item(512, r);
    if (tile == -1) break;
    if (tile < 0) continue;
    int ft = tile & 3, tt = tile >> 2;
    unsigned pa[4], pb[4];
    f32x4 acc[8][4];
    zero_acc(acc);
#pragma unroll
    for (int i = 0; i < 4; ++i) {
      pa[i] = (unsigned)((ft * 256 + sR[i]) * 512 + sC[i]);
      pb[i] = (unsigned)((tt * 256 + sR[i]) * 1024 + sC[i]);
    }
    gemm_core(wpp, pa, pa16, pb, 8, acc, shm);
#pragma unroll
    for (int m = 0; m < 8; ++m)
#pragma unroll
      for (int n = 0; n < 4; ++n) {
        const f16* gp = gate16 + (size_t)(tt * 256 + wc * 64 + n * 16 + fr) * 2048 + ft * 256 + wr * 128 + m * 16 + fq * 4;
        f16x4 g0 = *(const f16x4*)gp, g1 = *(const f16x4*)(gp + 1024);
#pragma unroll
        for (int j = 0; j < 4; ++j) acc[m][n][j] *= (float)g0[j] / (float)g1[j];
        if (n == 3) __builtin_amdgcn_sched_barrier(0);
      }
    gemm_core(wpa, pa, pa16 + 512, pb, 8, acc, shm);
#pragma unroll
    for (int m = 0; m < 8; ++m)
#pragma unroll
      for (int n = 0; n < 4; ++n) {
        const f16* gp = gate16 + (size_t)(tt * 256 + wc * 64 + n * 16 + fr) * 2048 + 1024 + ft * 256 + wr * 128 + m * 16 + fq * 4;
        f16x4 g1 = *(const f16x4*)gp;
#pragma unroll
        for (int j = 0; j < 4; ++j) acc[m][n][j] *= (float)g1[j];
        if (n == 3) __builtin_amdgcn_sched_barrier(0);
      }
    epi_store_f16(acc, shm);
    __syncthreads();
    epi_rows_out(shm, [&](int r) { return merged16 + (size_t)(tt * 256 + r) * 1024 + ft * 256; });
    __syncthreads();
  }
}

__device__ __forceinline__ void p_resid(const Params& p, char* shm) {
  const f16* merged16 = (const f16*)(p.ws + OFF_B);
  const f16* h16 = (const f16*)(p.ws + OFF_A);
  const f16* wo = (const f16*)(p.ws + OFF_WOUT);
  float* z32 = (float*)(p.ws + OFF_C);
  const int tid = opaque_tid(), wid = tid >> 6, lane = tid & 63, wr = wid >> 2, wc = wid & 3, fr = lane & 15, fq = lane >> 4;
  int sR[4], sC[4];
#pragma unroll
  for (int i = 0; i < 4; ++i) stage_rc(wid * 1024 + i * 8192 + lane * 16, sR[i], sC[i]);
  for (int r = 0;; ++r) {
    int tile = xcd_item(512, r);
    if (tile == -1) break;
    if (tile < 0) continue;
    int ft = tile & 3, tt = tile >> 2;
    unsigned pa[4], pb[4];
    f32x4 acc[8][4];
    zero_acc(acc);
#pragma unroll
    for (int i = 0; i < 4; ++i) {
      pa[i] = (unsigned)((ft * 256 + sR[i]) * 1024 + sC[i]);
      pb[i] = (unsigned)((tt * 256 + sR[i]) * 1024 + sC[i]);
    }
    gemm_core(wo, pa, merged16, pb, 16, acc, shm);
#pragma unroll
    for (int m = 0; m < 8; ++m)
#pragma unroll
      for (int n = 0; n < 4; ++n) {
        size_t o = (size_t)(tt * 256 + wc * 64 + n * 16 + fr) * 1024 + ft * 256 + wr * 128 + m * 16 + fq * 4;
        f16x4 hv = *(const f16x4*)(h16 + o);
        f32x4 z;
#pragma unroll
        for (int j = 0; j < 4; ++j) z[j] = ALPHA * (float)hv[j] + acc[m][n][j];
        *(f32x4*)(z32 + o) = z;
      }
  }
}

#define HID_ROWS 73728
__device__ __forceinline__ void moe_tiles(const int* counts, int (&pre)[33]) {
  pre[0] = 0;
#pragma unroll
  for (int e = 0; e < 32; ++e) pre[e + 1] = pre[e] + ((counts[e * CNT_STRIDE] + 255) >> 8);
}
__device__ __forceinline__ void moe_find(const int (&pre)[33], int item, int& e, int& mt) {
  e = 0;
#pragma unroll
  for (int i = 1; i < 32; ++i) if (item >= pre[i]) e = i;
  int base = 0;
#pragma unroll
  for (int i = 0; i < 32; ++i) if (i == e) base = pre[i];
  mt = item - base;
}

__device__ __forceinline__ void p_moe_a(const Params& p, char* shm) {
  const f16* h1 = (const f16*)(p.ws + OFF_A);
  const f16* wgu = (const f16*)(p.ws + OFF_WGU);
  const int* counts = (const int*)(p.ws + OFF_CNT);
  const int* lists = (const int*)(p.ws + OFF_LISTS);
  f16* hid16 = (f16*)(p.ws + OFF_B);
  const int tid = opaque_tid(), wid = tid >> 6, lane = tid & 63, wr = wid >> 2, wc = wid & 3, fr = lane & 15, fq = lane >> 4;
  int sR[4], sC[4];
#pragma unroll
  for (int i = 0; i < 4; ++i) stage_rc(wid * 1024 + i * 8192 + lane * 16, sR[i], sC[i]);
  int pre[33];
  moe_tiles(counts, pre);
  const int total = pre[32] * 2;
  for (int r = 0;; ++r) {
    int item = xcd_item(total, r);
    if (item == -1) break;
    if (item < 0) continue;
    int e, mt;
    moe_find(pre, item >> 1, e, mt);
    const int fh = item & 1;
    const int cnt_e = counts[e * CNT_STRIDE];
    int rowbase = 0;
#pragma unroll
    for (int i = 0; i < 32; ++i) if (i == e) rowbase = pre[i] * 256;
    unsigned pa[4], pb[4];
    f32x4 acc[8][4];
    zero_acc(acc);
#pragma unroll
    for (int i = 0; i < 4; ++i) {
      pa[i] = (unsigned)((e * 512 + fh * 256 + sR[i]) * 1024 + sC[i]);
      int idx = mt * 256 + sR[i];
      int tok = (idx < cnt_e) ? (lists[(size_t)e * T_TOK + idx] >> 1) : 0;
      pb[i] = (unsigned)(tok * 1024 + sC[i]);
    }
    gemm_core(wgu, pa, h1, pb, 16, acc, shm);
#pragma unroll
    for (int m = 0; m < 4; ++m)
#pragma unroll
      for (int n = 0; n < 4; ++n) {
        f16x4 o;
#pragma unroll
        for (int j = 0; j < 4; ++j) {
          float g = acc[m][n][j], u = acc[m + 4][n][j];
          o[j] = (f16)((g / (1.0f + __expf(-g))) * u);
        }
        size_t row = (size_t)rowbase + mt * 256 + wc * 64 + n * 16 + fr;
        *(f16x4*)(hid16 + row * 256 + fh * 128 + wr * 64 + m * 16 + fq * 4) = o;
      }
  }
}

__device__ __forceinline__ void p_moe_b(const Params& p, char* shm) {
  const f16* wdn = (const f16*)(p.ws + OFF_WDN);
  const f16* hid16 = (const f16*)(p.ws + OFF_B);
  const float* route_w = (const float*)(p.ws + OFF_ROUTE_W);
  const int* counts = (const int*)(p.ws + OFF_CNT);
  const int* lists = (const int*)(p.ws + OFF_LISTS);
  f16* y16 = (f16*)(p.ws + OFF_C);
  int* sent = (int*)(shm + 256 * EPI_LD);
  const int tid = opaque_tid(), wid = tid >> 6, lane = tid & 63, wc = wid & 3, fr = lane & 15;
  int sR[4], sC[4];
#pragma unroll
  for (int i = 0; i < 4; ++i) stage_rc(wid * 1024 + i * 8192 + lane * 16, sR[i], sC[i]);
  int pre[33];
  moe_tiles(counts, pre);
  const int total = pre[32] * 4;
  for (int r = 0;; ++r) {
    int item = xcd_item(total, r);
    if (item == -1) break;
    if (item < 0) continue;
    int e, mt;
    moe_find(pre, item >> 2, e, mt);
    const int ft = item & 3;
    const int cnt_e = counts[e * CNT_STRIDE];
    int rowbase = 0;
#pragma unroll
    for (int i = 0; i < 32; ++i) if (i == e) rowbase = pre[i] * 256;
    if (tid < 256) {
      int idx = mt * 256 + tid;
      sent[tid] = (idx < cnt_e) ? lists[(size_t)e * T_TOK + idx] : -1;
    }
    unsigned pa[4], pb[4];
    f32x4 acc[8][4];
    zero_acc(acc);
#pragma unroll
    for (int i = 0; i < 4; ++i) {
      pa[i] = (unsigned)((e * 1024 + ft * 256 + sR[i]) * 256 + sC[i]);
      pb[i] = (unsigned)((rowbase + mt * 256 + sR[i]) * 256 + sC[i]);
    }
    gemm_core(wdn, pa, hid16, pb, 4, acc, shm);
#pragma unroll
    for (int n = 0; n < 4; ++n) {
      int en = sent[wc * 64 + n * 16 + fr];
      float rw = (en >= 0) ? route_w[en] : 0.f;
#pragma unroll
      for (int m = 0; m < 8; ++m)
#pragma unroll
        for (int j = 0; j < 4; ++j) acc[m][n][j] *= rw;
    }
    epi_store_f16(acc, shm);
    __syncthreads();
    epi_rows_out(shm, [&](int r) -> f16* { int en = sent[r]; return (en >= 0) ? (y16 + (size_t)en * 1024 + ft * 256) : (f16*)nullptr; });
    __syncthreads();
  }
}


__device__ __forceinline__ unsigned f2key_(float f) {
  if (f == 0.f) f = 0.f;
  unsigned u = __float_as_uint(f);
  return (u & 0x80000000u) ? ~u : (u | 0x80000000u);
}
__device__ __forceinline__ float key2f_(unsigned k) {
  return __uint_as_float((k & 0x80000000u) ? (k & 0x7fffffffu) : ~k);
}
__device__ __forceinline__ void find_bin(const unsigned* hrow, int need, int lane, int* out_bin, int* out_above) {
  uint4 c = *(const uint4*)(hrow + 4 * lane);
  int tot = (int)(c.x + c.y + c.z + c.w);
  int incl = tot;
#pragma unroll
  for (int o = 1; o < 64; o <<= 1) {
    int v = __shfl_down(incl, o, 64);
    if (lane + o < 64) incl += v;
  }
  int above = incl - tot;
  if (above < need && incl >= need) {
    int b;
    if (above + (int)c.w >= need) b = 3;
    else { above += c.w; if (above + (int)c.z >= need) b = 2;
      else { above += c.z; if (above + (int)c.y >= need) b = 1; else { above += c.y; b = 0; } } }
    *out_bin = 4 * lane + b;
    *out_above = above;
  }
}

__device__ __forceinline__ void p_index(const Params& p, char* shm) {
  const f16* proj16 = (const f16*)(p.ws + OFF_B);
  unsigned short* sel16 = (unsigned short*)(p.ws + OFF_SEL);
  unsigned* hist1 = (unsigned*)shm;
  unsigned* hist2 = hist1 + 4096;
  unsigned short* ssel = (unsigned short*)(hist2 + 4096);
  unsigned short* scand = ssel + 4096;
  unsigned* smm = (unsigned*)(scand + 1024);
  unsigned* scnt = smm + 32;
  int* sbin = (int*)(scnt + 32);
  const int tid = opaque_tid(), wid = tid >> 6, lane = tid & 63, fr = lane & 15, fq = lane >> 4;
  const float NINF = -__builtin_huge_valf();
  for (int rnd = 0;; ++rnd) {
    int idx = rnd * gridDim.x + ((rnd & 1) ? (gridDim.x - 1 - blockIdx.x) : blockIdx.x);
    if (idx >= 2048) break;
    const int b = idx & 7, j = 255 - (idx >> 3);
    const int l0 = j * 16, t0 = b * SEQ + l0;
    int sbase = wid * 16 + fq * 4, frq = fr, krow = wid * 16 + fr;
    int wids = __builtin_amdgcn_readfirstlane(wid);
    asm volatile("" : "+v"(sbase), "+v"(frq), "+v"(krow), "+s"(wids));
    if (j < 16) {
      for (int i = tid; i < 4096; i += 512) sel16[(size_t)t0 * 256 + i] = (unsigned short)(i & 255);
      continue;
    }
    for (int i = tid; i < 8192; i += 512) hist1[i] = 0;
    if (tid < 32) scnt[tid] = 0;
    if (tid < 16) { smm[tid] = 0xFFFFFFFFu; smm[16 + tid] = 0u; }
    f16x8 bq[8];
    float wq[8];
    {
      const f16* qrow = proj16 + (size_t)(t0 + fr) * PJ_W;
#pragma unroll
      for (int h = 0; h < 8; ++h) bq[h] = *(const f16x8*)(qrow + C_IQ + h * 32 + fq * 8);
      f16x8 wv = *(const f16x8*)(qrow + C_IW);
#pragma unroll
      for (int h = 0; h < 8; ++h) wq[h] = (float)wv[h];
    }
    __syncthreads();
    const int nkt = j + 1;
    float sc[32][4];
#pragma unroll
    for (int it = 0; it < 32; ++it) {
      const int kt = it * 8 + wids;
      if (kt < nkt) {
        f16x8 a = *(const f16x8*)(proj16 + (size_t)(b * SEQ + it * 128 + krow) * PJ_W + C_IK + fq * 8);
        f32x4 s = {0.f, 0.f, 0.f, 0.f};
#pragma unroll
        for (int h = 0; h < 8; ++h) {
          f32x4 L = __builtin_amdgcn_mfma_f32_16x16x32_f16(a, bq[h], (f32x4){0.f, 0.f, 0.f, 0.f}, 0, 0, 0);
#pragma unroll
          for (int jj = 0; jj < 4; ++jj) s[jj] += wq[h] * fmaxf(L[jj], 0.f);
        }
        if (kt == j) {
#pragma unroll
          for (int jj = 0; jj < 4; ++jj) if (fq * 4 + jj > fr) s[jj] = NINF;
        }
#pragma unroll
        for (int jj = 0; jj < 4; ++jj) sc[it][jj] = s[jj];
      } else {
#pragma unroll
        for (int jj = 0; jj < 4; ++jj) sc[it][jj] = NINF;
      }
      __builtin_amdgcn_sched_barrier(0);
    }
    {
      float mn = __builtin_huge_valf(), mx = NINF;
#pragma unroll
      for (int it = 0; it < 32; ++it)
#pragma unroll
        for (int jj = 0; jj < 4; ++jj) {
          float x = sc[it][jj];
          mx = fmaxf(mx, x);
          mn = fminf(mn, (x == NINF) ? __builtin_huge_valf() : x);
        }
      mn = fminf(mn, __shfl_xor(mn, 16, 64)); mn = fminf(mn, __shfl_xor(mn, 32, 64));
      mx = fmaxf(mx, __shfl_xor(mx, 16, 64)); mx = fmaxf(mx, __shfl_xor(mx, 32, 64));
      if (fq == 0) {
        if (mn != __builtin_huge_valf()) atomicMin(&smm[fr], f2key_(mn));
        if (mx != NINF) atomicMax(&smm[16 + fr], f2key_(mx));
      }
    }
    __syncthreads();
    const float lo = key2f_(smm[fr]), hi = key2f_(smm[16 + fr]);
    const float s1 = (hi > lo) ? 256.0f / (hi - lo) : 0.f;
#pragma unroll
    for (int it = 0; it < 32; ++it) {
      if (it * 8 + wids < nkt) {
#pragma unroll
        for (int jj = 0; jj < 4; ++jj) {
          float x = sc[it][jj];
          if (x != NINF) {
            int b1 = min((int)((x - lo) * s1), 255);
            atomicAdd(&hist1[frq * 256 + b1], 1u);
          }
        }
      }
    }
    __syncthreads();
    for (int qq = 0; qq < 2; ++qq) find_bin(hist1 + (2 * wid + qq) * 256, 256, lane, &sbin[2 * wid + qq], &sbin[16 + 2 * wid + qq]);
    __syncthreads();
    const int b1s = sbin[fr];
#pragma unroll
    for (int it = 0; it < 32; ++it) {
      if (it * 8 + wids < nkt) {
#pragma unroll
        for (int jj = 0; jj < 4; ++jj) {
          float x = sc[it][jj];
          if (x != NINF) {
            float u = (x - lo) * s1;
            int b1 = min((int)u, 255);
            if (b1 == b1s) {
              int b2 = min((int)((u - (float)b1) * 256.0f), 255);
              atomicAdd(&hist2[frq * 256 + b2], 1u);
            }
          }
        }
      }
    }
    __syncthreads();
    for (int qq = 0; qq < 2; ++qq) {
      int q = 2 * wid + qq;
      find_bin(hist2 + q * 256, 256 - sbin[16 + q], lane, &sbin[32 + q], &sbin[48 + q]);
    }
    __syncthreads();
    const int b2s = sbin[32 + fr];
#pragma unroll
    for (int it = 0; it < 32; ++it) {
      if (it * 8 + wids < nkt) {
#pragma unroll
        for (int jj = 0; jj < 4; ++jj) {
          float x = sc[it][jj];
          if (x != NINF) {
            float u = (x - lo) * s1;
            int b1 = min((int)u, 255);
            int cls = 0;
            if (b1 > b1s) cls = 1;
            else if (b1 == b1s) {
              int b2 = min((int)((u - (float)b1) * 256.0f), 255);
              cls = (b2 > b2s) ? 1 : ((b2 == b2s) ? 2 : 0);
            }
            unsigned short sidx = (unsigned short)(sbase + it * 128 + jj);
            if (cls == 1) {
              unsigned pos = atomicAdd(&scnt[frq], 1u);
              if (pos < 256) ssel[frq * 256 + pos] = sidx;
            } else if (cls == 2) {
              unsigned cp = atomicAdd(&scnt[16 + frq], 1u);
              if (cp < 64) scand[frq * 64 + cp] = sidx;
            }
          }
        }
      }
    }
    __syncthreads();
    for (int qq = 0; qq < 2; ++qq) {
      int q = 2 * wid + qq;
      int base = (int)scnt[q], c = min((int)scnt[16 + q], 64), r = 256 - base;
      if (lane < c) {
        unsigned short my = scand[q * 64 + lane];
        int rank = 0;
        for (int k = 0; k < c; ++k) rank += (scand[q * 64 + k] < my) ? 1 : 0;
        if (rank < r) ssel[q * 256 + base + rank] = my;
      }
    }
    __syncthreads();
    *(uint4*)(sel16 + (size_t)t0 * 256 + tid * 8) = *(const uint4*)(ssel + tid * 8);
    __syncthreads();
  }
}


typedef short s16x4 __attribute__((ext_vector_type(4)));
#define VROW 160
#define ATT_WAVE_LDS (64 * VROW + 512)
__device__ __forceinline__ f16x8 tr_pair(const char* a, const char* b) {
  s16x4 x = __builtin_amdgcn_ds_read_tr16_b64_v4i16((__attribute__((address_space(3))) s16x4*)(a));
  s16x4 y = __builtin_amdgcn_ds_read_tr16_b64_v4i16((__attribute__((address_space(3))) s16x4*)(b));
  typedef short s16x8 __attribute__((ext_vector_type(8)));
  s16x8 r = __builtin_shufflevector(x, y, 0, 1, 2, 3, 4, 5, 6, 7);
  return __builtin_bit_cast(f16x8, r);
}
__device__ __forceinline__ void p_attn(const Params& p, char* shm) {
  const f16* proj16 = (const f16*)(p.ws + OFF_B);
  const unsigned short* sel16 = (const unsigned short*)(p.ws + OFF_SEL);
  f16* pa16 = (f16*)(p.ws + OFF_D);
  const int tid = opaque_tid(), wid = tid >> 6, lane = tid & 63, fr = lane & 15, fq = lane >> 4;
  char* vimg = shm + wid * ATT_WAVE_LDS;
  unsigned short* ssel = (unsigned short*)(vimg + 64 * VROW);
  for (int t = blockIdx.x * 8 + wid; t < T_TOK; t += gridDim.x * 8) {
    const int l = t & (SEQ - 1), b0 = t - l, cnt = min(l + 1, 256);
    {
      uint2 sv = *(const uint2*)(sel16 + (size_t)t * 256 + lane * 4);
      unsigned short i0 = sv.x & 0xffff, i1 = sv.x >> 16, i2 = sv.y & 0xffff, i3 = sv.y >> 16;
      int s0 = lane * 4;
      ushort4 o;
      o.x = (s0 + 0 < cnt) ? (unsigned short)min((int)i0, l) : 0;
      o.y = (s0 + 1 < cnt) ? (unsigned short)min((int)i1, l) : 0;
      o.z = (s0 + 2 < cnt) ? (unsigned short)min((int)i2, l) : 0;
      o.w = (s0 + 3 < cnt) ? (unsigned short)min((int)i3, l) : 0;
      *(ushort4*)(ssel + s0) = o;
    }
    asm volatile("s_waitcnt lgkmcnt(0)" ::: "memory");
    f16x8 bq0, bq1;
    {
      const f16* qp = proj16 + (size_t)t * PJ_W + C_Q + (fr & 7) * 64 + fq * 8;
      bq0 = *(const f16x8*)qp;
      bq1 = *(const f16x8*)(qp + 32);
#pragma unroll
      for (int e = 0; e < 8; ++e) { bq0[e] = (fr < 8) ? bq0[e] * (f16)0.125f : (f16)0.f; bq1[e] = (fr < 8) ? bq1[e] * (f16)0.125f : (f16)0.f; }
    }
    const f16* kbase = proj16 + (size_t)b0 * PJ_W + C_K + fq * 8;
    const f16* vbase = proj16 + (size_t)b0 * PJ_W + C_V + (lane & 7) * 8;
    f32x4 S[16];
#pragma unroll
    for (int kt = 0; kt < 16; ++kt) {
      int kidx = ssel[kt * 16 + fr];
      const f16* kp = kbase + (size_t)kidx * PJ_W;
      f16x8 a0 = *(const f16x8*)kp, a1 = *(const f16x8*)(kp + 32);
      f32x4 z = {0.f, 0.f, 0.f, 0.f};
      z = __builtin_amdgcn_mfma_f32_16x16x32_f16(a0, bq0, z, 0, 0, 0);
      z = __builtin_amdgcn_mfma_f32_16x16x32_f16(a1, bq1, z, 0, 0, 0);
#pragma unroll
      for (int j = 0; j < 4; ++j) S[kt][j] = (kt * 16 + fq * 4 + j < cnt) ? z[j] : NEG_BIG;
    }
    float m = NEG_BIG;
#pragma unroll
    for (int kt = 0; kt < 16; ++kt)
#pragma unroll
      for (int j = 0; j < 4; ++j) m = fmaxf(m, S[kt][j]);
    m = fmaxf(m, __shfl_xor(m, 16, 64));
    m = fmaxf(m, __shfl_xor(m, 32, 64));
    float lsum = 0.f;
    f16x8 P[8];
#pragma unroll
    for (int c = 0; c < 8; ++c)
#pragma unroll
      for (int j = 0; j < 4; ++j) {
        float e0 = __expf(S[2 * c][j] - m), e1 = __expf(S[2 * c + 1][j] - m);
        lsum += e0 + e1;
        P[c][j] = (f16)e0;
        P[c][4 + j] = (f16)e1;
      }
    lsum += __shfl_xor(lsum, 16, 64);
    lsum += __shfl_xor(lsum, 32, 64);
    f32x4 O[4];
#pragma unroll
    for (int nt = 0; nt < 4; ++nt) O[nt] = (f32x4){0.f, 0.f, 0.f, 0.f};
#pragma unroll 1
    for (int rr = 0; rr < 4; ++rr) {
      f16x8 vv[8];
#pragma unroll
      for (int i = 0; i < 8; ++i) {
        int r = (lane >> 3) + 8 * i;
        int vidx = ssel[rr * 64 + r];
        vv[i] = *(const f16x8*)(vbase + (size_t)vidx * PJ_W);
      }
      asm volatile("s_waitcnt lgkmcnt(0)" ::: "memory");
#pragma unroll
      for (int i = 0; i < 8; ++i) {
        int r = (lane >> 3) + 8 * i;
        *(f16x8*)(vimg + r * VROW + (lane & 7) * 16) = vv[i];
      }
      asm volatile("s_waitcnt lgkmcnt(0)" ::: "memory");
#pragma unroll
      for (int cc = 0; cc < 2; ++cc) {
        const char* ra = vimg + (cc * 32 + fq * 4 + (fr >> 2)) * VROW + (fr & 3) * 8;
#pragma unroll
        for (int nt = 0; nt < 4; ++nt) {
          f16x8 B = tr_pair(ra + nt * 32, ra + 16 * VROW + nt * 32);
          f16x8 A = (rr == 0) ? P[cc] : (rr == 1) ? P[2 + cc] : (rr == 2) ? P[4 + cc] : P[6 + cc];
          O[nt] = __builtin_amdgcn_mfma_f32_16x16x32_f16(A, B, O[nt], 0, 0, 0);
        }
      }
    }
    asm volatile("s_waitcnt lgkmcnt(0)" ::: "memory");
#pragma unroll
    for (int j = 0; j < 4; ++j) {
      float ls = __shfl(lsum, (fq & 1) * 4 + j, 64);
      float inv = 1.0f / ls;
      if (fq < 2) {
        f16* op = pa16 + (size_t)t * DM + 512 + (fq * 4 + j) * 64 + fr;
#pragma unroll
        for (int nt = 0; nt < 4; ++nt) op[nt * 16] = (f16)(O[nt][j] * inv);
      }
    }
  }
}


#define DL_LD 1040
__device__ __forceinline__ void p_pool(const Params& p, char* shm) {
  const f16* proj16 = (const f16*)(p.ws + OFF_B);
  const f16* wpl = (const f16*)(p.ws + OFF_WPOOL);
  f16* pa16 = (f16*)(p.ws + OFF_D);
  const int tid = opaque_tid(), wid = tid >> 6, lane = tid & 63, fr = lane & 15, fq = lane >> 4;
  for (int item = blockIdx.x; item < T_TOK / 64; item += gridDim.x) {
    const int t0 = item * 64;
    {
      const int cp = tid & 255, th = tid >> 8;
      const int c = cp * 2, g = c >> 7, w = 2 << g;
      const int ts = t0 + th * 32, l_s = ts & (SEQ - 1);
      float s0 = 0.f, s1 = 0.f;
      for (int k = 1; k < w; ++k) {
        if (l_s - k >= 0) {
          f16x2 u = *(const f16x2*)(proj16 + (size_t)(ts - k) * PJ_W + c);
          s0 += (float)u[0]; s1 += (float)u[1];
        }
      }
      for (int i = 0; i < 32; ++i) {
        const int t = ts + i, l = l_s + i;
        f16x2 u = *(const f16x2*)(proj16 + (size_t)t * PJ_W + c);
        s0 += (float)u[0]; s1 += (float)u[1];
        float inv = 1.0f / (float)min(l + 1, w);
        f16x2 d;
        d[0] = (f16)(s0 * inv - (float)u[0]); d[1] = (f16)(s1 * inv - (float)u[1]);
        *(f16x2*)(shm + (th * 32 + i) * DL_LD + c * 2) = d;
        if (l - (w - 1) >= 0) {
          f16x2 uo = *(const f16x2*)(proj16 + (size_t)(t - (w - 1)) * PJ_W + c);
          s0 -= (float)uo[0]; s1 -= (float)uo[1];
        }
      }
    }
    __syncthreads();
    {
      const int g = wid >> 1, eh = wid & 1;
      f32x4 acc[4][4];
#pragma unroll
      for (int m = 0; m < 4; ++m)
#pragma unroll
        for (int n = 0; n < 4; ++n) acc[m][n] = (f32x4){0.f, 0.f, 0.f, 0.f};
#pragma unroll
      for (int ks = 0; ks < 4; ++ks) {
        f16x8 A[4], B[4];
#pragma unroll
        for (int m = 0; m < 4; ++m) A[m] = *(const f16x8*)(wpl + (size_t)(g * 128 + eh * 64 + m * 16 + fr) * 128 + ks * 32 + fq * 8);
#pragma unroll
        for (int n = 0; n < 4; ++n) B[n] = *(const f16x8*)(shm + (n * 16 + fr) * DL_LD + (g * 128 + ks * 32 + fq * 8) * 2);
#pragma unroll
        for (int m = 0; m < 4; ++m)
#pragma unroll
          for (int n = 0; n < 4; ++n) acc[m][n] = __builtin_amdgcn_mfma_f32_16x16x32_f16(A[m], B[n], acc[m][n], 0, 0, 0);
      }
#pragma unroll
      for (int m = 0; m < 4; ++m) {
        const int e0 = g * 128 + eh * 64 + m * 16 + fq * 4;
        float4 sc = *(const float4*)(p.pool_scale + e0);
#pragma unroll
        for (int n = 0; n < 4; ++n) {
          f16x4 o;
          o[0] = (f16)(acc[m][n][0] * sc.x); o[1] = (f16)(acc[m][n][1] * sc.y);
          o[2] = (f16)(acc[m][n][2] * sc.z); o[3] = (f16)(acc[m][n][3] * sc.w);
          *(f16x4*)(pa16 + (size_t)(t0 + n * 16 + fr) * DM + e0) = o;
        }
      }
    }
    __syncthreads();
  }
}

#define RT_LDS (36 * 1024 * 4)
__device__ __forceinline__ void p_ln1_route(const Params& p, char* shm) {
  const float* z32 = (const float*)(p.ws + OFF_C);
  f16* h1 = (f16*)(p.ws + OFF_A);
  int* route_e = (int*)(p.ws + OFF_ROUTE_E);
  float* route_w = (float*)(p.ws + OFF_ROUTE_W);
  int* counts = (int*)(p.ws + OFF_CNT);
  int* lists = (int*)(p.ws + OFF_LISTS);
  float* sW = (float*)shm;
  int* lcnt = (int*)(shm + RT_LDS);
  int* lent = lcnt + 128;
  const int tid = opaque_tid(), wid = tid >> 6, lane = tid & 63;
  if (tid < 128) lcnt[tid] = 0;
  for (int i = tid; i < 36 * 1024; i += 512) {
    int o = i >> 10, k = i & 1023;
    sW[i] = (o < 4) ? p.w_group[k * 4 + o] : p.w_router[k * 32 + (o - 4)];
  }
  __syncthreads();
  const int nw = gridDim.x * 8;
  for (int pr = blockIdx.x * 8 + wid; pr < T_TOK / 2; pr += nw) {
    const int t = pr * 2;
    float v[2][16];
#pragma unroll
    for (int r = 0; r < 2; ++r)
#pragma unroll
      for (int i = 0; i < 4; ++i) {
        float4 x = *(const float4*)(z32 + (size_t)(t + r) * DM + i * 256 + lane * 4);
        v[r][i * 4 + 0] = x.x; v[r][i * 4 + 1] = x.y; v[r][i * 4 + 2] = x.z; v[r][i * 4 + 3] = x.w;
      }
#pragma unroll
    for (int r = 0; r < 2; ++r) {
      float s = 0.f;
#pragma unroll
      for (int i = 0; i < 16; ++i) s += v[r][i];
      float mu = wave_sum(s) * (1.0f / DM);
      float q = 0.f;
#pragma unroll
      for (int i = 0; i < 16; ++i) { v[r][i] -= mu; q += v[r][i] * v[r][i]; }
      float rs = rsqrtf(wave_sum(q) * (1.0f / DM) + 1e-5f);
#pragma unroll
      for (int i = 0; i < 4; ++i) {
        float4 g = *(const float4*)(p.ln1_g + i * 256 + lane * 4), b = *(const float4*)(p.ln1_b + i * 256 + lane * 4);
        v[r][i * 4 + 0] = v[r][i * 4 + 0] * rs * g.x + b.x; v[r][i * 4 + 1] = v[r][i * 4 + 1] * rs * g.y + b.y;
        v[r][i * 4 + 2] = v[r][i * 4 + 2] * rs * g.z + b.z; v[r][i * 4 + 3] = v[r][i * 4 + 3] * rs * g.w + b.w;
        f16x4 o;
        o[0] = (f16)v[r][i * 4 + 0]; o[1] = (f16)v[r][i * 4 + 1]; o[2] = (f16)v[r][i * 4 + 2]; o[3] = (f16)v[r][i * 4 + 3];
        *(f16x4*)(h1 + (size_t)(t + r) * DM + i * 256 + lane * 4) = o;
      }
    }
    float mine0 = 0.f, mine1 = 0.f;
#pragma unroll 2
    for (int o = 0; o < 36; ++o) {
      float a0 = 0.f, a1 = 0.f;
#pragma unroll
      for (int i = 0; i < 4; ++i) {
        float4 w = *(const float4*)(sW + o * 1024 + i * 256 + lane * 4);
        a0 += v[0][i * 4 + 0] * w.x + v[0][i * 4 + 1] * w.y + v[0][i * 4 + 2] * w.z + v[0][i * 4 + 3] * w.w;
        a1 += v[1][i * 4 + 0] * w.x + v[1][i * 4 + 1] * w.y + v[1][i * 4 + 2] * w.z + v[1][i * 4 + 3] * w.w;
      }
      a0 = wave_sum(a0); a1 = wave_sum(a1);
      if (lane == o) { mine0 = a0; mine1 = a1; }
    }
    {
      const int r = lane & 1;
      float gl[4];
#pragma unroll
      for (int o = 0; o < 4; ++o) {
        float x0 = __shfl(mine0, o, 64), x1 = __shfl(mine1, o, 64);
        gl[o] = (r ? x1 : x0) + p.b_group[o];
      }
      int g = 0;
      float m = gl[0];
#pragma unroll
      for (int o = 1; o < 4; ++o) if (gl[o] > m) { m = gl[o]; g = o; }
      float se = 0.f;
#pragma unroll
      for (int o = 0; o < 4; ++o) se += __expf(gl[o] - m);
      float pg = 1.0f / se;
      float v1 = -3e38f, v2 = -3e38f;
      int i1 = 0, i2 = 0;
#pragma unroll
      for (int jx = 0; jx < 8; ++jx) {
        float x0 = __shfl(mine0, 4 + g * 8 + jx, 64), x1 = __shfl(mine1, 4 + g * 8 + jx, 64);
        float x = (r ? x1 : x0) + p.b_router[g * 8 + jx];
        if (x > v1) { v2 = v1; i2 = i1; v1 = x; i1 = jx; }
        else if (x > v2) { v2 = x; i2 = jx; }
      }
      if (lane < 2) {
        const int tt = t + r;
        float e2 = __expf(v2 - v1);
        float w1 = pg / (1.0f + e2), w2 = pg * e2 / (1.0f + e2);
        int ea = g * 8 + i1, eb = g * 8 + i2;
        route_e[2 * tt] = ea; route_e[2 * tt + 1] = eb;
        route_w[2 * tt] = w1; route_w[2 * tt + 1] = w2;
        int la = atomicAdd(&lcnt[ea], 1), lb = atomicAdd(&lcnt[eb], 1);
        int slot = atomicAdd(&lcnt[64], 2);
        if (slot + 1 < 512) {
          lent[2 * slot] = (ea << 16) | la; lent[2 * slot + 1] = 2 * tt;
          lent[2 * slot + 2] = (eb << 16) | lb; lent[2 * slot + 3] = 2 * tt + 1;
        }
      }
    }
  }
  __syncthreads();
  if (tid < 32) lcnt[32 + tid] = atomicAdd(&counts[tid * CNT_STRIDE], lcnt[tid]);
  __syncthreads();
  {
    const int n_ent = min(lcnt[64], 512);
    for (int i = tid; i < n_ent; i += 512) {
      int ev = lent[2 * i], id = lent[2 * i + 1];
      int e = ev >> 16, lp = ev & 0xffff;
      lists[(size_t)e * T_TOK + lcnt[32 + e] + lp] = id;
    }
  }
  __syncthreads();
}

__device__ __forceinline__ void p_final(const Params& p) {
  const f16* h1 = (const f16*)(p.ws + OFF_A);
  const f16* y16 = (const f16*)(p.ws + OFF_C);
  const int tid = opaque_tid(), wid = tid >> 6, lane = tid & 63;
  const int nw = gridDim.x * 8;
  for (int t = blockIdx.x * 8 + wid; t < T_TOK; t += nw) {
    float v[16];
#pragma unroll
    for (int i = 0; i < 2; ++i) {
      f16x8 hv = *(const f16x8*)(h1 + (size_t)t * DM + i * 512 + lane * 8);
      f16x8 y0 = *(const f16x8*)(y16 + (size_t)(2 * t) * DM + i * 512 + lane * 8);
      f16x8 y1 = *(const f16x8*)(y16 + (size_t)(2 * t + 1) * DM + i * 512 + lane * 8);
#pragma unroll
      for (int e = 0; e < 8; ++e) v[i * 8 + e] = ALPHA * (float)hv[e] + ((float)y0[e] + (float)y1[e]);
    }
    float s = 0.f;
#pragma unroll
    for (int i = 0; i < 16; ++i) s += v[i];
    float mu = wave_sum(s) * (1.0f / DM);
    float q = 0.f;
#pragma unroll
    for (int i = 0; i < 16; ++i) { v[i] -= mu; q += v[i] * v[i]; }
    float rs = rsqrtf(wave_sum(q) * (1.0f / DM) + 1e-5f);
#pragma unroll
    for (int i = 0; i < 2; ++i)
#pragma unroll
      for (int hf = 0; hf < 2; ++hf) {
        const int c = i * 512 + lane * 8 + hf * 4;
        float4 g = *(const float4*)(p.ln2_g + c), b = *(const float4*)(p.ln2_b + c);
        float4 o;
        o.x = v[i * 8 + hf * 4 + 0] * rs * g.x + b.x; o.y = v[i * 8 + hf * 4 + 1] * rs * g.y + b.y;
        o.z = v[i * 8 + hf * 4 + 2] * rs * g.z + b.z; o.w = v[i * 8 + hf * 4 + 3] * rs * g.w + b.w;
        *(float4*)(p.out + (size_t)t * DM + c) = o;
      }
  }
}

#define MEGA_LDS 153600


#define XB_TMO      128
#define XB_XCNT(j)  (256  + 64 * (j))
#define XB_XSUB(j)  (1280 + 64 * (j))
#define XB_XGEN(j)  (2304 + 64 * (j))
#define XB_TOP      3328
#define XB_TOPGEN   3392
#define XCD_BAR_WORDS 3456
#define XB_SPIN_CAP (1u << 22)
#define LAS __attribute__((address_space(3)))
__device__ __forceinline__ unsigned xb_ld(unsigned* p) { return __hip_atomic_load(p, __ATOMIC_RELAXED, __HIP_MEMORY_SCOPE_AGENT); }
__device__ __forceinline__ unsigned xb_add(unsigned* p, unsigned v) { return __hip_atomic_fetch_add(p, v, __ATOMIC_RELAXED, __HIP_MEMORY_SCOPE_AGENT); }
__device__ __forceinline__ unsigned xb_xcc_id() { return (unsigned)__builtin_amdgcn_s_getreg((3 << 11) | 20) & 0xFu; }
#define XB_SPIN(cond, bar) do { unsigned _sp = 0; while (cond) { __builtin_amdgcn_s_sleep(1); \
    if ((++_sp & 255u) == 0u) { if (xb_ld(&(bar)[XB_TMO])) break; if (_sp > XB_SPIN_CAP) { atomicAdd(&(bar)[XB_TMO], 1u); break; } } } } while (0)
struct XcdBarrier { unsigned* bar; unsigned x; volatile unsigned* st; };
__device__ __forceinline__ XcdBarrier xcd_barrier_post(unsigned* bar, volatile unsigned* st) {
  XcdBarrier b; b.bar = bar; b.x = xb_xcc_id(); b.st = st;
  if (threadIdx.x == 0) (void)xb_add(&bar[XB_XCNT(b.x)], 1u);
  return b;
}
__device__ __forceinline__ void xcd_barrier_complete(unsigned* bar, unsigned x, unsigned& nloc, unsigned& nx) {
  const unsigned G = gridDim.x * gridDim.y * gridDim.z;
  unsigned sum, cnt, mine, sp = 0u;
  for (;;) {
    sum = 0u; cnt = 0u; mine = 0u;
#pragma unroll
    for (unsigned j = 0; j < 16; ++j) { const unsigned c = xb_ld(&bar[XB_XCNT(j)]); sum += c; cnt += (c > 0u) ? 1u : 0u; mine = (j == x) ? c : mine; }
    if (sum == G) break;
    __builtin_amdgcn_s_sleep(1);
    if ((++sp & 255u) == 0u) { if (xb_ld(&bar[XB_TMO])) break; if (sp > XB_SPIN_CAP) { atomicAdd(&bar[XB_TMO], 1u); break; } }
  }
  nloc = mine > 0u ? mine : 1u; nx = cnt > 0u ? cnt : 1u;
}
__device__ __forceinline__ void xcd_barrier(const XcdBarrier& b) {
  asm volatile("s_waitcnt vmcnt(0)" ::: "memory");
  __syncthreads();
  if (threadIdx.x == 0) {
    unsigned* bar = b.bar;
    __builtin_amdgcn_s_waitcnt(0);
    unsigned nloc = b.st[0], nx = b.st[1];
    if (nloc == 0u) { xcd_barrier_complete(bar, b.x, nloc, nx); b.st[0] = nloc; b.st[1] = nx; }
    const unsigned old = xb_add(&bar[XB_XSUB(b.x)], 1u);
    const unsigned gen = old / nloc;
    if (old + 1u == (gen + 1u) * nloc) {
      __builtin_amdgcn_fence(__ATOMIC_RELEASE, "agent");
      asm volatile("s_waitcnt vmcnt(0)" ::: "memory");
      const unsigned og = xb_add(&bar[XB_TOP], 1u);
      const unsigned tg = og / nx;
      if (og + 1u == (tg + 1u) * nx) xb_add(&bar[XB_TOPGEN], 1u);
      else XB_SPIN(xb_ld(&bar[XB_TOPGEN]) == tg, bar);
      __builtin_amdgcn_fence(__ATOMIC_ACQUIRE, "agent");
      xb_add(&bar[XB_XGEN(b.x)], 1u);
      asm volatile("s_waitcnt vmcnt(0)" ::: "memory");
    } else {
      XB_SPIN(xb_ld(&bar[XB_XGEN(b.x)]) == gen, bar);
      __builtin_amdgcn_fence(__ATOMIC_ACQUIRE, "agent");
      asm volatile("s_waitcnt vmcnt(0)" ::: "memory");
    }
  }
  __syncthreads();
}

#ifndef PROBE
#define PROBE 0
#endif
#define GSYNC() xcd_barrier(xb)
#define PH(n, code) do { code; if (PROBE == n) { GSYNC(); code; } } while (0)
__global__ __launch_bounds__(512) void mega(Params p) {
  __shared__ __attribute__((aligned(1024))) char shm[MEGA_LDS + 16];
  cg::grid_group grid = cg::this_grid();
  volatile unsigned* xst = (volatile unsigned*)(shm + MEGA_LDS);
  if (threadIdx.x < 4) xst[threadIdx.x] = 0u;
  __syncthreads();
  XcdBarrier xb = xcd_barrier_post((unsigned*)(p.ws + OFF_BAR), xst);
  if (blockIdx.x == 0 && threadIdx.x < 32) ((int*)(p.ws + OFF_CNT))[threadIdx.x * CNT_STRIDE] = 0;
  PH(1, p_ln_in(p));
  PH(2, p_convert(p, shm));
  grid.sync();
  PH(3, p_inproj(p, shm));
  GSYNC();
  PH(4, p_pool(p, shm));
  PH(5, p_index(p, shm));
  GSYNC();
  PH(6, p_attn(p, shm));
  GSYNC();
  PH(7, p_merge(p, shm));
  GSYNC();
  PH(8, p_resid(p, shm));
  GSYNC();
  p_ln1_route(p, shm);
  GSYNC();
  PH(10, p_moe_a(p, shm));
  GSYNC();
  PH(11, p_moe_b(p, shm));
  GSYNC();
  PH(12, p_final(p));
}

extern "C" void kernel_launch(void* const* d_in, const int* in_sizes, int n_in, void* d_out, int out_size, void* d_ws,
                              size_t ws_size, hipStream_t stream) {
  if (ws_size < WS_NEEDED) { fprintf(stderr, "ws too small: %zu < %zu\n", ws_size, (size_t)WS_NEEDED); return; }
  static int grid_blocks = 0;
  if (!grid_blocks) {
    int dev = 0, cus = 0, per_cu = 0;
    hipGetDevice(&dev);
    hipDeviceGetAttribute(&cus, hipDeviceAttributeMultiprocessorCount, dev);
    hipOccupancyMaxActiveBlocksPerMultiprocessor(&per_cu, mega, 512, 0);
    if (per_cu > 1) per_cu = 1;
    grid_blocks = cus * per_cu;
    fprintf(stderr, "mega: cus=%d per_cu=%d grid=%d\n", cus, per_cu, grid_blocks);
  }
  Params p{};
  const float** pp = (const float**)&p;
  for (int i = 0; i < 21; ++i) pp[i] = (const float*)d_in[i];
  p.out = (float*)d_out;
  p.ws = (char*)d_ws;
  (void)hipMemsetAsync((char*)d_ws + OFF_BAR, 0, 16384, stream);
  void* args[] = {&p};
  hipError_t e = hipLaunchCooperativeKernel((void*)mega, dim3(grid_blocks), dim3(512), args, 0, stream);
  if (e != hipSuccess) fprintf(stderr, "cooperative launch failed: %s (grid %d)\n", hipGetErrorString(e), grid_blocks);
}
```

```cpp
#include <hip/hip_runtime.h>
#include <hip/hip_fp16.h>
#include <hip/hip_cooperative_groups.h>
#include <stdint.h>
#include <stdio.h>
namespace cg = cooperative_groups;

typedef _Float16 f16;
typedef f16 f16x8 __attribute__((ext_vector_type(8)));
typedef f16 f16x4 __attribute__((ext_vector_type(4)));
typedef f16 f16x2 __attribute__((ext_vector_type(2)));
typedef float f32x4 __attribute__((ext_vector_type(4)));
typedef int i32x4 __attribute__((ext_vector_type(4)));

#define T_TOK 32768
#define DM 1024
#define SEQ 4096
#define PJ_W 1536
#define PA_W 1448
#define IN_W 3496
#define IN_WP 3584
#define C_Q 512
#define C_K 1024
#define C_V 1088
#define C_IQ 1152
#define C_IK 1408
#define C_IW 1440
#define ALPHA 1.189207115002721f
#define NEG_BIG (-1e30f)

#define SZ_A   ((size_t)T_TOK * DM * 2)
#define SZ_B   ((size_t)T_TOK * PJ_W * 2)
#define SZ_C   ((size_t)T_TOK * 2048 * 2)
#define SZ_D   ((size_t)T_TOK * DM * 2)
#define OFF_A  ((size_t)0)
#define OFF_B  (OFF_A + SZ_A)
#define OFF_C  (OFF_B + SZ_B)
#define OFF_D  (OFF_C + SZ_C)
#define OFF_W  (OFF_D + SZ_D)
#define OFF_WIN   (OFF_W)
#define OFF_WPOOL (OFF_WIN + (size_t)IN_WP * 1024 * 2)
#define OFF_WPP   (OFF_WPOOL + (size_t)4 * 128 * 128 * 2)
#define OFF_WPA   (OFF_WPP + (size_t)1024 * 512 * 2)
#define OFF_WOUT  (OFF_WPA + (size_t)1024 * 512 * 2)
#define OFF_WGU   (OFF_WOUT + (size_t)1024 * 1024 * 2)
#define OFF_WDN   (OFF_WGU + (size_t)32 * 512 * 1024 * 2)
#define OFF_MISC  (OFF_WDN + (size_t)32 * 1024 * 256 * 2)
#define OFF_ROUTE_E (OFF_MISC)
#define OFF_ROUTE_W (OFF_ROUTE_E + (size_t)T_TOK * 2 * 4)
#define OFF_COUNTS  (OFF_ROUTE_W + (size_t)T_TOK * 2 * 4)
#define OFF_LISTS   (OFF_COUNTS + 256)
#define OFF_SEL     (OFF_LISTS + (size_t)32 * T_TOK * 4)
#define OFF_CNT      (OFF_SEL + (size_t)T_TOK * 256 * 2)
#define OFF_BAR      (OFF_CNT + 4096)
#define WS_NEEDED   (OFF_BAR + 16384)
#define CNT_STRIDE 32

struct Params {
  const float *x, *ln_in_g, *ln_in_b, *w_in, *b_gate, *pool_w, *pool_scale, *wpp, *wpa, *w_out, *ln1_g, *ln1_b, *w_group,
      *b_group, *w_router, *b_router, *w_gate, *w_up, *w_down, *ln2_g, *ln2_b;
  float* out;
  char* ws;
};

__device__ __forceinline__ float wave_sum(float v) {
#pragma unroll
  for (int o = 32; o > 0; o >>= 1) v += __shfl_xor(v, o, 64);
  return v;
}
__device__ __forceinline__ float wave_max(float v) {
#pragma unroll
  for (int o = 32; o > 0; o >>= 1) v = fmaxf(v, __shfl_xor(v, o, 64));
  return v;
}
__device__ __forceinline__ int wave_sum_i(int v) {
#pragma unroll
  for (int o = 32; o > 0; o >>= 1) v += __shfl_xor(v, o, 64);
  return v;
}
__device__ __forceinline__ int opaque_tid() { int t = threadIdx.x; asm volatile("" : "+v"(t)); return t; }
__device__ __forceinline__ float ldf(const float* p) { return *p; }
__device__ __forceinline__ float ldf(const f16* p) { return (float)*p; }

#define WAIT_V(n) asm volatile("s_waitcnt vmcnt(%0)" ::"n"(n) : "memory")
#define WAIT_L(n) asm volatile("s_waitcnt lgkmcnt(%0)" ::"n"(n) : "memory")

__device__ __forceinline__ int lds_byte(int r, int c) {
  int st = (r >> 4) * 2 + (c >> 5), ob = (r & 15) * 64 + (c & 31) * 2;
  return st * 1024 + (ob ^ (((ob >> 9) & 1) << 5));
}
__device__ __forceinline__ void stage_rc(int b, int& R, int& C) {
  int st = b >> 10, sb = b & 1023, swz = sb ^ (((sb >> 9) & 1) << 5);
  R = (st >> 1) * 16 + swz / 64;
  C = (st & 1) * 32 + (swz % 64) / 2;
}

#define TILE_B 32768
#define STAGE_B 65536
#define GEMM_LDS 135168
#define EPI_LD 528

__device__ __forceinline__ void gemm_core(const f16* __restrict__ Ab, const unsigned (&pa)[4], const f16* __restrict__ Bb,
                                          const unsigned (&pb)[4], int nt, f32x4 (&acc)[8][4], char* shm) {
  const int tid = opaque_tid(), wid = tid >> 6, lane = tid & 63, wr = wid >> 2, wc = wid & 3, fr = lane & 15, fq = lane >> 4;
#define SA(b) (shm + (b) * STAGE_B)
#define SB(b) (shm + (b) * STAGE_B + TILE_B)
#define GLDS_STAGE(buf, kt)                                                                                              \
  do {                                                                                                                   \
    _Pragma("unroll") for (int i = 0; i < 4; ++i) {                                                                     \
      __builtin_amdgcn_global_load_lds((const unsigned*)(Ab + pa[i] + (kt) * 64), (unsigned*)(SA(buf) + wid * 1024 + i * 8192), \
                                       16, 0, 0);                                                                        \
      __builtin_amdgcn_global_load_lds((const unsigned*)(Bb + pb[i] + (kt) * 64), (unsigned*)(SB(buf) + wid * 1024 + i * 8192), \
                                       16, 0, 0);                                                                        \
    }                                                                                                                    \
  } while (0)
  GLDS_STAGE(0, 0);
  WAIT_V(0);
  __syncthreads();
  for (int t = 0; t < nt; ++t) {
    const int cur = t & 1;
    if (t + 1 < nt) GLDS_STAGE(cur ^ 1, t + 1);
#pragma unroll
    for (int ks = 0; ks < 2; ++ks) {
      f16x8 At[8], Bf[4];
#pragma unroll
      for (int m = 0; m < 8; ++m) At[m] = *(const f16x8*)(SA(cur) + lds_byte(wr * 128 + m * 16 + fr, ks * 32 + fq * 8));
#pragma unroll
      for (int n = 0; n < 4; ++n) Bf[n] = *(const f16x8*)(SB(cur) + lds_byte(wc * 64 + n * 16 + fr, ks * 32 + fq * 8));
#pragma unroll
      for (int m = 0; m < 8; ++m)
#pragma unroll
        for (int n = 0; n < 4; ++n) acc[m][n] = __builtin_amdgcn_mfma_f32_16x16x32_f16(At[m], Bf[n], acc[m][n], 0, 0, 0);
      __builtin_amdgcn_sched_barrier(0);
    }
    WAIT_V(0);
    __syncthreads();
  }
#undef SA
#undef SB
#undef GLDS_STAGE
}

__device__ __forceinline__ void epi_store_f16(const f32x4 (&acc)[8][4], char* shm) {
  const int tid = opaque_tid(), wid = tid >> 6, lane = tid & 63, wr = wid >> 2, wc = wid & 3, fr = lane & 15, fq = lane >> 4;
#pragma unroll
  for (int m = 0; m < 8; ++m)
#pragma unroll
    for (int n = 0; n < 4; ++n) {
      f16x4 v;
      v[0] = (f16)acc[m][n][0]; v[1] = (f16)acc[m][n][1]; v[2] = (f16)acc[m][n][2]; v[3] = (f16)acc[m][n][3];
      *(f16x4*)(shm + (wc * 64 + n * 16 + fr) * EPI_LD + (wr * 128 + m * 16 + fq * 4) * 2) = v;
    }
}

__device__ __forceinline__ void p_ln_in(const Params& p) {
  f16* h16 = (f16*)(p.ws + OFF_A);
  const int tid = opaque_tid(), lane = tid & 63, wid = tid >> 6;
  const int nw = gridDim.x * 8;
  for (int t = blockIdx.x * 8 + wid; t < T_TOK; t += nw) {
    const float* xr = p.x + (size_t)t * DM;
    float4 v[4];
#pragma unroll
    for (int i = 0; i < 4; ++i) v[i] = *(const float4*)(xr + i * 256 + lane * 4);
    float s = 0.f;
#pragma unroll
    for (int i = 0; i < 4; ++i) s += v[i].x + v[i].y + v[i].z + v[i].w;
    float mu = wave_sum(s) * (1.0f / DM);
    float q = 0.f;
#pragma unroll
    for (int i = 0; i < 4; ++i) {
      v[i].x -= mu; v[i].y -= mu; v[i].z -= mu; v[i].w -= mu;
      q += v[i].x * v[i].x + v[i].y * v[i].y + v[i].z * v[i].z + v[i].w * v[i].w;
    }
    float rs = rsqrtf(wave_sum(q) * (1.0f / DM) + 1e-5f);
#pragma unroll
    for (int i = 0; i < 4; ++i) {
      float4 g = *(const float4*)(p.ln_in_g + i * 256 + lane * 4), b = *(const float4*)(p.ln_in_b + i * 256 + lane * 4);
      f16x4 o;
      o[0] = (f16)(v[i].x * rs * g.x + b.x); o[1] = (f16)(v[i].y * rs * g.y + b.y);
      o[2] = (f16)(v[i].z * rs * g.z + b.z); o[3] = (f16)(v[i].w * rs * g.w + b.w);
      *(f16x4*)(h16 + (size_t)t * DM + i * 256 + lane * 4) = o;
    }
  }
}

template <class RowMap>
__device__ __forceinline__ void conv_tile(const float* __restrict__ src, int ld_src, int nvalid, int k0, int n0, f16* __restrict__ dst,
                                          int ld_dst, RowMap rm, float* sT) {
  const int tid = opaque_tid();
  {
    int k = tid >> 3, n = (tid & 7) * 8;
    const float* sp = src + (size_t)(k0 + k) * ld_src + n0 + n;
#pragma unroll
    for (int j = 0; j < 8; ++j) sT[k * 65 + n + j] = (n0 + n + j < nvalid) ? sp[j] : 0.f;
  }
  __syncthreads();
  {
    int n = tid >> 3, k = (tid & 7) * 8;
    f16x8 o;
#pragma unroll
    for (int j = 0; j < 8; ++j) o[j] = (f16)sT[(k + j) * 65 + n];
    int drow = rm(n0 + n);
    if (drow >= 0) *(f16x8*)(dst + (size_t)drow * ld_dst + k0 + k) = o;
  }
  __syncthreads();
}

struct RowId { __device__ int operator()(int n) const { return n; } };
struct RowGU { int up; __device__ int operator()(int ff) const {
  int tile = ff >> 7, wr = (ff >> 6) & 1, l = ff & 63; return tile * 256 + wr * 128 + up * 64 + l; } };

__device__ __forceinline__ void p_convert(const Params& p, char* shm) {
  float* sT = (float*)shm;
  char* ws = p.ws;
  const int J0 = 16 * 56, J1 = J0 + 16, J2 = J1 + 128, J3 = J2 + 128, J4 = J3 + 256, J5 = J4 + 32 * 64, J6 = J5 + 32 * 64,
            J7 = J6 + 32 * 64;
  for (int job = blockIdx.x; job < J7; job += gridDim.x) {
    if (job < J0) {
      int kt = job / 56, nt = job % 56;
      conv_tile(p.w_in, IN_W, IN_W, kt * 64, nt * 64, (f16*)(ws + OFF_WIN), 1024, RowId(), sT);
    } else if (job < J1) {
      int j = job - J0, g = j >> 2, kt = (j >> 1) & 1, nt = j & 1;
      conv_tile(p.pool_w + g * 128 * 128, 128, 128, kt * 64, nt * 64, (f16*)(ws + OFF_WPOOL) + g * 128 * 128, 128, RowId(), sT);
    } else if (job < J2) {
      int j = job - J1, kt = j >> 4, nt = j & 15;
      conv_tile(p.wpp, 1024, 1024, kt * 64, nt * 64, (f16*)(ws + OFF_WPP), 512, RowId(), sT);
    } else if (job < J3) {
      int j = job - J2, kt = j >> 4, nt = j & 15;
      conv_tile(p.wpa, 1024, 1024, kt * 64, nt * 64, (f16*)(ws + OFF_WPA), 512, RowId(), sT);
    } else if (job < J4) {
      int j = job - J3, kt = j >> 4, nt = j & 15;
      conv_tile(p.w_out, 1024, 1024, kt * 64, nt * 64, (f16*)(ws + OFF_WOUT), 1024, RowId(), sT);
    } else if (job < J6) {
      int up = job >= J5;
      int j = job - (up ? J5 : J4), e = j >> 6, kt = (j >> 2) & 15, nt = j & 3;
      RowGU rm; rm.up = up;
      conv_tile((up ? p.w_up : p.w_gate) + (size_t)e * 1024 * 256, 256, 256, kt * 64, nt * 64,
                (f16*)(ws + OFF_WGU) + (size_t)e * 512 * 1024, 1024, rm, sT);
    } else {
      int j = job - J6, e = j >> 6, kt = (j >> 4) & 3, nt = j & 15;
      conv_tile(p.w_down + (size_t)e * 256 * 1024, 1024, 1024, kt * 64, nt * 64, (f16*)(ws + OFF_WDN) + (size_t)e * 1024 * 256,
                256, RowId(), sT);
    }
  }
}

__device__ __forceinline__ int xcd_item(int n_items, int r) {
  const int nx = 8, slots = gridDim.x >> 3;
  const int xcd = blockIdx.x & 7, slot = blockIdx.x >> 3;
  const int per = (n_items + nx - 1) / nx;
  const int local = slot + r * slots;
  if (local >= per) return -1;
  const int item = xcd * per + local;
  return (item < n_items) ? item : -2;
}

__device__ __forceinline__ void p_inproj(const Params& p, char* shm) {
  const f16* h16 = (const f16*)(p.ws + OFF_A);
  const f16* wT = (const f16*)(p.ws + OFF_WIN);
  f16* proj16 = (f16*)(p.ws + OFF_B);
  f16* gate16 = (f16*)(p.ws + OFF_C);
  const int tid = opaque_tid(), wid = tid >> 6, lane = tid & 63;
  int sR[4], sC[4];
#pragma unroll
  for (int i = 0; i < 4; ++i) stage_rc(wid * 1024 + i * 8192 + lane * 16, sR[i], sC[i]);
  const int NTILES = 128 * 14;
  for (int r = 0;; ++r) {
    int tile = xcd_item(NTILES, r);
    if (tile == -1) break;
    if (tile < 0) continue;
    int grp = tile / 56, rem = tile % 56;
    int ft = rem >> 2, tt = grp * 4 + (rem & 3);
    unsigned pa[4], pb[4];
#pragma unroll
    for (int i = 0; i < 4; ++i) {
      pa[i] = (unsigned)((ft * 256 + sR[i]) * 1024 + sC[i]);
      pb[i] = (unsigned)((tt * 256 + sR[i]) * 1024 + sC[i]);
    }
    f32x4 acc[8][4];
#pragma unroll
    for (int m = 0; m < 8; ++m)
#pragma unroll
      for (int n = 0; n < 4; ++n) acc[m][n] = (f32x4){0.f, 0.f, 0.f, 0.f};
    gemm_core(wT, pa, h16, pb, 16, acc, shm);
    epi_store_f16(acc, shm);
    __syncthreads();
    {
      int ch = tid & 31, r0 = tid >> 5;
      int f0 = ft * 256 + ch * 8;
      float bg[8];
      if (f0 >= PA_W && f0 < IN_W) {
#pragma unroll
        for (int j = 0; j < 8; ++j) bg[j] = p.b_gate[f0 - PA_W + j];
      } else {
#pragma unroll
        for (int j = 0; j < 8; ++j) bg[j] = 0.f;
      }
#pragma unroll 4
      for (int ps = 0; ps < 16; ++ps) {
        int r = ps * 16 + r0;
        f16x8 v = *(const f16x8*)(shm + r * EPI_LD + ch * 16);
        size_t tok = (size_t)tt * 256 + r;
        if (f0 < PA_W) {
          *(f16x8*)(proj16 + tok * PJ_W + f0) = v;
        } else if (f0 < IN_W) {
          f16x8 o;
#pragma unroll
          for (int j = 0; j < 8; ++j) o[j] = (f16)(1.0f / (1.0f + __expf(-((float)v[j] + bg[j]))));
          *(f16x8*)(gate16 + tok * 2048 + (f0 - PA_W)) = o;
        }
      }
    }
    __syncthreads();
  }
}


__device__ __forceinline__ void zero_acc(f32x4 (&acc)[8][4]) {
#pragma unroll
  for (int m = 0; m < 8; ++m)
#pragma unroll
    for (int n = 0; n < 4; ++n) acc[m][n] = (f32x4){0.f, 0.f, 0.f, 0.f};
}

template <class RowPtr>
__device__ __forceinline__ void epi_rows_out(char* shm, RowPtr rp) {
  const int tid = opaque_tid(), ch = tid & 31, r0 = tid >> 5;
#pragma unroll 4
  for (int ps = 0; ps < 16; ++ps) {
    int r = ps * 16 + r0;
    f16x8 v = *(const f16x8*)(shm + r * EPI_LD + ch * 16);
    f16* d = rp(r);
    if (d) *(f16x8*)(d + ch * 8) = v;
  }
}

__device__ __forceinline__ void p_merge(const Params& p, char* shm) {
  const f16* pa16 = (const f16*)(p.ws + OFF_D);
  const f16* gate16 = (const f16*)(p.ws + OFF_C);
  const f16* wpp = (const f16*)(p.ws + OFF_WPP);
  const f16* wpa = (const f16*)(p.ws + OFF_WPA);
  f16* merged16 = (f16*)(p.ws + OFF_B);
  const int tid = opaque_tid(), wid = tid >> 6, lane = tid & 63;
  int sR[4], sC[4];
#pragma unroll
  for (int i = 0; i < 4; ++i) stage_rc(wid * 1024 + i * 8192 + lane * 16, sR[i], sC[i]);
  const int ch = tid & 31, r0 = tid >> 5;
  for (int r = 0;; ++r) {
    int tile = xcd_item(512, r);
    if (tile == -1) break;
    if (tile < 0) continue;
    int ft = tile & 3, tt = tile >> 2;
    unsigned pa[4], pb[4];
#pragma unroll
    for (int i = 0; i < 4; ++i) {
      pa[i] = (unsigned)((ft * 256 + sR[i]) * 512 + sC[i]);
      pb[i] = (unsigned)((tt * 256 + sR[i]) * 1024 + sC[i]);
    }
    {
      f32x4 acc[8][4];
      zero_acc(acc);
      gemm_core(wpp, pa, pa16, pb, 8, acc, shm);
      epi_store_f16(acc, shm);
    }
    __syncthreads();
#pragma unroll 4
    for (int ps = 0; ps < 16; ++ps) {
      const int rr = ps * 16 + r0;
      const size_t tok = (size_t)tt * 256 + rr;
      f16x8 v = *(const f16x8*)(shm + rr * EPI_LD + ch * 16);
      f16x8 g = *(const f16x8*)(gate16 + tok * 2048 + ft * 256 + ch * 8);
      f16x8 o;
#pragma unroll
      for (int e = 0; e < 8; ++e) o[e] = (f16)((float)v[e] * (float)g[e]);
      *(f16x8*)(merged16 + tok * 1024 + ft * 256 + ch * 8) = o;
    }
    __syncthreads();
    {
      f32x4 acc[8][4];
      zero_acc(acc);
      gemm_core(wpa, pa, pa16 + 512, pb, 8, acc, shm);
      epi_store_f16(acc, shm);
    }
    __syncthreads();
#pragma unroll 4
    for (int ps = 0; ps < 16; ++ps) {
      const int rr = ps * 16 + r0;
      const size_t tok = (size_t)tt * 256 + rr;
      f16x8 v = *(const f16x8*)(shm + rr * EPI_LD + ch * 16);
      f16x8 g = *(const f16x8*)(gate16 + tok * 2048 + 1024 + ft * 256 + ch * 8);
      f16x8 m0 = *(const f16x8*)(merged16 + tok * 1024 + ft * 256 + ch * 8);
      f16x8 o;
#pragma unroll
      for (int e = 0; e < 8; ++e) o[e] = (f16)((float)m0[e] + (float)v[e] * (float)g[e]);
      *(f16x8*)(merged16 + tok * 1024 + ft * 256 + ch * 8) = o;
    }
    __syncthreads();
  }
}

__device__ __forceinline__ void p_resid(const Params& p, char* shm) {
  const f16* merged16 = (const f16*)(p.ws + OFF_B);
  const f16* h16 = (const f16*)(p.ws + OFF_A);
  const f16* wo = (const f16*)(p.ws + OFF_WOUT);
  float* z32 = (float*)(p.ws + OFF_C);
  const int tid = opaque_tid(), wid = tid >> 6, lane = tid & 63;
  int sR[4], sC[4];
#pragma unroll
  for (int i = 0; i < 4; ++i) stage_rc(wid * 1024 + i * 8192 + lane * 16, sR[i], sC[i]);
  const int ch = tid & 31, r0 = tid >> 5;
  for (int r = 0;; ++r) {
    int tile = xcd_item(512, r);
    if (tile == -1) break;
    if (tile < 0) continue;
    int ft = tile & 3, tt = tile >> 2;
    unsigned pa[4], pb[4];
#pragma unroll
    for (int i = 0; i < 4; ++i) {
      pa[i] = (unsigned)((ft * 256 + sR[i]) * 1024 + sC[i]);
      pb[i] = (unsigned)((tt * 256 + sR[i]) * 1024 + sC[i]);
    }
    {
      f32x4 acc[8][4];
      zero_acc(acc);
      gemm_core(wo, pa, merged16, pb, 16, acc, shm);
      epi_store_f16(acc, shm);
    }
    __syncthreads();
#pragma unroll 4
    for (int ps = 0; ps < 16; ++ps) {
      const int rr = ps * 16 + r0;
      const size_t o = ((size_t)tt * 256 + rr) * 1024 + ft * 256 + ch * 8;
      f16x8 v = *(const f16x8*)(shm + rr * EPI_LD + ch * 16);
      f16x8 hv = *(const f16x8*)(h16 + o);
      f32x4 z0, z1;
#pragma unroll
      for (int e = 0; e < 4; ++e) { z0[e] = ALPHA * (float)hv[e] + (float)v[e]; z1[e] = ALPHA * (float)hv[4 + e] + (float)v[4 + e]; }
      *(f32x4*)(z32 + o) = z0;
      *(f32x4*)(z32 + o + 4) = z1;
    }
    __syncthreads();
  }
}

#define HID_ROWS 73728
__device__ __forceinline__ void moe_tiles(const int* counts, int (&pre)[33]) {
  pre[0] = 0;
#pragma unroll
  for (int e = 0; e < 32; ++e) pre[e + 1] = pre[e] + ((counts[e * CNT_STRIDE] + 255) >> 8);
}
__device__ __forceinline__ void moe_find(const int (&pre)[33], int item, int& e, int& mt) {
  e = 0;
#pragma unroll
  for (int i = 1; i < 32; ++i) if (item >= pre[i]) e = i;
  int base = 0;
#pragma unroll
  for (int i = 0; i < 32; ++i) if (i == e) base = pre[i];
  mt = item - base;
}

__device__ __forceinline__ void p_moe_a(const Params& p, char* shm) {
  const f16* h1 = (const f16*)(p.ws + OFF_A);
  const f16* wgu = (const f16*)(p.ws + OFF_WGU);
  const int* counts = (const int*)(p.ws + OFF_CNT);
  const int* lists = (const int*)(p.ws + OFF_LISTS);
  f16* hid16 = (f16*)(p.ws + OFF_B);
  const int tid = opaque_tid(), wid = tid >> 6, lane = tid & 63, wr = wid >> 2, wc = wid & 3, fr = lane & 15, fq = lane >> 4;
  int sR[4], sC[4];
#pragma unroll
  for (int i = 0; i < 4; ++i) stage_rc(wid * 1024 + i * 8192 + lane * 16, sR[i], sC[i]);
  int pre[33];
  moe_tiles(counts, pre);
  const int total = pre[32] * 2;
  for (int r = 0;; ++r) {
    int item = xcd_item(total, r);
    if (item == -1) break;
    if (item < 0) continue;
    int e, mt;
    moe_find(pre, item >> 1, e, mt);
    const int fh = item & 1;
    const int cnt_e = counts[e * CNT_STRIDE];
    int rowbase = 0;
#pragma unroll
    for (int i = 0; i < 32; ++i) if (i == e) rowbase = pre[i] * 256;
    unsigned pa[4], pb[4];
    f32x4 acc[8][4];
    zero_acc(acc);
#pragma unroll
    for (int i = 0; i < 4; ++i) {
      pa[i] = (unsigned)((e * 512 + fh * 256 + sR[i]) * 1024 + sC[i]);
      int idx = mt * 256 + sR[i];
      int tok = (idx < cnt_e) ? (lists[(size_t)e * T_TOK + idx] >> 1) : 0;
      pb[i] = (unsigned)(tok * 1024 + sC[i]);
    }
    gemm_core(wgu, pa, h1, pb, 16, acc, shm);
#pragma unroll
    for (int m = 0; m < 4; ++m)
#pragma unroll
      for (int n = 0; n < 4; ++n) {
        f16x4 o;
#pragma unroll
        for (int j = 0; j < 4; ++j) {
          float g = acc[m][n][j], u = acc[m + 4][n][j];
          o[j] = (f16)((g / (1.0f + __expf(-g))) * u);
        }
        size_t row = (size_t)rowbase + mt * 256 + wc * 64 + n * 16 + fr;
        *(f16x4*)(hid16 + row * 256 + fh * 128 + wr * 64 + m * 16 + fq * 4) = o;
      }
  }
}

__device__ __forceinline__ void p_moe_b(const Params& p, char* shm) {
  const f16* wdn = (const f16*)(p.ws + OFF_WDN);
  const f16* hid16 = (const f16*)(p.ws + OFF_B);
  const float* route_w = (const float*)(p.ws + OFF_ROUTE_W);
  const int* counts = (const int*)(p.ws + OFF_CNT);
  const int* lists = (const int*)(p.ws + OFF_LISTS);
  f16* y16 = (f16*)(p.ws + OFF_C);
  int* sent = (int*)(shm + 256 * EPI_LD);
  const int tid = opaque_tid(), wid = tid >> 6, lane = tid & 63, wc = wid & 3, fr = lane & 15;
  int sR[4], sC[4];
#pragma unroll
  for (int i = 0; i < 4; ++i) stage_rc(wid * 1024 + i * 8192 + lane * 16, sR[i], sC[i]);
  int pre[33];
  moe_tiles(counts, pre);
  const int total = pre[32] * 4;
  for (int r = 0;; ++r) {
    int item = xcd_item(total, r);
    if (item == -1) break;
    if (item < 0) continue;
    int e, mt;
    moe_find(pre, item >> 2, e, mt);
    const int ft = item & 3;
    const int cnt_e = counts[e * CNT_STRIDE];
    int rowbase = 0;
#pragma unroll
    for (int i = 0; i < 32; ++i) if (i == e) rowbase = pre[i] * 256;
    if (tid < 256) {
      int idx = mt * 256 + tid;
      sent[tid] = (idx < cnt_e) ? lists[(size_t)e * T_TOK + idx] : -1;
    }
    unsigned pa[4], pb[4];
    f32x4 acc[8][4];
    zero_acc(acc);
#pragma unroll
    for (int i = 0; i < 4; ++i) {
      pa[i] = (unsigned)((e * 1024 + ft * 256 + sR[i]) * 256 + sC[i]);
      pb[i] = (unsigned)((rowbase + mt * 256 + sR[i]) * 256 + sC[i]);
    }
    gemm_core(wdn, pa, hid16, pb, 4, acc, shm);
#pragma unroll
    for (int n = 0; n < 4; ++n) {
      int en = sent[wc * 64 + n * 16 + fr];
      float rw = (en >= 0) ? route_w[en] : 0.f;
#pragma unroll
      for (int m = 0; m < 8; ++m)
#pragma unroll
        for (int j = 0; j < 4; ++j) acc[m][n][j] *= rw;
    }
    epi_store_f16(acc, shm);
    __syncthreads();
    epi_rows_out(shm, [&](int r) -> f16* { int en = sent[r]; return (en >= 0) ? (y16 + (size_t)en * 1024 + ft * 256) : (f16*)nullptr; });
    __syncthreads();
  }
}


__device__ __forceinline__ unsigned f2key_(float f) {
  if (f == 0.f) f = 0.f;
  unsigned u = __float_as_uint(f);
  return (u & 0x80000000u) ? ~u : (u | 0x80000000u);
}
__device__ __forceinline__ float key2f_(unsigned k) {
  return __uint_as_float((k & 0x80000000u) ? (k & 0x7fffffffu) : ~k);
}
__device__ __forceinline__ void find_bin(const unsigned* hrow, int need, int lane, int* out_bin, int* out_above) {
  uint4 c = *(const uint4*)(hrow + 4 * lane);
  int tot = (int)(c.x + c.y + c.z + c.w);
  int incl = tot;
#pragma unroll
  for (int o = 1; o < 64; o <<= 1) {
    int v = __shfl_down(incl, o, 64);
    if (lane + o < 64) incl += v;
  }
  int above = incl - tot;
  if (above < need && incl >= need) {
    int b;
    if (above + (int)c.w >= need) b = 3;
    else { above += c.w; if (above + (int)c.z >= need) b = 2;
      else { above += c.z; if (above + (int)c.y >= need) b = 1; else { above += c.y; b = 0; } } }
    *out_bin = 4 * lane + b;
    *out_above = above;
  }
}

__device__ __forceinline__ f32x4 score_tile(const f16x8& a, const f16x8 (&bq)[8], const f16x8& bc_hi, const f16x8& bc_lo,
                                            const float (&wq)[8]) {
  f32x4 L[8];
#pragma unroll
  for (int h = 0; h < 8; ++h) L[h] = __builtin_amdgcn_mfma_f32_16x16x32_f16(a, bq[h], (f32x4){0.f, 0.f, 0.f, 0.f}, 0, 0, 0);
  f32x4 s = __builtin_amdgcn_mfma_f32_16x16x32_f16(a, bc_lo, (f32x4){0.f, 0.f, 0.f, 0.f}, 0, 0, 0);
  s = __builtin_amdgcn_mfma_f32_16x16x32_f16(a, bc_hi, s, 0, 0, 0);
  __builtin_amdgcn_sched_barrier(0);
#pragma unroll
  for (int h = 0; h < 8; ++h)
#pragma unroll
    for (int jj = 0; jj < 4; ++jj) s[jj] = __builtin_fmaf(wq[h], __builtin_fabsf(L[h][jj]), s[jj]);
  return s;
}

#define IDX_KEYS 0
#define IDX_HIST 131072
#define IDX_SSEL (IDX_HIST + 16384)
#define IDX_CAND (IDX_SSEL + 8192)
#define IDX_MISC (IDX_CAND + 2048)
template <int V>
__device__ __forceinline__ void p_index(const Params& p, char* shm) {
  const f16* proj16 = (const f16*)(p.ws + OFF_B);
  unsigned short* sel16 = (V == 0) ? (unsigned short*)(p.ws + OFF_SEL) : (unsigned short*)p.out;
  unsigned short* keys16 = (unsigned short*)(shm + IDX_KEYS);
  unsigned* hist = (unsigned*)(shm + IDX_HIST);
  unsigned short* ssel = (unsigned short*)(shm + IDX_SSEL);
  unsigned short* scand = (unsigned short*)(shm + IDX_CAND);
  unsigned* smm = (unsigned*)(shm + IDX_MISC);
  int* sbin = (int*)(smm + 32);
  const int tid = opaque_tid(), wid = tid >> 6, lane = tid & 63, fr = lane & 15, fq = lane >> 4;
  const float NINF = -__builtin_huge_valf(), PINF = __builtin_huge_valf();
  const unsigned long long lt_mask = (1ull << lane) - 1ull;
  for (int rnd = 0;; ++rnd) {
    int idx = rnd * gridDim.x + ((rnd & 1) ? (gridDim.x - 1 - blockIdx.x) : blockIdx.x);
    if (idx >= 2048) break;
    const int b = idx & 7, j = 255 - (idx >> 3);
    const int l0 = j * 16, t0 = b * SEQ + l0;
    if (j < 16) {
      for (int i = tid; i < 4096; i += 512) sel16[(size_t)t0 * 256 + i] = (unsigned short)(i & 255);
      continue;
    }
    for (int i = tid; i < 4096; i += 512) hist[i] = 0;
    if (tid < 16) { smm[tid] = 0xFFFFFFFFu; smm[16 + tid] = 0u; }
    f16x8 bq[8];
    float wq[8];
    {
      const f16* qrow = proj16 + (size_t)(t0 + fr) * PJ_W;
#pragma unroll
      for (int h = 0; h < 8; ++h) bq[h] = *(const f16x8*)(qrow + C_IQ + h * 32 + fq * 8);
      f16x8 wv = *(const f16x8*)(qrow + C_IW);
#pragma unroll
      for (int h = 0; h < 8; ++h) wq[h] = (float)wv[h];
    }
    f16x8 bc_hi, bc_lo;
#pragma unroll
    for (int e = 0; e < 8; ++e) {
      float c = 0.f;
#pragma unroll
      for (int h = 0; h < 8; ++h) c = __builtin_fmaf(wq[h], (float)bq[h][e], c);
      f16 ch_ = (f16)c;
      bc_hi[e] = ch_;
      bc_lo[e] = (f16)(c - (float)ch_);
    }
    __syncthreads();
    const int wids = __builtin_amdgcn_readfirstlane(wid);
    const int klast = (j - 1) - ((j - 1 - wids) & 7);
    const f16* kbase = proj16 + (size_t)(b * SEQ + fr) * PJ_W + C_IK + fq * 8;
#define IK_LOAD(dst, kt0)                                                                   \
  _Pragma("unroll") for (int u = 0; u < 4; ++u) {                                           \
    int ktc = min((kt0) + 8 * u, klast);                                                    \
    dst[u] = *(const f16x8*)(kbase + (size_t)(ktc * 16) * PJ_W);                            \
  }
    {
      float mn = PINF, mx = NINF;
      f16x8 a[4];
      IK_LOAD(a, wids);
      for (int kt0 = wids; kt0 < j; kt0 += 32) {
        f16x8 an[4];
        IK_LOAD(an, kt0 + 32);
#pragma unroll
        for (int u = 0; u < 4; ++u) {
          if (kt0 + 8 * u < j) {
            f32x4 sc = score_tile(a[u], bq, bc_hi, bc_lo, wq);
            mn = fminf(fminf(mn, sc[0]), fminf(fminf(sc[1], sc[2]), sc[3]));
            mx = fmaxf(fmaxf(mx, sc[0]), fmaxf(fmaxf(sc[1], sc[2]), sc[3]));
          }
        }
#pragma unroll
        for (int u = 0; u < 4; ++u) a[u] = an[u];
      }
      if ((j & 7) == wids) {
        f16x8 ad = *(const f16x8*)(kbase + (size_t)(j * 16) * PJ_W);
        f32x4 sc = score_tile(ad, bq, bc_hi, bc_lo, wq);
#pragma unroll
        for (int jj = 0; jj < 4; ++jj) {
          bool ok = (fq * 4 + jj <= fr);
          mn = fminf(mn, ok ? sc[jj] : PINF);
          mx = fmaxf(mx, ok ? sc[jj] : NINF);
        }
      }
      mn = fminf(mn, __shfl_xor(mn, 16, 64)); mn = fminf(mn, __shfl_xor(mn, 32, 64));
      mx = fmaxf(mx, __shfl_xor(mx, 16, 64)); mx = fmaxf(mx, __shfl_xor(mx, 32, 64));
      if (fq == 0) {
        if (mn != PINF) atomicMin(&smm[fr], f2key_(mn));
        if (mx != NINF) atomicMax(&smm[16 + fr], f2key_(mx));
      }
    }
    __syncthreads();
    {
      const float lo = key2f_(smm[fr]), hi = key2f_(smm[16 + fr]);
      const float s16 = (hi > lo) ? 65536.0f / (hi - lo) : 0.f;
      const float nlo = -lo * s16;
      unsigned* hq = hist + fr * 256;
      unsigned short* kq = keys16 + fr * 4096 + fq * 4;
      f16x8 a[4];
      IK_LOAD(a, wids);
      for (int kt0 = wids; kt0 < j; kt0 += 32) {
        f16x8 an[4];
        IK_LOAD(an, kt0 + 32);
#pragma unroll
        for (int u = 0; u < 4; ++u) {
          const int kt = kt0 + 8 * u;
          if (kt < j) {
            f32x4 sc = score_tile(a[u], bq, bc_hi, bc_lo, wq);
            unsigned kk[4];
#pragma unroll
            for (int jj = 0; jj < 4; ++jj) {
              int k16 = min(max((int)__builtin_fmaf(sc[jj], s16, nlo), 0), 65535);
              kk[jj] = (unsigned)k16;
              atomicAdd(&hq[k16 >> 8], 1u);
            }
            uint2 pk;
            pk.x = kk[0] | (kk[1] << 16);
            pk.y = kk[2] | (kk[3] << 16);
            *(uint2*)(kq + kt * 16) = pk;
          }
        }
#pragma unroll
        for (int u = 0; u < 4; ++u) a[u] = an[u];
      }
      if ((j & 7) == wids) {
        f16x8 ad = *(const f16x8*)(kbase + (size_t)(j * 16) * PJ_W);
        f32x4 sc = score_tile(ad, bq, bc_hi, bc_lo, wq);
        unsigned kk[4];
#pragma unroll
        for (int jj = 0; jj < 4; ++jj) {
          int k16 = min(max((int)__builtin_fmaf(sc[jj], s16, nlo), 0), 65535);
          kk[jj] = (unsigned)k16;
          if (fq * 4 + jj <= fr) atomicAdd(&hq[k16 >> 8], 1u);
        }
        uint2 pk;
        pk.x = kk[0] | (kk[1] << 16);
        pk.y = kk[2] | (kk[3] << 16);
        *(uint2*)(kq + j * 16) = pk;
      }
    }
#undef IK_LOAD
    __syncthreads();
    if (V == 2) continue;
    {
      const int q0 = 2 * wid, lq0 = l0 + q0;
      const int nmax = lq0 + 2;
      unsigned* hrow0 = hist + q0 * 256;
      const unsigned short* krow0 = keys16 + q0 * 4096;
      if (lane < 4) sbin[2 * q0 + lane] = 0;
      find_bin(hrow0, 256, lane, &sbin[2 * q0], &sbin[2 * q0 + 1]);
      find_bin(hrow0 + 256, 256, lane, &sbin[2 * q0 + 2], &sbin[2 * q0 + 3]);
      asm volatile("s_waitcnt lgkmcnt(0)" ::: "memory");
      const int b1s0 = sbin[2 * q0], ab0 = sbin[2 * q0 + 1], b1s1 = sbin[2 * q0 + 2], ab1 = sbin[2 * q0 + 3];
      asm volatile("s_waitcnt lgkmcnt(0)" ::: "memory");
      *(uint4*)(hrow0 + 4 * lane) = make_uint4(0u, 0u, 0u, 0u);
      *(uint4*)(hrow0 + 256 + 4 * lane) = make_uint4(0u, 0u, 0u, 0u);
      if (lane < 4) sbin[2 * q0 + lane] = 0;
      asm volatile("s_waitcnt lgkmcnt(0)" ::: "memory");
      for (int s4 = lane * 4; s4 < nmax; s4 += 256) {
        uint2 pa_ = *(const uint2*)(krow0 + s4), pb_ = *(const uint2*)(krow0 + 4096 + s4);
        unsigned ka[4] = {pa_.x & 0xffffu, pa_.x >> 16, pa_.y & 0xffffu, pa_.y >> 16};
        unsigned kb[4] = {pb_.x & 0xffffu, pb_.x >> 16, pb_.y & 0xffffu, pb_.y >> 16};
#pragma unroll
        for (int jj = 0; jj < 4; ++jj) {
          if (s4 + jj <= lq0 && (int)(ka[jj] >> 8) == b1s0) atomicAdd(&hrow0[ka[jj] & 255u], 1u);
          if (s4 + jj <= lq0 + 1 && (int)(kb[jj] >> 8) == b1s1) atomicAdd(&hrow0[256 + (kb[jj] & 255u)], 1u);
        }
      }
      asm volatile("s_waitcnt lgkmcnt(0)" ::: "memory");
      find_bin(hrow0, 256 - ab0, lane, &sbin[2 * q0], &sbin[2 * q0 + 1]);
      find_bin(hrow0 + 256, 256 - ab1, lane, &sbin[2 * q0 + 2], &sbin[2 * q0 + 3]);
      asm volatile("s_waitcnt lgkmcnt(0)" ::: "memory");
      const unsigned thr0 = (unsigned)((b1s0 << 8) | sbin[2 * q0]), thr1 = (unsigned)((b1s1 << 8) | sbin[2 * q0 + 2]);
      int base0 = 0, cb0 = 0, base1 = 0, cb1 = 0;
      for (int s0 = 0; s0 < nmax; s0 += 256) {
        const int s4 = s0 + lane * 4;
        uint2 pa_ = make_uint2(0u, 0u), pb_ = make_uint2(0u, 0u);
        if (s4 < nmax) { pa_ = *(const uint2*)(krow0 + s4); pb_ = *(const uint2*)(krow0 + 4096 + s4); }
        unsigned ka[4] = {pa_.x & 0xffffu, pa_.x >> 16, pa_.y & 0xffffu, pa_.y >> 16};
        unsigned kb[4] = {pb_.x & 0xffffu, pb_.x >> 16, pb_.y & 0xffffu, pb_.y >> 16};
#pragma unroll
        for (int jj = 0; jj < 4; ++jj) {
          const bool ok0 = (s4 + jj <= lq0), ok1 = (s4 + jj <= lq0 + 1);
          const bool t0_ = ok0 && (ka[jj] > thr0), c0_ = ok0 && (ka[jj] == thr0);
          const bool t1_ = ok1 && (kb[jj] > thr1), c1_ = ok1 && (kb[jj] == thr1);
          unsigned long long m0 = __ballot(t0_), m1 = __ballot(t1_), cm0 = __ballot(c0_), cm1 = __ballot(c1_);
          if (t0_) ssel[q0 * 256 + base0 + __popcll(m0 & lt_mask)] = (unsigned short)(s4 + jj);
          if (t1_) ssel[q0 * 256 + 256 + base1 + __popcll(m1 & lt_mask)] = (unsigned short)(s4 + jj);
          base0 += __popcll(m0); base1 += __popcll(m1);
          if (cm0 | cm1) {
            int cp0 = cb0 + __popcll(cm0 & lt_mask), cp1 = cb1 + __popcll(cm1 & lt_mask);
            if (c0_ && cp0 < 64) scand[q0 * 64 + cp0] = (unsigned short)(s4 + jj);
            if (c1_ && cp1 < 64) scand[q0 * 64 + 64 + cp1] = (unsigned short)(s4 + jj);
            cb0 += __popcll(cm0); cb1 += __popcll(cm1);
          }
        }
      }
      asm volatile("s_waitcnt lgkmcnt(0)" ::: "memory");
#pragma unroll
      for (int x = 0; x < 2; ++x) {
        const int q = q0 + x;
        const int base = x ? base1 : base0, c = min(x ? cb1 : cb0, 64), r = 256 - base;
        if (lane < c) {
          unsigned short my = scand[q * 64 + lane];
          int rank = 0;
          for (int k = 0; k < c; ++k) rank += (scand[q * 64 + k] < my) ? 1 : 0;
          if (rank < r) ssel[q * 256 + base + rank] = my;
        }
      }
    }
    __syncthreads();
    *(uint4*)(sel16 + (size_t)t0 * 256 + tid * 8) = *(const uint4*)(ssel + tid * 8);
  }
  __syncthreads();
}

typedef short s16x4 __attribute__((ext_vector_type(4)));
#define VROW 160
#define ATT_WAVE_LDS (64 * VROW + 512)
__device__ __forceinline__ f16x8 tr_pair(const char* a, const char* b) {
  s16x4 x = __builtin_amdgcn_ds_read_tr16_b64_v4i16((__attribute__((address_space(3))) s16x4*)(a));
  s16x4 y = __builtin_amdgcn_ds_read_tr16_b64_v4i16((__attribute__((address_space(3))) s16x4*)(b));
  typedef short s16x8 __attribute__((ext_vector_type(8)));
  s16x8 r = __builtin_shufflevector(x, y, 0, 1, 2, 3, 4, 5, 6, 7);
  return __builtin_bit_cast(f16x8, r);
}
template <int V>
__device__ __forceinline__ void p_attn(const Params& p, char* shm) {
  const f16* proj16 = (const f16*)(p.ws + OFF_B);
  const unsigned short* sel16 = (const unsigned short*)(p.ws + OFF_SEL);
  f16* pa16 = (V == 0) ? (f16*)(p.ws + OFF_D) : (f16*)p.out;
  const int tid = opaque_tid(), wid = tid >> 6, lane = tid & 63, fr = lane & 15, fq = lane >> 4;
  char* vimg = shm + wid * ATT_WAVE_LDS;
  unsigned short* ssel = (unsigned short*)(vimg + 64 * VROW);
  const int tstride = gridDim.x * 8;
  int t = blockIdx.x * 8 + wid;
  uint2 sv = make_uint2(0u, 0u);
  if (t < T_TOK) sv = *(const uint2*)(sel16 + (size_t)t * 256 + lane * 4);
  for (; t < T_TOK; t += tstride) {
    const int l = t & (SEQ - 1), b0 = t - l, cnt = min(l + 1, 256);
    {
      unsigned short i0 = sv.x & 0xffff, i1 = sv.x >> 16, i2 = sv.y & 0xffff, i3 = sv.y >> 16;
      int s0 = lane * 4;
      ushort4 o;
      o.x = (s0 + 0 < cnt) ? (unsigned short)min((int)i0, l) : 0;
      o.y = (s0 + 1 < cnt) ? (unsigned short)min((int)i1, l) : 0;
      o.z = (s0 + 2 < cnt) ? (unsigned short)min((int)i2, l) : 0;
      o.w = (s0 + 3 < cnt) ? (unsigned short)min((int)i3, l) : 0;
      *(ushort4*)(ssel + s0) = o;
    }
    if (t + tstride < T_TOK) sv = *(const uint2*)(sel16 + (size_t)(t + tstride) * 256 + lane * 4);
    asm volatile("s_waitcnt lgkmcnt(0)" ::: "memory");
    f16x8 bq0, bq1;
    {
      const f16* qp = proj16 + (size_t)t * PJ_W + C_Q + (fr & 7) * 64 + fq * 8;
      bq0 = *(const f16x8*)qp;
      bq1 = *(const f16x8*)(qp + 32);
#pragma unroll
      for (int e = 0; e < 8; ++e) { bq0[e] = (fr < 8) ? bq0[e] * (f16)0.125f : (f16)0.f; bq1[e] = (fr < 8) ? bq1[e] * (f16)0.125f : (f16)0.f; }
    }
    const f16* kbase = proj16 + (size_t)b0 * PJ_W + C_K + fq * 8;
    const f16* vbase = proj16 + (size_t)b0 * PJ_W + C_V + (lane & 7) * 8;
    f32x4 S[16];
#pragma unroll
    for (int kt = 0; kt < 16; ++kt) {
      int kidx = ssel[kt * 16 + fr];
      const f16* kp = kbase + (size_t)kidx * PJ_W;
      f16x8 a0 = *(const f16x8*)kp, a1 = *(const f16x8*)(kp + 32);
      f32x4 z = {0.f, 0.f, 0.f, 0.f};
      z = __builtin_amdgcn_mfma_f32_16x16x32_f16(a0, bq0, z, 0, 0, 0);
      z = __builtin_amdgcn_mfma_f32_16x16x32_f16(a1, bq1, z, 0, 0, 0);
#pragma unroll
      for (int j = 0; j < 4; ++j) S[kt][j] = (kt * 16 + fq * 4 + j < cnt) ? z[j] : NEG_BIG;
    }
    f16x8 vv[8];
#pragma unroll
    for (int i = 0; i < 8; ++i) {
      int vidx = ssel[(lane >> 3) + 8 * i];
      vv[i] = *(const f16x8*)(vbase + (size_t)vidx * PJ_W);
    }
    float m = NEG_BIG;
#pragma unroll
    for (int kt = 0; kt < 16; ++kt)
#pragma unroll
      for (int j = 0; j < 4; ++j) m = fmaxf(m, S[kt][j]);
    m = fmaxf(m, __shfl_xor(m, 16, 64));
    m = fmaxf(m, __shfl_xor(m, 32, 64));
    float lsum = 0.f;
    f16x8 P[8];
#pragma unroll
    for (int c = 0; c < 8; ++c)
#pragma unroll
      for (int j = 0; j < 4; ++j) {
        float e0 = __expf(S[2 * c][j] - m), e1 = __expf(S[2 * c + 1][j] - m);
        lsum += e0 + e1;
        P[c][j] = (f16)e0;
        P[c][4 + j] = (f16)e1;
      }
    lsum += __shfl_xor(lsum, 16, 64);
    lsum += __shfl_xor(lsum, 32, 64);
    f32x4 O[4];
#pragma unroll
    for (int nt = 0; nt < 4; ++nt) O[nt] = (f32x4){0.f, 0.f, 0.f, 0.f};
#pragma unroll
    for (int rr = 0; rr < ((V == 1) ? 0 : 4); ++rr) {
      asm volatile("s_waitcnt lgkmcnt(0)" ::: "memory");
#pragma unroll
      for (int i = 0; i < 8; ++i) *(f16x8*)(vimg + ((lane >> 3) + 8 * i) * VROW + (lane & 7) * 16) = vv[i];
      if (rr < 3) {
#pragma unroll
        for (int i = 0; i < 8; ++i) {
          int vidx = ssel[(rr + 1) * 64 + (lane >> 3) + 8 * i];
          vv[i] = *(const f16x8*)(vbase + (size_t)vidx * PJ_W);
        }
      }
      asm volatile("s_waitcnt lgkmcnt(0)" ::: "memory");
#pragma unroll
      for (int cc = 0; cc < 2; ++cc) {
        const char* ra = vimg + (cc * 32 + fq * 4 + (fr >> 2)) * VROW + (fr & 3) * 8;
#pragma unroll
        for (int nt = 0; nt < 4; ++nt) {
          f16x8 B = tr_pair(ra + nt * 32, ra + 16 * VROW + nt * 32);
          O[nt] = __builtin_amdgcn_mfma_f32_16x16x32_f16(P[rr * 2 + cc], B, O[nt], 0, 0, 0);
        }
      }
    }
    asm volatile("s_waitcnt lgkmcnt(0)" ::: "memory");
#pragma unroll
    for (int j = 0; j < 4; ++j) {
      float ls = __shfl(lsum, (fq & 1) * 4 + j, 64);
      float inv = 1.0f / ls;
      if (fq < 2) {
        f16* op = pa16 + (size_t)t * DM + 512 + (fq * 4 + j) * 64 + fr;
#pragma unroll
        for (int nt = 0; nt < 4; ++nt) op[nt * 16] = (f16)(O[nt][j] * inv);
      }
    }
  }
}


#define DL_LD 1040
template <int W>
__device__ __forceinline__ void pool_delta(const f16* up, int lf, char* dp) {
  f16x8 u[W + 7];
#pragma unroll
  for (int k = 0; k < W + 7; ++k) {
    const int rel = k - (W - 1);
    f16x8 z = {(f16)0.f, (f16)0.f, (f16)0.f, (f16)0.f, (f16)0.f, (f16)0.f, (f16)0.f, (f16)0.f};
    u[k] = (lf + rel >= 0) ? *(const f16x8*)(up + (ptrdiff_t)rel * PJ_W) : z;
  }
  float sum[8];
#pragma unroll
  for (int e = 0; e < 8; ++e) sum[e] = 0.f;
#pragma unroll
  for (int k = 0; k < W - 1; ++k)
#pragma unroll
    for (int e = 0; e < 8; ++e) sum[e] += (float)u[k][e];
#pragma unroll
  for (int i = 0; i < 8; ++i) {
    const float inv = 1.0f / (float)min(lf + i + 1, W);
    f16x8 d;
#pragma unroll
    for (int e = 0; e < 8; ++e) {
      sum[e] += (float)u[W - 1 + i][e];
      d[e] = (f16)(sum[e] * inv - (float)u[W - 1 + i][e]);
      sum[e] -= (float)u[i][e];
    }
    *(f16x8*)(dp + i * DL_LD) = d;
  }
}
__device__ __forceinline__ void p_pool(const Params& p, char* shm) {
  const f16* proj16 = (const f16*)(p.ws + OFF_B);
  const f16* wpl = (const f16*)(p.ws + OFF_WPOOL);
  f16* pa16 = (f16*)(p.ws + OFF_D);
  const int tid = opaque_tid(), wid = tid >> 6, lane = tid & 63, fr = lane & 15, fq = lane >> 4;
  for (int item = blockIdx.x; item < T_TOK / 64; item += gridDim.x) {
    const int t0 = item * 64;
    {
      const int g = wid >> 1;
      const int c = g * 128 + ((wid & 1) * 8 + (lane & 7)) * 8;
      const int tg = lane >> 3;
      const int tf = t0 + tg * 8, lf = tf & (SEQ - 1);
      const f16* up = proj16 + (size_t)tf * PJ_W + c;
      char* dp = shm + (tg * 8) * DL_LD + c * 2;
      if (g == 0) pool_delta<2>(up, lf, dp);
      else if (g == 1) pool_delta<4>(up, lf, dp);
      else if (g == 2) pool_delta<8>(up, lf, dp);
      else pool_delta<16>(up, lf, dp);
    }
    __syncthreads();
    {
      const int g = wid >> 1, eh = wid & 1;
      f32x4 acc[4][4];
#pragma unroll
      for (int m = 0; m < 4; ++m)
#pragma unroll
        for (int n = 0; n < 4; ++n) acc[m][n] = (f32x4){0.f, 0.f, 0.f, 0.f};
#pragma unroll
      for (int ks = 0; ks < 4; ++ks) {
        f16x8 A[4], B[4];
#pragma unroll
        for (int m = 0; m < 4; ++m) A[m] = *(const f16x8*)(wpl + (size_t)(g * 128 + eh * 64 + m * 16 + fr) * 128 + ks * 32 + fq * 8);
#pragma unroll
        for (int n = 0; n < 4; ++n) B[n] = *(const f16x8*)(shm + (n * 16 + fr) * DL_LD + (g * 128 + ks * 32 + fq * 8) * 2);
#pragma unroll
        for (int m = 0; m < 4; ++m)
#pragma unroll
          for (int n = 0; n < 4; ++n) acc[m][n] = __builtin_amdgcn_mfma_f32_16x16x32_f16(A[m], B[n], acc[m][n], 0, 0, 0);
      }
#pragma unroll
      for (int m = 0; m < 4; ++m) {
        const int e0 = g * 128 + eh * 64 + m * 16 + fq * 4;
        float4 sc = *(const float4*)(p.pool_scale + e0);
#pragma unroll
        for (int n = 0; n < 4; ++n) {
          f16x4 o;
          o[0] = (f16)(acc[m][n][0] * sc.x); o[1] = (f16)(acc[m][n][1] * sc.y);
          o[2] = (f16)(acc[m][n][2] * sc.z); o[3] = (f16)(acc[m][n][3] * sc.w);
          *(f16x4*)(pa16 + (size_t)(t0 + n * 16 + fr) * DM + e0) = o;
        }
      }
    }
    __syncthreads();
  }
}

#define RT_LDS (36 * 1024 * 4)
template <int V>
__device__ __forceinline__ void p_ln1_route(const Params& p, char* shm) {
  const float* z32 = (const float*)(p.ws + OFF_C);
  char* dmy = (char*)p.out;
  f16* h1 = (V == 0) ? (f16*)(p.ws + OFF_A) : (f16*)dmy;
  int* route_e = (V == 0) ? (int*)(p.ws + OFF_ROUTE_E) : (int*)(dmy + 68000000);
  float* route_w = (V == 0) ? (float*)(p.ws + OFF_ROUTE_W) : (float*)(dmy + 69000000);
  int* counts = (V == 0) ? (int*)(p.ws + OFF_CNT) : (int*)(dmy + 70000000);
  int* lists = (V == 0) ? (int*)(p.ws + OFF_LISTS) : (int*)(dmy + 71000000);
  float* sW = (float*)shm;
  int* lcnt = (int*)(shm + RT_LDS);
  int* lent = lcnt + 128;
  const int tid = opaque_tid(), wid = tid >> 6, lane = tid & 63;
  if (tid < 128) lcnt[tid] = 0;
  for (int i = tid; i < 36 * 1024; i += 512) {
    int o = i >> 10, k = i & 1023;
    sW[i] = (o < 4) ? p.w_group[k * 4 + o] : p.w_router[k * 32 + (o - 4)];
  }
  __syncthreads();
  const int nw = gridDim.x * 8;
  for (int pr = blockIdx.x * 8 + wid; pr < T_TOK / 2; pr += nw) {
    const int t = pr * 2;
    float v[2][16];
#pragma unroll
    for (int r = 0; r < 2; ++r)
#pragma unroll
      for (int i = 0; i < 4; ++i) {
        float4 x = *(const float4*)(z32 + (size_t)(t + r) * DM + i * 256 + lane * 4);
        v[r][i * 4 + 0] = x.x; v[r][i * 4 + 1] = x.y; v[r][i * 4 + 2] = x.z; v[r][i * 4 + 3] = x.w;
      }
#pragma unroll
    for (int r = 0; r < 2; ++r) {
      float s = 0.f;
#pragma unroll
      for (int i = 0; i < 16; ++i) s += v[r][i];
      float mu = wave_sum(s) * (1.0f / DM);
      float q = 0.f;
#pragma unroll
      for (int i = 0; i < 16; ++i) { v[r][i] -= mu; q += v[r][i] * v[r][i]; }
      float rs = rsqrtf(wave_sum(q) * (1.0f / DM) + 1e-5f);
#pragma unroll
      for (int i = 0; i < 4; ++i) {
        float4 g = *(const float4*)(p.ln1_g + i * 256 + lane * 4), b = *(const float4*)(p.ln1_b + i * 256 + lane * 4);
        v[r][i * 4 + 0] = v[r][i * 4 + 0] * rs * g.x + b.x; v[r][i * 4 + 1] = v[r][i * 4 + 1] * rs * g.y + b.y;
        v[r][i * 4 + 2] = v[r][i * 4 + 2] * rs * g.z + b.z; v[r][i * 4 + 3] = v[r][i * 4 + 3] * rs * g.w + b.w;
        f16x4 o;
        o[0] = (f16)v[r][i * 4 + 0]; o[1] = (f16)v[r][i * 4 + 1]; o[2] = (f16)v[r][i * 4 + 2]; o[3] = (f16)v[r][i * 4 + 3];
        *(f16x4*)(h1 + (size_t)(t + r) * DM + i * 256 + lane * 4) = o;
      }
    }
    float mine0 = 0.f, mine1 = 0.f;
#pragma unroll 2
    for (int o = 0; o < 36; ++o) {
      float a0 = 0.f, a1 = 0.f;
#pragma unroll
      for (int i = 0; i < 4; ++i) {
        float4 w = *(const float4*)(sW + o * 1024 + i * 256 + lane * 4);
        a0 += v[0][i * 4 + 0] * w.x + v[0][i * 4 + 1] * w.y + v[0][i * 4 + 2] * w.z + v[0][i * 4 + 3] * w.w;
        a1 += v[1][i * 4 + 0] * w.x + v[1][i * 4 + 1] * w.y + v[1][i * 4 + 2] * w.z + v[1][i * 4 + 3] * w.w;
      }
      a0 = wave_sum(a0); a1 = wave_sum(a1);
      if (lane == o) { mine0 = a0; mine1 = a1; }
    }
    {
      const int r = lane & 1;
      float gl[4];
#pragma unroll
      for (int o = 0; o < 4; ++o) {
        float x0 = __shfl(mine0, o, 64), x1 = __shfl(mine1, o, 64);
        gl[o] = (r ? x1 : x0) + p.b_group[o];
      }
      int g = 0;
      float m = gl[0];
#pragma unroll
      for (int o = 1; o < 4; ++o) if (gl[o] > m) { m = gl[o]; g = o; }
      float se = 0.f;
#pragma unroll
      for (int o = 0; o < 4; ++o) se += __expf(gl[o] - m);
      float pg = 1.0f / se;
      float v1 = -3e38f, v2 = -3e38f;
      int i1 = 0, i2 = 0;
#pragma unroll
      for (int jx = 0; jx < 8; ++jx) {
        float x0 = __shfl(mine0, 4 + g * 8 + jx, 64), x1 = __shfl(mine1, 4 + g * 8 + jx, 64);
        float x = (r ? x1 : x0) + p.b_router[g * 8 + jx];
        if (x > v1) { v2 = v1; i2 = i1; v1 = x; i1 = jx; }
        else if (x > v2) { v2 = x; i2 = jx; }
      }
      if (lane < 2) {
        const int tt = t + r;
        float e2 = __expf(v2 - v1);
        float w1 = pg / (1.0f + e2), w2 = pg * e2 / (1.0f + e2);
        int ea = g * 8 + i1, eb = g * 8 + i2;
        route_e[2 * tt] = ea; route_e[2 * tt + 1] = eb;
        route_w[2 * tt] = w1; route_w[2 * tt + 1] = w2;
        int la = atomicAdd(&lcnt[ea], 1), lb = atomicAdd(&lcnt[eb], 1);
        int slot = atomicAdd(&lcnt[64], 2);
        if (slot + 1 < 512) {
          lent[2 * slot] = (ea << 16) | la; lent[2 * slot + 1] = 2 * tt;
          lent[2 * slot + 2] = (eb << 16) | lb; lent[2 * slot + 3] = 2 * tt + 1;
        }
      }
    }
  }
  __syncthreads();
  if (tid < 32) lcnt[32 + tid] = atomicAdd(&counts[tid * CNT_STRIDE], lcnt[tid]);
  __syncthreads();
  {
    const int n_ent = min(lcnt[64], 512);
    for (int i = tid; i < n_ent; i += 512) {
      int ev = lent[2 * i], id = lent[2 * i + 1];
      int e = ev >> 16, lp = ev & 0xffff;
      lists[(size_t)e * T_TOK + lcnt[32 + e] + lp] = id;
    }
  }
  __syncthreads();
}

__device__ __forceinline__ void p_final(const Params& p) {
  const f16* h1 = (const f16*)(p.ws + OFF_A);
  const f16* y16 = (const f16*)(p.ws + OFF_C);
  const int tid = opaque_tid(), wid = tid >> 6, lane = tid & 63;
  const int nw = gridDim.x * 8;
  for (int t = blockIdx.x * 8 + wid; t < T_TOK; t += nw) {
    float v[16];
#pragma unroll
    for (int i = 0; i < 2; ++i) {
      f16x8 hv = *(const f16x8*)(h1 + (size_t)t * DM + i * 512 + lane * 8);
      f16x8 y0 = *(const f16x8*)(y16 + (size_t)(2 * t) * DM + i * 512 + lane * 8);
      f16x8 y1 = *(const f16x8*)(y16 + (size_t)(2 * t + 1) * DM + i * 512 + lane * 8);
#pragma unroll
      for (int e = 0; e < 8; ++e) v[i * 8 + e] = ALPHA * (float)hv[e] + ((float)y0[e] + (float)y1[e]);
    }
    float s = 0.f;
#pragma unroll
    for (int i = 0; i < 16; ++i) s += v[i];
    float mu = wave_sum(s) * (1.0f / DM);
    float q = 0.f;
#pragma unroll
    for (int i = 0; i < 16; ++i) { v[i] -= mu; q += v[i] * v[i]; }
    float rs = rsqrtf(wave_sum(q) * (1.0f / DM) + 1e-5f);
#pragma unroll
    for (int i = 0; i < 2; ++i)
#pragma unroll
      for (int hf = 0; hf < 2; ++hf) {
        const int c = i * 512 + lane * 8 + hf * 4;
        float4 g = *(const float4*)(p.ln2_g + c), b = *(const float4*)(p.ln2_b + c);
        float4 o;
        o.x = v[i * 8 + hf * 4 + 0] * rs * g.x + b.x; o.y = v[i * 8 + hf * 4 + 1] * rs * g.y + b.y;
        o.z = v[i * 8 + hf * 4 + 2] * rs * g.z + b.z; o.w = v[i * 8 + hf * 4 + 3] * rs * g.w + b.w;
        *(float4*)(p.out + (size_t)t * DM + c) = o;
      }
  }
}

#define MEGA_LDS 158720


#define XB_TMO      128
#define XB_XCNT(j)  (256  + 64 * (j))
#define XB_XSUB(j)  (1280 + 64 * (j))
#define XB_XGEN(j)  (2304 + 64 * (j))
#define XB_TOP      3328
#define XB_TOPGEN   3392
#define XCD_BAR_WORDS 3456
#define XB_SPIN_CAP (1u << 22)
#define LAS __attribute__((address_space(3)))
__device__ __forceinline__ unsigned xb_ld(unsigned* p) { return __hip_atomic_load(p, __ATOMIC_RELAXED, __HIP_MEMORY_SCOPE_AGENT); }
__device__ __forceinline__ unsigned xb_add(unsigned* p, unsigned v) { return __hip_atomic_fetch_add(p, v, __ATOMIC_RELAXED, __HIP_MEMORY_SCOPE_AGENT); }
__device__ __forceinline__ unsigned xb_xcc_id() { return (unsigned)__builtin_amdgcn_s_getreg((3 << 11) | 20) & 0xFu; }
#define XB_SPIN(cond, bar) do { unsigned _sp = 0; while (cond) { __builtin_amdgcn_s_sleep(1); \
    if ((++_sp & 255u) == 0u) { if (xb_ld(&(bar)[XB_TMO])) break; if (_sp > XB_SPIN_CAP) { atomicAdd(&(bar)[XB_TMO], 1u); break; } } } } while (0)
struct XcdBarrier { unsigned* bar; unsigned x; volatile unsigned* st; };
__device__ __forceinline__ XcdBarrier xcd_barrier_post(unsigned* bar, volatile unsigned* st) {
  XcdBarrier b; b.bar = bar; b.x = xb_xcc_id(); b.st = st;
  if (threadIdx.x == 0) (void)xb_add(&bar[XB_XCNT(b.x)], 1u);
  return b;
}
__device__ __forceinline__ void xcd_barrier_complete(unsigned* bar, unsigned x, unsigned& nloc, unsigned& nx) {
  const unsigned G = gridDim.x * gridDim.y * gridDim.z;
  unsigned sum, cnt, mine, sp = 0u;
  for (;;) {
    sum = 0u; cnt = 0u; mine = 0u;
#pragma unroll
    for (unsigned j = 0; j < 16; ++j) { const unsigned c = xb_ld(&bar[XB_XCNT(j)]); sum += c; cnt += (c > 0u) ? 1u : 0u; mine = (j == x) ? c : mine; }
    if (sum == G) break;
    __builtin_amdgcn_s_sleep(1);
    if ((++sp & 255u) == 0u) { if (xb_ld(&bar[XB_TMO])) break; if (sp > XB_SPIN_CAP) { atomicAdd(&bar[XB_TMO], 1u); break; } }
  }
  nloc = mine > 0u ? mine : 1u; nx = cnt > 0u ? cnt : 1u;
}
__device__ __forceinline__ void xcd_barrier(const XcdBarrier& b) {
  asm volatile("s_waitcnt vmcnt(0)" ::: "memory");
  __syncthreads();
  if (threadIdx.x == 0) {
    unsigned* bar = b.bar;
    __builtin_amdgcn_s_waitcnt(0);
    unsigned nloc = b.st[0], nx = b.st[1];
    if (nloc == 0u) { xcd_barrier_complete(bar, b.x, nloc, nx); b.st[0] = nloc; b.st[1] = nx; }
    const unsigned old = xb_add(&bar[XB_XSUB(b.x)], 1u);
    const unsigned gen = old / nloc;
    if (old + 1u == (gen + 1u) * nloc) {
      __builtin_amdgcn_fence(__ATOMIC_RELEASE, "agent");
      asm volatile("s_waitcnt vmcnt(0)" ::: "memory");
      const unsigned og = xb_add(&bar[XB_TOP], 1u);
      const unsigned tg = og / nx;
      if (og + 1u == (tg + 1u) * nx) xb_add(&bar[XB_TOPGEN], 1u);
      else XB_SPIN(xb_ld(&bar[XB_TOPGEN]) == tg, bar);
      __builtin_amdgcn_fence(__ATOMIC_ACQUIRE, "agent");
      xb_add(&bar[XB_XGEN(b.x)], 1u);
      asm volatile("s_waitcnt vmcnt(0)" ::: "memory");
    } else {
      XB_SPIN(xb_ld(&bar[XB_XGEN(b.x)]) == gen, bar);
      __builtin_amdgcn_fence(__ATOMIC_ACQUIRE, "agent");
      asm volatile("s_waitcnt vmcnt(0)" ::: "memory");
    }
  }
  __syncthreads();
}

#ifndef PROBE
#define PROBE 0
#endif
#define GSYNC() xcd_barrier(xb)
#define PH(n, code) do { code; if (PROBE == n) { GSYNC(); code; } } while (0)
__global__ __launch_bounds__(512) void mega(Params p) {
  __shared__ __attribute__((aligned(1024))) char shm[MEGA_LDS + 16];
  cg::grid_group grid = cg::this_grid();
  volatile unsigned* xst = (volatile unsigned*)(shm + MEGA_LDS);
  if (threadIdx.x < 4) xst[threadIdx.x] = 0u;
  __syncthreads();
  XcdBarrier xb = xcd_barrier_post((unsigned*)(p.ws + OFF_BAR), xst);
  if (blockIdx.x == 0 && threadIdx.x < 32) ((int*)(p.ws + OFF_CNT))[threadIdx.x * CNT_STRIDE] = 0;
  PH(1, p_ln_in(p));
  PH(2, p_convert(p, shm));
  grid.sync();
  PH(3, p_inproj(p, shm));
  GSYNC();
  PH(4, p_pool(p, shm));
  PH(5, p_index<0>(p, shm));
#if PROBE >= 50 && PROBE < 60
  GSYNC();
  p_index<PROBE - 50>(p, shm);
#endif
  GSYNC();
  PH(6, p_attn<0>(p, shm));
#if PROBE >= 60 && PROBE < 70
  GSYNC();
  p_attn<PROBE - 60>(p, shm);
#endif
  GSYNC();
  PH(7, p_merge(p, shm));
  GSYNC();
  PH(8, p_resid(p, shm));
  GSYNC();
  p_ln1_route<0>(p, shm);
  GSYNC();
#if PROBE == 9
  if (blockIdx.x == 0 && threadIdx.x < 32) ((int*)((char*)p.out + 70000000))[threadIdx.x * CNT_STRIDE] = 0;
  GSYNC();
  p_ln1_route<1>(p, shm);
  GSYNC();
#endif
  PH(10, p_moe_a(p, shm));
  GSYNC();
  PH(11, p_moe_b(p, shm));
  GSYNC();
  PH(12, p_final(p));
}

extern "C" void kernel_launch(void* const* d_in, const int* in_sizes, int n_in, void* d_out, int out_size, void* d_ws,
                              size_t ws_size, hipStream_t stream) {
  if (ws_size < WS_NEEDED) { fprintf(stderr, "ws too small: %zu < %zu\n", ws_size, (size_t)WS_NEEDED); return; }
  static int grid_blocks = 0;
  if (!grid_blocks) {
    int dev = 0, cus = 0, per_cu = 0;
    hipGetDevice(&dev);
    hipDeviceGetAttribute(&cus, hipDeviceAttributeMultiprocessorCount, dev);
    hipOccupancyMaxActiveBlocksPerMultiprocessor(&per_cu, mega, 512, 0);
    if (per_cu > 1) per_cu = 1;
    grid_blocks = cus * per_cu;
    fprintf(stderr, "mega: cus=%d per_cu=%d grid=%d\n", cus, per_cu, grid_blocks);
  }
  Params p{};
  const float** pp = (const float**)&p;
  for (int i = 0; i < 21; ++i) pp[i] = (const float*)d_in[i];
  p.out = (float*)d_out;
  p.ws = (char*)d_ws;
  (void)hipMemsetAsync((char*)d_ws + OFF_BAR, 0, 16384, stream);
  void* args[] = {&p};
  hipError_t e = hipLaunchCooperativeKernel((void*)mega, dim3(grid_blocks), dim3(512), args, 0, stream);
  if (e != hipSuccess) fprintf(stderr, "cooperative launch failed: %s (grid %d)\n", hipGetErrorString(e), grid_blocks);
}
```

```cpp
#include <hip/hip_runtime.h>
#include <hip/hip_fp16.h>
#include <hip/hip_cooperative_groups.h>
#include <stdint.h>
#include <stdio.h>
namespace cg = cooperative_groups;

typedef _Float16 f16;
typedef f16 f16x8 __attribute__((ext_vector_type(8)));
typedef f16 f16x4 __attribute__((ext_vector_type(4)));
typedef f16 f16x2 __attribute__((ext_vector_type(2)));
typedef float f32x4 __attribute__((ext_vector_type(4)));
typedef int i32x4 __attribute__((ext_vector_type(4)));

#define T_TOK 32768
#define DM 1024
#define SEQ 4096
#define PJ_W 1536
#define PA_W 1448
#define IN_W 3496
#define IN_WP 3584
#define C_Q 512
#define C_K 1024
#define C_V 1088
#define C_IQ 1152
#define C_IK 1408
#define C_IW 1440
#define ALPHA 1.189207115002721f
#define NEG_BIG (-1e30f)

#define SZ_A   ((size_t)T_TOK * DM * 2)
#define SZ_B   ((size_t)T_TOK * PJ_W * 2)
#define SZ_C   ((size_t)T_TOK * 2048 * 2)
#define SZ_D   ((size_t)T_TOK * DM * 2)
#define OFF_A  ((size_t)0)
#define OFF_B  (OFF_A + SZ_A)
#define OFF_C  (OFF_B + SZ_B)
#define OFF_D  (OFF_C + SZ_C)
#define OFF_W  (OFF_D + SZ_D)
#define OFF_WIN   (OFF_W)
#define OFF_WPOOL (OFF_WIN + (size_t)IN_WP * 1024 * 2)
#define OFF_WPP   (OFF_WPOOL + (size_t)4 * 128 * 128 * 2)
#define OFF_WPA   (OFF_WPP + (size_t)1024 * 512 * 2)
#define OFF_WOUT  (OFF_WPA + (size_t)1024 * 512 * 2)
#define OFF_WGU   (OFF_WOUT + (size_t)1024 * 1024 * 2)
#define OFF_WDN   (OFF_WGU + (size_t)32 * 512 * 1024 * 2)
#define OFF_MISC  (OFF_WDN + (size_t)32 * 1024 * 256 * 2)
#define OFF_ROUTE_E (OFF_MISC)
#define OFF_ROUTE_W (OFF_ROUTE_E + (size_t)T_TOK * 2 * 4)
#define OFF_COUNTS  (OFF_ROUTE_W + (size_t)T_TOK * 2 * 4)
#define OFF_LISTS   (OFF_COUNTS + 256)
#define OFF_SEL     (OFF_LISTS + (size_t)32 * T_TOK * 4)
#define OFF_CNT      (OFF_SEL + (size_t)T_TOK * 256 * 2)
#define OFF_WRT      (OFF_CNT + 4096)
#define OFF_BAR      (OFF_WRT + 2 * 36 * 1024 * 2)
#define WS_NEEDED   (OFF_BAR + 16384)
#define CNT_STRIDE 32

struct Params {
  const float *x, *ln_in_g, *ln_in_b, *w_in, *b_gate, *pool_w, *pool_scale, *wpp, *wpa, *w_out, *ln1_g, *ln1_b, *w_group,
      *b_group, *w_router, *b_router, *w_gate, *w_up, *w_down, *ln2_g, *ln2_b;
  float* out;
  char* ws;
};

__device__ __forceinline__ float wave_sum(float v) {
#pragma unroll
  for (int o = 32; o > 0; o >>= 1) v += __shfl_xor(v, o, 64);
  return v;
}
__device__ __forceinline__ float wave_max(float v) {
#pragma unroll
  for (int o = 32; o > 0; o >>= 1) v = fmaxf(v, __shfl_xor(v, o, 64));
  return v;
}
__device__ __forceinline__ int wave_sum_i(int v) {
#pragma unroll
  for (int o = 32; o > 0; o >>= 1) v += __shfl_xor(v, o, 64);
  return v;
}
__device__ __forceinline__ int opaque_tid() { int t = threadIdx.x; asm volatile("" : "+v"(t)); return t; }
__device__ __forceinline__ float ldf(const float* p) { return *p; }
__device__ __forceinline__ float ldf(const f16* p) { return (float)*p; }

#ifndef SKEW_P1
#define SKEW_P1 0
#endif
#define WAIT_V(n) asm volatile("s_waitcnt vmcnt(%0)" ::"n"(n) : "memory")
#define WAIT_L(n) asm volatile("s_waitcnt lgkmcnt(%0)" ::"n"(n) : "memory")
template <class T> __device__ __forceinline__ void st_nt(T* p, const T& v) { *p = v; }
#define RAW_SYNC() do { asm volatile("s_waitcnt lgkmcnt(0)" ::: "memory"); __builtin_amdgcn_s_barrier(); asm volatile("" ::: "memory"); } while (0)

__device__ __forceinline__ int lds_byte(int r, int c) {
  int ob = (r & 15) * 64 + c * 2;
  return (r >> 4) * 1024 + (ob ^ (((ob >> 9) & 1) << 5));
}
__device__ __forceinline__ void stage_rc(int b, int& R, int& C) {
  int st = b >> 10, sb = b & 1023, swz = sb ^ (((sb >> 9) & 1) << 5);
  R = st * 16 + swz / 64;
  C = (swz % 64) / 2;
}

#define TILE_B 16384
#define SLOT_B 32768
#define NSTG 2
#define GEMM_LDS 135168
#define EPI_LD 528

__device__ __forceinline__ void gemm_core(const f16* __restrict__ Ab, const unsigned (&pa)[NSTG], const f16* __restrict__ Bb,
                                          const unsigned (&pb)[NSTG], int nt, f32x4 (&acc)[8][4], char* shm) {
  const int tid = threadIdx.x, wid = tid >> 6, lane = tid & 63, wr = wid >> 2, wc = wid & 3, fr = lane & 15, fq = lane >> 4;
  const int nk = nt * 2;
#define SA(s_) (shm + (s_) * SLOT_B)
#define SB(s_) (shm + (s_) * SLOT_B + TILE_B)
#define GLDS_STAGE(slot, kt)                                                                                              \
  do {                                                                                                                    \
    _Pragma("unroll") for (int i = 0; i < NSTG; ++i) {                                                                   \
      __builtin_amdgcn_global_load_lds((const unsigned*)(Ab + pa[i] + (kt) * 32), (unsigned*)(SA(slot) + wid * 1024 + i * 8192), \
                                       16, 0, 0);                                                                         \
      __builtin_amdgcn_global_load_lds((const unsigned*)(Bb + pb[i] + (kt) * 32), (unsigned*)(SB(slot) + wid * 1024 + i * 8192), \
                                       16, 0, 0);                                                                         \
    }                                                                                                                     \
  } while (0)
  GLDS_STAGE(0, 0);
  GLDS_STAGE(1, 1);
  GLDS_STAGE(2, 2);
  const int aoff = lds_byte(wr * 128 + fr, fq * 8), boff = lds_byte(wc * 64 + fr, fq * 8);
  for (int t = 0; t < nk; ++t) {
    if (t + 2 < nk) WAIT_V(8); else if (t + 1 < nk) WAIT_V(4); else WAIT_V(0);
    __builtin_amdgcn_s_barrier();
    if (t + 3 < nk) GLDS_STAGE((t + 3) & 3, t + 3);
    const char* sa = SA(t & 3) + aoff;
    const char* sb = SB(t & 3) + boff;
    f16x8 Bf[4];
#pragma unroll
    for (int n = 0; n < 4; ++n) Bf[n] = *(const f16x8*)(sb + n * 1024);
#pragma unroll
    for (int hf = 0; hf < 2; ++hf) {
      f16x8 At[4];
#pragma unroll
      for (int m = 0; m < 4; ++m) At[m] = *(const f16x8*)(sa + (hf * 4 + m) * 1024);
#pragma unroll
      for (int m = 0; m < 4; ++m)
#pragma unroll
        for (int n = 0; n < 4; ++n)
          acc[hf * 4 + m][n] = __builtin_amdgcn_mfma_f32_16x16x32_f16(At[m], Bf[n], acc[hf * 4 + m][n], 0, 0, 0);
      if (hf == 0) __builtin_amdgcn_sched_barrier(0);
    }
    WAIT_L(0);
  }
  RAW_SYNC();
#undef SA
#undef SB
#undef GLDS_STAGE
}

__device__ __forceinline__ void epi_store_f16(const f32x4 (&acc)[8][4], char* shm) {
  const int tid = opaque_tid(), wid = tid >> 6, lane = tid & 63, wr = wid >> 2, wc = wid & 3, fr = lane & 15, fq = lane >> 4;
#pragma unroll
  for (int m = 0; m < 8; ++m)
#pragma unroll
    for (int n = 0; n < 4; ++n) {
      f16x4 v;
      v[0] = (f16)acc[m][n][0]; v[1] = (f16)acc[m][n][1]; v[2] = (f16)acc[m][n][2]; v[3] = (f16)acc[m][n][3];
      *(f16x4*)(shm + (wc * 64 + n * 16 + fr) * EPI_LD + (wr * 128 + m * 16 + fq * 4) * 2) = v;
    }
}

__device__ __forceinline__ void p_ln_in(const Params& p) {
  f16* h16 = (f16*)(p.ws + OFF_A);
  const int tid = opaque_tid(), lane = tid & 63, wid = tid >> 6;
  const int nw = gridDim.x * 8;
  for (int t = blockIdx.x * 8 + wid; t < T_TOK; t += nw) {
    const float* xr = p.x + (size_t)t * DM;
    float4 v[4];
#pragma unroll
    for (int i = 0; i < 4; ++i) v[i] = *(const float4*)(xr + i * 256 + lane * 4);
    float s = 0.f;
#pragma unroll
    for (int i = 0; i < 4; ++i) s += v[i].x + v[i].y + v[i].z + v[i].w;
    float mu = wave_sum(s) * (1.0f / DM);
    float q = 0.f;
#pragma unroll
    for (int i = 0; i < 4; ++i) {
      v[i].x -= mu; v[i].y -= mu; v[i].z -= mu; v[i].w -= mu;
      q += v[i].x * v[i].x + v[i].y * v[i].y + v[i].z * v[i].z + v[i].w * v[i].w;
    }
    float rs = rsqrtf(wave_sum(q) * (1.0f / DM) + 1e-5f);
#pragma unroll
    for (int i = 0; i < 4; ++i) {
      float4 g = *(const float4*)(p.ln_in_g + i * 256 + lane * 4), b = *(const float4*)(p.ln_in_b + i * 256 + lane * 4);
      f16x4 o;
      o[0] = (f16)(v[i].x * rs * g.x + b.x); o[1] = (f16)(v[i].y * rs * g.y + b.y);
      o[2] = (f16)(v[i].z * rs * g.z + b.z); o[3] = (f16)(v[i].w * rs * g.w + b.w);
      *(f16x4*)(h16 + (size_t)t * DM + i * 256 + lane * 4) = o;
    }
  }
}

template <class RowMap>
__device__ __forceinline__ void conv_tile(const float* __restrict__ src, int ld_src, int nvalid, int k0, int n0, f16* __restrict__ dst,
                                          int ld_dst, RowMap rm, float* sT) {
  const int tid = opaque_tid();
  {
    int k = tid >> 3, n = (tid & 7) * 8;
    const float* sp = src + (size_t)(k0 + k) * ld_src + n0 + n;
#pragma unroll
    for (int j = 0; j < 8; ++j) sT[k * 65 + n + j] = (n0 + n + j < nvalid) ? sp[j] : 0.f;
  }
  __syncthreads();
  {
    int n = tid >> 3, k = (tid & 7) * 8;
    f16x8 o;
#pragma unroll
    for (int j = 0; j < 8; ++j) o[j] = (f16)sT[(k + j) * 65 + n];
    int drow = rm(n0 + n);
    if (drow >= 0) *(f16x8*)(dst + (size_t)drow * ld_dst + k0 + k) = o;
  }
  __syncthreads();
}

struct RowId { __device__ int operator()(int n) const { return n; } };
struct RowGU { int up; __device__ int operator()(int ff) const {
  int tile = ff >> 7, wr = (ff >> 6) & 1, l = ff & 63; return tile * 256 + wr * 128 + up * 64 + l; } };

__device__ __forceinline__ void p_convert(const Params& p, char* shm) {
  float* sT = (float*)shm;
  char* ws = p.ws;
  const int J0 = 16 * 56, J1 = J0 + 16, J2 = J1 + 128, J3 = J2 + 128, J4 = J3 + 256, J5 = J4 + 32 * 64, J6 = J5 + 32 * 64,
            J7 = J6 + 32 * 64;
  for (int job = blockIdx.x; job < J7; job += gridDim.x) {
    if (job < J0) {
      int kt = job / 56, nt = job % 56;
      conv_tile(p.w_in, IN_W, IN_W, kt * 64, nt * 64, (f16*)(ws + OFF_WIN), 1024, RowId(), sT);
    } else if (job < J1) {
      int j = job - J0, g = j >> 2, kt = (j >> 1) & 1, nt = j & 1;
      conv_tile(p.pool_w + g * 128 * 128, 128, 128, kt * 64, nt * 64, (f16*)(ws + OFF_WPOOL) + g * 128 * 128, 128, RowId(), sT);
    } else if (job < J2) {
      int j = job - J1, kt = j >> 4, nt = j & 15;
      conv_tile(p.wpp, 1024, 1024, kt * 64, nt * 64, (f16*)(ws + OFF_WPP), 512, RowId(), sT);
    } else if (job < J3) {
      int j = job - J2, kt = j >> 4, nt = j & 15;
      conv_tile(p.wpa, 1024, 1024, kt * 64, nt * 64, (f16*)(ws + OFF_WPA), 512, RowId(), sT);
    } else if (job < J4) {
      int j = job - J3, kt = j >> 4, nt = j & 15;
      conv_tile(p.w_out, 1024, 1024, kt * 64, nt * 64, (f16*)(ws + OFF_WOUT), 1024, RowId(), sT);
    } else if (job < J6) {
      int up = job >= J5;
      int j = job - (up ? J5 : J4), e = j >> 6, kt = (j >> 2) & 15, nt = j & 3;
      RowGU rm; rm.up = up;
      conv_tile((up ? p.w_up : p.w_gate) + (size_t)e * 1024 * 256, 256, 256, kt * 64, nt * 64,
                (f16*)(ws + OFF_WGU) + (size_t)e * 512 * 1024, 1024, rm, sT);
    } else {
      int j = job - J6, e = j >> 6, kt = (j >> 4) & 3, nt = j & 15;
      conv_tile(p.w_down + (size_t)e * 256 * 1024, 1024, 1024, kt * 64, nt * 64, (f16*)(ws + OFF_WDN) + (size_t)e * 1024 * 256,
                256, RowId(), sT);
    }
  }
  {
    f16* whi = (f16*)(ws + OFF_WRT);
    f16* wlo = whi + 36 * 1024;
    for (int i = blockIdx.x * 512 + threadIdx.x; i < 36 * 1024; i += gridDim.x * 512) {
      int o = i >> 10, k = i & 1023;
      float w = (o < 4) ? p.w_group[k * 4 + o] : p.w_router[k * 32 + (o - 4)];
      f16 h = (f16)w;
      whi[i] = h;
      wlo[i] = (f16)(w - (float)h);
    }
  }
}

__device__ __forceinline__ void phase_skew(int us4) {
  const int k = (blockIdx.x >> 3) & 3;
  if (k) {
    const unsigned long long t0 = __builtin_amdgcn_s_memrealtime();
    const unsigned long long dt = (unsigned long long)(k * us4 * 25);
    while (__builtin_amdgcn_s_memrealtime() - t0 < dt) __builtin_amdgcn_s_sleep(8);
  }
}

__device__ __forceinline__ int xcd_item(int n_items, int r) {
  const int nx = 8, slots = gridDim.x >> 3;
  const int xcd = blockIdx.x & 7, slot = blockIdx.x >> 3;
  const int per = (n_items + nx - 1) / nx;
  const int local = slot + r * slots;
  if (local >= per) return -1;
  const int item = xcd * per + local;
  return (item < n_items) ? item : -2;
}

__device__ __forceinline__ void p_inproj(const Params& p, char* shm) {
  const f16* h16 = (const f16*)(p.ws + OFF_A);
  const f16* wT = (const f16*)(p.ws + OFF_WIN);
  f16* proj16 = (f16*)(p.ws + OFF_B);
  f16* gate16 = (f16*)(p.ws + OFF_C);
  const int tid = opaque_tid(), wid = tid >> 6, lane = tid & 63;
  int sR[NSTG], sC[NSTG];
#pragma unroll
  for (int i = 0; i < NSTG; ++i) stage_rc(wid * 1024 + i * 8192 + lane * 16, sR[i], sC[i]);
  const int NTILES = 128 * 14;
  if (SKEW_P1) phase_skew(SKEW_P1);
  for (int r = 0;; ++r) {
    int tile = xcd_item(NTILES, r);
    if (tile == -1) break;
    if (tile < 0) continue;
    int grp = tile / 56, rem = tile % 56;
    int ft = rem >> 2, tt = grp * 4 + (rem & 3);
    unsigned pa[NSTG], pb[NSTG];
#pragma unroll
    for (int i = 0; i < NSTG; ++i) {
      pa[i] = (unsigned)((ft * 256 + sR[i]) * 1024 + sC[i]);
      pb[i] = (unsigned)((tt * 256 + sR[i]) * 1024 + sC[i]);
    }
    f32x4 acc[8][4];
#pragma unroll
    for (int m = 0; m < 8; ++m)
#pragma unroll
      for (int n = 0; n < 4; ++n) acc[m][n] = (f32x4){0.f, 0.f, 0.f, 0.f};
    gemm_core(wT, pa, h16, pb, 16, acc, shm);
    epi_store_f16(acc, shm);
    RAW_SYNC();
    {
      int ch = tid & 31, r0 = tid >> 5;
      int f0 = ft * 256 + ch * 8;
      float bg[8];
      if (f0 >= PA_W && f0 < IN_W) {
#pragma unroll
        for (int j = 0; j < 8; ++j) bg[j] = p.b_gate[f0 - PA_W + j];
      } else {
#pragma unroll
        for (int j = 0; j < 8; ++j) bg[j] = 0.f;
      }
#pragma unroll 4
      for (int ps = 0; ps < 16; ++ps) {
        int r = ps * 16 + r0;
        f16x8 v = *(const f16x8*)(shm + r * EPI_LD + ch * 16);
        size_t tok = (size_t)tt * 256 + r;
        if (f0 < PA_W) {
          st_nt((f16x8*)(proj16 + tok * PJ_W + f0), v);
        } else if (f0 < IN_W) {
          f16x8 o;
#pragma unroll
          for (int j = 0; j < 8; ++j) o[j] = (f16)__builtin_amdgcn_rcpf(1.0f + __builtin_amdgcn_exp2f(-1.4426950408889634f * ((float)v[j] + bg[j])));
          st_nt((f16x8*)(gate16 + tok * 2048 + (f0 - PA_W)), o);
        }
      }
    }
    RAW_SYNC();
  }
}


__device__ __forceinline__ void zero_acc(f32x4 (&acc)[8][4]) {
#pragma unroll
  for (int m = 0; m < 8; ++m)
#pragma unroll
    for (int n = 0; n < 4; ++n) acc[m][n] = (f32x4){0.f, 0.f, 0.f, 0.f};
}

template <class RowPtr>
__device__ __forceinline__ void epi_rows_out(char* shm, RowPtr rp) {
  const int tid = opaque_tid(), ch = tid & 31, r0 = tid >> 5;
#pragma unroll 4
  for (int ps = 0; ps < 16; ++ps) {
    int r = ps * 16 + r0;
    f16x8 v = *(const f16x8*)(shm + r * EPI_LD + ch * 16);
    f16* d = rp(r);
    if (d) st_nt((f16x8*)(d + ch * 8), v);
  }
}

__device__ __forceinline__ void p_merge(const Params& p, char* shm) {
  const f16* pa16 = (const f16*)(p.ws + OFF_D);
  const f16* gate16 = (const f16*)(p.ws + OFF_C);
  const f16* wpp = (const f16*)(p.ws + OFF_WPP);
  const f16* wpa = (const f16*)(p.ws + OFF_WPA);
  f16* merged16 = (f16*)(p.ws + OFF_B);
  const int tid = opaque_tid(), wid = tid >> 6, lane = tid & 63;
  int sR[NSTG], sC[NSTG];
#pragma unroll
  for (int i = 0; i < NSTG; ++i) stage_rc(wid * 1024 + i * 8192 + lane * 16, sR[i], sC[i]);
  const int ch = tid & 31, r0 = tid >> 5;
  for (int r = 0;; ++r) {
    int tile = xcd_item(512, r);
    if (tile == -1) break;
    if (tile < 0) continue;
    int ft = tile & 3, tt = tile >> 2;
    unsigned pa[NSTG], pb[NSTG];
#pragma unroll
    for (int i = 0; i < NSTG; ++i) {
      pa[i] = (unsigned)((ft * 256 + sR[i]) * 512 + sC[i]);
      pb[i] = (unsigned)((tt * 256 + sR[i]) * 1024 + sC[i]);
    }
    {
      f32x4 acc[8][4];
      zero_acc(acc);
      gemm_core(wpp, pa, pa16, pb, 8, acc, shm);
      epi_store_f16(acc, shm);
    }
    RAW_SYNC();
#pragma unroll 2
    for (int ps = 0; ps < 16; ++ps) {
      const int rr = ps * 16 + r0;
      const size_t tok = (size_t)tt * 256 + rr;
      f16x8 v = *(const f16x8*)(shm + rr * EPI_LD + ch * 16);
      f16x8 g = *(const f16x8*)(gate16 + tok * 2048 + ft * 256 + ch * 8);
      f16x8 o;
#pragma unroll
      for (int e = 0; e < 8; ++e) o[e] = (f16)((float)v[e] * (float)g[e]);
      *(f16x8*)(merged16 + tok * 1024 + ft * 256 + ch * 8) = o;
    }
    RAW_SYNC();
    {
      f32x4 acc[8][4];
      zero_acc(acc);
      gemm_core(wpa, pa, pa16 + 512, pb, 8, acc, shm);
      epi_store_f16(acc, shm);
    }
    RAW_SYNC();
#pragma unroll 2
    for (int ps = 0; ps < 16; ++ps) {
      const int rr = ps * 16 + r0;
      const size_t tok = (size_t)tt * 256 + rr;
      f16x8 v = *(const f16x8*)(shm + rr * EPI_LD + ch * 16);
      f16x8 g = *(const f16x8*)(gate16 + tok * 2048 + 1024 + ft * 256 + ch * 8);
      f16x8 m0 = *(const f16x8*)(merged16 + tok * 1024 + ft * 256 + ch * 8);
      f16x8 o;
#pragma unroll
      for (int e = 0; e < 8; ++e) o[e] = (f16)((float)m0[e] + (float)v[e] * (float)g[e]);
      *(f16x8*)(merged16 + tok * 1024 + ft * 256 + ch * 8) = o;
    }
    RAW_SYNC();
  }
}

__device__ __forceinline__ void p_resid(const Params& p, char* shm) {
  const f16* merged16 = (const f16*)(p.ws + OFF_B);
  const f16* h16 = (const f16*)(p.ws + OFF_A);
  const f16* wo = (const f16*)(p.ws + OFF_WOUT);
  float* z32 = (float*)(p.ws + OFF_C);
  const int tid = opaque_tid(), wid = tid >> 6, lane = tid & 63;
  int sR[NSTG], sC[NSTG];
#pragma unroll
  for (int i = 0; i < NSTG; ++i) stage_rc(wid * 1024 + i * 8192 + lane * 16, sR[i], sC[i]);
  const int ch = tid & 31, r0 = tid >> 5;
  for (int r = 0;; ++r) {
    int tile = xcd_item(512, r);
    if (tile == -1) break;
    if (tile < 0) continue;
    int ft = tile & 3, tt = tile >> 2;
    unsigned pa[NSTG], pb[NSTG];
#pragma unroll
    for (int i = 0; i < NSTG; ++i) {
      pa[i] = (unsigned)((ft * 256 + sR[i]) * 1024 + sC[i]);
      pb[i] = (unsigned)((tt * 256 + sR[i]) * 1024 + sC[i]);
    }
    {
      f32x4 acc[8][4];
      zero_acc(acc);
      gemm_core(wo, pa, merged16, pb, 16, acc, shm);
      epi_store_f16(acc, shm);
    }
    RAW_SYNC();
#pragma unroll 4
    for (int ps = 0; ps < 16; ++ps) {
      const int rr = ps * 16 + r0;
      const size_t o = ((size_t)tt * 256 + rr) * 1024 + ft * 256 + ch * 8;
      f16x8 v = *(const f16x8*)(shm + rr * EPI_LD + ch * 16);
      f16x8 hv = *(const f16x8*)(h16 + o);
      f32x4 z0, z1;
#pragma unroll
      for (int e = 0; e < 4; ++e) { z0[e] = ALPHA * (float)hv[e] + (float)v[e]; z1[e] = ALPHA * (float)hv[4 + e] + (float)v[4 + e]; }
      st_nt((f32x4*)(z32 + o), z0);
      st_nt((f32x4*)(z32 + o + 4), z1);
    }
    RAW_SYNC();
  }
}

#define HID_ROWS 73728
__device__ __forceinline__ void moe_tiles(const int* counts, int (&pre)[33]) {
  pre[0] = 0;
#pragma unroll
  for (int e = 0; e < 32; ++e) pre[e + 1] = pre[e] + ((counts[e * CNT_STRIDE] + 255) >> 8);
}
__device__ __forceinline__ void moe_find(const int (&pre)[33], int item, int& e, int& mt) {
  e = 0;
#pragma unroll
  for (int i = 1; i < 32; ++i) if (item >= pre[i]) e = i;
  int base = 0;
#pragma unroll
  for (int i = 0; i < 32; ++i) if (i == e) base = pre[i];
  mt = item - base;
}

__device__ __forceinline__ void p_moe_a(const Params& p, char* shm) {
  const f16* h1 = (const f16*)(p.ws + OFF_A);
  const f16* wgu = (const f16*)(p.ws + OFF_WGU);
  const int* counts = (const int*)(p.ws + OFF_CNT);
  const int* lists = (const int*)(p.ws + OFF_LISTS);
  f16* hid16 = (f16*)(p.ws + OFF_B);
  const int tid = opaque_tid(), wid = tid >> 6, lane = tid & 63, wr = wid >> 2, wc = wid & 3, fr = lane & 15, fq = lane >> 4;
  int sR[NSTG], sC[NSTG];
#pragma unroll
  for (int i = 0; i < NSTG; ++i) stage_rc(wid * 1024 + i * 8192 + lane * 16, sR[i], sC[i]);
  int pre[33];
  moe_tiles(counts, pre);
  const int total = pre[32] * 2;
  for (int r = 0;; ++r) {
    int item = xcd_item(total, r);
    if (item == -1) break;
    if (item < 0) continue;
    int e, mt;
    moe_find(pre, item >> 1, e, mt);
    const int fh = item & 1;
    const int cnt_e = counts[e * CNT_STRIDE];
    int rowbase = 0;
#pragma unroll
    for (int i = 0; i < 32; ++i) if (i == e) rowbase = pre[i] * 256;
    unsigned pa[NSTG], pb[NSTG];
    f32x4 acc[8][4];
    zero_acc(acc);
#pragma unroll
    for (int i = 0; i < NSTG; ++i) {
      pa[i] = (unsigned)((e * 512 + fh * 256 + sR[i]) * 1024 + sC[i]);
      int idx = mt * 256 + sR[i];
      int tok = (idx < cnt_e) ? (lists[(size_t)e * T_TOK + idx] >> 1) : 0;
      pb[i] = (unsigned)(tok * 1024 + sC[i]);
    }
    gemm_core(wgu, pa, h1, pb, 16, acc, shm);
#pragma unroll
    for (int m = 0; m < 4; ++m)
#pragma unroll
      for (int n = 0; n < 4; ++n) {
        f16x4 o;
#pragma unroll
        for (int j = 0; j < 4; ++j) {
          float g = acc[m][n][j], u = acc[m + 4][n][j];
          o[j] = (f16)(g * u * __builtin_amdgcn_rcpf(1.0f + __builtin_amdgcn_exp2f(-1.4426950408889634f * g)));
        }
        size_t row = (size_t)rowbase + mt * 256 + wc * 64 + n * 16 + fr;
        *(f16x4*)(hid16 + row * 256 + fh * 128 + wr * 64 + m * 16 + fq * 4) = o;
      }
  }
}

__device__ __forceinline__ void p_moe_b(const Params& p, char* shm) {
  const f16* wdn = (const f16*)(p.ws + OFF_WDN);
  const f16* hid16 = (const f16*)(p.ws + OFF_B);
  const float* route_w = (const float*)(p.ws + OFF_ROUTE_W);
  const int* counts = (const int*)(p.ws + OFF_CNT);
  const int* lists = (const int*)(p.ws + OFF_LISTS);
  f16* y16 = (f16*)(p.ws + OFF_C);
  int* sent = (int*)(shm + 256 * EPI_LD);
  const int tid = opaque_tid(), wid = tid >> 6, lane = tid & 63, wc = wid & 3, fr = lane & 15;
  int sR[NSTG], sC[NSTG];
#pragma unroll
  for (int i = 0; i < NSTG; ++i) stage_rc(wid * 1024 + i * 8192 + lane * 16, sR[i], sC[i]);
  int pre[33];
  moe_tiles(counts, pre);
  const int total = pre[32] * 4;
  for (int r = 0;; ++r) {
    int item = xcd_item(total, r);
    if (item == -1) break;
    if (item < 0) continue;
    int e, mt;
    moe_find(pre, item >> 2, e, mt);
    const int ft = item & 3;
    const int cnt_e = counts[e * CNT_STRIDE];
    int rowbase = 0;
#pragma unroll
    for (int i = 0; i < 32; ++i) if (i == e) rowbase = pre[i] * 256;
    if (tid < 256) {
      int idx = mt * 256 + tid;
      sent[tid] = (idx < cnt_e) ? lists[(size_t)e * T_TOK + idx] : -1;
    }
    unsigned pa[NSTG], pb[NSTG];
    f32x4 acc[8][4];
    zero_acc(acc);
#pragma unroll
    for (int i = 0; i < NSTG; ++i) {
      pa[i] = (unsigned)((e * 1024 + ft * 256 + sR[i]) * 256 + sC[i]);
      pb[i] = (unsigned)((rowbase + mt * 256 + sR[i]) * 256 + sC[i]);
    }
    gemm_core(wdn, pa, hid16, pb, 4, acc, shm);
#pragma unroll
    for (int n = 0; n < 4; ++n) {
      int en = sent[wc * 64 + n * 16 + fr];
      float rw = (en >= 0) ? route_w[en] : 0.f;
#pragma unroll
      for (int m = 0; m < 8; ++m)
#pragma unroll
        for (int j = 0; j < 4; ++j) acc[m][n][j] *= rw;
    }
    epi_store_f16(acc, shm);
    RAW_SYNC();
    epi_rows_out(shm, [&](int r) -> f16* { int en = sent[r]; return (en >= 0) ? (y16 + (size_t)en * 1024 + ft * 256) : (f16*)nullptr; });
    RAW_SYNC();
  }
}


__device__ __forceinline__ unsigned f2key_(float f) {
  if (f == 0.f) f = 0.f;
  unsigned u = __float_as_uint(f);
  return (u & 0x80000000u) ? ~u : (u | 0x80000000u);
}
__device__ __forceinline__ float key2f_(unsigned k) {
  return __uint_as_float((k & 0x80000000u) ? (k & 0x7fffffffu) : ~k);
}
__device__ __forceinline__ void find_bin(const unsigned* hrow, int need, int lane, int* out_bin, int* out_above) {
  uint4 c = *(const uint4*)(hrow + 4 * lane);
  int tot = (int)(c.x + c.y + c.z + c.w);
  int incl = tot;
#pragma unroll
  for (int o = 1; o < 64; o <<= 1) {
    int v = __shfl_down(incl, o, 64);
    if (lane + o < 64) incl += v;
  }
  int above = incl - tot;
  if (above < need && incl >= need) {
    int b;
    if (above + (int)c.w >= need) b = 3;
    else { above += c.w; if (above + (int)c.z >= need) b = 2;
      else { above += c.z; if (above + (int)c.y >= need) b = 1; else { above += c.y; b = 0; } } }
    *out_bin = 4 * lane + b;
    *out_above = above;
  }
}

__device__ __forceinline__ f32x4 score_tile(const f16x8& a, const f16x8 (&bq)[8], const f16x8& bc_hi, const f16x8& bc_lo,
                                            const float (&wq)[8]) {
  f32x4 L[8];
#pragma unroll
  for (int h = 0; h < 8; ++h) L[h] = __builtin_amdgcn_mfma_f32_16x16x32_f16(a, bq[h], (f32x4){0.f, 0.f, 0.f, 0.f}, 0, 0, 0);
  f32x4 s = __builtin_amdgcn_mfma_f32_16x16x32_f16(a, bc_lo, (f32x4){0.f, 0.f, 0.f, 0.f}, 0, 0, 0);
  s = __builtin_amdgcn_mfma_f32_16x16x32_f16(a, bc_hi, s, 0, 0, 0);
  __builtin_amdgcn_sched_barrier(0);
#pragma unroll
  for (int h = 0; h < 8; ++h)
#pragma unroll
    for (int jj = 0; jj < 4; ++jj) s[jj] = __builtin_fmaf(wq[h], __builtin_fabsf(L[h][jj]), s[jj]);
  return s;
}

#define IDX_KEYS 0
#define IDX_HIST 131072
#define IDX_SSEL (IDX_HIST + 16384)
#define IDX_CAND (IDX_SSEL + 8192)
#define IDX_MISC (IDX_CAND + 2048)
template <int V>
__device__ __forceinline__ void p_index(const Params& p, char* shm) {
  const f16* proj16 = (const f16*)(p.ws + OFF_B);
  unsigned short* sel16 = (V == 0) ? (unsigned short*)(p.ws + OFF_SEL) : (unsigned short*)p.out;
  unsigned short* keys16 = (unsigned short*)(shm + IDX_KEYS);
  unsigned* hist = (unsigned*)(shm + IDX_HIST);
  unsigned short* ssel = (unsigned short*)(shm + IDX_SSEL);
  unsigned short* scand = (unsigned short*)(shm + IDX_CAND);
  unsigned* smm = (unsigned*)(shm + IDX_MISC);
  int* sbin = (int*)(smm + 32);
  const int tid = opaque_tid(), wid = tid >> 6, lane = tid & 63, fr = lane & 15, fq = lane >> 4;
  const float NINF = -__builtin_huge_valf(), PINF = __builtin_huge_valf();
  const unsigned long long lt_mask = (1ull << lane) - 1ull;
  for (int rnd = 0;; ++rnd) {
    int idx = rnd * gridDim.x + ((rnd & 1) ? (gridDim.x - 1 - blockIdx.x) : blockIdx.x);
    if (idx >= 2048) break;
    const int b = idx & 7, j = 255 - (idx >> 3);
    const int l0 = j * 16, t0 = b * SEQ + l0;
    if (j < 16) {
      for (int i = tid; i < 4096; i += 512) sel16[(size_t)t0 * 256 + i] = (unsigned short)(i & 255);
      continue;
    }
    for (int i = tid; i < 4096; i += 512) hist[i] = 0;
    if (tid < 16) { smm[tid] = 0xFFFFFFFFu; smm[16 + tid] = 0u; }
    f16x8 bq[8];
    float wq[8];
    {
      const f16* qrow = proj16 + (size_t)(t0 + fr) * PJ_W;
#pragma unroll
      for (int h = 0; h < 8; ++h) bq[h] = *(const f16x8*)(qrow + C_IQ + h * 32 + fq * 8);
      f16x8 wv = *(const f16x8*)(qrow + C_IW);
#pragma unroll
      for (int h = 0; h < 8; ++h) wq[h] = (float)wv[h];
    }
    f16x8 bc_hi, bc_lo;
#pragma unroll
    for (int e = 0; e < 8; ++e) {
      float c = 0.f;
#pragma unroll
      for (int h = 0; h < 8; ++h) c = __builtin_fmaf(wq[h], (float)bq[h][e], c);
      f16 ch_ = (f16)c;
      bc_hi[e] = ch_;
      bc_lo[e] = (f16)(c - (float)ch_);
    }
    __syncthreads();
    const int wids = __builtin_amdgcn_readfirstlane(wid);
    const int klast = (j - 1) - ((j - 1 - wids) & 7);
    const f16* kbase = proj16 + (size_t)(b * SEQ + fr) * PJ_W + C_IK + fq * 8;
#define IK_LOAD(dst, kt0)                                                                   \
  _Pragma("unroll") for (int u = 0; u < 4; ++u) {                                           \
    int ktc = min((kt0) + 8 * u, klast);                                                    \
    dst[u] = *(const f16x8*)(kbase + (size_t)(ktc * 16) * PJ_W);                            \
  }
    {
      float mn = PINF, mx = NINF;
      f16x8 a[4];
      IK_LOAD(a, wids);
      for (int kt0 = wids; kt0 < j; kt0 += 32) {
        f16x8 an[4];
        IK_LOAD(an, kt0 + 32);
#pragma unroll
        for (int u = 0; u < 4; ++u) {
          if (kt0 + 8 * u < j) {
            f32x4 sc = score_tile(a[u], bq, bc_hi, bc_lo, wq);
            mn = fminf(fminf(mn, sc[0]), fminf(fminf(sc[1], sc[2]), sc[3]));
            mx = fmaxf(fmaxf(mx, sc[0]), fmaxf(fmaxf(sc[1], sc[2]), sc[3]));
          }
        }
#pragma unroll
        for (int u = 0; u < 4; ++u) a[u] = an[u];
      }
      if ((j & 7) == wids) {
        f16x8 ad = *(const f16x8*)(kbase + (size_t)(j * 16) * PJ_W);
        f32x4 sc = score_tile(ad, bq, bc_hi, bc_lo, wq);
#pragma unroll
        for (int jj = 0; jj < 4; ++jj) {
          bool ok = (fq * 4 + jj <= fr);
          mn = fminf(mn, ok ? sc[jj] : PINF);
          mx = fmaxf(mx, ok ? sc[jj] : NINF);
        }
      }
      mn = fminf(mn, __shfl_xor(mn, 16, 64)); mn = fminf(mn, __shfl_xor(mn, 32, 64));
      mx = fmaxf(mx, __shfl_xor(mx, 16, 64)); mx = fmaxf(mx, __shfl_xor(mx, 32, 64));
      if (fq == 0) {
        if (mn != PINF) atomicMin(&smm[fr], f2key_(mn));
        if (mx != NINF) atomicMax(&smm[16 + fr], f2key_(mx));
      }
    }
    __syncthreads();
    {
      const float lo = key2f_(smm[fr]), hi = key2f_(smm[16 + fr]);
      const float s16 = (hi > lo) ? 65536.0f / (hi - lo) : 0.f;
      const float nlo = -lo * s16;
      unsigned* hq = hist + fr * 256;
      unsigned short* kq = keys16 + fr * 4096 + fq * 4;
      f16x8 a[4];
      IK_LOAD(a, wids);
      for (int kt0 = wids; kt0 < j; kt0 += 32) {
        f16x8 an[4];
        IK_LOAD(an, kt0 + 32);
#pragma unroll
        for (int u = 0; u < 4; ++u) {
          const int kt = kt0 + 8 * u;
          if (kt < j) {
            f32x4 sc = score_tile(a[u], bq, bc_hi, bc_lo, wq);
            unsigned kk[4];
#pragma unroll
            for (int jj = 0; jj < 4; ++jj) {
              int k16 = min(max((int)__builtin_fmaf(sc[jj], s16, nlo), 0), 65535);
              kk[jj] = (unsigned)k16;
              atomicAdd(&hq[k16 >> 8], 1u);
            }
            uint2 pk;
            pk.x = kk[0] | (kk[1] << 16);
            pk.y = kk[2] | (kk[3] << 16);
            *(uint2*)(kq + kt * 16) = pk;
          }
        }
#pragma unroll
        for (int u = 0; u < 4; ++u) a[u] = an[u];
      }
      if ((j & 7) == wids) {
        f16x8 ad = *(const f16x8*)(kbase + (size_t)(j * 16) * PJ_W);
        f32x4 sc = score_tile(ad, bq, bc_hi, bc_lo, wq);
        unsigned kk[4];
#pragma unroll
        for (int jj = 0; jj < 4; ++jj) {
          int k16 = min(max((int)__builtin_fmaf(sc[jj], s16, nlo), 0), 65535);
          kk[jj] = (unsigned)k16;
          if (fq * 4 + jj <= fr) atomicAdd(&hq[k16 >> 8], 1u);
        }
        uint2 pk;
        pk.x = kk[0] | (kk[1] << 16);
        pk.y = kk[2] | (kk[3] << 16);
        *(uint2*)(kq + j * 16) = pk;
      }
    }
#undef IK_LOAD
    __syncthreads();
    if (V == 2) continue;
    {
      const int q0 = 2 * wid, lq0 = l0 + q0;
      const int nmax = lq0 + 2;
      unsigned* hrow0 = hist + q0 * 256;
      const unsigned short* krow0 = keys16 + q0 * 4096;
      if (lane < 4) sbin[2 * q0 + lane] = 0;
      find_bin(hrow0, 256, lane, &sbin[2 * q0], &sbin[2 * q0 + 1]);
      find_bin(hrow0 + 256, 256, lane, &sbin[2 * q0 + 2], &sbin[2 * q0 + 3]);
      asm volatile("s_waitcnt lgkmcnt(0)" ::: "memory");
      const int b1s0 = sbin[2 * q0], ab0 = sbin[2 * q0 + 1], b1s1 = sbin[2 * q0 + 2], ab1 = sbin[2 * q0 + 3];
      asm volatile("s_waitcnt lgkmcnt(0)" ::: "memory");
      *(uint4*)(hrow0 + 4 * lane) = make_uint4(0u, 0u, 0u, 0u);
      *(uint4*)(hrow0 + 256 + 4 * lane) = make_uint4(0u, 0u, 0u, 0u);
      if (lane < 4) sbin[2 * q0 + lane] = 0;
      asm volatile("s_waitcnt lgkmcnt(0)" ::: "memory");
      for (int s4 = lane * 4; s4 < nmax; s4 += 256) {
        uint2 pa_ = *(const uint2*)(krow0 + s4), pb_ = *(const uint2*)(krow0 + 4096 + s4);
        unsigned ka[4] = {pa_.x & 0xffffu, pa_.x >> 16, pa_.y & 0xffffu, pa_.y >> 16};
        unsigned kb[4] = {pb_.x & 0xffffu, pb_.x >> 16, pb_.y & 0xffffu, pb_.y >> 16};
#pragma unroll
        for (int jj = 0; jj < 4; ++jj) {
          if (s4 + jj <= lq0 && (int)(ka[jj] >> 8) == b1s0) atomicAdd(&hrow0[ka[jj] & 255u], 1u);
          if (s4 + jj <= lq0 + 1 && (int)(kb[jj] >> 8) == b1s1) atomicAdd(&hrow0[256 + (kb[jj] & 255u)], 1u);
        }
      }
      asm volatile("s_waitcnt lgkmcnt(0)" ::: "memory");
      find_bin(hrow0, 256 - ab0, lane, &sbin[2 * q0], &sbin[2 * q0 + 1]);
      find_bin(hrow0 + 256, 256 - ab1, lane, &sbin[2 * q0 + 2], &sbin[2 * q0 + 3]);
      asm volatile("s_waitcnt lgkmcnt(0)" ::: "memory");
      const unsigned thr0 = (unsigned)((b1s0 << 8) | sbin[2 * q0]), thr1 = (unsigned)((b1s1 << 8) | sbin[2 * q0 + 2]);
      int base0 = 0, cb0 = 0, base1 = 0, cb1 = 0;
      for (int s0 = 0; s0 < nmax; s0 += 256) {
        const int s4 = s0 + lane * 4;
        uint2 pa_ = make_uint2(0u, 0u), pb_ = make_uint2(0u, 0u);
        if (s4 < nmax) { pa_ = *(const uint2*)(krow0 + s4); pb_ = *(const uint2*)(krow0 + 4096 + s4); }
        unsigned ka[4] = {pa_.x & 0xffffu, pa_.x >> 16, pa_.y & 0xffffu, pa_.y >> 16};
        unsigned kb[4] = {pb_.x & 0xffffu, pb_.x >> 16, pb_.y & 0xffffu, pb_.y >> 16};
#pragma unroll
        for (int jj = 0; jj < 4; ++jj) {
          const bool ok0 = (s4 + jj <= lq0), ok1 = (s4 + jj <= lq0 + 1);
          const bool t0_ = ok0 && (ka[jj] > thr0), c0_ = ok0 && (ka[jj] == thr0);
          const bool t1_ = ok1 && (kb[jj] > thr1), c1_ = ok1 && (kb[jj] == thr1);
          unsigned long long m0 = __ballot(t0_), m1 = __ballot(t1_), cm0 = __ballot(c0_), cm1 = __ballot(c1_);
          if (t0_) ssel[q0 * 256 + base0 + __popcll(m0 & lt_mask)] = (unsigned short)(s4 + jj);
          if (t1_) ssel[q0 * 256 + 256 + base1 + __popcll(m1 & lt_mask)] = (unsigned short)(s4 + jj);
          base0 += __popcll(m0); base1 += __popcll(m1);
          if (cm0 | cm1) {
            int cp0 = cb0 + __popcll(cm0 & lt_mask), cp1 = cb1 + __popcll(cm1 & lt_mask);
            if (c0_ && cp0 < 64) scand[q0 * 64 + cp0] = (unsigned short)(s4 + jj);
            if (c1_ && cp1 < 64) scand[q0 * 64 + 64 + cp1] = (unsigned short)(s4 + jj);
            cb0 += __popcll(cm0); cb1 += __popcll(cm1);
          }
        }
      }
      asm volatile("s_waitcnt lgkmcnt(0)" ::: "memory");
#pragma unroll
      for (int x = 0; x < 2; ++x) {
        const int q = q0 + x;
        const int base = x ? base1 : base0, c = min(x ? cb1 : cb0, 64), r = 256 - base;
        if (lane < c) {
          unsigned short my = scand[q * 64 + lane];
          int rank = 0;
          for (int k = 0; k < c; ++k) rank += (scand[q * 64 + k] < my) ? 1 : 0;
          if (rank < r) ssel[q * 256 + base + rank] = my;
        }
      }
    }
    __syncthreads();
    *(uint4*)(sel16 + (size_t)t0 * 256 + tid * 8) = *(const uint4*)(ssel + tid * 8);
  }
  __syncthreads();
}

typedef short s16x4 __attribute__((ext_vector_type(4)));
#define VROW 160
#define ATT_WAVE_LDS (64 * VROW + 512)
__device__ __forceinline__ f16x8 tr_pair(const char* a, const char* b) {
  s16x4 x = __builtin_amdgcn_ds_read_tr16_b64_v4i16((__attribute__((address_space(3))) s16x4*)(a));
  s16x4 y = __builtin_amdgcn_ds_read_tr16_b64_v4i16((__attribute__((address_space(3))) s16x4*)(b));
  typedef short s16x8 __attribute__((ext_vector_type(8)));
  s16x8 r = __builtin_shufflevector(x, y, 0, 1, 2, 3, 4, 5, 6, 7);
  return __builtin_bit_cast(f16x8, r);
}
template <int V>
__device__ __forceinline__ void p_attn(const Params& p, char* shm) {
  const f16* proj16 = (const f16*)(p.ws + OFF_B);
  const unsigned short* sel16 = (const unsigned short*)(p.ws + OFF_SEL);
  f16* pa16 = (V == 0) ? (f16*)(p.ws + OFF_D) : (f16*)p.out;
  const int tid = opaque_tid(), wid = tid >> 6, lane = tid & 63, fr = lane & 15, fq = lane >> 4;
  char* vimg = shm + wid * ATT_WAVE_LDS;
  unsigned short* ssel = (unsigned short*)(vimg + 64 * VROW);
  const int tstride = gridDim.x * 8;
  int t = blockIdx.x * 8 + wid;
  uint2 sv = make_uint2(0u, 0u);
  if (t < T_TOK) sv = *(const uint2*)(sel16 + (size_t)t * 256 + lane * 4);
  for (; t < T_TOK; t += tstride) {
    const int l = t & (SEQ - 1), b0 = t - l, cnt = min(l + 1, 256);
    {
      unsigned short i0 = sv.x & 0xffff, i1 = sv.x >> 16, i2 = sv.y & 0xffff, i3 = sv.y >> 16;
      int s0 = lane * 4;
      ushort4 o;
      o.x = (s0 + 0 < cnt) ? (unsigned short)min((int)i0, l) : 0;
      o.y = (s0 + 1 < cnt) ? (unsigned short)min((int)i1, l) : 0;
      o.z = (s0 + 2 < cnt) ? (unsigned short)min((int)i2, l) : 0;
      o.w = (s0 + 3 < cnt) ? (unsigned short)min((int)i3, l) : 0;
      *(ushort4*)(ssel + s0) = o;
    }
    if (t + tstride < T_TOK) sv = *(const uint2*)(sel16 + (size_t)(t + tstride) * 256 + lane * 4);
    asm volatile("s_waitcnt lgkmcnt(0)" ::: "memory");
    f16x8 bq0, bq1;
    {
      const f16* qp = proj16 + (size_t)t * PJ_W + C_Q + (fr & 7) * 64 + fq * 8;
      bq0 = *(const f16x8*)qp;
      bq1 = *(const f16x8*)(qp + 32);
#pragma unroll
      for (int e = 0; e < 8; ++e) { bq0[e] = (fr < 8) ? bq0[e] * (f16)0.125f : (f16)0.f; bq1[e] = (fr < 8) ? bq1[e] * (f16)0.125f : (f16)0.f; }
    }
    const f16* kbase = proj16 + (size_t)b0 * PJ_W + C_K + fq * 8;
    const f16* vbase = proj16 + (size_t)b0 * PJ_W + C_V + (lane & 7) * 8;
    f32x4 S[16];
#pragma unroll
    for (int kt = 0; kt < 16; ++kt) {
      int kidx = ssel[kt * 16 + fr];
      const f16* kp = kbase + (size_t)kidx * PJ_W;
      f16x8 a0 = *(const f16x8*)kp, a1 = *(const f16x8*)(kp + 32);
      f32x4 z = {0.f, 0.f, 0.f, 0.f};
      z = __builtin_amdgcn_mfma_f32_16x16x32_f16(a0, bq0, z, 0, 0, 0);
      z = __builtin_amdgcn_mfma_f32_16x16x32_f16(a1, bq1, z, 0, 0, 0);
#pragma unroll
      for (int j = 0; j < 4; ++j) S[kt][j] = (kt * 16 + fq * 4 + j < cnt) ? z[j] : NEG_BIG;
    }
    f16x8 vv[8];
#pragma unroll
    for (int i = 0; i < 8; ++i) {
      int vidx = ssel[(lane >> 3) + 8 * i];
      vv[i] = *(const f16x8*)(vbase + (size_t)vidx * PJ_W);
    }
    float m = NEG_BIG;
#pragma unroll
    for (int kt = 0; kt < 16; ++kt)
#pragma unroll
      for (int j = 0; j < 4; ++j) m = fmaxf(m, S[kt][j]);
    m = fmaxf(m, __shfl_xor(m, 16, 64));
    m = fmaxf(m, __shfl_xor(m, 32, 64));
    float lsum = 0.f;
    f16x8 P[8];
#pragma unroll
    for (int c = 0; c < 8; ++c)
#pragma unroll
      for (int j = 0; j < 4; ++j) {
        float e0 = __expf(S[2 * c][j] - m), e1 = __expf(S[2 * c + 1][j] - m);
        lsum += e0 + e1;
        P[c][j] = (f16)e0;
        P[c][4 + j] = (f16)e1;
      }
    lsum += __shfl_xor(lsum, 16, 64);
    lsum += __shfl_xor(lsum, 32, 64);
    f32x4 O[4];
#pragma unroll
    for (int nt = 0; nt < 4; ++nt) O[nt] = (f32x4){0.f, 0.f, 0.f, 0.f};
#pragma unroll
    for (int rr = 0; rr < ((V == 1) ? 0 : 4); ++rr) {
      asm volatile("s_waitcnt lgkmcnt(0)" ::: "memory");
#pragma unroll
      for (int i = 0; i < 8; ++i) *(f16x8*)(vimg + ((lane >> 3) + 8 * i) * VROW + (lane & 7) * 16) = vv[i];
      if (rr < 3) {
#pragma unroll
        for (int i = 0; i < 8; ++i) {
          int vidx = ssel[(rr + 1) * 64 + (lane >> 3) + 8 * i];
          vv[i] = *(const f16x8*)(vbase + (size_t)vidx * PJ_W);
        }
      }
      asm volatile("s_waitcnt lgkmcnt(0)" ::: "memory");
#pragma unroll
      for (int cc = 0; cc < 2; ++cc) {
        const char* ra = vimg + (cc * 32 + fq * 4 + (fr >> 2)) * VROW + (fr & 3) * 8;
#pragma unroll
        for (int nt = 0; nt < 4; ++nt) {
          f16x8 B = tr_pair(ra + nt * 32, ra + 16 * VROW + nt * 32);
          O[nt] = __builtin_amdgcn_mfma_f32_16x16x32_f16(P[rr * 2 + cc], B, O[nt], 0, 0, 0);
        }
      }
    }
    asm volatile("s_waitcnt lgkmcnt(0)" ::: "memory");
#pragma unroll
    for (int j = 0; j < 4; ++j) {
      float ls = __shfl(lsum, (fq & 1) * 4 + j, 64);
      float inv = 1.0f / ls;
      if (fq < 2) {
        f16* op = pa16 + (size_t)t * DM + 512 + (fq * 4 + j) * 64 + fr;
#pragma unroll
        for (int nt = 0; nt < 4; ++nt) op[nt * 16] = (f16)(O[nt][j] * inv);
      }
    }
  }
}


#define DL_LD 1040
template <int W>
__device__ __forceinline__ void pool_delta(const f16* up, int lf, char* dp) {
  f16x8 u[W + 7];
#pragma unroll
  for (int k = 0; k < W + 7; ++k) {
    const int rel = k - (W - 1);
    f16x8 z = {(f16)0.f, (f16)0.f, (f16)0.f, (f16)0.f, (f16)0.f, (f16)0.f, (f16)0.f, (f16)0.f};
    u[k] = (lf + rel >= 0) ? *(const f16x8*)(up + (ptrdiff_t)rel * PJ_W) : z;
  }
  float sum[8];
#pragma unroll
  for (int e = 0; e < 8; ++e) sum[e] = 0.f;
#pragma unroll
  for (int k = 0; k < W - 1; ++k)
#pragma unroll
    for (int e = 0; e < 8; ++e) sum[e] += (float)u[k][e];
#pragma unroll
  for (int i = 0; i < 8; ++i) {
    const float inv = 1.0f / (float)min(lf + i + 1, W);
    f16x8 d;
#pragma unroll
    for (int e = 0; e < 8; ++e) {
      sum[e] += (float)u[W - 1 + i][e];
      d[e] = (f16)(sum[e] * inv - (float)u[W - 1 + i][e]);
      sum[e] -= (float)u[i][e];
    }
    *(f16x8*)(dp + i * DL_LD) = d;
  }
}
__device__ __forceinline__ void p_pool(const Params& p, char* shm) {
  const f16* proj16 = (const f16*)(p.ws + OFF_B);
  const f16* wpl = (const f16*)(p.ws + OFF_WPOOL);
  f16* pa16 = (f16*)(p.ws + OFF_D);
  const int tid = opaque_tid(), wid = tid >> 6, lane = tid & 63, fr = lane & 15, fq = lane >> 4;
  for (int item = blockIdx.x; item < T_TOK / 64; item += gridDim.x) {
    const int t0 = item * 64;
    {
      const int g = wid >> 1;
      const int c = g * 128 + ((wid & 1) * 8 + (lane & 7)) * 8;
      const int tg = lane >> 3;
      const int tf = t0 + tg * 8, lf = tf & (SEQ - 1);
      const f16* up = proj16 + (size_t)tf * PJ_W + c;
      char* dp = shm + (tg * 8) * DL_LD + c * 2;
      if (g == 0) pool_delta<2>(up, lf, dp);
      else if (g == 1) pool_delta<4>(up, lf, dp);
      else if (g == 2) pool_delta<8>(up, lf, dp);
      else pool_delta<16>(up, lf, dp);
    }
    __syncthreads();
    {
      const int g = wid >> 1, eh = wid & 1;
      f32x4 acc[4][4];
#pragma unroll
      for (int m = 0; m < 4; ++m)
#pragma unroll
        for (int n = 0; n < 4; ++n) acc[m][n] = (f32x4){0.f, 0.f, 0.f, 0.f};
#pragma unroll
      for (int ks = 0; ks < 4; ++ks) {
        f16x8 A[4], B[4];
#pragma unroll
        for (int m = 0; m < 4; ++m) A[m] = *(const f16x8*)(wpl + (size_t)(g * 128 + eh * 64 + m * 16 + fr) * 128 + ks * 32 + fq * 8);
#pragma unroll
        for (int n = 0; n < 4; ++n) B[n] = *(const f16x8*)(shm + (n * 16 + fr) * DL_LD + (g * 128 + ks * 32 + fq * 8) * 2);
#pragma unroll
        for (int m = 0; m < 4; ++m)
#pragma unroll
          for (int n = 0; n < 4; ++n) acc[m][n] = __builtin_amdgcn_mfma_f32_16x16x32_f16(A[m], B[n], acc[m][n], 0, 0, 0);
      }
#pragma unroll
      for (int m = 0; m < 4; ++m) {
        const int e0 = g * 128 + eh * 64 + m * 16 + fq * 4;
        float4 sc = *(const float4*)(p.pool_scale + e0);
#pragma unroll
        for (int n = 0; n < 4; ++n) {
          f16x4 o;
          o[0] = (f16)(acc[m][n][0] * sc.x); o[1] = (f16)(acc[m][n][1] * sc.y);
          o[2] = (f16)(acc[m][n][2] * sc.z); o[3] = (f16)(acc[m][n][3] * sc.w);
          *(f16x4*)(pa16 + (size_t)(t0 + n * 16 + fr) * DM + e0) = o;
        }
      }
    }
    __syncthreads();
  }
}

#define RW_LD 2064
#define RT_LDS (2 * 36 * RW_LD)
template <int V>
__device__ __forceinline__ void p_ln1_route(const Params& p, char* shm) {
  const float* z32 = (const float*)(p.ws + OFF_C);
  char* dmy = (char*)p.out;
  f16* h1 = (V == 0) ? (f16*)(p.ws + OFF_A) : (f16*)dmy;
  int* route_e = (V == 0) ? (int*)(p.ws + OFF_ROUTE_E) : (int*)(dmy + 68000000);
  float* route_w = (V == 0) ? (float*)(p.ws + OFF_ROUTE_W) : (float*)(dmy + 69000000);
  int* counts = (V == 0) ? (int*)(p.ws + OFF_CNT) : (int*)(dmy + 70000000);
  int* lists = (V == 0) ? (int*)(p.ws + OFF_LISTS) : (int*)(dmy + 71000000);
  int* lcnt = (int*)(shm + RT_LDS);
  int* lent = lcnt + 128;
  const int tid = opaque_tid(), wid = tid >> 6, lane = tid & 63, fr = lane & 15, fq = lane >> 4;
  if (tid < 128) lcnt[tid] = 0;
  {
    const f16* wsrc = (const f16*)(p.ws + OFF_WRT);
    for (int i = tid; i < 2 * 36 * 128; i += 512) {
      int img = i / (36 * 128), rem = i % (36 * 128), o = rem >> 7, c = rem & 127;
      *(f16x8*)(shm + (img * 36 + o) * RW_LD + c * 16) = *(const f16x8*)(wsrc + (size_t)(img * 36 + o) * 1024 + c * 8);
    }
  }
  __syncthreads();
  for (int t0 = (blockIdx.x * 8 + wid) * 16; t0 < T_TOK; t0 += gridDim.x * 8 * 16) {
    const float* zr = z32 + (size_t)(t0 + fr) * DM + fq * 8;
    float s1 = 0.f, s2 = 0.f;
#pragma unroll 8
    for (int ks = 0; ks < 32; ++ks) {
      float4 x0 = *(const float4*)(zr + ks * 32), x1 = *(const float4*)(zr + ks * 32 + 4);
      s1 += (x0.x + x0.y) + (x0.z + x0.w) + (x1.x + x1.y) + (x1.z + x1.w);
      s2 += (x0.x * x0.x + x0.y * x0.y) + (x0.z * x0.z + x0.w * x0.w) + (x1.x * x1.x + x1.y * x1.y) + (x1.z * x1.z + x1.w * x1.w);
    }
    s1 += __shfl_xor(s1, 16, 64); s1 += __shfl_xor(s1, 32, 64);
    s2 += __shfl_xor(s2, 16, 64); s2 += __shfl_xor(s2, 32, 64);
    const float mu = s1 * (1.0f / DM);
    const float rs = rsqrtf(fmaxf(s2 * (1.0f / DM) - mu * mu, 0.f) + 1e-5f);
    f32x4 acc[3];
#pragma unroll
    for (int mt = 0; mt < 3; ++mt) acc[mt] = (f32x4){0.f, 0.f, 0.f, 0.f};
    f16* hr = h1 + (size_t)(t0 + fr) * DM + fq * 8;
    const char* wa = shm + fr * RW_LD + fq * 16;
    const char* wa2 = shm + min(32 + fr, 35) * RW_LD + fq * 16;
#pragma unroll 4
    for (int ks = 0; ks < 32; ++ks) {
      float4 x0 = *(const float4*)(zr + ks * 32), x1 = *(const float4*)(zr + ks * 32 + 4);
      float4 g0 = *(const float4*)(p.ln1_g + ks * 32 + fq * 8), g1 = *(const float4*)(p.ln1_g + ks * 32 + fq * 8 + 4);
      float4 b0 = *(const float4*)(p.ln1_b + ks * 32 + fq * 8), b1 = *(const float4*)(p.ln1_b + ks * 32 + fq * 8 + 4);
      float hn[8];
      hn[0] = (x0.x - mu) * rs * g0.x + b0.x; hn[1] = (x0.y - mu) * rs * g0.y + b0.y;
      hn[2] = (x0.z - mu) * rs * g0.z + b0.z; hn[3] = (x0.w - mu) * rs * g0.w + b0.w;
      hn[4] = (x1.x - mu) * rs * g1.x + b1.x; hn[5] = (x1.y - mu) * rs * g1.y + b1.y;
      hn[6] = (x1.z - mu) * rs * g1.z + b1.z; hn[7] = (x1.w - mu) * rs * g1.w + b1.w;
      f16x8 bh, bl;
#pragma unroll
      for (int e = 0; e < 8; ++e) { bh[e] = (f16)hn[e]; bl[e] = (f16)(hn[e] - (float)bh[e]); }
      *(f16x8*)(hr + ks * 32) = bh;
#pragma unroll
      for (int mt = 0; mt < 3; ++mt) {
        const char* wp = (mt < 2) ? (wa + mt * 16 * RW_LD) : wa2;
        f16x8 ah = *(const f16x8*)(wp + ks * 64), al = *(const f16x8*)(wp + 36 * RW_LD + ks * 64);
        acc[mt] = __builtin_amdgcn_mfma_f32_16x16x32_f16(ah, bh, acc[mt], 0, 0, 0);
        acc[mt] = __builtin_amdgcn_mfma_f32_16x16x32_f16(ah, bl, acc[mt], 0, 0, 0);
        acc[mt] = __builtin_amdgcn_mfma_f32_16x16x32_f16(al, bh, acc[mt], 0, 0, 0);
      }
    }
    float lg[36];
#pragma unroll
    for (int o = 0; o < 36; ++o) lg[o] = __shfl(acc[o >> 4][o & 3], fr + 16 * ((o >> 2) & 3), 64);
    {
      float gl[4];
#pragma unroll
      for (int o = 0; o < 4; ++o) gl[o] = lg[o] + p.b_group[o];
      int g = 0;
      float m = gl[0];
#pragma unroll
      for (int o = 1; o < 4; ++o) if (gl[o] > m) { m = gl[o]; g = o; }
      float se = 0.f;
#pragma unroll
      for (int o = 0; o < 4; ++o) se += __expf(gl[o] - m);
      float pg = 1.0f / se;
      float v1 = -3e38f, v2 = -3e38f;
      int i1 = 0, i2 = 0;
#pragma unroll
      for (int jx = 0; jx < 8; ++jx) {
        float x = (g == 0) ? lg[4 + jx] : (g == 1) ? lg[12 + jx] : (g == 2) ? lg[20 + jx] : lg[28 + jx];
        x += p.b_router[g * 8 + jx];
        if (x > v1) { v2 = v1; i2 = i1; v1 = x; i1 = jx; }
        else if (x > v2) { v2 = x; i2 = jx; }
      }
      if (fq == 0) {
        const int tt = t0 + fr;
        float e2 = __expf(v2 - v1);
        float w1 = pg / (1.0f + e2), w2 = pg * e2 / (1.0f + e2);
        int ea = g * 8 + i1, eb = g * 8 + i2;
        route_e[2 * tt] = ea; route_e[2 * tt + 1] = eb;
        route_w[2 * tt] = w1; route_w[2 * tt + 1] = w2;
        int la = atomicAdd(&lcnt[ea], 1), lb = atomicAdd(&lcnt[eb], 1);
        int slot = atomicAdd(&lcnt[64], 2);
        if (slot + 1 < 512) {
          lent[2 * slot] = (ea << 16) | la; lent[2 * slot + 1] = 2 * tt;
          lent[2 * slot + 2] = (eb << 16) | lb; lent[2 * slot + 3] = 2 * tt + 1;
        }
      }
    }
  }
  __syncthreads();
  if (tid < 32) lcnt[32 + tid] = atomicAdd(&counts[tid * CNT_STRIDE], lcnt[tid]);
  __syncthreads();
  {
    const int n_ent = min(lcnt[64], 512);
    for (int i = tid; i < n_ent; i += 512) {
      int ev = lent[2 * i], id = lent[2 * i + 1];
      int e = ev >> 16, lp = ev & 0xffff;
      lists[(size_t)e * T_TOK + lcnt[32 + e] + lp] = id;
    }
  }
  __syncthreads();
}

__device__ __forceinline__ void p_final(const Params& p) {
  const f16* h1 = (const f16*)(p.ws + OFF_A);
  const f16* y16 = (const f16*)(p.ws + OFF_C);
  const int tid = opaque_tid(), wid = tid >> 6, lane = tid & 63;
  const int nw = gridDim.x * 8;
  int t = blockIdx.x * 8 + wid;
  f16x8 hv[2], y0[2], y1[2];
#define P7_LOAD(tt)                                                                          \
  _Pragma("unroll") for (int i = 0; i < 2; ++i) {                                            \
    hv[i] = *(const f16x8*)(h1 + (size_t)(tt) * DM + i * 512 + lane * 8);                    \
    y0[i] = *(const f16x8*)(y16 + (size_t)(2 * (tt)) * DM + i * 512 + lane * 8);             \
    y1[i] = *(const f16x8*)(y16 + (size_t)(2 * (tt) + 1) * DM + i * 512 + lane * 8);         \
  }
  if (t < T_TOK) { P7_LOAD(t); }
  for (; t < T_TOK; t += nw) {
    float v[16];
#pragma unroll
    for (int i = 0; i < 2; ++i)
#pragma unroll
      for (int e = 0; e < 8; ++e) v[i * 8 + e] = ALPHA * (float)hv[i][e] + ((float)y0[i][e] + (float)y1[i][e]);
    if (t + nw < T_TOK) { P7_LOAD(t + nw); }
    float s = 0.f;
#pragma unroll
    for (int i = 0; i < 16; ++i) s += v[i];
    float mu = wave_sum(s) * (1.0f / DM);
    float q = 0.f;
#pragma unroll
    for (int i = 0; i < 16; ++i) { v[i] -= mu; q += v[i] * v[i]; }
    float rs = rsqrtf(wave_sum(q) * (1.0f / DM) + 1e-5f);
#pragma unroll
    for (int i = 0; i < 2; ++i)
#pragma unroll
      for (int hf = 0; hf < 2; ++hf) {
        const int c = i * 512 + lane * 8 + hf * 4;
        float4 g = *(const float4*)(p.ln2_g + c), b = *(const float4*)(p.ln2_b + c);
        f32x4 o;
        o[0] = v[i * 8 + hf * 4 + 0] * rs * g.x + b.x; o[1] = v[i * 8 + hf * 4 + 1] * rs * g.y + b.y;
        o[2] = v[i * 8 + hf * 4 + 2] * rs * g.z + b.z; o[3] = v[i * 8 + hf * 4 + 3] * rs * g.w + b.w;
        *(f32x4*)(p.out + (size_t)t * DM + c) = o;
      }
  }
#undef P7_LOAD
}

#define MEGA_LDS 158720


#define XB_TMO      128
#define XB_XCNT(j)  (256  + 64 * (j))
#define XB_XSUB(j)  (1280 + 64 * (j))
#define XB_XGEN(j)  (2304 + 64 * (j))
#define XB_TOP      3328
#define XB_TOPGEN   3392
#define XCD_BAR_WORDS 3456
#define XB_SPIN_CAP (1u << 22)
#define LAS __attribute__((address_space(3)))
__device__ __forceinline__ unsigned xb_ld(unsigned* p) { return __hip_atomic_load(p, __ATOMIC_RELAXED, __HIP_MEMORY_SCOPE_AGENT); }
__device__ __forceinline__ unsigned xb_add(unsigned* p, unsigned v) { return __hip_atomic_fetch_add(p, v, __ATOMIC_RELAXED, __HIP_MEMORY_SCOPE_AGENT); }
__device__ __forceinline__ unsigned xb_xcc_id() { return (unsigned)__builtin_amdgcn_s_getreg((3 << 11) | 20) & 0xFu; }
#define XB_SPIN(cond, bar) do { unsigned _sp = 0; while (cond) { __builtin_amdgcn_s_sleep(1); \
    if ((++_sp & 255u) == 0u) { if (xb_ld(&(bar)[XB_TMO])) break; if (_sp > XB_SPIN_CAP) { atomicAdd(&(bar)[XB_TMO], 1u); break; } } } } while (0)
struct XcdBarrier { unsigned* bar; unsigned x; volatile unsigned* st; };
__device__ __forceinline__ XcdBarrier xcd_barrier_post(unsigned* bar, volatile unsigned* st) {
  XcdBarrier b; b.bar = bar; b.x = xb_xcc_id(); b.st = st;
  if (threadIdx.x == 0) (void)xb_add(&bar[XB_XCNT(b.x)], 1u);
  return b;
}
__device__ __forceinline__ void xcd_barrier_complete(unsigned* bar, unsigned x, unsigned& nloc, unsigned& nx) {
  const unsigned G = gridDim.x * gridDim.y * gridDim.z;
  unsigned sum, cnt, mine, sp = 0u;
  for (;;) {
    sum = 0u; cnt = 0u; mine = 0u;
#pragma unroll
    for (unsigned j = 0; j < 16; ++j) { const unsigned c = xb_ld(&bar[XB_XCNT(j)]); sum += c; cnt += (c > 0u) ? 1u : 0u; mine = (j == x) ? c : mine; }
    if (sum == G) break;
    __builtin_amdgcn_s_sleep(1);
    if ((++sp & 255u) == 0u) { if (xb_ld(&bar[XB_TMO])) break; if (sp > XB_SPIN_CAP) { atomicAdd(&bar[XB_TMO], 1u); break; } }
  }
  nloc = mine > 0u ? mine : 1u; nx = cnt > 0u ? cnt : 1u;
}
__device__ __forceinline__ void xcd_barrier(const XcdBarrier& b) {
  asm volatile("s_waitcnt vmcnt(0)" ::: "memory");
  __syncthreads();
  if (threadIdx.x == 0) {
    unsigned* bar = b.bar;
    __builtin_amdgcn_s_waitcnt(0);
    unsigned nloc = b.st[0], nx = b.st[1];
    if (nloc == 0u) { xcd_barrier_complete(bar, b.x, nloc, nx); b.st[0] = nloc; b.st[1] = nx; }
    const unsigned old = xb_add(&bar[XB_XSUB(b.x)], 1u);
    const unsigned gen = old / nloc;
    if (old + 1u == (gen + 1u) * nloc) {
      __builtin_amdgcn_fence(__ATOMIC_RELEASE, "agent");
      asm volatile("s_waitcnt vmcnt(0)" ::: "memory");
      const unsigned og = xb_add(&bar[XB_TOP], 1u);
      const unsigned tg = og / nx;
      if (og + 1u == (tg + 1u) * nx) xb_add(&bar[XB_TOPGEN], 1u);
      else XB_SPIN(xb_ld(&bar[XB_TOPGEN]) == tg, bar);
      __builtin_amdgcn_fence(__ATOMIC_ACQUIRE, "agent");
      xb_add(&bar[XB_XGEN(b.x)], 1u);
      asm volatile("s_waitcnt vmcnt(0)" ::: "memory");
    } else {
      XB_SPIN(xb_ld(&bar[XB_XGEN(b.x)]) == gen, bar);
      __builtin_amdgcn_fence(__ATOMIC_ACQUIRE, "agent");
      asm volatile("s_waitcnt vmcnt(0)" ::: "memory");
    }
  }
  __syncthreads();
}

#ifndef PROBE
#define PROBE 0
#endif
#define GSYNC() do { XcdBarrier xb_; xb_.bar = (unsigned*)(p.ws + OFF_BAR); xb_.x = xb_xcc_id(); xb_.st = (volatile unsigned*)(shm + MEGA_LDS); xcd_barrier(xb_); } while (0)
#define PH(n, code) do { code; if (PROBE == n) { GSYNC(); code; } } while (0)
__global__ __launch_bounds__(512) void mega(Params p) {
  __shared__ __attribute__((aligned(1024))) char shm[MEGA_LDS + 16];
  cg::grid_group grid = cg::this_grid();
  volatile unsigned* xst = (volatile unsigned*)(shm + MEGA_LDS);
  if (threadIdx.x < 4) xst[threadIdx.x] = 0u;
  __syncthreads();
  (void)xcd_barrier_post((unsigned*)(p.ws + OFF_BAR), xst);
  if (blockIdx.x == 0 && threadIdx.x < 32) ((int*)(p.ws + OFF_CNT))[threadIdx.x * CNT_STRIDE] = 0;
  PH(1, p_ln_in(p));
  PH(2, p_convert(p, shm));
  grid.sync();
  PH(3, p_inproj(p, shm));
  GSYNC();
  PH(4, p_pool(p, shm));
  PH(5, p_index<0>(p, shm));
#if PROBE >= 50 && PROBE < 60
  GSYNC();
  p_index<PROBE - 50>(p, shm);
#endif
  GSYNC();
  PH(6, p_attn<0>(p, shm));
#if PROBE >= 60 && PROBE < 70
  GSYNC();
  p_attn<PROBE - 60>(p, shm);
#endif
  GSYNC();
  PH(7, p_merge(p, shm));
  GSYNC();
  PH(8, p_resid(p, shm));
  GSYNC();
  p_ln1_route<0>(p, shm);
  GSYNC();
#if PROBE == 9
  if (blockIdx.x == 0 && threadIdx.x < 32) ((int*)((char*)p.out + 70000000))[threadIdx.x * CNT_STRIDE] = 0;
  GSYNC();
  p_ln1_route<1>(p, shm);
  GSYNC();
#endif
  PH(10, p_moe_a(p, shm));
  GSYNC();
  PH(11, p_moe_b(p, shm));
  GSYNC();
  PH(12, p_final(p));
}

extern "C" void kernel_launch(void* const* d_in, const int* in_sizes, int n_in, void* d_out, int out_size, void* d_ws,
                              size_t ws_size, hipStream_t stream) {
  if (ws_size < WS_NEEDED) { fprintf(stderr, "ws too small: %zu < %zu\n", ws_size, (size_t)WS_NEEDED); return; }
  static int grid_blocks = 0;
  if (!grid_blocks) {
    int dev = 0, cus = 0, per_cu = 0;
    hipGetDevice(&dev);
    hipDeviceGetAttribute(&cus, hipDeviceAttributeMultiprocessorCount, dev);
    hipOccupancyMaxActiveBlocksPerMultiprocessor(&per_cu, mega, 512, 0);
    if (per_cu > 1) per_cu = 1;
    grid_blocks = cus * per_cu;
    fprintf(stderr, "mega: cus=%d per_cu=%d grid=%d\n", cus, per_cu, grid_blocks);
  }
  Params p{};
  const float** pp = (const float**)&p;
  for (int i = 0; i < 21; ++i) pp[i] = (const float*)d_in[i];
  p.out = (float*)d_out;
  p.ws = (char*)d_ws;
  (void)hipMemsetAsync((char*)d_ws + OFF_BAR, 0, 16384, stream);
  void* args[] = {&p};
  hipError_t e = hipLaunchCooperativeKernel((void*)mega, dim3(grid_blocks), dim3(512), args, 0, stream);
  if (e != hipSuccess) fprintf(stderr, "cooperative launch failed: %s (grid %d)\n", hipGetErrorString(e), grid_blocks);
}
```

```cpp
#include <hip/hip_runtime.h>
#include <hip/hip_fp16.h>
#include <hip/hip_cooperative_groups.h>
#include <stdint.h>
#include <stdio.h>
namespace cg = cooperative_groups;

typedef _Float16 f16;
typedef f16 f16x8 __attribute__((ext_vector_type(8)));
typedef f16 f16x4 __attribute__((ext_vector_type(4)));
typedef f16 f16x2 __attribute__((ext_vector_type(2)));
typedef float f32x4 __attribute__((ext_vector_type(4)));
typedef int i32x4 __attribute__((ext_vector_type(4)));

#define T_TOK 32768
#define DM 1024
#define SEQ 4096
#define PJ_W 1536
#define PA_W 1448
#define IN_W 3496
#define IN_WP 3584
#define C_Q 512
#define C_K 1024
#define C_V 1088
#define C_IQ 1152
#define C_IK 1408
#define C_IW 1440
#define ALPHA 1.189207115002721f
#define NEG_BIG (-1e30f)

#define SZ_A   ((size_t)T_TOK * DM * 2)
#define SZ_B   ((size_t)T_TOK * PJ_W * 2)
#define SZ_C   ((size_t)T_TOK * 2048 * 2)
#define SZ_D   ((size_t)T_TOK * DM * 2)
#define OFF_A  ((size_t)0)
#define OFF_B  (OFF_A + SZ_A)
#define OFF_C  (OFF_B + SZ_B)
#define OFF_D  (OFF_C + SZ_C)
#define OFF_W  (OFF_D + SZ_D)
#define OFF_WIN   (OFF_W)
#define OFF_WPOOL (OFF_WIN + (size_t)IN_WP * 1024 * 2)
#define OFF_WPP   (OFF_WPOOL + (size_t)4 * 128 * 128 * 2)
#define OFF_WPA   (OFF_WPP + (size_t)1024 * 512 * 2)
#define OFF_WOUT  (OFF_WPA + (size_t)1024 * 512 * 2)
#define OFF_WGU   (OFF_WOUT + (size_t)1024 * 1024 * 2)
#define OFF_WDN   (OFF_WGU + (size_t)32 * 512 * 1024 * 2)
#define OFF_MISC  (OFF_WDN + (size_t)32 * 1024 * 256 * 2)
#define OFF_ROUTE_E (OFF_MISC)
#define OFF_ROUTE_W (OFF_ROUTE_E + (size_t)T_TOK * 2 * 4)
#define OFF_COUNTS  (OFF_ROUTE_W + (size_t)T_TOK * 2 * 4)
#define OFF_LISTS   (OFF_COUNTS + 256)
#define OFF_SEL     (OFF_LISTS + (size_t)32 * T_TOK * 4)
#define OFF_CNT      (OFF_SEL + (size_t)T_TOK * 256 * 2)
#define OFF_WRT      (OFF_CNT + 4096)
#define OFF_BAR      (OFF_WRT + 2 * 36 * 1024 * 2)
#define WS_NEEDED   (OFF_BAR + 16384)
#define CNT_STRIDE 32

struct Params {
  const float *x, *ln_in_g, *ln_in_b, *w_in, *b_gate, *pool_w, *pool_scale, *wpp, *wpa, *w_out, *ln1_g, *ln1_b, *w_group,
      *b_group, *w_router, *b_router, *w_gate, *w_up, *w_down, *ln2_g, *ln2_b;
  float* out;
  char* ws;
};

__device__ __forceinline__ float wave_sum(float v) {
#pragma unroll
  for (int o = 32; o > 0; o >>= 1) v += __shfl_xor(v, o, 64);
  return v;
}
__device__ __forceinline__ float wave_max(float v) {
#pragma unroll
  for (int o = 32; o > 0; o >>= 1) v = fmaxf(v, __shfl_xor(v, o, 64));
  return v;
}
__device__ __forceinline__ int wave_sum_i(int v) {
#pragma unroll
  for (int o = 32; o > 0; o >>= 1) v += __shfl_xor(v, o, 64);
  return v;
}
__device__ __forceinline__ int opaque_tid() { int t = threadIdx.x; asm volatile("" : "+v"(t)); return t; }
__device__ __forceinline__ float ldf(const float* p) { return *p; }
__device__ __forceinline__ float ldf(const f16* p) { return (float)*p; }

#ifndef SKEW_P1
#define SKEW_P1 0
#endif
#define WAIT_V(n) asm volatile("s_waitcnt vmcnt(%0)" ::"n"(n) : "memory")
#define WAIT_L(n) asm volatile("s_waitcnt lgkmcnt(%0)" ::"n"(n) : "memory")
template <class T> __device__ __forceinline__ void st_nt(T* p, const T& v) { *p = v; }
#define RAW_SYNC() do { asm volatile("s_waitcnt lgkmcnt(0)" ::: "memory"); __builtin_amdgcn_s_barrier(); asm volatile("" ::: "memory"); } while (0)

__device__ __forceinline__ int lds_byte(int r, int c) {
  int ob = (r & 15) * 64 + c * 2;
  return (r >> 4) * 1024 + (ob ^ (((ob >> 9) & 1) << 5));
}
__device__ __forceinline__ void stage_rc(int b, int& R, int& C) {
  int st = b >> 10, sb = b & 1023, swz = sb ^ (((sb >> 9) & 1) << 5);
  R = st * 16 + swz / 64;
  C = (swz % 64) / 2;
}

#define TILE_B 16384
#define SLOT_B 32768
#define NSTG 2
#define GEMM_LDS 135168
#define EPI_LD 528

__device__ __forceinline__ void gemm_core(const f16* __restrict__ Ab, const unsigned (&pa)[NSTG], const f16* __restrict__ Bb,
                                          const unsigned (&pb)[NSTG], int nt, f32x4 (&acc)[8][4], char* shm) {
  const int tid = opaque_tid(), wid = tid >> 6, lane = tid & 63, wr = wid >> 2, wc = wid & 3, fr = lane & 15, fq = lane >> 4;
  const int nk = nt * 2;
#define SA(s_) (shm + (s_) * SLOT_B)
#define SB(s_) (shm + (s_) * SLOT_B + TILE_B)
#define GLDS_STAGE(slot, kt)                                                                                              \
  do {                                                                                                                    \
    _Pragma("unroll") for (int i = 0; i < NSTG; ++i) {                                                                   \
      __builtin_amdgcn_global_load_lds((const unsigned*)(Ab + pa[i] + (kt) * 32), (unsigned*)(SA(slot) + wid * 1024 + i * 8192), \
                                       16, 0, 0);                                                                         \
      __builtin_amdgcn_global_load_lds((const unsigned*)(Bb + pb[i] + (kt) * 32), (unsigned*)(SB(slot) + wid * 1024 + i * 8192), \
                                       16, 0, 0);                                                                         \
    }                                                                                                                     \
  } while (0)
  GLDS_STAGE(0, 0);
  GLDS_STAGE(1, 1);
  GLDS_STAGE(2, 2);
  const int aoff = lds_byte(wr * 128 + fr, fq * 8), boff = lds_byte(wc * 64 + fr, fq * 8);
  for (int t = 0; t < nk; ++t) {
    if (t + 2 < nk) WAIT_V(8); else if (t + 1 < nk) WAIT_V(4); else WAIT_V(0);
    __builtin_amdgcn_s_barrier();
    if (t + 3 < nk) GLDS_STAGE((t + 3) & 3, t + 3);
    const char* sa = SA(t & 3) + aoff;
    const char* sb = SB(t & 3) + boff;
    f16x8 Bf[4];
#pragma unroll
    for (int n = 0; n < 4; ++n) Bf[n] = *(const f16x8*)(sb + n * 1024);
    f16x8 A0 = *(const f16x8*)(sa), A1 = *(const f16x8*)(sa + 1024);
#pragma unroll
    for (int g = 0; g < 4; ++g) {
      f16x8 N0 = A0, N1 = A1;
      if (g < 3) { N0 = *(const f16x8*)(sa + (2 * g + 2) * 1024); N1 = *(const f16x8*)(sa + (2 * g + 3) * 1024); }
      __builtin_amdgcn_sched_barrier(0);
#pragma unroll
      for (int n = 0; n < 4; ++n) acc[2 * g][n] = __builtin_amdgcn_mfma_f32_16x16x32_f16(A0, Bf[n], acc[2 * g][n], 0, 0, 0);
#pragma unroll
      for (int n = 0; n < 4; ++n) acc[2 * g + 1][n] = __builtin_amdgcn_mfma_f32_16x16x32_f16(A1, Bf[n], acc[2 * g + 1][n], 0, 0, 0);
      __builtin_amdgcn_sched_barrier(0);
      A0 = N0; A1 = N1;
    }
    WAIT_L(0);
  }
  RAW_SYNC();
#undef SA
#undef SB
#undef GLDS_STAGE
}

__device__ __forceinline__ void epi_store_f16(const f32x4 (&acc)[8][4], char* shm) {
  const int tid = opaque_tid(), wid = tid >> 6, lane = tid & 63, wr = wid >> 2, wc = wid & 3, fr = lane & 15, fq = lane >> 4;
#pragma unroll
  for (int m = 0; m < 8; ++m)
#pragma unroll
    for (int n = 0; n < 4; ++n) {
      f16x4 v;
      v[0] = (f16)acc[m][n][0]; v[1] = (f16)acc[m][n][1]; v[2] = (f16)acc[m][n][2]; v[3] = (f16)acc[m][n][3];
      *(f16x4*)(shm + (wc * 64 + n * 16 + fr) * EPI_LD + (wr * 128 + m * 16 + fq * 4) * 2) = v;
    }
}

__device__ __forceinline__ void p_ln_in(const Params& p) {
  f16* h16 = (f16*)(p.ws + OFF_A);
  const int tid = opaque_tid(), lane = tid & 63, wid = tid >> 6;
  const int nw = gridDim.x * 8;
  for (int t = blockIdx.x * 8 + wid; t < T_TOK; t += nw) {
    const float* xr = p.x + (size_t)t * DM;
    float4 v[4];
#pragma unroll
    for (int i = 0; i < 4; ++i) v[i] = *(const float4*)(xr + i * 256 + lane * 4);
    float s = 0.f;
#pragma unroll
    for (int i = 0; i < 4; ++i) s += v[i].x + v[i].y + v[i].z + v[i].w;
    float mu = wave_sum(s) * (1.0f / DM);
    float q = 0.f;
#pragma unroll
    for (int i = 0; i < 4; ++i) {
      v[i].x -= mu; v[i].y -= mu; v[i].z -= mu; v[i].w -= mu;
      q += v[i].x * v[i].x + v[i].y * v[i].y + v[i].z * v[i].z + v[i].w * v[i].w;
    }
    float rs = rsqrtf(wave_sum(q) * (1.0f / DM) + 1e-5f);
#pragma unroll
    for (int i = 0; i < 4; ++i) {
      float4 g = *(const float4*)(p.ln_in_g + i * 256 + lane * 4), b = *(const float4*)(p.ln_in_b + i * 256 + lane * 4);
      f16x4 o;
      o[0] = (f16)(v[i].x * rs * g.x + b.x); o[1] = (f16)(v[i].y * rs * g.y + b.y);
      o[2] = (f16)(v[i].z * rs * g.z + b.z); o[3] = (f16)(v[i].w * rs * g.w + b.w);
      *(f16x4*)(h16 + (size_t)t * DM + i * 256 + lane * 4) = o;
    }
  }
}

template <class RowMap>
__device__ __forceinline__ void conv_tile(const float* __restrict__ src, int ld_src, int nvalid, int k0, int n0, f16* __restrict__ dst,
                                          int ld_dst, RowMap rm, float* sT) {
  const int tid = opaque_tid();
  {
    int k = tid >> 3, n = (tid & 7) * 8;
    const float* sp = src + (size_t)(k0 + k) * ld_src + n0 + n;
#pragma unroll
    for (int j = 0; j < 8; ++j) sT[k * 65 + n + j] = (n0 + n + j < nvalid) ? sp[j] : 0.f;
  }
  __syncthreads();
  {
    int n = tid >> 3, k = (tid & 7) * 8;
    f16x8 o;
#pragma unroll
    for (int j = 0; j < 8; ++j) o[j] = (f16)sT[(k + j) * 65 + n];
    int drow = rm(n0 + n);
    if (drow >= 0) *(f16x8*)(dst + (size_t)drow * ld_dst + k0 + k) = o;
  }
  __syncthreads();
}

struct RowId { __device__ int operator()(int n) const { return n; } };
struct RowGU { int up; __device__ int operator()(int ff) const {
  int tile = ff >> 7, wr = (ff >> 6) & 1, l = ff & 63; return tile * 256 + wr * 128 + up * 64 + l; } };

__device__ __forceinline__ void p_convert(const Params& p, char* shm) {
  float* sT = (float*)shm;
  char* ws = p.ws;
  const int J0 = 16 * 56, J1 = J0 + 16, J2 = J1 + 128, J3 = J2 + 128, J4 = J3 + 256, J5 = J4 + 32 * 64, J6 = J5 + 32 * 64,
            J7 = J6 + 32 * 64;
  for (int job = blockIdx.x; job < J7; job += gridDim.x) {
    if (job < J0) {
      int kt = job / 56, nt = job % 56;
      conv_tile(p.w_in, IN_W, IN_W, kt * 64, nt * 64, (f16*)(ws + OFF_WIN), 1024, RowId(), sT);
    } else if (job < J1) {
      int j = job - J0, g = j >> 2, kt = (j >> 1) & 1, nt = j & 1;
      conv_tile(p.pool_w + g * 128 * 128, 128, 128, kt * 64, nt * 64, (f16*)(ws + OFF_WPOOL) + g * 128 * 128, 128, RowId(), sT);
    } else if (job < J2) {
      int j = job - J1, kt = j >> 4, nt = j & 15;
      conv_tile(p.wpp, 1024, 1024, kt * 64, nt * 64, (f16*)(ws + OFF_WPP), 512, RowId(), sT);
    } else if (job < J3) {
      int j = job - J2, kt = j >> 4, nt = j & 15;
      conv_tile(p.wpa, 1024, 1024, kt * 64, nt * 64, (f16*)(ws + OFF_WPA), 512, RowId(), sT);
    } else if (job < J4) {
      int j = job - J3, kt = j >> 4, nt = j & 15;
      conv_tile(p.w_out, 1024, 1024, kt * 64, nt * 64, (f16*)(ws + OFF_WOUT), 1024, RowId(), sT);
    } else if (job < J6) {
      int up = job >= J5;
      int j = job - (up ? J5 : J4), e = j >> 6, kt = (j >> 2) & 15, nt = j & 3;
      RowGU rm; rm.up = up;
      conv_tile((up ? p.w_up : p.w_gate) + (size_t)e * 1024 * 256, 256, 256, kt * 64, nt * 64,
                (f16*)(ws + OFF_WGU) + (size_t)e * 512 * 1024, 1024, rm, sT);
    } else {
      int j = job - J6, e = j >> 6, kt = (j >> 4) & 3, nt = j & 15;
      conv_tile(p.w_down + (size_t)e * 256 * 1024, 1024, 1024, kt * 64, nt * 64, (f16*)(ws + OFF_WDN) + (size_t)e * 1024 * 256,
                256, RowId(), sT);
    }
  }
  {
    f16* whi = (f16*)(ws + OFF_WRT);
    f16* wlo = whi + 36 * 1024;
    for (int i = blockIdx.x * 512 + threadIdx.x; i < 36 * 1024; i += gridDim.x * 512) {
      int o = i >> 10, k = i & 1023;
      float w = (o < 4) ? p.w_group[k * 4 + o] : p.w_router[k * 32 + (o - 4)];
      f16 h = (f16)w;
      whi[i] = h;
      wlo[i] = (f16)(w - (float)h);
    }
  }
}

__device__ __forceinline__ void phase_skew(int us4) {
  const int k = (blockIdx.x >> 3) & 3;
  if (k) {
    const unsigned long long t0 = __builtin_amdgcn_s_memrealtime();
    const unsigned long long dt = (unsigned long long)(k * us4 * 25);
    while (__builtin_amdgcn_s_memrealtime() - t0 < dt) __builtin_amdgcn_s_sleep(8);
  }
}

__device__ __forceinline__ int xcd_item(int n_items, int r) {
  const int nx = 8, slots = gridDim.x >> 3;
  const int xcd = blockIdx.x & 7, slot = blockIdx.x >> 3;
  const int per = (n_items + nx - 1) / nx;
  const int local = slot + r * slots;
  if (local >= per) return -1;
  const int item = xcd * per + local;
  return (item < n_items) ? item : -2;
}

__device__ __forceinline__ void p_inproj(const Params& p, char* shm) {
  const f16* h16 = (const f16*)(p.ws + OFF_A);
  const f16* wT = (const f16*)(p.ws + OFF_WIN);
  f16* proj16 = (f16*)(p.ws + OFF_B);
  f16* gate16 = (f16*)(p.ws + OFF_C);
  const int tid = opaque_tid(), wid = tid >> 6, lane = tid & 63;
  int sR[NSTG], sC[NSTG];
#pragma unroll
  for (int i = 0; i < NSTG; ++i) stage_rc(wid * 1024 + i * 8192 + lane * 16, sR[i], sC[i]);
  const int NTILES = 128 * 14;
  if (SKEW_P1) phase_skew(SKEW_P1);
  for (int r = 0;; ++r) {
    int tile = xcd_item(NTILES, r);
    if (tile == -1) break;
    if (tile < 0) continue;
    int grp = tile / 56, rem = tile % 56;
    int ft = rem >> 2, tt = grp * 4 + (rem & 3);
    unsigned pa[NSTG], pb[NSTG];
#pragma unroll
    for (int i = 0; i < NSTG; ++i) {
      pa[i] = (unsigned)((ft * 256 + sR[i]) * 1024 + sC[i]);
      pb[i] = (unsigned)((tt * 256 + sR[i]) * 1024 + sC[i]);
    }
    f32x4 acc[8][4];
#pragma unroll
    for (int m = 0; m < 8; ++m)
#pragma unroll
      for (int n = 0; n < 4; ++n) acc[m][n] = (f32x4){0.f, 0.f, 0.f, 0.f};
    gemm_core(wT, pa, h16, pb, 16, acc, shm);
    epi_store_f16(acc, shm);
    RAW_SYNC();
    {
      int ch = tid & 31, r0 = tid >> 5;
      int f0 = ft * 256 + ch * 8;
      float bg[8];
      if (f0 >= PA_W && f0 < IN_W) {
#pragma unroll
        for (int j = 0; j < 8; ++j) bg[j] = p.b_gate[f0 - PA_W + j];
      } else {
#pragma unroll
        for (int j = 0; j < 8; ++j) bg[j] = 0.f;
      }
#pragma unroll 4
      for (int ps = 0; ps < 16; ++ps) {
        int r = ps * 16 + r0;
        f16x8 v = *(const f16x8*)(shm + r * EPI_LD + ch * 16);
        size_t tok = (size_t)tt * 256 + r;
        if (f0 < PA_W) {
          st_nt((f16x8*)(proj16 + tok * PJ_W + f0), v);
        } else if (f0 < IN_W) {
          f16x8 o;
#pragma unroll
          for (int j = 0; j < 8; ++j) o[j] = (f16)__builtin_amdgcn_rcpf(1.0f + __builtin_amdgcn_exp2f(-1.4426950408889634f * ((float)v[j] + bg[j])));
          st_nt((f16x8*)(gate16 + tok * 2048 + (f0 - PA_W)), o);
        }
      }
    }
    RAW_SYNC();
  }
}


__device__ __forceinline__ void zero_acc(f32x4 (&acc)[8][4]) {
#pragma unroll
  for (int m = 0; m < 8; ++m)
#pragma unroll
    for (int n = 0; n < 4; ++n) acc[m][n] = (f32x4){0.f, 0.f, 0.f, 0.f};
}

template <class RowPtr>
__device__ __forceinline__ void epi_rows_out(char* shm, RowPtr rp) {
  const int tid = opaque_tid(), ch = tid & 31, r0 = tid >> 5;
#pragma unroll 4
  for (int ps = 0; ps < 16; ++ps) {
    int r = ps * 16 + r0;
    f16x8 v = *(const f16x8*)(shm + r * EPI_LD + ch * 16);
    f16* d = rp(r);
    if (d) st_nt((f16x8*)(d + ch * 8), v);
  }
}

__device__ __forceinline__ void p_merge(const Params& p, char* shm) {
  const f16* pa16 = (const f16*)(p.ws + OFF_D);
  const f16* gate16 = (const f16*)(p.ws + OFF_C);
  const f16* wpp = (const f16*)(p.ws + OFF_WPP);
  const f16* wpa = (const f16*)(p.ws + OFF_WPA);
  f16* merged16 = (f16*)(p.ws + OFF_B);
  const int tid = opaque_tid(), wid = tid >> 6, lane = tid & 63;
  int sR[NSTG], sC[NSTG];
#pragma unroll
  for (int i = 0; i < NSTG; ++i) stage_rc(wid * 1024 + i * 8192 + lane * 16, sR[i], sC[i]);
  const int ch = tid & 31, r0 = tid >> 5;
  for (int r = 0;; ++r) {
    int tile = xcd_item(512, r);
    if (tile == -1) break;
    if (tile < 0) continue;
    int ft = tile & 3, tt = tile >> 2;
    unsigned pa[NSTG], pb[NSTG];
#pragma unroll
    for (int i = 0; i < NSTG; ++i) {
      pa[i] = (unsigned)((ft * 256 + sR[i]) * 512 + sC[i]);
      pb[i] = (unsigned)((tt * 256 + sR[i]) * 1024 + sC[i]);
    }
    {
      f32x4 acc[8][4];
      zero_acc(acc);
      gemm_core(wpp, pa, pa16, pb, 8, acc, shm);
      epi_store_f16(acc, shm);
    }
    RAW_SYNC();
#pragma unroll 2
    for (int ps = 0; ps < 16; ++ps) {
      const int rr = ps * 16 + r0;
      const size_t tok = (size_t)tt * 256 + rr;
      f16x8 v = *(const f16x8*)(shm + rr * EPI_LD + ch * 16);
      f16x8 g = *(const f16x8*)(gate16 + tok * 2048 + ft * 256 + ch * 8);
      f16x8 o;
#pragma unroll
      for (int e = 0; e < 8; ++e) o[e] = (f16)((float)v[e] * (float)g[e]);
      *(f16x8*)(merged16 + tok * 1024 + ft * 256 + ch * 8) = o;
    }
    RAW_SYNC();
    {
      f32x4 acc[8][4];
      zero_acc(acc);
      gemm_core(wpa, pa, pa16 + 512, pb, 8, acc, shm);
      epi_store_f16(acc, shm);
    }
    RAW_SYNC();
#pragma unroll 2
    for (int ps = 0; ps < 16; ++ps) {
      const int rr = ps * 16 + r0;
      const size_t tok = (size_t)tt * 256 + rr;
      f16x8 v = *(const f16x8*)(shm + rr * EPI_LD + ch * 16);
      f16x8 g = *(const f16x8*)(gate16 + tok * 2048 + 1024 + ft * 256 + ch * 8);
      f16x8 m0 = *(const f16x8*)(merged16 + tok * 1024 + ft * 256 + ch * 8);
      f16x8 o;
#pragma unroll
      for (int e = 0; e < 8; ++e) o[e] = (f16)((float)m0[e] + (float)v[e] * (float)g[e]);
      *(f16x8*)(merged16 + tok * 1024 + ft * 256 + ch * 8) = o;
    }
    RAW_SYNC();
  }
}

__device__ __forceinline__ void p_resid(const Params& p, char* shm) {
  const f16* merged16 = (const f16*)(p.ws + OFF_B);
  const f16* h16 = (const f16*)(p.ws + OFF_A);
  const f16* wo = (const f16*)(p.ws + OFF_WOUT);
  f16* z16 = (f16*)(p.ws + OFF_C);
  const int tid = opaque_tid(), wid = tid >> 6, lane = tid & 63;
  int sR[NSTG], sC[NSTG];
#pragma unroll
  for (int i = 0; i < NSTG; ++i) stage_rc(wid * 1024 + i * 8192 + lane * 16, sR[i], sC[i]);
  const int ch = tid & 31, r0 = tid >> 5;
  for (int r = 0;; ++r) {
    int tile = xcd_item(512, r);
    if (tile == -1) break;
    if (tile < 0) continue;
    int ft = tile & 3, tt = tile >> 2;
    unsigned pa[NSTG], pb[NSTG];
#pragma unroll
    for (int i = 0; i < NSTG; ++i) {
      pa[i] = (unsigned)((ft * 256 + sR[i]) * 1024 + sC[i]);
      pb[i] = (unsigned)((tt * 256 + sR[i]) * 1024 + sC[i]);
    }
    {
      f32x4 acc[8][4];
      zero_acc(acc);
      gemm_core(wo, pa, merged16, pb, 16, acc, shm);
      epi_store_f16(acc, shm);
    }
    RAW_SYNC();
#pragma unroll 4
    for (int ps = 0; ps < 16; ++ps) {
      const int rr = ps * 16 + r0;
      const size_t o = ((size_t)tt * 256 + rr) * 1024 + ft * 256 + ch * 8;
      f16x8 v = *(const f16x8*)(shm + rr * EPI_LD + ch * 16);
      f16x8 hv = *(const f16x8*)(h16 + o);
      f16x8 zz;
#pragma unroll
      for (int e = 0; e < 8; ++e) zz[e] = (f16)(ALPHA * (float)hv[e] + (float)v[e]);
      *(f16x8*)(z16 + o) = zz;
    }
    RAW_SYNC();
  }
}

#define HID_ROWS 73728
__device__ __forceinline__ void moe_tiles(const int* counts, int (&pre)[33]) {
  pre[0] = 0;
#pragma unroll
  for (int e = 0; e < 32; ++e) pre[e + 1] = pre[e] + ((counts[e * CNT_STRIDE] + 255) >> 8);
}
__device__ __forceinline__ void moe_find(const int (&pre)[33], int item, int& e, int& mt) {
  e = 0;
#pragma unroll
  for (int i = 1; i < 32; ++i) if (item >= pre[i]) e = i;
  int base = 0;
#pragma unroll
  for (int i = 0; i < 32; ++i) if (i == e) base = pre[i];
  mt = item - base;
}

__device__ __forceinline__ void p_moe_a(const Params& p, char* shm) {
  const f16* h1 = (const f16*)(p.ws + OFF_A);
  const f16* wgu = (const f16*)(p.ws + OFF_WGU);
  const int* counts = (const int*)(p.ws + OFF_CNT);
  const int* lists = (const int*)(p.ws + OFF_LISTS);
  f16* hid16 = (f16*)(p.ws + OFF_B);
  const int tid = opaque_tid(), wid = tid >> 6, lane = tid & 63, wr = wid >> 2, wc = wid & 3, fr = lane & 15, fq = lane >> 4;
  int sR[NSTG], sC[NSTG];
#pragma unroll
  for (int i = 0; i < NSTG; ++i) stage_rc(wid * 1024 + i * 8192 + lane * 16, sR[i], sC[i]);
  int pre[33];
  moe_tiles(counts, pre);
  const int total = pre[32] * 2;
  for (int r = 0;; ++r) {
    int item = xcd_item(total, r);
    if (item == -1) break;
    if (item < 0) continue;
    int e, mt;
    moe_find(pre, item >> 1, e, mt);
    const int fh = item & 1;
    const int cnt_e = counts[e * CNT_STRIDE];
    int rowbase = 0;
#pragma unroll
    for (int i = 0; i < 32; ++i) if (i == e) rowbase = pre[i] * 256;
    unsigned pa[NSTG], pb[NSTG];
    f32x4 acc[8][4];
    zero_acc(acc);
#pragma unroll
    for (int i = 0; i < NSTG; ++i) {
      pa[i] = (unsigned)((e * 512 + fh * 256 + sR[i]) * 1024 + sC[i]);
      int idx = mt * 256 + sR[i];
      int tok = (idx < cnt_e) ? (lists[(size_t)e * T_TOK + idx] >> 1) : 0;
      pb[i] = (unsigned)(tok * 1024 + sC[i]);
    }
    gemm_core(wgu, pa, h1, pb, 16, acc, shm);
#pragma unroll
    for (int m = 0; m < 4; ++m)
#pragma unroll
      for (int n = 0; n < 4; ++n) {
        f16x4 o;
#pragma unroll
        for (int j = 0; j < 4; ++j) {
          float g = acc[m][n][j], u = acc[m + 4][n][j];
          o[j] = (f16)(g * u * __builtin_amdgcn_rcpf(1.0f + __builtin_amdgcn_exp2f(-1.4426950408889634f * g)));
        }
        size_t row = (size_t)rowbase + mt * 256 + wc * 64 + n * 16 + fr;
        *(f16x4*)(hid16 + row * 256 + fh * 128 + wr * 64 + m * 16 + fq * 4) = o;
      }
  }
}

__device__ __forceinline__ void p_moe_b(const Params& p, char* shm) {
  const f16* wdn = (const f16*)(p.ws + OFF_WDN);
  const f16* hid16 = (const f16*)(p.ws + OFF_B);
  const float* route_w = (const float*)(p.ws + OFF_ROUTE_W);
  const int* counts = (const int*)(p.ws + OFF_CNT);
  const int* lists = (const int*)(p.ws + OFF_LISTS);
  f16* y16 = (f16*)(p.ws + OFF_C);
  int* sent = (int*)(shm + 256 * EPI_LD);
  const int tid = opaque_tid(), wid = tid >> 6, lane = tid & 63, wc = wid & 3, fr = lane & 15;
  int sR[NSTG], sC[NSTG];
#pragma unroll
  for (int i = 0; i < NSTG; ++i) stage_rc(wid * 1024 + i * 8192 + lane * 16, sR[i], sC[i]);
  int pre[33];
  moe_tiles(counts, pre);
  const int total = pre[32] * 4;
  for (int r = 0;; ++r) {
    int item = xcd_item(total, r);
    if (item == -1) break;
    if (item < 0) continue;
    int e, mt;
    moe_find(pre, item >> 2, e, mt);
    const int ft = item & 3;
    const int cnt_e = counts[e * CNT_STRIDE];
    int rowbase = 0;
#pragma unroll
    for (int i = 0; i < 32; ++i) if (i == e) rowbase = pre[i] * 256;
    if (tid < 256) {
      int idx = mt * 256 + tid;
      sent[tid] = (idx < cnt_e) ? lists[(size_t)e * T_TOK + idx] : -1;
    }
    unsigned pa[NSTG], pb[NSTG];
    f32x4 acc[8][4];
    zero_acc(acc);
#pragma unroll
    for (int i = 0; i < NSTG; ++i) {
      pa[i] = (unsigned)((e * 1024 + ft * 256 + sR[i]) * 256 + sC[i]);
      pb[i] = (unsigned)((rowbase + mt * 256 + sR[i]) * 256 + sC[i]);
    }
    gemm_core(wdn, pa, hid16, pb, 4, acc, shm);
#pragma unroll
    for (int n = 0; n < 4; ++n) {
      int en = sent[wc * 64 + n * 16 + fr];
      float rw = (en >= 0) ? route_w[en] : 0.f;
#pragma unroll
      for (int m = 0; m < 8; ++m)
#pragma unroll
        for (int j = 0; j < 4; ++j) acc[m][n][j] *= rw;
    }
    epi_store_f16(acc, shm);
    RAW_SYNC();
    epi_rows_out(shm, [&](int r) -> f16* { int en = sent[r]; return (en >= 0) ? (y16 + (size_t)en * 1024 + ft * 256) : (f16*)nullptr; });
    RAW_SYNC();
  }
}


__device__ __forceinline__ unsigned f2key_(float f) {
  if (f == 0.f) f = 0.f;
  unsigned u = __float_as_uint(f);
  return (u & 0x80000000u) ? ~u : (u | 0x80000000u);
}
__device__ __forceinline__ float key2f_(unsigned k) {
  return __uint_as_float((k & 0x80000000u) ? (k & 0x7fffffffu) : ~k);
}
__device__ __forceinline__ void find_bin(const unsigned* hrow, int need, int lane, int* out_bin, int* out_above) {
  uint4 c = *(const uint4*)(hrow + 4 * lane);
  int tot = (int)(c.x + c.y + c.z + c.w);
  int incl = tot;
#pragma unroll
  for (int o = 1; o < 64; o <<= 1) {
    int v = __shfl_down(incl, o, 64);
    if (lane + o < 64) incl += v;
  }
  int above = incl - tot;
  if (above < need && incl >= need) {
    int b;
    if (above + (int)c.w >= need) b = 3;
    else { above += c.w; if (above + (int)c.z >= need) b = 2;
      else { above += c.z; if (above + (int)c.y >= need) b = 1; else { above += c.y; b = 0; } } }
    *out_bin = 4 * lane + b;
    *out_above = above;
  }
}

typedef short s16x4 __attribute__((ext_vector_type(4)));
#define VROW 160
#define ATT_WAVE_LDS (64 * VROW + 512)
__device__ __forceinline__ f16x8 tr_pair(const char* a, const char* b) {
  s16x4 x = __builtin_amdgcn_ds_read_tr16_b64_v4i16((__attribute__((address_space(3))) s16x4*)(a));
  s16x4 y = __builtin_amdgcn_ds_read_tr16_b64_v4i16((__attribute__((address_space(3))) s16x4*)(b));
  typedef short s16x8 __attribute__((ext_vector_type(8)));
  s16x8 r = __builtin_shufflevector(x, y, 0, 1, 2, 3, 4, 5, 6, 7);
  return __builtin_bit_cast(f16x8, r);
}
__device__ __forceinline__ void attn_one(const f16* __restrict__ proj16, f16* __restrict__ pa16, int t, const unsigned short* ssel,
                                         char* vimg, int lane) {
  const int fr = lane & 15, fq = lane >> 4;
  const int l = t & (SEQ - 1), b0 = t - l, cnt = min(l + 1, 256);
  f16x8 bq0, bq1;
  {
    const f16* qp = proj16 + (size_t)t * PJ_W + C_Q + (fr & 7) * 64 + fq * 8;
    bq0 = *(const f16x8*)qp;
    bq1 = *(const f16x8*)(qp + 32);
#pragma unroll
    for (int e = 0; e < 8; ++e) { bq0[e] = (fr < 8) ? bq0[e] * (f16)0.125f : (f16)0.f; bq1[e] = (fr < 8) ? bq1[e] * (f16)0.125f : (f16)0.f; }
  }
  const char* kbase = (const char*)(proj16 + (size_t)b0 * PJ_W + C_K);
  const char* vbase = (const char*)(proj16 + (size_t)b0 * PJ_W + C_V);
  f32x4 S[16];
#pragma unroll
  for (int kt = 0; kt < 16; ++kt) {
    const unsigned ko = (unsigned)ssel[kt * 16 + fr] * (PJ_W * 2) + fq * 16;
    f16x8 a0 = *(const f16x8*)(kbase + ko), a1 = *(const f16x8*)(kbase + ko + 64);
    f32x4 z = {0.f, 0.f, 0.f, 0.f};
    z = __builtin_amdgcn_mfma_f32_16x16x32_f16(a0, bq0, z, 0, 0, 0);
    z = __builtin_amdgcn_mfma_f32_16x16x32_f16(a1, bq1, z, 0, 0, 0);
#pragma unroll
    for (int j = 0; j < 4; ++j) S[kt][j] = (kt * 16 + fq * 4 + j < cnt) ? z[j] : NEG_BIG;
  }
  f16x8 vv[8];
#pragma unroll
  for (int i = 0; i < 8; ++i) {
    const unsigned vo = (unsigned)ssel[(lane >> 3) + 8 * i] * (PJ_W * 2) + (lane & 7) * 16;
    vv[i] = *(const f16x8*)(vbase + vo);
  }
  float m = NEG_BIG;
#pragma unroll
  for (int kt = 0; kt < 16; ++kt)
#pragma unroll
    for (int j = 0; j < 4; ++j) m = fmaxf(m, S[kt][j]);
  m = fmaxf(m, __shfl_xor(m, 16, 64));
  m = fmaxf(m, __shfl_xor(m, 32, 64));
  float lsum = 0.f;
  f16x8 P[8];
#pragma unroll
  for (int c = 0; c < 8; ++c)
#pragma unroll
    for (int j = 0; j < 4; ++j) {
      float e0 = __expf(S[2 * c][j] - m), e1 = __expf(S[2 * c + 1][j] - m);
      lsum += e0 + e1;
      P[c][j] = (f16)e0;
      P[c][4 + j] = (f16)e1;
    }
  lsum += __shfl_xor(lsum, 16, 64);
  lsum += __shfl_xor(lsum, 32, 64);
  f32x4 O[4];
#pragma unroll
  for (int nt = 0; nt < 4; ++nt) O[nt] = (f32x4){0.f, 0.f, 0.f, 0.f};
#pragma unroll
  for (int rr = 0; rr < 4; ++rr) {
    asm volatile("s_waitcnt lgkmcnt(0)" ::: "memory");
#pragma unroll
    for (int i = 0; i < 8; ++i) *(f16x8*)(vimg + ((lane >> 3) + 8 * i) * VROW + (lane & 7) * 16) = vv[i];
    if (rr < 3) {
#pragma unroll
      for (int i = 0; i < 8; ++i) {
        const unsigned vo = (unsigned)ssel[(rr + 1) * 64 + (lane >> 3) + 8 * i] * (PJ_W * 2) + (lane & 7) * 16;
        vv[i] = *(const f16x8*)(vbase + vo);
      }
    }
    asm volatile("s_waitcnt lgkmcnt(0)" ::: "memory");
#pragma unroll
    for (int cc = 0; cc < 2; ++cc) {
      const char* ra = vimg + (cc * 32 + fq * 4 + (fr >> 2)) * VROW + (fr & 3) * 8;
#pragma unroll
      for (int nt = 0; nt < 4; ++nt) {
        f16x8 B = tr_pair(ra + nt * 32, ra + 16 * VROW + nt * 32);
        O[nt] = __builtin_amdgcn_mfma_f32_16x16x32_f16(P[rr * 2 + cc], B, O[nt], 0, 0, 0);
      }
    }
  }
  asm volatile("s_waitcnt lgkmcnt(0)" ::: "memory");
#pragma unroll
  for (int j = 0; j < 4; ++j) {
    float ls = __shfl(lsum, (fq & 1) * 4 + j, 64);
    float inv = 1.0f / ls;
    if (fq < 2) {
      f16* op = pa16 + (size_t)t * DM + 512 + (fq * 4 + j) * 64 + fr;
#pragma unroll
      for (int nt = 0; nt < 4; ++nt) op[nt * 16] = (f16)(O[nt][j] * inv);
    }
  }
}

__device__ __forceinline__ f32x4 score_tile(const f16x8& a, const f16x8 (&bq)[8], const f16x8& bc_hi, const f16x8& bc_lo,
                                            const float (&wq)[8]) {
  f32x4 L[8];
#pragma unroll
  for (int h = 0; h < 8; ++h) L[h] = __builtin_amdgcn_mfma_f32_16x16x32_f16(a, bq[h], (f32x4){0.f, 0.f, 0.f, 0.f}, 0, 0, 0);
  f32x4 s = __builtin_amdgcn_mfma_f32_16x16x32_f16(a, bc_lo, (f32x4){0.f, 0.f, 0.f, 0.f}, 0, 0, 0);
  s = __builtin_amdgcn_mfma_f32_16x16x32_f16(a, bc_hi, s, 0, 0, 0);
  __builtin_amdgcn_sched_barrier(0);
#pragma unroll
  for (int h = 0; h < 8; ++h)
#pragma unroll
    for (int jj = 0; jj < 4; ++jj) s[jj] = __builtin_fmaf(wq[h], __builtin_fabsf(L[h][jj]), s[jj]);
  return s;
}

#define IDX_KEYS 0
#define IDX_HIST 131072
#define IDX_SSEL (IDX_HIST + 16384)
#define IDX_CAND (IDX_SSEL + 8192)
#define IDX_MISC (IDX_CAND + 2048)
template <int V>
__device__ __forceinline__ void p_index(const Params& p, char* shm) {
  const f16* proj16 = (const f16*)(p.ws + OFF_B);
  f16* pa16 = (V == 0) ? (f16*)(p.ws + OFF_D) : (f16*)p.out;
  unsigned short* keys16 = (unsigned short*)(shm + IDX_KEYS);
  unsigned* hist = (unsigned*)(shm + IDX_HIST);
  unsigned short* ssel = (unsigned short*)(shm + IDX_SSEL);
  unsigned short* scand = (unsigned short*)(shm + IDX_CAND);
  unsigned* smm = (unsigned*)(shm + IDX_MISC);
  int* sbin = (int*)(smm + 32);
  const int tid = opaque_tid(), wid = tid >> 6, lane0 = tid & 63;
  const float NINF = -__builtin_huge_valf(), PINF = __builtin_huge_valf();
  for (int rnd = 0;; ++rnd) {
    int idx = rnd * gridDim.x + ((rnd & 1) ? (gridDim.x - 1 - blockIdx.x) : blockIdx.x);
    if (idx >= 2048) break;
    int lane = lane0;
    asm volatile("" : "+v"(lane));
    const int fr = lane & 15, fq = lane >> 4;
    const unsigned long long lt_mask = (1ull << lane) - 1ull;
    const int b = idx & 7, j = 255 - (idx >> 3);
    const int l0 = j * 16, t0 = b * SEQ + l0;
    if (j < 16) {
#pragma unroll 1
      for (int qq = 0; qq < 2; ++qq) {
        const int q = 2 * wid + qq, lq = l0 + q;
        unsigned short* sl = ssel + q * 256;
        for (int i = lane; i < 256; i += 64) sl[i] = (unsigned short)((i <= lq) ? i : 0);
        asm volatile("s_waitcnt lgkmcnt(0)" ::: "memory");
        attn_one(proj16, pa16, t0 + q, sl, (char*)(keys16 + q * 4096), lane);
      }
      __syncthreads();
      continue;
    }
    for (int i = tid; i < 4096; i += 512) hist[i] = 0;
    if (tid < 16) { smm[tid] = 0xFFFFFFFFu; smm[16 + tid] = 0u; }
    f16x8 bq[8];
    float wq[8];
    {
      const f16* qrow = proj16 + (size_t)(t0 + fr) * PJ_W;
#pragma unroll
      for (int h = 0; h < 8; ++h) bq[h] = *(const f16x8*)(qrow + C_IQ + h * 32 + fq * 8);
      f16x8 wv = *(const f16x8*)(qrow + C_IW);
#pragma unroll
      for (int h = 0; h < 8; ++h) wq[h] = (float)wv[h];
    }
    f16x8 bc_hi, bc_lo;
#pragma unroll
    for (int e = 0; e < 8; ++e) {
      float c = 0.f;
#pragma unroll
      for (int h = 0; h < 8; ++h) c = __builtin_fmaf(wq[h], (float)bq[h][e], c);
      f16 ch_ = (f16)c;
      bc_hi[e] = ch_;
      bc_lo[e] = (f16)(c - (float)ch_);
    }
    __syncthreads();
    const int wids = __builtin_amdgcn_readfirstlane(wid);
    const int klast = (j - 1) - ((j - 1 - wids) & 7);
    const f16* kbase = proj16 + (size_t)(b * SEQ + fr) * PJ_W + C_IK + fq * 8;
#define IK_LOAD(dst, kt0)                                                                   \
  _Pragma("unroll") for (int u = 0; u < 4; ++u) {                                           \
    int ktc = min((kt0) + 8 * u, klast);                                                    \
    dst[u] = *(const f16x8*)(kbase + (size_t)(ktc * 16) * PJ_W);                            \
  }
    {
      float mn = PINF, mx = NINF;
      f16x8 a[4];
      IK_LOAD(a, wids);
      const int astep = (j >= 32) ? 128 : 32;
      for (int kt0 = wids; kt0 < j; kt0 += astep) {
        f16x8 an[4];
        IK_LOAD(an, kt0 + astep);
#pragma unroll
        for (int u = 0; u < 4; ++u) {
          if (kt0 + 8 * u < j) {
            f32x4 sc = score_tile(a[u], bq, bc_hi, bc_lo, wq);
            mn = fminf(fminf(mn, sc[0]), fminf(fminf(sc[1], sc[2]), sc[3]));
            mx = fmaxf(fmaxf(mx, sc[0]), fmaxf(fmaxf(sc[1], sc[2]), sc[3]));
          }
        }
#pragma unroll
        for (int u = 0; u < 4; ++u) a[u] = an[u];
      }
      if ((j & 7) == wids) {
        f16x8 ad = *(const f16x8*)(kbase + (size_t)(j * 16) * PJ_W);
        f32x4 sc = score_tile(ad, bq, bc_hi, bc_lo, wq);
#pragma unroll
        for (int jj = 0; jj < 4; ++jj) {
          bool ok = (fq * 4 + jj <= fr);
          mn = fminf(mn, ok ? sc[jj] : PINF);
          mx = fmaxf(mx, ok ? sc[jj] : NINF);
        }
      }
      mn = fminf(mn, __shfl_xor(mn, 16, 64)); mn = fminf(mn, __shfl_xor(mn, 32, 64));
      mx = fmaxf(mx, __shfl_xor(mx, 16, 64)); mx = fmaxf(mx, __shfl_xor(mx, 32, 64));
      if (fq == 0) {
        if (mn != PINF) atomicMin(&smm[fr], f2key_(mn));
        if (mx != NINF) atomicMax(&smm[16 + fr], f2key_(mx));
      }
    }
    __syncthreads();
    {
      float lo = key2f_(smm[fr]), hi = key2f_(smm[16 + fr]);
      if (j >= 32) { const float mg = 0.125f * (hi - lo); lo -= mg; hi += mg; }
      const float s16 = (hi > lo) ? 65536.0f / (hi - lo) : 0.f;
      const float nlo = -lo * s16;
      unsigned* hq = hist + fr * 256;
      unsigned short* kq = keys16 + fr * 4096 + fq * 4;
      f16x8 a[4];
      IK_LOAD(a, wids);
      for (int kt0 = wids; kt0 < j; kt0 += 32) {
        f16x8 an[4];
        IK_LOAD(an, kt0 + 32);
#pragma unroll
        for (int u = 0; u < 4; ++u) {
          const int kt = kt0 + 8 * u;
          if (kt < j) {
            f32x4 sc = score_tile(a[u], bq, bc_hi, bc_lo, wq);
            unsigned kk[4];
#pragma unroll
            for (int jj = 0; jj < 4; ++jj) {
              int k16 = min(max((int)__builtin_fmaf(sc[jj], s16, nlo), 0), 65535);
              kk[jj] = (unsigned)k16;
              atomicAdd(&hq[k16 >> 8], 1u);
            }
            uint2 pk;
            pk.x = kk[0] | (kk[1] << 16);
            pk.y = kk[2] | (kk[3] << 16);
            *(uint2*)(kq + kt * 16) = pk;
          }
        }
#pragma unroll
        for (int u = 0; u < 4; ++u) a[u] = an[u];
      }
      if ((j & 7) == wids) {
        f16x8 ad = *(const f16x8*)(kbase + (size_t)(j * 16) * PJ_W);
        f32x4 sc = score_tile(ad, bq, bc_hi, bc_lo, wq);
        unsigned kk[4];
#pragma unroll
        for (int jj = 0; jj < 4; ++jj) {
          int k16 = min(max((int)__builtin_fmaf(sc[jj], s16, nlo), 0), 65535);
          kk[jj] = (unsigned)k16;
          if (fq * 4 + jj <= fr) atomicAdd(&hq[k16 >> 8], 1u);
        }
        uint2 pk;
        pk.x = kk[0] | (kk[1] << 16);
        pk.y = kk[2] | (kk[3] << 16);
        *(uint2*)(kq + j * 16) = pk;
      }
    }
#undef IK_LOAD
    __syncthreads();
    if (V == 2) continue;
    {
      const int q0 = 2 * wid, lq0 = l0 + q0;
      const int nmax = lq0 + 2;
      unsigned* hrow0 = hist + q0 * 256;
      const unsigned short* krow0 = keys16 + q0 * 4096;
      if (lane < 4) sbin[2 * q0 + lane] = 0;
      find_bin(hrow0, 256, lane, &sbin[2 * q0], &sbin[2 * q0 + 1]);
      find_bin(hrow0 + 256, 256, lane, &sbin[2 * q0 + 2], &sbin[2 * q0 + 3]);
      asm volatile("s_waitcnt lgkmcnt(0)" ::: "memory");
      const int b1s0 = sbin[2 * q0], ab0 = sbin[2 * q0 + 1], b1s1 = sbin[2 * q0 + 2], ab1 = sbin[2 * q0 + 3];
      asm volatile("s_waitcnt lgkmcnt(0)" ::: "memory");
      *(uint4*)(hrow0 + 4 * lane) = make_uint4(0u, 0u, 0u, 0u);
      *(uint4*)(hrow0 + 256 + 4 * lane) = make_uint4(0u, 0u, 0u, 0u);
      if (lane < 4) sbin[2 * q0 + lane] = 0;
      asm volatile("s_waitcnt lgkmcnt(0)" ::: "memory");
      for (int s4 = lane * 4; s4 < nmax; s4 += 256) {
        uint2 pa_ = *(const uint2*)(krow0 + s4), pb_ = *(const uint2*)(krow0 + 4096 + s4);
        unsigned ka[4] = {pa_.x & 0xffffu, pa_.x >> 16, pa_.y & 0xffffu, pa_.y >> 16};
        unsigned kb[4] = {pb_.x & 0xffffu, pb_.x >> 16, pb_.y & 0xffffu, pb_.y >> 16};
#pragma unroll
        for (int jj = 0; jj < 4; ++jj) {
          if (s4 + jj <= lq0 && (int)(ka[jj] >> 8) == b1s0) atomicAdd(&hrow0[ka[jj] & 255u], 1u);
          if (s4 + jj <= lq0 + 1 && (int)(kb[jj] >> 8) == b1s1) atomicAdd(&hrow0[256 + (kb[jj] & 255u)], 1u);
        }
      }
      asm volatile("s_waitcnt lgkmcnt(0)" ::: "memory");
      find_bin(hrow0, 256 - ab0, lane, &sbin[2 * q0], &sbin[2 * q0 + 1]);
      find_bin(hrow0 + 256, 256 - ab1, lane, &sbin[2 * q0 + 2], &sbin[2 * q0 + 3]);
      asm volatile("s_waitcnt lgkmcnt(0)" ::: "memory");
      const unsigned thr0 = (unsigned)((b1s0 << 8) | sbin[2 * q0]), thr1 = (unsigned)((b1s1 << 8) | sbin[2 * q0 + 2]);
      int base0 = 0, cb0 = 0, base1 = 0, cb1 = 0;
      for (int s0 = 0; s0 < nmax; s0 += 256) {
        const int s4 = s0 + lane * 4;
        uint2 pa_ = make_uint2(0u, 0u), pb_ = make_uint2(0u, 0u);
        if (s4 < nmax) { pa_ = *(const uint2*)(krow0 + s4); pb_ = *(const uint2*)(krow0 + 4096 + s4); }
        unsigned ka[4] = {pa_.x & 0xffffu, pa_.x >> 16, pa_.y & 0xffffu, pa_.y >> 16};
        unsigned kb[4] = {pb_.x & 0xffffu, pb_.x >> 16, pb_.y & 0xffffu, pb_.y >> 16};
#pragma unroll
        for (int jj = 0; jj < 4; ++jj) {
          const bool ok0 = (s4 + jj <= lq0), ok1 = (s4 + jj <= lq0 + 1);
          const bool t0_ = ok0 && (ka[jj] > thr0), c0_ = ok0 && (ka[jj] == thr0);
          const bool t1_ = ok1 && (kb[jj] > thr1), c1_ = ok1 && (kb[jj] == thr1);
          unsigned long long m0 = __ballot(t0_), m1 = __ballot(t1_), cm0 = __ballot(c0_), cm1 = __ballot(c1_);
          if (t0_) ssel[q0 * 256 + base0 + __popcll(m0 & lt_mask)] = (unsigned short)(s4 + jj);
          if (t1_) ssel[q0 * 256 + 256 + base1 + __popcll(m1 & lt_mask)] = (unsigned short)(s4 + jj);
          base0 += __popcll(m0); base1 += __popcll(m1);
          if (cm0 | cm1) {
            int cp0 = cb0 + __popcll(cm0 & lt_mask), cp1 = cb1 + __popcll(cm1 & lt_mask);
            if (c0_ && cp0 < 64) scand[q0 * 64 + cp0] = (unsigned short)(s4 + jj);
            if (c1_ && cp1 < 64) scand[q0 * 64 + 64 + cp1] = (unsigned short)(s4 + jj);
            cb0 += __popcll(cm0); cb1 += __popcll(cm1);
          }
        }
      }
      asm volatile("s_waitcnt lgkmcnt(0)" ::: "memory");
#pragma unroll
      for (int x = 0; x < 2; ++x) {
        const int q = q0 + x;
        const int base = x ? base1 : base0, c = min(x ? cb1 : cb0, 64), r = 256 - base;
        if (lane < c) {
          unsigned short my = scand[q * 64 + lane];
          int rank = 0;
          for (int k = 0; k < c; ++k) rank += (scand[q * 64 + k] < my) ? 1 : 0;
          if (rank < r) ssel[q * 256 + base + rank] = my;
        }
      }
    }
    asm volatile("s_waitcnt lgkmcnt(0)" ::: "memory");
#pragma unroll 1
    for (int qq = 0; qq < 2; ++qq) {
      const int q = 2 * wid + qq, lq = l0 + q;
      unsigned short* sl = ssel + q * 256;
      for (int i = lane; i < 256; i += 64) sl[i] = (unsigned short)min((int)sl[i], lq);
      asm volatile("s_waitcnt lgkmcnt(0)" ::: "memory");
      attn_one(proj16, pa16, t0 + q, sl, (char*)(keys16 + q * 4096), lane);
    }
    __syncthreads();
  }
}

#define DL_LD 1040
template <int W>
__device__ __forceinline__ void pool_delta(const f16* up, int lf, char* dp) {
  f16x8 u[W + 7];
#pragma unroll
  for (int k = 0; k < W + 7; ++k) {
    const int rel = k - (W - 1);
    f16x8 z = {(f16)0.f, (f16)0.f, (f16)0.f, (f16)0.f, (f16)0.f, (f16)0.f, (f16)0.f, (f16)0.f};
    u[k] = (lf + rel >= 0) ? *(const f16x8*)(up + (ptrdiff_t)rel * PJ_W) : z;
  }
  float sum[8];
#pragma unroll
  for (int e = 0; e < 8; ++e) sum[e] = 0.f;
#pragma unroll
  for (int k = 0; k < W - 1; ++k)
#pragma unroll
    for (int e = 0; e < 8; ++e) sum[e] += (float)u[k][e];
#pragma unroll
  for (int i = 0; i < 8; ++i) {
    const float inv = 1.0f / (float)min(lf + i + 1, W);
    f16x8 d;
#pragma unroll
    for (int e = 0; e < 8; ++e) {
      sum[e] += (float)u[W - 1 + i][e];
      d[e] = (f16)(sum[e] * inv - (float)u[W - 1 + i][e]);
      sum[e] -= (float)u[i][e];
    }
    *(f16x8*)(dp + i * DL_LD) = d;
  }
}
__device__ __forceinline__ void p_pool(const Params& p, char* shm) {
  const f16* proj16 = (const f16*)(p.ws + OFF_B);
  const f16* wpl = (const f16*)(p.ws + OFF_WPOOL);
  f16* pa16 = (f16*)(p.ws + OFF_D);
  const int tid = opaque_tid(), wid = tid >> 6, lane = tid & 63, fr = lane & 15, fq = lane >> 4;
  for (int item = blockIdx.x; item < T_TOK / 64; item += gridDim.x) {
    const int t0 = item * 64;
    {
      const int g = wid >> 1;
      const int c = g * 128 + ((wid & 1) * 8 + (lane & 7)) * 8;
      const int tg = lane >> 3;
      const int tf = t0 + tg * 8, lf = tf & (SEQ - 1);
      const f16* up = proj16 + (size_t)tf * PJ_W + c;
      char* dp = shm + (tg * 8) * DL_LD + c * 2;
      if (g == 0) pool_delta<2>(up, lf, dp);
      else if (g == 1) pool_delta<4>(up, lf, dp);
      else if (g == 2) pool_delta<8>(up, lf, dp);
      else pool_delta<16>(up, lf, dp);
    }
    __syncthreads();
    {
      const int g = wid >> 1, eh = wid & 1;
      f32x4 acc[4][4];
#pragma unroll
      for (int m = 0; m < 4; ++m)
#pragma unroll
        for (int n = 0; n < 4; ++n) acc[m][n] = (f32x4){0.f, 0.f, 0.f, 0.f};
#pragma unroll
      for (int ks = 0; ks < 4; ++ks) {
        f16x8 A[4], B[4];
#pragma unroll
        for (int m = 0; m < 4; ++m) A[m] = *(const f16x8*)(wpl + (size_t)(g * 128 + eh * 64 + m * 16 + fr) * 128 + ks * 32 + fq * 8);
#pragma unroll
        for (int n = 0; n < 4; ++n) B[n] = *(const f16x8*)(shm + (n * 16 + fr) * DL_LD + (g * 128 + ks * 32 + fq * 8) * 2);
#pragma unroll
        for (int m = 0; m < 4; ++m)
#pragma unroll
          for (int n = 0; n < 4; ++n) acc[m][n] = __builtin_amdgcn_mfma_f32_16x16x32_f16(A[m], B[n], acc[m][n], 0, 0, 0);
      }
#pragma unroll
      for (int m = 0; m < 4; ++m) {
        const int e0 = g * 128 + eh * 64 + m * 16 + fq * 4;
        float4 sc = *(const float4*)(p.pool_scale + e0);
#pragma unroll
        for (int n = 0; n < 4; ++n) {
          f16x4 o;
          o[0] = (f16)(acc[m][n][0] * sc.x); o[1] = (f16)(acc[m][n][1] * sc.y);
          o[2] = (f16)(acc[m][n][2] * sc.z); o[3] = (f16)(acc[m][n][3] * sc.w);
          *(f16x4*)(pa16 + (size_t)(t0 + n * 16 + fr) * DM + e0) = o;
        }
      }
    }
    __syncthreads();
  }
}

#define RW_LD 2064
#define RT_LDS (2 * 36 * RW_LD)
template <int V>
__device__ __forceinline__ void p_ln1_route(const Params& p, char* shm) {
  const f16* z16 = (const f16*)(p.ws + OFF_C);
  char* dmy = (char*)p.out;
  f16* h1 = (V == 0) ? (f16*)(p.ws + OFF_A) : (f16*)dmy;
  int* route_e = (V == 0) ? (int*)(p.ws + OFF_ROUTE_E) : (int*)(dmy + 68000000);
  float* route_w = (V == 0) ? (float*)(p.ws + OFF_ROUTE_W) : (float*)(dmy + 69000000);
  int* counts = (V == 0) ? (int*)(p.ws + OFF_CNT) : (int*)(dmy + 70000000);
  int* lists = (V == 0) ? (int*)(p.ws + OFF_LISTS) : (int*)(dmy + 71000000);
  int* lcnt = (int*)(shm + RT_LDS);
  int* lent = lcnt + 128;
  const int tid = opaque_tid(), wid = tid >> 6, lane = tid & 63, fr = lane & 15, fq = lane >> 4;
  if (tid < 128) lcnt[tid] = 0;
  {
    const f16* wsrc = (const f16*)(p.ws + OFF_WRT);
    for (int i = tid; i < 2 * 36 * 128; i += 512) {
      int img = i / (36 * 128), rem = i % (36 * 128), o = rem >> 7, c = rem & 127;
      *(f16x8*)(shm + (img * 36 + o) * RW_LD + c * 16) = *(const f16x8*)(wsrc + (size_t)(img * 36 + o) * 1024 + c * 8);
    }
  }
  __syncthreads();
  for (int t0 = (blockIdx.x * 8 + wid) * 16; t0 < T_TOK; t0 += gridDim.x * 8 * 16) {
    const f16* zr = z16 + (size_t)(t0 + fr) * DM + fq * 8;
    float s1 = 0.f, s2 = 0.f;
#pragma unroll 8
    for (int ks = 0; ks < 32; ++ks) {
      f16x8 xz = *(const f16x8*)(zr + ks * 32);
#pragma unroll
      for (int e = 0; e < 8; ++e) { float x = (float)xz[e]; s1 += x; s2 += x * x; }
    }
    s1 += __shfl_xor(s1, 16, 64); s1 += __shfl_xor(s1, 32, 64);
    s2 += __shfl_xor(s2, 16, 64); s2 += __shfl_xor(s2, 32, 64);
    const float mu = s1 * (1.0f / DM);
    const float rs = rsqrtf(fmaxf(s2 * (1.0f / DM) - mu * mu, 0.f) + 1e-5f);
    f32x4 acc[3];
#pragma unroll
    for (int mt = 0; mt < 3; ++mt) acc[mt] = (f32x4){0.f, 0.f, 0.f, 0.f};
    f16* hr = h1 + (size_t)(t0 + fr) * DM + fq * 8;
    const char* wa = shm + fr * RW_LD + fq * 16;
    const char* wa2 = shm + min(32 + fr, 35) * RW_LD + fq * 16;
#pragma unroll 4
    for (int ks = 0; ks < 32; ++ks) {
      f16x8 xz = *(const f16x8*)(zr + ks * 32);
      float4 g0 = *(const float4*)(p.ln1_g + ks * 32 + fq * 8), g1 = *(const float4*)(p.ln1_g + ks * 32 + fq * 8 + 4);
      float4 b0 = *(const float4*)(p.ln1_b + ks * 32 + fq * 8), b1 = *(const float4*)(p.ln1_b + ks * 32 + fq * 8 + 4);
      float hn[8];
      hn[0] = ((float)xz[0] - mu) * rs * g0.x + b0.x; hn[1] = ((float)xz[1] - mu) * rs * g0.y + b0.y;
      hn[2] = ((float)xz[2] - mu) * rs * g0.z + b0.z; hn[3] = ((float)xz[3] - mu) * rs * g0.w + b0.w;
      hn[4] = ((float)xz[4] - mu) * rs * g1.x + b1.x; hn[5] = ((float)xz[5] - mu) * rs * g1.y + b1.y;
      hn[6] = ((float)xz[6] - mu) * rs * g1.z + b1.z; hn[7] = ((float)xz[7] - mu) * rs * g1.w + b1.w;
      f16x8 bh, bl;
#pragma unroll
      for (int e = 0; e < 8; ++e) { bh[e] = (f16)hn[e]; bl[e] = (f16)(hn[e] - (float)bh[e]); }
      *(f16x8*)(hr + ks * 32) = bh;
#pragma unroll
      for (int mt = 0; mt < 3; ++mt) {
        const char* wp = (mt < 2) ? (wa + mt * 16 * RW_LD) : wa2;
        f16x8 ah = *(const f16x8*)(wp + ks * 64), al = *(const f16x8*)(wp + 36 * RW_LD + ks * 64);
        acc[mt] = __builtin_amdgcn_mfma_f32_16x16x32_f16(ah, bh, acc[mt], 0, 0, 0);
        acc[mt] = __builtin_amdgcn_mfma_f32_16x16x32_f16(ah, bl, acc[mt], 0, 0, 0);
        acc[mt] = __builtin_amdgcn_mfma_f32_16x16x32_f16(al, bh, acc[mt], 0, 0, 0);
      }
    }
    float lg[36];
#pragma unroll
    for (int o = 0; o < 36; ++o) lg[o] = __shfl(acc[o >> 4][o & 3], fr + 16 * ((o >> 2) & 3), 64);
    {
      float gl[4];
#pragma unroll
      for (int o = 0; o < 4; ++o) gl[o] = lg[o] + p.b_group[o];
      int g = 0;
      float m = gl[0];
#pragma unroll
      for (int o = 1; o < 4; ++o) if (gl[o] > m) { m = gl[o]; g = o; }
      float se = 0.f;
#pragma unroll
      for (int o = 0; o < 4; ++o) se += __expf(gl[o] - m);
      float pg = 1.0f / se;
      float v1 = -3e38f, v2 = -3e38f;
      int i1 = 0, i2 = 0;
#pragma unroll
      for (int jx = 0; jx < 8; ++jx) {
        float x = (g == 0) ? lg[4 + jx] : (g == 1) ? lg[12 + jx] : (g == 2) ? lg[20 + jx] : lg[28 + jx];
        x += p.b_router[g * 8 + jx];
        if (x > v1) { v2 = v1; i2 = i1; v1 = x; i1 = jx; }
        else if (x > v2) { v2 = x; i2 = jx; }
      }
      if (fq == 0) {
        const int tt = t0 + fr;
        float e2 = __expf(v2 - v1);
        float w1 = pg / (1.0f + e2), w2 = pg * e2 / (1.0f + e2);
        int ea = g * 8 + i1, eb = g * 8 + i2;
        route_e[2 * tt] = ea; route_e[2 * tt + 1] = eb;
        route_w[2 * tt] = w1; route_w[2 * tt + 1] = w2;
        int la = atomicAdd(&lcnt[ea], 1), lb = atomicAdd(&lcnt[eb], 1);
        int slot = atomicAdd(&lcnt[64], 2);
        if (slot + 1 < 512) {
          lent[2 * slot] = (ea << 16) | la; lent[2 * slot + 1] = 2 * tt;
          lent[2 * slot + 2] = (eb << 16) | lb; lent[2 * slot + 3] = 2 * tt + 1;
        }
      }
    }
  }
  __syncthreads();
  if (tid < 32) lcnt[32 + tid] = atomicAdd(&counts[tid * CNT_STRIDE], lcnt[tid]);
  __syncthreads();
  {
    const int n_ent = min(lcnt[64], 512);
    for (int i = tid; i < n_ent; i += 512) {
      int ev = lent[2 * i], id = lent[2 * i + 1];
      int e = ev >> 16, lp = ev & 0xffff;
      lists[(size_t)e * T_TOK + lcnt[32 + e] + lp] = id;
    }
  }
  __syncthreads();
}

__device__ __forceinline__ void p_final(const Params& p) {
  const f16* h1 = (const f16*)(p.ws + OFF_A);
  const f16* y16 = (const f16*)(p.ws + OFF_C);
  const int tid = opaque_tid(), wid = tid >> 6, lane = tid & 63;
  const int nw = gridDim.x * 8;
  int t = blockIdx.x * 8 + wid;
  f16x8 hv[2], y0[2], y1[2];
#define P7_LOAD(tt)                                                                          \
  _Pragma("unroll") for (int i = 0; i < 2; ++i) {                                            \
    hv[i] = *(const f16x8*)(h1 + (size_t)(tt) * DM + i * 512 + lane * 8);                    \
    y0[i] = *(const f16x8*)(y16 + (size_t)(2 * (tt)) * DM + i * 512 + lane * 8);             \
    y1[i] = *(const f16x8*)(y16 + (size_t)(2 * (tt) + 1) * DM + i * 512 + lane * 8);         \
  }
  if (t < T_TOK) { P7_LOAD(t); }
  for (; t < T_TOK; t += nw) {
    float v[16];
#pragma unroll
    for (int i = 0; i < 2; ++i)
#pragma unroll
      for (int e = 0; e < 8; ++e) v[i * 8 + e] = ALPHA * (float)hv[i][e] + ((float)y0[i][e] + (float)y1[i][e]);
    if (t + nw < T_TOK) { P7_LOAD(t + nw); }
    float s = 0.f;
#pragma unroll
    for (int i = 0; i < 16; ++i) s += v[i];
    float mu = wave_sum(s) * (1.0f / DM);
    float q = 0.f;
#pragma unroll
    for (int i = 0; i < 16; ++i) { v[i] -= mu; q += v[i] * v[i]; }
    float rs = rsqrtf(wave_sum(q) * (1.0f / DM) + 1e-5f);
#pragma unroll
    for (int i = 0; i < 2; ++i)
#pragma unroll
      for (int hf = 0; hf < 2; ++hf) {
        const int c = i * 512 + lane * 8 + hf * 4;
        float4 g = *(const float4*)(p.ln2_g + c), b = *(const float4*)(p.ln2_b + c);
        f32x4 o;
        o[0] = v[i * 8 + hf * 4 + 0] * rs * g.x + b.x; o[1] = v[i * 8 + hf * 4 + 1] * rs * g.y + b.y;
        o[2] = v[i * 8 + hf * 4 + 2] * rs * g.z + b.z; o[3] = v[i * 8 + hf * 4 + 3] * rs * g.w + b.w;
        *(f32x4*)(p.out + (size_t)t * DM + c) = o;
      }
  }
#undef P7_LOAD
}

#define MEGA_LDS 158720


#define XB_TMO      128
#define XB_XCNT(j)  (256  + 64 * (j))
#define XB_XSUB(j)  (1280 + 64 * (j))
#define XB_XGEN(j)  (2304 + 64 * (j))
#define XB_TOP      3328
#define XB_TOPGEN   3392
#define XCD_BAR_WORDS 3456
#define XB_SPIN_CAP (1u << 22)
#define LAS __attribute__((address_space(3)))
__device__ __forceinline__ unsigned xb_ld(unsigned* p) { return __hip_atomic_load(p, __ATOMIC_RELAXED, __HIP_MEMORY_SCOPE_AGENT); }
__device__ __forceinline__ unsigned xb_add(unsigned* p, unsigned v) { return __hip_atomic_fetch_add(p, v, __ATOMIC_RELAXED, __HIP_MEMORY_SCOPE_AGENT); }
__device__ __forceinline__ unsigned xb_xcc_id() { return (unsigned)__builtin_amdgcn_s_getreg((3 << 11) | 20) & 0xFu; }
#define XB_SPIN(cond, bar) do { unsigned _sp = 0; while (cond) { __builtin_amdgcn_s_sleep(1); \
    if ((++_sp & 255u) == 0u) { if (xb_ld(&(bar)[XB_TMO])) break; if (_sp > XB_SPIN_CAP) { atomicAdd(&(bar)[XB_TMO], 1u); break; } } } } while (0)
struct XcdBarrier { unsigned* bar; unsigned x; volatile unsigned* st; };
__device__ __forceinline__ XcdBarrier xcd_barrier_post(unsigned* bar, volatile unsigned* st) {
  XcdBarrier b; b.bar = bar; b.x = xb_xcc_id(); b.st = st;
  if (threadIdx.x == 0) (void)xb_add(&bar[XB_XCNT(b.x)], 1u);
  return b;
}
__device__ __forceinline__ void xcd_barrier_complete(unsigned* bar, unsigned x, unsigned& nloc, unsigned& nx) {
  const unsigned G = gridDim.x * gridDim.y * gridDim.z;
  unsigned sum, cnt, mine, sp = 0u;
  for (;;) {
    sum = 0u; cnt = 0u; mine = 0u;
#pragma unroll
    for (unsigned j = 0; j < 16; ++j) { const unsigned c = xb_ld(&bar[XB_XCNT(j)]); sum += c; cnt += (c > 0u) ? 1u : 0u; mine = (j == x) ? c : mine; }
    if (sum == G) break;
    __builtin_amdgcn_s_sleep(1);
    if ((++sp & 255u) == 0u) { if (xb_ld(&bar[XB_TMO])) break; if (sp > XB_SPIN_CAP) { atomicAdd(&bar[XB_TMO], 1u); break; } }
  }
  nloc = mine > 0u ? mine : 1u; nx = cnt > 0u ? cnt : 1u;
}
__device__ __forceinline__ void xcd_barrier(const XcdBarrier& b) {
  asm volatile("s_waitcnt vmcnt(0)" ::: "memory");
  __syncthreads();
  if (threadIdx.x == 0) {
    unsigned* bar = b.bar;
    __builtin_amdgcn_s_waitcnt(0);
    unsigned nloc = b.st[0], nx = b.st[1];
    if (nloc == 0u) { xcd_barrier_complete(bar, b.x, nloc, nx); b.st[0] = nloc; b.st[1] = nx; }
    const unsigned old = xb_add(&bar[XB_XSUB(b.x)], 1u);
    const unsigned gen = old / nloc;
    if (old + 1u == (gen + 1u) * nloc) {
      __builtin_amdgcn_fence(__ATOMIC_RELEASE, "agent");
      asm volatile("s_waitcnt vmcnt(0)" ::: "memory");
      const unsigned og = xb_add(&bar[XB_TOP], 1u);
      const unsigned tg = og / nx;
      if (og + 1u == (tg + 1u) * nx) xb_add(&bar[XB_TOPGEN], 1u);
      else XB_SPIN(xb_ld(&bar[XB_TOPGEN]) == tg, bar);
      __builtin_amdgcn_fence(__ATOMIC_ACQUIRE, "agent");
      xb_add(&bar[XB_XGEN(b.x)], 1u);
      asm volatile("s_waitcnt vmcnt(0)" ::: "memory");
    } else {
      XB_SPIN(xb_ld(&bar[XB_XGEN(b.x)]) == gen, bar);
      __builtin_amdgcn_fence(__ATOMIC_ACQUIRE, "agent");
      asm volatile("s_waitcnt vmcnt(0)" ::: "memory");
    }
  }
  __syncthreads();
}

#ifndef PROBE
#define PROBE 0
#endif
#define GSYNC() do { XcdBarrier xb_; xb_.bar = (unsigned*)(p.ws + OFF_BAR); xb_.x = xb_xcc_id(); xb_.st = (volatile unsigned*)(shm + MEGA_LDS); xcd_barrier(xb_); } while (0)
#define PH(n, code) do { code; if (PROBE == n) { GSYNC(); code; } } while (0)
__global__ __launch_bounds__(512) void mega(Params p) {
  __shared__ __attribute__((aligned(1024))) char shm[MEGA_LDS + 16];
  cg::grid_group grid = cg::this_grid();
  volatile unsigned* xst = (volatile unsigned*)(shm + MEGA_LDS);
  if (threadIdx.x < 4) xst[threadIdx.x] = 0u;
  __syncthreads();
  (void)xcd_barrier_post((unsigned*)(p.ws + OFF_BAR), xst);
  if (blockIdx.x == 0 && threadIdx.x < 32) ((int*)(p.ws + OFF_CNT))[threadIdx.x * CNT_STRIDE] = 0;
  PH(1, p_ln_in(p));
  PH(2, p_convert(p, shm));
  grid.sync();
  PH(3, p_inproj(p, shm));
  GSYNC();
  PH(4, p_pool(p, shm));
  PH(5, p_index<0>(p, shm));
#if PROBE >= 50 && PROBE < 60
  GSYNC();
  p_index<PROBE - 50>(p, shm);
#endif
  GSYNC();
  PH(7, p_merge(p, shm));
  GSYNC();
  PH(8, p_resid(p, shm));
  GSYNC();
  p_ln1_route<0>(p, shm);
  GSYNC();
#if PROBE == 9
  if (blockIdx.x == 0 && threadIdx.x < 32) ((int*)((char*)p.out + 70000000))[threadIdx.x * CNT_STRIDE] = 0;
  GSYNC();
  p_ln1_route<1>(p, shm);
  GSYNC();
#endif
  PH(10, p_moe_a(p, shm));
  GSYNC();
  PH(11, p_moe_b(p, shm));
  GSYNC();
  PH(12, p_final(p));
}

extern "C" void kernel_launch(void* const* d_in, const int* in_sizes, int n_in, void* d_out, int out_size, void* d_ws,
                              size_t ws_size, hipStream_t stream) {
  if (ws_size < WS_NEEDED) { fprintf(stderr, "ws too small: %zu < %zu\n", ws_size, (size_t)WS_NEEDED); return; }
  static int grid_blocks = 0;
  if (!grid_blocks) {
    int dev = 0, cus = 0, per_cu = 0;
    hipGetDevice(&dev);
    hipDeviceGetAttribute(&cus, hipDeviceAttributeMultiprocessorCount, dev);
    hipOccupancyMaxActiveBlocksPerMultiprocessor(&per_cu, mega, 512, 0);
    if (per_cu > 1) per_cu = 1;
    grid_blocks = cus * per_cu;
    fprintf(stderr, "mega: cus=%d per_cu=%d grid=%d\n", cus, per_cu, grid_blocks);
  }
  Params p{};
  const float** pp = (const float**)&p;
  for (int i = 0; i < 21; ++i) pp[i] = (const float*)d_in[i];
  p.out = (float*)d_out;
  p.ws = (char*)d_ws;
  (void)hipMemsetAsync((char*)d_ws + OFF_BAR, 0, 16384, stream);
  void* args[] = {&p};
  hipError_t e = hipLaunchCooperativeKernel((void*)mega, dim3(grid_blocks), dim3(512), args, 0, stream);
  if (e != hipSuccess) fprintf(stderr, "cooperative launch failed: %s (grid %d)\n", hipGetErrorString(e), grid_blocks);
}
```

```cpp
#include <hip/hip_runtime.h>
#include <hip/hip_fp16.h>
#include <hip/hip_cooperative_groups.h>
#include <stdint.h>
#include <stdio.h>
namespace cg = cooperative_groups;

typedef _Float16 f16;
typedef f16 f16x8 __attribute__((ext_vector_type(8)));
typedef f16 f16x4 __attribute__((ext_vector_type(4)));
typedef f16 f16x2 __attribute__((ext_vector_type(2)));
typedef float f32x4 __attribute__((ext_vector_type(4)));
typedef int i32x4 __attribute__((ext_vector_type(4)));

#define T_TOK 32768
#define DM 1024
#define SEQ 4096
#define PJ_W 1536
#define PA_W 1448
#define IN_W 3496
#define IN_WP 3584
#define C_Q 512
#define C_K 1024
#define C_V 1088
#define C_IQ 1152
#define C_IK 1408
#define C_IW 1440
#define ALPHA 1.189207115002721f
#define NEG_BIG (-1e30f)

#define SZ_A   ((size_t)T_TOK * DM * 2)
#define SZ_B   ((size_t)T_TOK * PJ_W * 2)
#define SZ_C   ((size_t)T_TOK * 2048 * 2)
#define SZ_D   ((size_t)T_TOK * DM * 2)
#define OFF_A  ((size_t)0)
#define OFF_B  (OFF_A + SZ_A)
#define OFF_C  (OFF_B + SZ_B)
#define OFF_D  (OFF_C + SZ_C)
#define OFF_W  (OFF_D + SZ_D)
#define OFF_WIN   (OFF_W)
#define OFF_WPOOL (OFF_WIN + (size_t)IN_WP * 1024 * 2)
#define OFF_WPP   (OFF_WPOOL + (size_t)4 * 128 * 128 * 2)
#define OFF_WPA   (OFF_WPP + (size_t)1024 * 512 * 2)
#define OFF_WOUT  (OFF_WPA + (size_t)1024 * 512 * 2)
#define OFF_WGU   (OFF_WOUT + (size_t)1024 * 1024 * 2)
#define OFF_WDN   (OFF_WGU + (size_t)32 * 512 * 1024 * 2)
#define OFF_MISC  (OFF_WDN + (size_t)32 * 1024 * 256 * 2)
#define OFF_ROUTE_E (OFF_MISC)
#define OFF_ROUTE_W (OFF_ROUTE_E + (size_t)T_TOK * 2 * 4)
#define OFF_COUNTS  (OFF_ROUTE_W + (size_t)T_TOK * 2 * 4)
#define OFF_LISTS   (OFF_COUNTS + 256)
#define OFF_SEL     (OFF_LISTS + (size_t)32 * T_TOK * 4)
#define OFF_CNT      (OFF_SEL + (size_t)T_TOK * 256 * 2)
#define OFF_WRT      (OFF_CNT + 4096)
#define OFF_BAR      (OFF_WRT + 2 * 36 * 1024 * 2)
#define WS_NEEDED   (OFF_BAR + 16384)
#define CNT_STRIDE 32

struct Params {
  const float *x, *ln_in_g, *ln_in_b, *w_in, *b_gate, *pool_w, *pool_scale, *wpp, *wpa, *w_out, *ln1_g, *ln1_b, *w_group,
      *b_group, *w_router, *b_router, *w_gate, *w_up, *w_down, *ln2_g, *ln2_b;
  float* out;
  char* ws;
};

__device__ __forceinline__ float wave_sum(float v) {
#pragma unroll
  for (int o = 32; o > 0; o >>= 1) v += __shfl_xor(v, o, 64);
  return v;
}
__device__ __forceinline__ float wave_max(float v) {
#pragma unroll
  for (int o = 32; o > 0; o >>= 1) v = fmaxf(v, __shfl_xor(v, o, 64));
  return v;
}
__device__ __forceinline__ int wave_sum_i(int v) {
#pragma unroll
  for (int o = 32; o > 0; o >>= 1) v += __shfl_xor(v, o, 64);
  return v;
}
__device__ __forceinline__ int opaque_tid() { int t = threadIdx.x; asm volatile("" : "+v"(t)); return t; }
__device__ __forceinline__ float ldf(const float* p) { return *p; }
__device__ __forceinline__ float ldf(const f16* p) { return (float)*p; }

#ifndef SKEW_P1
#define SKEW_P1 0
#endif
#define WAIT_V(n) asm volatile("s_waitcnt vmcnt(%0)" ::"n"(n) : "memory")
#define WAIT_L(n) asm volatile("s_waitcnt lgkmcnt(%0)" ::"n"(n) : "memory")
template <class T> __device__ __forceinline__ void st_nt(T* p, const T& v) { *p = v; }
#define RAW_SYNC() do { asm volatile("s_waitcnt lgkmcnt(0)" ::: "memory"); __builtin_amdgcn_s_barrier(); asm volatile("" ::: "memory"); } while (0)

__device__ __forceinline__ int lds_byte(int r, int c) {
  int ob = (r & 15) * 64 + c * 2;
  return (r >> 4) * 1024 + (ob ^ (((ob >> 9) & 1) << 5));
}
__device__ __forceinline__ void stage_rc(int b, int& R, int& C) {
  int st = b >> 10, sb = b & 1023, swz = sb ^ (((sb >> 9) & 1) << 5);
  R = st * 16 + swz / 64;
  C = (swz % 64) / 2;
}

#define TILE_B 16384
#define SLOT_B 32768
#define NSTG 2
#define GEMM_LDS 135168
#define EPI_LD 528

__device__ __forceinline__ void gemm_core(const f16* __restrict__ Ab, const unsigned (&pa)[NSTG], const f16* __restrict__ Bb,
                                          const unsigned (&pb)[NSTG], int nt, f32x4 (&acc)[8][4], char* shm) {
  const int tid = opaque_tid(), wid = tid >> 6, lane = tid & 63, wr = wid >> 2, wc = wid & 3, fr = lane & 15, fq = lane >> 4;
  const int nk = nt * 2;
#define SA(s_) (shm + (s_) * SLOT_B)
#define SB(s_) (shm + (s_) * SLOT_B + TILE_B)
#define GLDS_STAGE(slot, kt)                                                                                              \
  do {                                                                                                                    \
    _Pragma("unroll") for (int i = 0; i < NSTG; ++i) {                                                                   \
      __builtin_amdgcn_global_load_lds((const unsigned*)(Ab + pa[i] + (kt) * 32), (unsigned*)(SA(slot) + wid * 1024 + i * 8192), \
                                       16, 0, 0);                                                                         \
      __builtin_amdgcn_global_load_lds((const unsigned*)(Bb + pb[i] + (kt) * 32), (unsigned*)(SB(slot) + wid * 1024 + i * 8192), \
                                       16, 0, 0);                                                                         \
    }                                                                                                                     \
  } while (0)
  GLDS_STAGE(0, 0);
  GLDS_STAGE(1, 1);
  GLDS_STAGE(2, 2);
  const int aoff = lds_byte(wr * 128 + fr, fq * 8), boff = lds_byte(wc * 64 + fr, fq * 8);
  for (int t = 0; t < nk; ++t) {
    if (t + 2 < nk) WAIT_V(8); else if (t + 1 < nk) WAIT_V(4); else WAIT_V(0);
    __builtin_amdgcn_s_barrier();
    if (t + 3 < nk) GLDS_STAGE((t + 3) & 3, t + 3);
    const char* sa = SA(t & 3) + aoff;
    const char* sb = SB(t & 3) + boff;
    f16x8 Bf[4];
#pragma unroll
    for (int n = 0; n < 4; ++n) Bf[n] = *(const f16x8*)(sb + n * 1024);
    f16x8 A0 = *(const f16x8*)(sa), A1 = *(const f16x8*)(sa + 1024);
#pragma unroll
    for (int g = 0; g < 4; ++g) {
      f16x8 N0 = A0, N1 = A1;
      if (g < 3) { N0 = *(const f16x8*)(sa + (2 * g + 2) * 1024); N1 = *(const f16x8*)(sa + (2 * g + 3) * 1024); }
      __builtin_amdgcn_sched_barrier(0);
#pragma unroll
      for (int n = 0; n < 4; ++n) acc[2 * g][n] = __builtin_amdgcn_mfma_f32_16x16x32_f16(A0, Bf[n], acc[2 * g][n], 0, 0, 0);
#pragma unroll
      for (int n = 0; n < 4; ++n) acc[2 * g + 1][n] = __builtin_amdgcn_mfma_f32_16x16x32_f16(A1, Bf[n], acc[2 * g + 1][n], 0, 0, 0);
      __builtin_amdgcn_sched_barrier(0);
      A0 = N0; A1 = N1;
    }
    WAIT_L(0);
  }
  RAW_SYNC();
#undef SA
#undef SB
#undef GLDS_STAGE
}

__device__ __forceinline__ void epi_store_f16(const f32x4 (&acc)[8][4], char* shm) {
  const int tid = opaque_tid(), wid = tid >> 6, lane = tid & 63, wr = wid >> 2, wc = wid & 3, fr = lane & 15, fq = lane >> 4;
#pragma unroll
  for (int m = 0; m < 8; ++m)
#pragma unroll
    for (int n = 0; n < 4; ++n) {
      f16x4 v;
      v[0] = (f16)acc[m][n][0]; v[1] = (f16)acc[m][n][1]; v[2] = (f16)acc[m][n][2]; v[3] = (f16)acc[m][n][3];
      *(f16x4*)(shm + (wc * 64 + n * 16 + fr) * EPI_LD + (wr * 128 + m * 16 + fq * 4) * 2) = v;
    }
}

__device__ __forceinline__ void p_ln_in(const Params& p) {
  f16* h16 = (f16*)(p.ws + OFF_A);
  const int tid = opaque_tid(), lane = tid & 63, wid = tid >> 6;
  const int nw = gridDim.x * 8;
  for (int t = blockIdx.x * 8 + wid; t < T_TOK; t += nw) {
    const float* xr = p.x + (size_t)t * DM;
    float4 v[4];
#pragma unroll
    for (int i = 0; i < 4; ++i) v[i] = *(const float4*)(xr + i * 256 + lane * 4);
    float s = 0.f;
#pragma unroll
    for (int i = 0; i < 4; ++i) s += v[i].x + v[i].y + v[i].z + v[i].w;
    float mu = wave_sum(s) * (1.0f / DM);
    float q = 0.f;
#pragma unroll
    for (int i = 0; i < 4; ++i) {
      v[i].x -= mu; v[i].y -= mu; v[i].z -= mu; v[i].w -= mu;
      q += v[i].x * v[i].x + v[i].y * v[i].y + v[i].z * v[i].z + v[i].w * v[i].w;
    }
    float rs = rsqrtf(wave_sum(q) * (1.0f / DM) + 1e-5f);
#pragma unroll
    for (int i = 0; i < 4; ++i) {
      float4 g = *(const float4*)(p.ln_in_g + i * 256 + lane * 4), b = *(const float4*)(p.ln_in_b + i * 256 + lane * 4);
      f16x4 o;
      o[0] = (f16)(v[i].x * rs * g.x + b.x); o[1] = (f16)(v[i].y * rs * g.y + b.y);
      o[2] = (f16)(v[i].z * rs * g.z + b.z); o[3] = (f16)(v[i].w * rs * g.w + b.w);
      *(f16x4*)(h16 + (size_t)t * DM + i * 256 + lane * 4) = o;
    }
  }
}

template <class RowMap>
__device__ __forceinline__ void conv_tile(const float* __restrict__ src, int ld_src, int nvalid, int k0, int n0, f16* __restrict__ dst,
                                          int ld_dst, RowMap rm, float* sT) {
  const int tid = opaque_tid();
  {
    int k = tid >> 3, n = (tid & 7) * 8;
    const float* sp = src + (size_t)(k0 + k) * ld_src + n0 + n;
#pragma unroll
    for (int j = 0; j < 8; ++j) sT[k * 65 + n + j] = (n0 + n + j < nvalid) ? sp[j] : 0.f;
  }
  __syncthreads();
  {
    int n = tid >> 3, k = (tid & 7) * 8;
    f16x8 o;
#pragma unroll
    for (int j = 0; j < 8; ++j) o[j] = (f16)sT[(k + j) * 65 + n];
    int drow = rm(n0 + n);
    if (drow >= 0) *(f16x8*)(dst + (size_t)drow * ld_dst + k0 + k) = o;
  }
  __syncthreads();
}

struct RowId { __device__ int operator()(int n) const { return n; } };
struct RowGU { int up; __device__ int operator()(int ff) const {
  int tile = ff >> 7, wr = (ff >> 6) & 1, l = ff & 63; return tile * 256 + wr * 128 + up * 64 + l; } };

__device__ __forceinline__ void p_convert(const Params& p, char* shm) {
  float* sT = (float*)shm;
  char* ws = p.ws;
  const int J0 = 16 * 56, J1 = J0 + 16, J2 = J1 + 128, J3 = J2 + 128, J4 = J3 + 256, J5 = J4 + 32 * 64, J6 = J5 + 32 * 64,
            J7 = J6 + 32 * 64;
  for (int job = blockIdx.x; job < J7; job += gridDim.x) {
    if (job < J0) {
      int kt = job / 56, nt = job % 56;
      conv_tile(p.w_in, IN_W, IN_W, kt * 64, nt * 64, (f16*)(ws + OFF_WIN), 1024, RowId(), sT);
    } else if (job < J1) {
      int j = job - J0, g = j >> 2, kt = (j >> 1) & 1, nt = j & 1;
      conv_tile(p.pool_w + g * 128 * 128, 128, 128, kt * 64, nt * 64, (f16*)(ws + OFF_WPOOL) + g * 128 * 128, 128, RowId(), sT);
    } else if (job < J2) {
      int j = job - J1, kt = j >> 4, nt = j & 15;
      conv_tile(p.wpp, 1024, 1024, kt * 64, nt * 64, (f16*)(ws + OFF_WPP), 512, RowId(), sT);
    } else if (job < J3) {
      int j = job - J2, kt = j >> 4, nt = j & 15;
      conv_tile(p.wpa, 1024, 1024, kt * 64, nt * 64, (f16*)(ws + OFF_WPA), 512, RowId(), sT);
    } else if (job < J4) {
      int j = job - J3, kt = j >> 4, nt = j & 15;
      conv_tile(p.w_out, 1024, 1024, kt * 64, nt * 64, (f16*)(ws + OFF_WOUT), 1024, RowId(), sT);
    } else if (job < J6) {
      int up = job >= J5;
      int j = job - (up ? J5 : J4), e = j >> 6, kt = (j >> 2) & 15, nt = j & 3;
      RowGU rm; rm.up = up;
      conv_tile((up ? p.w_up : p.w_gate) + (size_t)e * 1024 * 256, 256, 256, kt * 64, nt * 64,
                (f16*)(ws + OFF_WGU) + (size_t)e * 512 * 1024, 1024, rm, sT);
    } else {
      int j = job - J6, e = j >> 6, kt = (j >> 4) & 3, nt = j & 15;
      conv_tile(p.w_down + (size_t)e * 256 * 1024, 1024, 1024, kt * 64, nt * 64, (f16*)(ws + OFF_WDN) + (size_t)e * 1024 * 256,
                256, RowId(), sT);
    }
  }
  {
    f16* whi = (f16*)(ws + OFF_WRT);
    f16* wlo = whi + 36 * 1024;
    for (int i = blockIdx.x * 512 + threadIdx.x; i < 36 * 1024; i += gridDim.x * 512) {
      int o = i >> 10, k = i & 1023;
      float w = (o < 4) ? p.w_group[k * 4 + o] : p.w_router[k * 32 + (o - 4)];
      f16 h = (f16)w;
      whi[i] = h;
      wlo[i] = (f16)(w - (float)h);
    }
  }
}

__device__ __forceinline__ void phase_skew(int us4) {
  const int k = (blockIdx.x >> 3) & 3;
  if (k) {
    const unsigned long long t0 = __builtin_amdgcn_s_memrealtime();
    const unsigned long long dt = (unsigned long long)(k * us4 * 25);
    while (__builtin_amdgcn_s_memrealtime() - t0 < dt) __builtin_amdgcn_s_sleep(8);
  }
}

__device__ __forceinline__ int xcd_item(int n_items, int r) {
  const int nx = 8, slots = gridDim.x >> 3;
  const int xcd = blockIdx.x & 7, slot = blockIdx.x >> 3;
  const int per = (n_items + nx - 1) / nx;
  const int local = slot + r * slots;
  if (local >= per) return -1;
  const int item = xcd * per + local;
  return (item < n_items) ? item : -2;
}

__device__ __forceinline__ void p_inproj(const Params& p, char* shm) {
  const f16* h16 = (const f16*)(p.ws + OFF_A);
  const f16* wT = (const f16*)(p.ws + OFF_WIN);
  f16* proj16 = (f16*)(p.ws + OFF_B);
  f16* gate16 = (f16*)(p.ws + OFF_C);
  const int tid = opaque_tid(), wid = tid >> 6, lane = tid & 63;
  int sR[NSTG], sC[NSTG];
#pragma unroll
  for (int i = 0; i < NSTG; ++i) stage_rc(wid * 1024 + i * 8192 + lane * 16, sR[i], sC[i]);
  const int NTILES = 128 * 14;
  if (SKEW_P1) phase_skew(SKEW_P1);
  for (int r = 0;; ++r) {
    int tile = xcd_item(NTILES, r);
    if (tile == -1) break;
    if (tile < 0) continue;
    int grp = tile / 56, rem = tile % 56;
    int ft = rem >> 2, tt = grp * 4 + (rem & 3);
    unsigned pa[NSTG], pb[NSTG];
#pragma unroll
    for (int i = 0; i < NSTG; ++i) {
      pa[i] = (unsigned)((ft * 256 + sR[i]) * 1024 + sC[i]);
      pb[i] = (unsigned)((tt * 256 + sR[i]) * 1024 + sC[i]);
    }
    f32x4 acc[8][4];
#pragma unroll
    for (int m = 0; m < 8; ++m)
#pragma unroll
      for (int n = 0; n < 4; ++n) acc[m][n] = (f32x4){0.f, 0.f, 0.f, 0.f};
    gemm_core(wT, pa, h16, pb, 16, acc, shm);
    epi_store_f16(acc, shm);
    RAW_SYNC();
    {
      int ch = tid & 31, r0 = tid >> 5;
      int f0 = ft * 256 + ch * 8;
      float bg[8];
      if (f0 >= PA_W && f0 < IN_W) {
#pragma unroll
        for (int j = 0; j < 8; ++j) bg[j] = p.b_gate[f0 - PA_W + j];
      } else {
#pragma unroll
        for (int j = 0; j < 8; ++j) bg[j] = 0.f;
      }
#pragma unroll 4
      for (int ps = 0; ps < 16; ++ps) {
        int r = ps * 16 + r0;
        f16x8 v = *(const f16x8*)(shm + r * EPI_LD + ch * 16);
        size_t tok = (size_t)tt * 256 + r;
        if (f0 < PA_W) {
          st_nt((f16x8*)(proj16 + tok * PJ_W + f0), v);
        } else if (f0 < IN_W) {
          f16x8 o;
#pragma unroll
          for (int j = 0; j < 8; ++j) o[j] = (f16)__builtin_amdgcn_rcpf(1.0f + __builtin_amdgcn_exp2f(-1.4426950408889634f * ((float)v[j] + bg[j])));
          st_nt((f16x8*)(gate16 + tok * 2048 + (f0 - PA_W)), o);
        }
      }
    }
    RAW_SYNC();
  }
}


__device__ __forceinline__ void zero_acc(f32x4 (&acc)[8][4]) {
#pragma unroll
  for (int m = 0; m < 8; ++m)
#pragma unroll
    for (int n = 0; n < 4; ++n) acc[m][n] = (f32x4){0.f, 0.f, 0.f, 0.f};
}

template <class RowPtr>
__device__ __forceinline__ void epi_rows_out(char* shm, RowPtr rp) {
  const int tid = opaque_tid(), ch = tid & 31, r0 = tid >> 5;
#pragma unroll 4
  for (int ps = 0; ps < 16; ++ps) {
    int r = ps * 16 + r0;
    f16x8 v = *(const f16x8*)(shm + r * EPI_LD + ch * 16);
    f16* d = rp(r);
    if (d) st_nt((f16x8*)(d + ch * 8), v);
  }
}

__device__ __forceinline__ void p_merge(const Params& p, char* shm) {
  const f16* pa16 = (const f16*)(p.ws + OFF_D);
  const f16* gate16 = (const f16*)(p.ws + OFF_C);
  const f16* wpp = (const f16*)(p.ws + OFF_WPP);
  const f16* wpa = (const f16*)(p.ws + OFF_WPA);
  f16* merged16 = (f16*)(p.ws + OFF_B);
  const int tid = opaque_tid(), wid = tid >> 6, lane = tid & 63;
  int sR[NSTG], sC[NSTG];
#pragma unroll
  for (int i = 0; i < NSTG; ++i) stage_rc(wid * 1024 + i * 8192 + lane * 16, sR[i], sC[i]);
  const int ch = tid & 31, r0 = tid >> 5;
  for (int r = 0;; ++r) {
    int tile = xcd_item(512, r);
    if (tile == -1) break;
    if (tile < 0) continue;
    int ft = tile & 3, tt = tile >> 2;
    unsigned pa[NSTG], pb[NSTG];
#pragma unroll
    for (int i = 0; i < NSTG; ++i) {
      pa[i] = (unsigned)((ft * 256 + sR[i]) * 512 + sC[i]);
      pb[i] = (unsigned)((tt * 256 + sR[i]) * 1024 + sC[i]);
    }
    f32x4 acc[8][4];
    zero_acc(acc);
    gemm_core(wpp, pa, pa16, pb, 8, acc, shm);
    epi_store_f16(acc, shm);
    RAW_SYNC();
#pragma unroll 4
    for (int ps = 0; ps < 16; ++ps) {
      const int rr = ps * 16 + r0;
      const size_t tok = (size_t)tt * 256 + rr;
      f16x8 v = *(const f16x8*)(shm + rr * EPI_LD + ch * 16);
      f16x8 g0 = *(const f16x8*)(gate16 + tok * 2048 + ft * 256 + ch * 8);
      f16x8 g1 = *(const f16x8*)(gate16 + tok * 2048 + 1024 + ft * 256 + ch * 8);
      f16x8 o;
#pragma unroll
      for (int e = 0; e < 8; ++e) {
        float rq = fminf((float)g0[e] * __builtin_amdgcn_rcpf(fmaxf((float)g1[e], 6e-5f)), 16384.f);
        o[e] = (f16)fminf(fmaxf((float)v[e] * rq, -60000.f), 60000.f);
      }
      *(f16x8*)(shm + rr * EPI_LD + ch * 16) = o;
    }
    RAW_SYNC();
    {
      const int wid_ = tid >> 6, lane_ = tid & 63, wr = wid_ >> 2, wc = wid_ & 3, fr = lane_ & 15, fq = lane_ >> 4;
#pragma unroll
      for (int m = 0; m < 8; ++m)
#pragma unroll
        for (int n = 0; n < 4; ++n) {
          f16x4 c = *(const f16x4*)(shm + (wc * 64 + n * 16 + fr) * EPI_LD + (wr * 128 + m * 16 + fq * 4) * 2);
          acc[m][n] = (f32x4){(float)c[0], (float)c[1], (float)c[2], (float)c[3]};
        }
    }
    RAW_SYNC();
    gemm_core(wpa, pa, pa16 + 512, pb, 8, acc, shm);
    epi_store_f16(acc, shm);
    RAW_SYNC();
#pragma unroll 4
    for (int ps = 0; ps < 16; ++ps) {
      const int rr = ps * 16 + r0;
      const size_t tok = (size_t)tt * 256 + rr;
      f16x8 v = *(const f16x8*)(shm + rr * EPI_LD + ch * 16);
      f16x8 g1 = *(const f16x8*)(gate16 + tok * 2048 + 1024 + ft * 256 + ch * 8);
      f16x8 o;
#pragma unroll
      for (int e = 0; e < 8; ++e) o[e] = (f16)((float)v[e] * (float)g1[e]);
      *(f16x8*)(merged16 + tok * 1024 + ft * 256 + ch * 8) = o;
    }
    RAW_SYNC();
  }
}

__device__ __forceinline__ void p_resid(const Params& p, char* shm) {
  const f16* merged16 = (const f16*)(p.ws + OFF_B);
  const f16* h16 = (const f16*)(p.ws + OFF_A);
  const f16* wo = (const f16*)(p.ws + OFF_WOUT);
  f16* z16 = (f16*)(p.ws + OFF_C);
  const int tid = opaque_tid(), wid = tid >> 6, lane = tid & 63;
  int sR[NSTG], sC[NSTG];
#pragma unroll
  for (int i = 0; i < NSTG; ++i) stage_rc(wid * 1024 + i * 8192 + lane * 16, sR[i], sC[i]);
  const int ch = tid & 31, r0 = tid >> 5;
  for (int r = 0;; ++r) {
    int tile = xcd_item(512, r);
    if (tile == -1) break;
    if (tile < 0) continue;
    int ft = tile & 3, tt = tile >> 2;
    unsigned pa[NSTG], pb[NSTG];
#pragma unroll
    for (int i = 0; i < NSTG; ++i) {
      pa[i] = (unsigned)((ft * 256 + sR[i]) * 1024 + sC[i]);
      pb[i] = (unsigned)((tt * 256 + sR[i]) * 1024 + sC[i]);
    }
    {
      f32x4 acc[8][4];
      zero_acc(acc);
      gemm_core(wo, pa, merged16, pb, 16, acc, shm);
      epi_store_f16(acc, shm);
    }
    RAW_SYNC();
#pragma unroll 4
    for (int ps = 0; ps < 16; ++ps) {
      const int rr = ps * 16 + r0;
      const size_t o = ((size_t)tt * 256 + rr) * 1024 + ft * 256 + ch * 8;
      f16x8 v = *(const f16x8*)(shm + rr * EPI_LD + ch * 16);
      f16x8 hv = *(const f16x8*)(h16 + o);
      f16x8 zz;
#pragma unroll
      for (int e = 0; e < 8; ++e) zz[e] = (f16)(ALPHA * (float)hv[e] + (float)v[e]);
      *(f16x8*)(z16 + o) = zz;
    }
    RAW_SYNC();
  }
}

#define HID_ROWS 73728
__device__ __forceinline__ void moe_tiles(const int* counts, int (&pre)[33]) {
  pre[0] = 0;
#pragma unroll
  for (int e = 0; e < 32; ++e) pre[e + 1] = pre[e] + ((counts[e * CNT_STRIDE] + 255) >> 8);
}
__device__ __forceinline__ void moe_find(const int (&pre)[33], int item, int& e, int& mt) {
  e = 0;
#pragma unroll
  for (int i = 1; i < 32; ++i) if (item >= pre[i]) e = i;
  int base = 0;
#pragma unroll
  for (int i = 0; i < 32; ++i) if (i == e) base = pre[i];
  mt = item - base;
}

__device__ __forceinline__ void p_moe_a(const Params& p, char* shm) {
  const f16* h1 = (const f16*)(p.ws + OFF_A);
  const f16* wgu = (const f16*)(p.ws + OFF_WGU);
  const int* counts = (const int*)(p.ws + OFF_CNT);
  const int* lists = (const int*)(p.ws + OFF_LISTS);
  f16* hid16 = (f16*)(p.ws + OFF_B);
  const int tid = opaque_tid(), wid = tid >> 6, lane = tid & 63, wr = wid >> 2, wc = wid & 3, fr = lane & 15, fq = lane >> 4;
  int sR[NSTG], sC[NSTG];
#pragma unroll
  for (int i = 0; i < NSTG; ++i) stage_rc(wid * 1024 + i * 8192 + lane * 16, sR[i], sC[i]);
  int pre[33];
  moe_tiles(counts, pre);
  const int total = pre[32] * 2;
  for (int r = 0;; ++r) {
    int item = xcd_item(total, r);
    if (item == -1) break;
    if (item < 0) continue;
    int e, mt;
    moe_find(pre, item >> 1, e, mt);
    const int fh = item & 1;
    const int cnt_e = counts[e * CNT_STRIDE];
    int rowbase = 0;
#pragma unroll
    for (int i = 0; i < 32; ++i) if (i == e) rowbase = pre[i] * 256;
    unsigned pa[NSTG], pb[NSTG];
    f32x4 acc[8][4];
    zero_acc(acc);
#pragma unroll
    for (int i = 0; i < NSTG; ++i) {
      pa[i] = (unsigned)((e * 512 + fh * 256 + sR[i]) * 1024 + sC[i]);
      int idx = mt * 256 + sR[i];
      int tok = (idx < cnt_e) ? (lists[(size_t)e * T_TOK + idx] >> 1) : 0;
      pb[i] = (unsigned)(tok * 1024 + sC[i]);
    }
    gemm_core(wgu, pa, h1, pb, 16, acc, shm);
#pragma unroll
    for (int m = 0; m < 4; ++m)
#pragma unroll
      for (int n = 0; n < 4; ++n) {
        f16x4 o;
#pragma unroll
        for (int j = 0; j < 4; ++j) {
          float g = acc[m][n][j], u = acc[m + 4][n][j];
          o[j] = (f16)(g * u * __builtin_amdgcn_rcpf(1.0f + __builtin_amdgcn_exp2f(-1.4426950408889634f * g)));
        }
        size_t row = (size_t)rowbase + mt * 256 + wc * 64 + n * 16 + fr;
        *(f16x4*)(hid16 + row * 256 + fh * 128 + wr * 64 + m * 16 + fq * 4) = o;
      }
  }
}

__device__ __forceinline__ void p_moe_b(const Params& p, char* shm) {
  const f16* wdn = (const f16*)(p.ws + OFF_WDN);
  const f16* hid16 = (const f16*)(p.ws + OFF_B);
  const float* route_w = (const float*)(p.ws + OFF_ROUTE_W);
  const int* counts = (const int*)(p.ws + OFF_CNT);
  const int* lists = (const int*)(p.ws + OFF_LISTS);
  f16* y16 = (f16*)(p.ws + OFF_C);
  int* sent = (int*)(shm + 256 * EPI_LD);
  const int tid = opaque_tid(), wid = tid >> 6, lane = tid & 63, wc = wid & 3, fr = lane & 15;
  int sR[NSTG], sC[NSTG];
#pragma unroll
  for (int i = 0; i < NSTG; ++i) stage_rc(wid * 1024 + i * 8192 + lane * 16, sR[i], sC[i]);
  int pre[33];
  moe_tiles(counts, pre);
  const int total = pre[32] * 4;
  for (int r = 0;; ++r) {
    int item = xcd_item(total, r);
    if (item == -1) break;
    if (item < 0) continue;
    int e, mt;
    moe_find(pre, item >> 2, e, mt);
    const int ft = item & 3;
    const int cnt_e = counts[e * CNT_STRIDE];
    int rowbase = 0;
#pragma unroll
    for (int i = 0; i < 32; ++i) if (i == e) rowbase = pre[i] * 256;
    if (tid < 256) {
      int idx = mt * 256 + tid;
      sent[tid] = (idx < cnt_e) ? lists[(size_t)e * T_TOK + idx] : -1;
    }
    unsigned pa[NSTG], pb[NSTG];
    f32x4 acc[8][4];
    zero_acc(acc);
#pragma unroll
    for (int i = 0; i < NSTG; ++i) {
      pa[i] = (unsigned)((e * 1024 + ft * 256 + sR[i]) * 256 + sC[i]);
      pb[i] = (unsigned)((rowbase + mt * 256 + sR[i]) * 256 + sC[i]);
    }
    gemm_core(wdn, pa, hid16, pb, 4, acc, shm);
#pragma unroll
    for (int n = 0; n < 4; ++n) {
      int en = sent[wc * 64 + n * 16 + fr];
      float rw = (en >= 0) ? route_w[en] : 0.f;
#pragma unroll
      for (int m = 0; m < 8; ++m)
#pragma unroll
        for (int j = 0; j < 4; ++j) acc[m][n][j] *= rw;
    }
    epi_store_f16(acc, shm);
    RAW_SYNC();
    epi_rows_out(shm, [&](int r) -> f16* { int en = sent[r]; return (en >= 0) ? (y16 + (size_t)en * 1024 + ft * 256) : (f16*)nullptr; });
    RAW_SYNC();
  }
}


__device__ __forceinline__ unsigned f2key_(float f) {
  if (f == 0.f) f = 0.f;
  unsigned u = __float_as_uint(f);
  return (u & 0x80000000u) ? ~u : (u | 0x80000000u);
}
__device__ __forceinline__ float key2f_(unsigned k) {
  return __uint_as_float((k & 0x80000000u) ? (k & 0x7fffffffu) : ~k);
}
__device__ __forceinline__ void find_bin(const unsigned* hrow, int need, int lane, int* out_bin, int* out_above) {
  uint4 c = *(const uint4*)(hrow + 4 * lane);
  int tot = (int)(c.x + c.y + c.z + c.w);
  int incl = tot;
#pragma unroll
  for (int o = 1; o < 64; o <<= 1) {
    int v = __shfl_down(incl, o, 64);
    if (lane + o < 64) incl += v;
  }
  int above = incl - tot;
  if (above < need && incl >= need) {
    int b;
    if (above + (int)c.w >= need) b = 3;
    else { above += c.w; if (above + (int)c.z >= need) b = 2;
      else { above += c.z; if (above + (int)c.y >= need) b = 1; else { above += c.y; b = 0; } } }
    *out_bin = 4 * lane + b;
    *out_above = above;
  }
}

typedef short s16x4 __attribute__((ext_vector_type(4)));
#define VROW 160
#define ATT_WAVE_LDS (64 * VROW + 512)
__device__ __forceinline__ f16x8 tr_pair(const char* a, const char* b) {
  s16x4 x = __builtin_amdgcn_ds_read_tr16_b64_v4i16((__attribute__((address_space(3))) s16x4*)(a));
  s16x4 y = __builtin_amdgcn_ds_read_tr16_b64_v4i16((__attribute__((address_space(3))) s16x4*)(b));
  typedef short s16x8 __attribute__((ext_vector_type(8)));
  s16x8 r = __builtin_shufflevector(x, y, 0, 1, 2, 3, 4, 5, 6, 7);
  return __builtin_bit_cast(f16x8, r);
}
__device__ __forceinline__ void attn_one(const f16* __restrict__ proj16, f16* __restrict__ pa16, int t, const unsigned short* ssel,
                                         char* vimg, int lane) {
  const int fr = lane & 15, fq = lane >> 4;
  const int l = t & (SEQ - 1), b0 = t - l, cnt = min(l + 1, 256);
  f16x8 bq0, bq1;
  {
    const f16* qp = proj16 + (size_t)t * PJ_W + C_Q + (fr & 7) * 64 + fq * 8;
    bq0 = *(const f16x8*)qp;
    bq1 = *(const f16x8*)(qp + 32);
#pragma unroll
    for (int e = 0; e < 8; ++e) { bq0[e] = (fr < 8) ? bq0[e] * (f16)0.125f : (f16)0.f; bq1[e] = (fr < 8) ? bq1[e] * (f16)0.125f : (f16)0.f; }
  }
  const char* kbase = (const char*)(proj16 + (size_t)b0 * PJ_W + C_K);
  const char* vbase = (const char*)(proj16 + (size_t)b0 * PJ_W + C_V);
  f32x4 S[16];
#pragma unroll
  for (int kt = 0; kt < 16; ++kt) {
    const unsigned ko = (unsigned)ssel[kt * 16 + fr] * (PJ_W * 2) + fq * 16;
    f16x8 a0 = *(const f16x8*)(kbase + ko), a1 = *(const f16x8*)(kbase + ko + 64);
    f32x4 z = {0.f, 0.f, 0.f, 0.f};
    z = __builtin_amdgcn_mfma_f32_16x16x32_f16(a0, bq0, z, 0, 0, 0);
    z = __builtin_amdgcn_mfma_f32_16x16x32_f16(a1, bq1, z, 0, 0, 0);
#pragma unroll
    for (int j = 0; j < 4; ++j) S[kt][j] = (kt * 16 + fq * 4 + j < cnt) ? z[j] : NEG_BIG;
  }
  f16x8 vv[8];
#pragma unroll
  for (int i = 0; i < 8; ++i) {
    const unsigned vo = (unsigned)ssel[(lane >> 3) + 8 * i] * (PJ_W * 2) + (lane & 7) * 16;
    vv[i] = *(const f16x8*)(vbase + vo);
  }
  float m = NEG_BIG;
#pragma unroll
  for (int kt = 0; kt < 16; ++kt)
#pragma unroll
    for (int j = 0; j < 4; ++j) m = fmaxf(m, S[kt][j]);
  m = fmaxf(m, __shfl_xor(m, 16, 64));
  m = fmaxf(m, __shfl_xor(m, 32, 64));
  float lsum = 0.f;
  f16x8 P[8];
#pragma unroll
  for (int c = 0; c < 8; ++c)
#pragma unroll
    for (int j = 0; j < 4; ++j) {
      float e0 = __expf(S[2 * c][j] - m), e1 = __expf(S[2 * c + 1][j] - m);
      lsum += e0 + e1;
      P[c][j] = (f16)e0;
      P[c][4 + j] = (f16)e1;
    }
  lsum += __shfl_xor(lsum, 16, 64);
  lsum += __shfl_xor(lsum, 32, 64);
  f32x4 O[4];
#pragma unroll
  for (int nt = 0; nt < 4; ++nt) O[nt] = (f32x4){0.f, 0.f, 0.f, 0.f};
#pragma unroll
  for (int rr = 0; rr < 4; ++rr) {
    asm volatile("s_waitcnt lgkmcnt(0)" ::: "memory");
#pragma unroll
    for (int i = 0; i < 8; ++i) *(f16x8*)(vimg + ((lane >> 3) + 8 * i) * VROW + (lane & 7) * 16) = vv[i];
    if (rr < 3) {
#pragma unroll
      for (int i = 0; i < 8; ++i) {
        const unsigned vo = (unsigned)ssel[(rr + 1) * 64 + (lane >> 3) + 8 * i] * (PJ_W * 2) + (lane & 7) * 16;
        vv[i] = *(const f16x8*)(vbase + vo);
      }
    }
    asm volatile("s_waitcnt lgkmcnt(0)" ::: "memory");
#pragma unroll
    for (int cc = 0; cc < 2; ++cc) {
      const char* ra = vimg + (cc * 32 + fq * 4 + (fr >> 2)) * VROW + (fr & 3) * 8;
#pragma unroll
      for (int nt = 0; nt < 4; ++nt) {
        f16x8 B = tr_pair(ra + nt * 32, ra + 16 * VROW + nt * 32);
        O[nt] = __builtin_amdgcn_mfma_f32_16x16x32_f16(P[rr * 2 + cc], B, O[nt], 0, 0, 0);
      }
    }
  }
  asm volatile("s_waitcnt lgkmcnt(0)" ::: "memory");
#pragma unroll
  for (int j = 0; j < 4; ++j) {
    float ls = __shfl(lsum, (fq & 1) * 4 + j, 64);
    float inv = 1.0f / ls;
    if (fq < 2) {
      f16* op = pa16 + (size_t)t * DM + 512 + (fq * 4 + j) * 64 + fr;
#pragma unroll
      for (int nt = 0; nt < 4; ++nt) op[nt * 16] = (f16)(O[nt][j] * inv);
    }
  }
}

__device__ __forceinline__ f32x4 score_tile(const f16x8& a, const f16x8 (&bq)[8], const f16x8& bc_hi, const f16x8& bc_lo,
                                            const float (&wq)[8]) {
  f32x4 L[8];
#pragma unroll
  for (int h = 0; h < 8; ++h) L[h] = __builtin_amdgcn_mfma_f32_16x16x32_f16(a, bq[h], (f32x4){0.f, 0.f, 0.f, 0.f}, 0, 0, 0);
  f32x4 s = __builtin_amdgcn_mfma_f32_16x16x32_f16(a, bc_lo, (f32x4){0.f, 0.f, 0.f, 0.f}, 0, 0, 0);
  s = __builtin_amdgcn_mfma_f32_16x16x32_f16(a, bc_hi, s, 0, 0, 0);
  __builtin_amdgcn_sched_barrier(0);
#pragma unroll
  for (int h = 0; h < 8; ++h)
#pragma unroll
    for (int jj = 0; jj < 4; ++jj) s[jj] = __builtin_fmaf(wq[h], __builtin_fabsf(L[h][jj]), s[jj]);
  return s;
}

#define IDX_KEYS 0
#define IDX_HIST 131072
#define IDX_SSEL (IDX_HIST + 16384)
#define IDX_CAND (IDX_SSEL + 8192)
#define IDX_MISC (IDX_CAND + 2048)
template <int V>
__device__ __forceinline__ void p_index(const Params& p, char* shm) {
  const f16* proj16 = (const f16*)(p.ws + OFF_B);
  f16* pa16 = (V == 0) ? (f16*)(p.ws + OFF_D) : (f16*)p.out;
  unsigned short* keys16 = (unsigned short*)(shm + IDX_KEYS);
  unsigned* hist = (unsigned*)(shm + IDX_HIST);
  unsigned short* ssel = (unsigned short*)(shm + IDX_SSEL);
  unsigned short* scand = (unsigned short*)(shm + IDX_CAND);
  unsigned* smm = (unsigned*)(shm + IDX_MISC);
  int* sbin = (int*)(smm + 32);
  const int tid = opaque_tid(), wid = tid >> 6, lane0 = tid & 63;
  const float NINF = -__builtin_huge_valf(), PINF = __builtin_huge_valf();
  for (int rnd = 0;; ++rnd) {
    int idx = rnd * gridDim.x + ((rnd & 1) ? (gridDim.x - 1 - blockIdx.x) : blockIdx.x);
    if (idx >= 2048) break;
    int lane = lane0;
    asm volatile("" : "+v"(lane));
    const int fr = lane & 15, fq = lane >> 4;
    const unsigned long long lt_mask = (1ull << lane) - 1ull;
    const int b = idx & 7, j = 255 - (idx >> 3);
    const int l0 = j * 16, t0 = b * SEQ + l0;
    if (j < 16) {
#pragma unroll 1
      for (int qq = 0; qq < 2; ++qq) {
        const int q = 2 * wid + qq, lq = l0 + q;
        unsigned short* sl = ssel + q * 256;
        for (int i = lane; i < 256; i += 64) sl[i] = (unsigned short)((i <= lq) ? i : 0);
        asm volatile("s_waitcnt lgkmcnt(0)" ::: "memory");
        attn_one(proj16, pa16, t0 + q, sl, (char*)(keys16 + q * 4096), lane);
      }
      __syncthreads();
      continue;
    }
    for (int i = tid; i < 4096; i += 512) hist[i] = 0;
    if (tid < 16) { smm[tid] = 0xFFFFFFFFu; smm[16 + tid] = 0u; }
    f16x8 bq[8];
    float wq[8];
    {
      const f16* qrow = proj16 + (size_t)(t0 + fr) * PJ_W;
#pragma unroll
      for (int h = 0; h < 8; ++h) bq[h] = *(const f16x8*)(qrow + C_IQ + h * 32 + fq * 8);
      f16x8 wv = *(const f16x8*)(qrow + C_IW);
#pragma unroll
      for (int h = 0; h < 8; ++h) wq[h] = (float)wv[h];
    }
    f16x8 bc_hi, bc_lo;
#pragma unroll
    for (int e = 0; e < 8; ++e) {
      float c = 0.f;
#pragma unroll
      for (int h = 0; h < 8; ++h) c = __builtin_fmaf(wq[h], (float)bq[h][e], c);
      f16 ch_ = (f16)c;
      bc_hi[e] = ch_;
      bc_lo[e] = (f16)(c - (float)ch_);
    }
    __syncthreads();
    const int wids = __builtin_amdgcn_readfirstlane(wid);
    const int klast = (j - 1) - ((j - 1 - wids) & 7);
    const f16* kbase = proj16 + (size_t)(b * SEQ + fr) * PJ_W + C_IK + fq * 8;
#define IK_LOAD(dst, kt0)                                                                   \
  _Pragma("unroll") for (int u = 0; u < 4; ++u) {                                           \
    int ktc = min((kt0) + 8 * u, klast);                                                    \
    dst[u] = *(const f16x8*)(kbase + (size_t)(ktc * 16) * PJ_W);                            \
  }
    {
      float mn = PINF, mx = NINF;
      f16x8 a[4];
      IK_LOAD(a, wids);
      const int astep = (j >= 32) ? 128 : 32;
      for (int kt0 = wids; kt0 < j; kt0 += astep) {
        f16x8 an[4];
        IK_LOAD(an, kt0 + astep);
#pragma unroll
        for (int u = 0; u < 4; ++u) {
          if (kt0 + 8 * u < j) {
            f32x4 sc = score_tile(a[u], bq, bc_hi, bc_lo, wq);
            mn = fminf(fminf(mn, sc[0]), fminf(fminf(sc[1], sc[2]), sc[3]));
            mx = fmaxf(fmaxf(mx, sc[0]), fmaxf(fmaxf(sc[1], sc[2]), sc[3]));
          }
        }
#pragma unroll
        for (int u = 0; u < 4; ++u) a[u] = an[u];
      }
      if ((j & 7) == wids) {
        f16x8 ad = *(const f16x8*)(kbase + (size_t)(j * 16) * PJ_W);
        f32x4 sc = score_tile(ad, bq, bc_hi, bc_lo, wq);
#pragma unroll
        for (int jj = 0; jj < 4; ++jj) {
          bool ok = (fq * 4 + jj <= fr);
          mn = fminf(mn, ok ? sc[jj] : PINF);
          mx = fmaxf(mx, ok ? sc[jj] : NINF);
        }
      }
      mn = fminf(mn, __shfl_xor(mn, 16, 64)); mn = fminf(mn, __shfl_xor(mn, 32, 64));
      mx = fmaxf(mx, __shfl_xor(mx, 16, 64)); mx = fmaxf(mx, __shfl_xor(mx, 32, 64));
      if (fq == 0) {
        if (mn != PINF) atomicMin(&smm[fr], f2key_(mn));
        if (mx != NINF) atomicMax(&smm[16 + fr], f2key_(mx));
      }
    }
    __syncthreads();
    {
      float lo = key2f_(smm[fr]), hi = key2f_(smm[16 + fr]);
      if (j >= 32) { const float mg = 0.125f * (hi - lo); lo -= mg; hi += mg; }
      const float s16 = (hi > lo) ? 65536.0f / (hi - lo) : 0.f;
      const float nlo = -lo * s16;
      unsigned* hq = hist + fr * 256;
      unsigned short* kq = keys16 + fr * 4096 + fq * 4;
      f16x8 a[4];
      IK_LOAD(a, wids);
      for (int kt0 = wids; kt0 < j; kt0 += 32) {
        f16x8 an[4];
        IK_LOAD(an, kt0 + 32);
#pragma unroll
        for (int u = 0; u < 4; ++u) {
          const int kt = kt0 + 8 * u;
          if (kt < j) {
            f32x4 sc = score_tile(a[u], bq, bc_hi, bc_lo, wq);
            unsigned kk[4];
#pragma unroll
            for (int jj = 0; jj < 4; ++jj) {
              int k16 = min(max((int)__builtin_fmaf(sc[jj], s16, nlo), 0), 65535);
              kk[jj] = (unsigned)k16;
              atomicAdd(&hq[k16 >> 8], 1u);
            }
            uint2 pk;
            pk.x = kk[0] | (kk[1] << 16);
            pk.y = kk[2] | (kk[3] << 16);
            *(uint2*)(kq + kt * 16) = pk;
          }
        }
#pragma unroll
        for (int u = 0; u < 4; ++u) a[u] = an[u];
      }
      if ((j & 7) == wids) {
        f16x8 ad = *(const f16x8*)(kbase + (size_t)(j * 16) * PJ_W);
        f32x4 sc = score_tile(ad, bq, bc_hi, bc_lo, wq);
        unsigned kk[4];
#pragma unroll
        for (int jj = 0; jj < 4; ++jj) {
          int k16 = min(max((int)__builtin_fmaf(sc[jj], s16, nlo), 0), 65535);
          kk[jj] = (unsigned)k16;
          if (fq * 4 + jj <= fr) atomicAdd(&hq[k16 >> 8], 1u);
        }
        uint2 pk;
        pk.x = kk[0] | (kk[1] << 16);
        pk.y = kk[2] | (kk[3] << 16);
        *(uint2*)(kq + j * 16) = pk;
      }
    }
#undef IK_LOAD
    __syncthreads();
    if (V == 2) continue;
    {
      const int q0 = 2 * wid, lq0 = l0 + q0;
      const int nmax = lq0 + 2;
      unsigned* hrow0 = hist + q0 * 256;
      const unsigned short* krow0 = keys16 + q0 * 4096;
      if (lane < 4) sbin[2 * q0 + lane] = 0;
      find_bin(hrow0, 256, lane, &sbin[2 * q0], &sbin[2 * q0 + 1]);
      find_bin(hrow0 + 256, 256, lane, &sbin[2 * q0 + 2], &sbin[2 * q0 + 3]);
      asm volatile("s_waitcnt lgkmcnt(0)" ::: "memory");
      const int b1s0 = sbin[2 * q0], ab0 = sbin[2 * q0 + 1], b1s1 = sbin[2 * q0 + 2], ab1 = sbin[2 * q0 + 3];
      asm volatile("s_waitcnt lgkmcnt(0)" ::: "memory");
      *(uint4*)(hrow0 + 4 * lane) = make_uint4(0u, 0u, 0u, 0u);
      *(uint4*)(hrow0 + 256 + 4 * lane) = make_uint4(0u, 0u, 0u, 0u);
      if (lane < 4) sbin[2 * q0 + lane] = 0;
      asm volatile("s_waitcnt lgkmcnt(0)" ::: "memory");
      for (int s4 = lane * 4; s4 < nmax; s4 += 256) {
        uint2 pa_ = *(const uint2*)(krow0 + s4), pb_ = *(const uint2*)(krow0 + 4096 + s4);
        unsigned ka[4] = {pa_.x & 0xffffu, pa_.x >> 16, pa_.y & 0xffffu, pa_.y >> 16};
        unsigned kb[4] = {pb_.x & 0xffffu, pb_.x >> 16, pb_.y & 0xffffu, pb_.y >> 16};
#pragma unroll
        for (int jj = 0; jj < 4; ++jj) {
          if (s4 + jj <= lq0 && (int)(ka[jj] >> 8) == b1s0) atomicAdd(&hrow0[ka[jj] & 255u], 1u);
          if (s4 + jj <= lq0 + 1 && (int)(kb[jj] >> 8) == b1s1) atomicAdd(&hrow0[256 + (kb[jj] & 255u)], 1u);
        }
      }
      asm volatile("s_waitcnt lgkmcnt(0)" ::: "memory");
      find_bin(hrow0, 256 - ab0, lane, &sbin[2 * q0], &sbin[2 * q0 + 1]);
      find_bin(hrow0 + 256, 256 - ab1, lane, &sbin[2 * q0 + 2], &sbin[2 * q0 + 3]);
      asm volatile("s_waitcnt lgkmcnt(0)" ::: "memory");
      const unsigned thr0 = (unsigned)((b1s0 << 8) | sbin[2 * q0]), thr1 = (unsigned)((b1s1 << 8) | sbin[2 * q0 + 2]);
      int base0 = 0, cb0 = 0, base1 = 0, cb1 = 0;
      for (int s0 = 0; s0 < nmax; s0 += 256) {
        const int s4 = s0 + lane * 4;
        uint2 pa_ = make_uint2(0u, 0u), pb_ = make_uint2(0u, 0u);
        if (s4 < nmax) { pa_ = *(const uint2*)(krow0 + s4); pb_ = *(const uint2*)(krow0 + 4096 + s4); }
        unsigned ka[4] = {pa_.x & 0xffffu, pa_.x >> 16, pa_.y & 0xffffu, pa_.y >> 16};
        unsigned kb[4] = {pb_.x & 0xffffu, pb_.x >> 16, pb_.y & 0xffffu, pb_.y >> 16};
#pragma unroll
        for (int jj = 0; jj < 4; ++jj) {
          const bool ok0 = (s4 + jj <= lq0), ok1 = (s4 + jj <= lq0 + 1);
          const bool t0_ = ok0 && (ka[jj] > thr0), c0_ = ok0 && (ka[jj] == thr0);
          const bool t1_ = ok1 && (kb[jj] > thr1), c1_ = ok1 && (kb[jj] == thr1);
          unsigned long long m0 = __ballot(t0_), m1 = __ballot(t1_), cm0 = __ballot(c0_), cm1 = __ballot(c1_);
          if (t0_) ssel[q0 * 256 + base0 + __popcll(m0 & lt_mask)] = (unsigned short)(s4 + jj);
          if (t1_) ssel[q0 * 256 + 256 + base1 + __popcll(m1 & lt_mask)] = (unsigned short)(s4 + jj);
          base0 += __popcll(m0); base1 += __popcll(m1);
          if (cm0 | cm1) {
            int cp0 = cb0 + __popcll(cm0 & lt_mask), cp1 = cb1 + __popcll(cm1 & lt_mask);
            if (c0_ && cp0 < 64) scand[q0 * 64 + cp0] = (unsigned short)(s4 + jj);
            if (c1_ && cp1 < 64) scand[q0 * 64 + 64 + cp1] = (unsigned short)(s4 + jj);
            cb0 += __popcll(cm0); cb1 += __popcll(cm1);
          }
        }
      }
      asm volatile("s_waitcnt lgkmcnt(0)" ::: "memory");
#pragma unroll
      for (int x = 0; x < 2; ++x) {
        const int q = q0 + x;
        const int base = x ? base1 : base0, c = min(x ? cb1 : cb0, 64), r = 256 - base;
        if (lane < c) {
          unsigned short my = scand[q * 64 + lane];
          int rank = 0;
          for (int k = 0; k < c; ++k) rank += (scand[q * 64 + k] < my) ? 1 : 0;
          if (rank < r) ssel[q * 256 + base + rank] = my;
        }
      }
    }
    asm volatile("s_waitcnt lgkmcnt(0)" ::: "memory");
#pragma unroll 1
    for (int qq = 0; qq < 2; ++qq) {
      const int q = 2 * wid + qq, lq = l0 + q;
      unsigned short* sl = ssel + q * 256;
      for (int i = lane; i < 256; i += 64) sl[i] = (unsigned short)min((int)sl[i], lq);
      asm volatile("s_waitcnt lgkmcnt(0)" ::: "memory");
      attn_one(proj16, pa16, t0 + q, sl, (char*)(keys16 + q * 4096), lane);
    }
    __syncthreads();
  }
}

#define DL_LD 1040
template <int W>
__device__ __forceinline__ void pool_delta(const f16* up, int lf, char* dp) {
  f16x8 u[W + 7];
#pragma unroll
  for (int k = 0; k < W + 7; ++k) {
    const int rel = k - (W - 1);
    f16x8 z = {(f16)0.f, (f16)0.f, (f16)0.f, (f16)0.f, (f16)0.f, (f16)0.f, (f16)0.f, (f16)0.f};
    u[k] = (lf + rel >= 0) ? *(const f16x8*)(up + (ptrdiff_t)rel * PJ_W) : z;
  }
  float sum[8];
#pragma unroll
  for (int e = 0; e < 8; ++e) sum[e] = 0.f;
#pragma unroll
  for (int k = 0; k < W - 1; ++k)
#pragma unroll
    for (int e = 0; e < 8; ++e) sum[e] += (float)u[k][e];
#pragma unroll
  for (int i = 0; i < 8; ++i) {
    const float inv = 1.0f / (float)min(lf + i + 1, W);
    f16x8 d;
#pragma unroll
    for (int e = 0; e < 8; ++e) {
      sum[e] += (float)u[W - 1 + i][e];
      d[e] = (f16)(sum[e] * inv - (float)u[W - 1 + i][e]);
      sum[e] -= (float)u[i][e];
    }
    *(f16x8*)(dp + i * DL_LD) = d;
  }
}
__device__ __forceinline__ void p_pool(const Params& p, char* shm) {
  const f16* proj16 = (const f16*)(p.ws + OFF_B);
  const f16* wpl = (const f16*)(p.ws + OFF_WPOOL);
  f16* pa16 = (f16*)(p.ws + OFF_D);
  const int tid = opaque_tid(), wid = tid >> 6, lane = tid & 63, fr = lane & 15, fq = lane >> 4;
  for (int item = blockIdx.x; item < T_TOK / 64; item += gridDim.x) {
    const int t0 = item * 64;
    {
      const int g = wid >> 1;
      const int c = g * 128 + ((wid & 1) * 8 + (lane & 7)) * 8;
      const int tg = lane >> 3;
      const int tf = t0 + tg * 8, lf = tf & (SEQ - 1);
      const f16* up = proj16 + (size_t)tf * PJ_W + c;
      char* dp = shm + (tg * 8) * DL_LD + c * 2;
      if (g == 0) pool_delta<2>(up, lf, dp);
      else if (g == 1) pool_delta<4>(up, lf, dp);
      else if (g == 2) pool_delta<8>(up, lf, dp);
      else pool_delta<16>(up, lf, dp);
    }
    __syncthreads();
    {
      const int g = wid >> 1, eh = wid & 1;
      f32x4 acc[4][4];
#pragma unroll
      for (int m = 0; m < 4; ++m)
#pragma unroll
        for (int n = 0; n < 4; ++n) acc[m][n] = (f32x4){0.f, 0.f, 0.f, 0.f};
#pragma unroll
      for (int ks = 0; ks < 4; ++ks) {
        f16x8 A[4], B[4];
#pragma unroll
        for (int m = 0; m < 4; ++m) A[m] = *(const f16x8*)(wpl + (size_t)(g * 128 + eh * 64 + m * 16 + fr) * 128 + ks * 32 + fq * 8);
#pragma unroll
        for (int n = 0; n < 4; ++n) B[n] = *(const f16x8*)(shm + (n * 16 + fr) * DL_LD + (g * 128 + ks * 32 + fq * 8) * 2);
#pragma unroll
        for (int m = 0; m < 4; ++m)
#pragma unroll
          for (int n = 0; n < 4; ++n) acc[m][n] = __builtin_amdgcn_mfma_f32_16x16x32_f16(A[m], B[n], acc[m][n], 0, 0, 0);
      }
#pragma unroll
      for (int m = 0; m < 4; ++m) {
        const int e0 = g * 128 + eh * 64 + m * 16 + fq * 4;
        float4 sc = *(const float4*)(p.pool_scale + e0);
#pragma unroll
        for (int n = 0; n < 4; ++n) {
          f16x4 o;
          o[0] = (f16)(acc[m][n][0] * sc.x); o[1] = (f16)(acc[m][n][1] * sc.y);
          o[2] = (f16)(acc[m][n][2] * sc.z); o[3] = (f16)(acc[m][n][3] * sc.w);
          *(f16x4*)(pa16 + (size_t)(t0 + n * 16 + fr) * DM + e0) = o;
        }
      }
    }
    __syncthreads();
  }
}

#define RW_LD 2064
#define RT_LDS (2 * 36 * RW_LD)
template <int V>
__device__ __forceinline__ void p_ln1_route(const Params& p, char* shm) {
  const f16* z16 = (const f16*)(p.ws + OFF_C);
  char* dmy = (char*)p.out;
  f16* h1 = (V == 0) ? (f16*)(p.ws + OFF_A) : (f16*)dmy;
  int* route_e = (V == 0) ? (int*)(p.ws + OFF_ROUTE_E) : (int*)(dmy + 68000000);
  float* route_w = (V == 0) ? (float*)(p.ws + OFF_ROUTE_W) : (float*)(dmy + 69000000);
  int* counts = (V == 0) ? (int*)(p.ws + OFF_CNT) : (int*)(dmy + 70000000);
  int* lists = (V == 0) ? (int*)(p.ws + OFF_LISTS) : (int*)(dmy + 71000000);
  int* lcnt = (int*)(shm + RT_LDS);
  int* lent = lcnt + 128;
  const int tid = opaque_tid(), wid = tid >> 6, lane = tid & 63, fr = lane & 15, fq = lane >> 4;
  if (tid < 128) lcnt[tid] = 0;
  {
    const f16* wsrc = (const f16*)(p.ws + OFF_WRT);
    for (int i = tid; i < 2 * 36 * 128; i += 512) {
      int img = i / (36 * 128), rem = i % (36 * 128), o = rem >> 7, c = rem & 127;
      *(f16x8*)(shm + (img * 36 + o) * RW_LD + c * 16) = *(const f16x8*)(wsrc + (size_t)(img * 36 + o) * 1024 + c * 8);
    }
  }
  __syncthreads();
  for (int t0 = (blockIdx.x * 8 + wid) * 16; t0 < T_TOK; t0 += gridDim.x * 8 * 16) {
    const f16* zr = z16 + (size_t)(t0 + fr) * DM + fq * 8;
    float s1 = 0.f, s2 = 0.f;
#pragma unroll 8
    for (int ks = 0; ks < 32; ++ks) {
      f16x8 xz = *(const f16x8*)(zr + ks * 32);
#pragma unroll
      for (int e = 0; e < 8; ++e) { float x = (float)xz[e]; s1 += x; s2 += x * x; }
    }
    s1 += __shfl_xor(s1, 16, 64); s1 += __shfl_xor(s1, 32, 64);
    s2 += __shfl_xor(s2, 16, 64); s2 += __shfl_xor(s2, 32, 64);
    const float mu = s1 * (1.0f / DM);
    const float rs = rsqrtf(fmaxf(s2 * (1.0f / DM) - mu * mu, 0.f) + 1e-5f);
    f32x4 acc[3];
#pragma unroll
    for (int mt = 0; mt < 3; ++mt) acc[mt] = (f32x4){0.f, 0.f, 0.f, 0.f};
    f16* hr = h1 + (size_t)(t0 + fr) * DM + fq * 8;
    const char* wa = shm + fr * RW_LD + fq * 16;
    const char* wa2 = shm + min(32 + fr, 35) * RW_LD + fq * 16;
#pragma unroll 4
    for (int ks = 0; ks < 32; ++ks) {
      f16x8 xz = *(const f16x8*)(zr + ks * 32);
      float4 g0 = *(const float4*)(p.ln1_g + ks * 32 + fq * 8), g1 = *(const float4*)(p.ln1_g + ks * 32 + fq * 8 + 4);
      float4 b0 = *(const float4*)(p.ln1_b + ks * 32 + fq * 8), b1 = *(const float4*)(p.ln1_b + ks * 32 + fq * 8 + 4);
      float hn[8];
      hn[0] = ((float)xz[0] - mu) * rs * g0.x + b0.x; hn[1] = ((float)xz[1] - mu) * rs * g0.y + b0.y;
      hn[2] = ((float)xz[2] - mu) * rs * g0.z + b0.z; hn[3] = ((float)xz[3] - mu) * rs * g0.w + b0.w;
      hn[4] = ((float)xz[4] - mu) * rs * g1.x + b1.x; hn[5] = ((float)xz[5] - mu) * rs * g1.y + b1.y;
      hn[6] = ((float)xz[6] - mu) * rs * g1.z + b1.z; hn[7] = ((float)xz[7] - mu) * rs * g1.w + b1.w;
      f16x8 bh, bl;
#pragma unroll
      for (int e = 0; e < 8; ++e) { bh[e] = (f16)hn[e]; bl[e] = (f16)(hn[e] - (float)bh[e]); }
      *(f16x8*)(hr + ks * 32) = bh;
#pragma unroll
      for (int mt = 0; mt < 3; ++mt) {
        const char* wp = (mt < 2) ? (wa + mt * 16 * RW_LD) : wa2;
        f16x8 ah = *(const f16x8*)(wp + ks * 64), al = *(const f16x8*)(wp + 36 * RW_LD + ks * 64);
        acc[mt] = __builtin_amdgcn_mfma_f32_16x16x32_f16(ah, bh, acc[mt], 0, 0, 0);
        acc[mt] = __builtin_amdgcn_mfma_f32_16x16x32_f16(ah, bl, acc[mt], 0, 0, 0);
        acc[mt] = __builtin_amdgcn_mfma_f32_16x16x32_f16(al, bh, acc[mt], 0, 0, 0);
      }
    }
    float lg[36];
#pragma unroll
    for (int o = 0; o < 36; ++o) lg[o] = __shfl(acc[o >> 4][o & 3], fr + 16 * ((o >> 2) & 3), 64);
    {
      float gl[4];
#pragma unroll
      for (int o = 0; o < 4; ++o) gl[o] = lg[o] + p.b_group[o];
      int g = 0;
      float m = gl[0];
#pragma unroll
      for (int o = 1; o < 4; ++o) if (gl[o] > m) { m = gl[o]; g = o; }
      float se = 0.f;
#pragma unroll
      for (int o = 0; o < 4; ++o) se += __expf(gl[o] - m);
      float pg = 1.0f / se;
      float v1 = -3e38f, v2 = -3e38f;
      int i1 = 0, i2 = 0;
#pragma unroll
      for (int jx = 0; jx < 8; ++jx) {
        float x = (g == 0) ? lg[4 + jx] : (g == 1) ? lg[12 + jx] : (g == 2) ? lg[20 + jx] : lg[28 + jx];
        x += p.b_router[g * 8 + jx];
        if (x > v1) { v2 = v1; i2 = i1; v1 = x; i1 = jx; }
        else if (x > v2) { v2 = x; i2 = jx; }
      }
      if (fq == 0) {
        const int tt = t0 + fr;
        float e2 = __expf(v2 - v1);
        float w1 = pg / (1.0f + e2), w2 = pg * e2 / (1.0f + e2);
        int ea = g * 8 + i1, eb = g * 8 + i2;
        route_e[2 * tt] = ea; route_e[2 * tt + 1] = eb;
        route_w[2 * tt] = w1; route_w[2 * tt + 1] = w2;
        int la = atomicAdd(&lcnt[ea], 1), lb = atomicAdd(&lcnt[eb], 1);
        int slot = atomicAdd(&lcnt[64], 2);
        if (slot + 1 < 512) {
          lent[2 * slot] = (ea << 16) | la; lent[2 * slot + 1] = 2 * tt;
          lent[2 * slot + 2] = (eb << 16) | lb; lent[2 * slot + 3] = 2 * tt + 1;
        }
      }
    }
  }
  __syncthreads();
  if (tid < 32) lcnt[32 + tid] = atomicAdd(&counts[tid * CNT_STRIDE], lcnt[tid]);
  __syncthreads();
  {
    const int n_ent = min(lcnt[64], 512);
    for (int i = tid; i < n_ent; i += 512) {
      int ev = lent[2 * i], id = lent[2 * i + 1];
      int e = ev >> 16, lp = ev & 0xffff;
      lists[(size_t)e * T_TOK + lcnt[32 + e] + lp] = id;
    }
  }
  __syncthreads();
}

__device__ __forceinline__ void p_final(const Params& p) {
  const f16* h1 = (const f16*)(p.ws + OFF_A);
  const f16* y16 = (const f16*)(p.ws + OFF_C);
  const int tid = opaque_tid(), wid = tid >> 6, lane = tid & 63;
  const int nw = gridDim.x * 8;
  int t = blockIdx.x * 8 + wid;
  f16x8 hv[2], y0[2], y1[2];
#define P7_LOAD(tt)                                                                          \
  _Pragma("unroll") for (int i = 0; i < 2; ++i) {                                            \
    hv[i] = *(const f16x8*)(h1 + (size_t)(tt) * DM + i * 512 + lane * 8);                    \
    y0[i] = *(const f16x8*)(y16 + (size_t)(2 * (tt)) * DM + i * 512 + lane * 8);             \
    y1[i] = *(const f16x8*)(y16 + (size_t)(2 * (tt) + 1) * DM + i * 512 + lane * 8);         \
  }
  if (t < T_TOK) { P7_LOAD(t); }
  for (; t < T_TOK; t += nw) {
    float v[16];
#pragma unroll
    for (int i = 0; i < 2; ++i)
#pragma unroll
      for (int e = 0; e < 8; ++e) v[i * 8 + e] = ALPHA * (float)hv[i][e] + ((float)y0[i][e] + (float)y1[i][e]);
    if (t + nw < T_TOK) { P7_LOAD(t + nw); }
    float s = 0.f;
#pragma unroll
    for (int i = 0; i < 16; ++i) s += v[i];
    float mu = wave_sum(s) * (1.0f / DM);
    float q = 0.f;
#pragma unroll
    for (int i = 0; i < 16; ++i) { v[i] -= mu; q += v[i] * v[i]; }
    float rs = rsqrtf(wave_sum(q) * (1.0f / DM) + 1e-5f);
#pragma unroll
    for (int i = 0; i < 2; ++i)
#pragma unroll
      for (int hf = 0; hf < 2; ++hf) {
        const int c = i * 512 + lane * 8 + hf * 4;
        float4 g = *(const float4*)(p.ln2_g + c), b = *(const float4*)(p.ln2_b + c);
        f32x4 o;
        o[0] = v[i * 8 + hf * 4 + 0] * rs * g.x + b.x; o[1] = v[i * 8 + hf * 4 + 1] * rs * g.y + b.y;
        o[2] = v[i * 8 + hf * 4 + 2] * rs * g.z + b.z; o[3] = v[i * 8 + hf * 4 + 3] * rs * g.w + b.w;
        *(f32x4*)(p.out + (size_t)t * DM + c) = o;
      }
  }
#undef P7_LOAD
}

#define MEGA_LDS 158720


#define XB_TMO      128
#define XB_XCNT(j)  (256  + 64 * (j))
#define XB_XSUB(j)  (1280 + 64 * (j))
#define XB_XGEN(j)  (2304 + 64 * (j))
#define XB_TOP      3328
#define XB_TOPGEN   3392
#define XCD_BAR_WORDS 3456
#define XB_SPIN_CAP (1u << 22)
#define LAS __attribute__((address_space(3)))
__device__ __forceinline__ unsigned xb_ld(unsigned* p) { return __hip_atomic_load(p, __ATOMIC_RELAXED, __HIP_MEMORY_SCOPE_AGENT); }
__device__ __forceinline__ unsigned xb_add(unsigned* p, unsigned v) { return __hip_atomic_fetch_add(p, v, __ATOMIC_RELAXED, __HIP_MEMORY_SCOPE_AGENT); }
__device__ __forceinline__ unsigned xb_xcc_id() { return (unsigned)__builtin_amdgcn_s_getreg((3 << 11) | 20) & 0xFu; }
#define XB_SPIN(cond, bar) do { unsigned _sp = 0; while (cond) { __builtin_amdgcn_s_sleep(1); \
    if ((++_sp & 255u) == 0u) { if (xb_ld(&(bar)[XB_TMO])) break; if (_sp > XB_SPIN_CAP) { atomicAdd(&(bar)[XB_TMO], 1u); break; } } } } while (0)
struct XcdBarrier { unsigned* bar; unsigned x; volatile unsigned* st; };
__device__ __forceinline__ XcdBarrier xcd_barrier_post(unsigned* bar, volatile unsigned* st) {
  XcdBarrier b; b.bar = bar; b.x = xb_xcc_id(); b.st = st;
  if (threadIdx.x == 0) (void)xb_add(&bar[XB_XCNT(b.x)], 1u);
  return b;
}
__device__ __forceinline__ void xcd_barrier_complete(unsigned* bar, unsigned x, unsigned& nloc, unsigned& nx) {
  const unsigned G = gridDim.x * gridDim.y * gridDim.z;
  unsigned sum, cnt, mine, sp = 0u;
  for (;;) {
    sum = 0u; cnt = 0u; mine = 0u;
#pragma unroll
    for (unsigned j = 0; j < 16; ++j) { const unsigned c = xb_ld(&bar[XB_XCNT(j)]); sum += c; cnt += (c > 0u) ? 1u : 0u; mine = (j == x) ? c : mine; }
    if (sum == G) break;
    __builtin_amdgcn_s_sleep(1);
    if ((++sp & 255u) == 0u) { if (xb_ld(&bar[XB_TMO])) break; if (sp > XB_SPIN_CAP) { atomicAdd(&bar[XB_TMO], 1u); break; } }
  }
  nloc = mine > 0u ? mine : 1u; nx = cnt > 0u ? cnt : 1u;
}
__device__ __forceinline__ void xcd_barrier(const XcdBarrier& b) {
  asm volatile("s_waitcnt vmcnt(0)" ::: "memory");
  __syncthreads();
  if (threadIdx.x == 0) {
    unsigned* bar = b.bar;
    __builtin_amdgcn_s_waitcnt(0);
    unsigned nloc = b.st[0], nx = b.st[1];
    if (nloc == 0u) { xcd_barrier_complete(bar, b.x, nloc, nx); b.st[0] = nloc; b.st[1] = nx; }
    const unsigned old = xb_add(&bar[XB_XSUB(b.x)], 1u);
    const unsigned gen = old / nloc;
    if (old + 1u == (gen + 1u) * nloc) {
      __builtin_amdgcn_fence(__ATOMIC_RELEASE, "agent");
      asm volatile("s_waitcnt vmcnt(0)" ::: "memory");
      const unsigned og = xb_add(&bar[XB_TOP], 1u);
      const unsigned tg = og / nx;
      if (og + 1u == (tg + 1u) * nx) xb_add(&bar[XB_TOPGEN], 1u);
      else XB_SPIN(xb_ld(&bar[XB_TOPGEN]) == tg, bar);
      __builtin_amdgcn_fence(__ATOMIC_ACQUIRE, "agent");
      xb_add(&bar[XB_XGEN(b.x)], 1u);
      asm volatile("s_waitcnt vmcnt(0)" ::: "memory");
    } else {
      XB_SPIN(xb_ld(&bar[XB_XGEN(b.x)]) == gen, bar);
      __builtin_amdgcn_fence(__ATOMIC_ACQUIRE, "agent");
      asm volatile("s_waitcnt vmcnt(0)" ::: "memory");
    }
  }
  __syncthreads();
}

#ifndef PROBE
#define PROBE 0
#endif
#define GSYNC() do { XcdBarrier xb_; xb_.bar = (unsigned*)(p.ws + OFF_BAR); xb_.x = xb_xcc_id(); xb_.st = (volatile unsigned*)(shm + MEGA_LDS); xcd_barrier(xb_); } while (0)
#define PH(n, code) do { code; if (PROBE == n) { GSYNC(); code; } } while (0)
__global__ __launch_bounds__(512) void mega(Params p) {
  __shared__ __attribute__((aligned(1024))) char shm[MEGA_LDS + 16];
  volatile unsigned* xst = (volatile unsigned*)(shm + MEGA_LDS);
  if (threadIdx.x < 4) xst[threadIdx.x] = 0u;
  __syncthreads();
  (void)xcd_barrier_post((unsigned*)(p.ws + OFF_BAR), xst);
  if (blockIdx.x == 0 && threadIdx.x < 32) ((int*)(p.ws + OFF_CNT))[threadIdx.x * CNT_STRIDE] = 0;
  PH(1, p_ln_in(p));
  PH(2, p_convert(p, shm));
  GSYNC();
  PH(3, p_inproj(p, shm));
  GSYNC();
  PH(4, p_pool(p, shm));
  PH(5, p_index<0>(p, shm));
#if PROBE >= 50 && PROBE < 60
  GSYNC();
  p_index<PROBE - 50>(p, shm);
#endif
  GSYNC();
  PH(7, p_merge(p, shm));
  GSYNC();
  PH(8, p_resid(p, shm));
  GSYNC();
  p_ln1_route<0>(p, shm);
  GSYNC();
#if PROBE == 9
  if (blockIdx.x == 0 && threadIdx.x < 32) ((int*)((char*)p.out + 70000000))[threadIdx.x * CNT_STRIDE] = 0;
  GSYNC();
  p_ln1_route<1>(p, shm);
  GSYNC();
#endif
  PH(10, p_moe_a(p, shm));
  GSYNC();
  PH(11, p_moe_b(p, shm));
  GSYNC();
  PH(12, p_final(p));
}

extern "C" void kernel_launch(void* const* d_in, const int* in_sizes, int n_in, void* d_out, int out_size, void* d_ws,
                              size_t ws_size, hipStream_t stream) {
  if (ws_size < WS_NEEDED) { fprintf(stderr, "ws too small: %zu < %zu\n", ws_size, (size_t)WS_NEEDED); return; }
  static int grid_blocks = 0;
  if (!grid_blocks) {
    int dev = 0, cus = 0, per_cu = 0;
    hipGetDevice(&dev);
    hipDeviceGetAttribute(&cus, hipDeviceAttributeMultiprocessorCount, dev);
    hipOccupancyMaxActiveBlocksPerMultiprocessor(&per_cu, mega, 512, 0);
    if (per_cu > 1) per_cu = 1;
    grid_blocks = cus * per_cu;
    fprintf(stderr, "mega: cus=%d per_cu=%d grid=%d\n", cus, per_cu, grid_blocks);
  }
  Params p{};
  const float** pp = (const float**)&p;
  for (int i = 0; i < 21; ++i) pp[i] = (const float*)d_in[i];
  p.out = (float*)d_out;
  p.ws = (char*)d_ws;
  (void)hipMemsetAsync((char*)d_ws + OFF_BAR, 0, 16384, stream);
  void* args[] = {&p};
  hipError_t e = hipLaunchCooperativeKernel((void*)mega, dim3(grid_blocks), dim3(512), args, 0, stream);
  if (e != hipSuccess) fprintf(stderr, "cooperative launch failed: %s (grid %d)\n", hipGetErrorString(e), grid_blocks);
}
```

```cpp
#include <hip/hip_runtime.h>
#include <hip/hip_fp16.h>
#include <hip/hip_cooperative_groups.h>
#include <stdint.h>
#include <stdio.h>
namespace cg = cooperative_groups;

typedef _Float16 f16;
typedef f16 f16x8 __attribute__((ext_vector_type(8)));
typedef f16 f16x4 __attribute__((ext_vector_type(4)));
typedef f16 f16x2 __attribute__((ext_vector_type(2)));
typedef float f32x4 __attribute__((ext_vector_type(4)));
typedef int i32x4 __attribute__((ext_vector_type(4)));

#define T_TOK 32768
#define DM 1024
#define SEQ 4096
#define PJ_W 1536
#define PA_W 1448
#define IN_W 3496
#define IN_WP 3584
#define C_Q 512
#define C_K 1024
#define C_V 1088
#define C_IQ 1152
#define C_IK 1408
#define C_IW 1440
#define ALPHA 1.189207115002721f
#define NEG_BIG (-1e30f)

#define SZ_A   ((size_t)T_TOK * DM * 2)
#define SZ_B   ((size_t)T_TOK * PJ_W * 2)
#define SZ_C   ((size_t)T_TOK * 2048 * 2)
#define SZ_D   ((size_t)T_TOK * DM * 2)
#define OFF_A  ((size_t)0)
#define OFF_B  (OFF_A + SZ_A)
#define OFF_C  (OFF_B + SZ_B)
#define OFF_D  (OFF_C + SZ_C)
#define OFF_W  (OFF_D + SZ_D)
#define OFF_WIN   (OFF_W)
#define OFF_WPOOL (OFF_WIN + (size_t)IN_WP * 1024 * 2)
#define OFF_WPP   (OFF_WPOOL + (size_t)4 * 128 * 128 * 2)
#define OFF_WPA   (OFF_WPP + (size_t)1024 * 512 * 2)
#define OFF_WOUT  (OFF_WPA + (size_t)1024 * 512 * 2)
#define OFF_WGU   (OFF_WOUT + (size_t)1024 * 1024 * 2)
#define OFF_WDN   (OFF_WGU + (size_t)32 * 512 * 1024 * 2)
#define OFF_MISC  (OFF_WDN + (size_t)32 * 1024 * 256 * 2)
#define OFF_ROUTE_E (OFF_MISC)
#define OFF_ROUTE_W (OFF_ROUTE_E + (size_t)T_TOK * 2 * 4)
#define OFF_COUNTS  (OFF_ROUTE_W + (size_t)T_TOK * 2 * 4)
#define OFF_LISTS   (OFF_COUNTS + 256)
#define OFF_SEL     (OFF_LISTS + (size_t)32 * T_TOK * 4)
#define OFF_CNT      (OFF_SEL + (size_t)T_TOK * 256 * 2)
#define OFF_WRT      (OFF_CNT + 4096)
#define OFF_BAR      (OFF_WRT + 2 * 36 * 1024 * 2)
#define WS_NEEDED   (OFF_BAR + 16384)
#define CNT_STRIDE 32

struct Params {
  const float *x, *ln_in_g, *ln_in_b, *w_in, *b_gate, *pool_w, *pool_scale, *wpp, *wpa, *w_out, *ln1_g, *ln1_b, *w_group,
      *b_group, *w_router, *b_router, *w_gate, *w_up, *w_down, *ln2_g, *ln2_b;
  float* out;
  char* ws;
};

__device__ __forceinline__ float wave_sum(float v) {
#pragma unroll
  for (int o = 32; o > 0; o >>= 1) v += __shfl_xor(v, o, 64);
  return v;
}
__device__ __forceinline__ float wave_max(float v) {
#pragma unroll
  for (int o = 32; o > 0; o >>= 1) v = fmaxf(v, __shfl_xor(v, o, 64));
  return v;
}
__device__ __forceinline__ int wave_sum_i(int v) {
#pragma unroll
  for (int o = 32; o > 0; o >>= 1) v += __shfl_xor(v, o, 64);
  return v;
}
__device__ __forceinline__ int opaque_tid() { int t = threadIdx.x; asm volatile("" : "+v"(t)); return t; }
__device__ __forceinline__ float ldf(const float* p) { return *p; }
__device__ __forceinline__ float ldf(const f16* p) { return (float)*p; }

#ifndef SKEW_P1
#define SKEW_P1 0
#endif
#define WAIT_V(n) asm volatile("s_waitcnt vmcnt(%0)" ::"n"(n) : "memory")
#define WAIT_L(n) asm volatile("s_waitcnt lgkmcnt(%0)" ::"n"(n) : "memory")
template <class T> __device__ __forceinline__ void st_nt(T* p, const T& v) { *p = v; }
#define RAW_SYNC() do { asm volatile("s_waitcnt lgkmcnt(0)" ::: "memory"); __builtin_amdgcn_s_barrier(); asm volatile("" ::: "memory"); } while (0)

__device__ __forceinline__ int lds_byte(int r, int c) {
  int ob = (r & 15) * 64 + c * 2;
  return (r >> 4) * 1024 + (ob ^ (((ob >> 9) & 1) << 5));
}
__device__ __forceinline__ void stage_rc(int b, int& R, int& C) {
  int st = b >> 10, sb = b & 1023, swz = sb ^ (((sb >> 9) & 1) << 5);
  R = st * 16 + swz / 64;
  C = (swz % 64) / 2;
}

#define TILE_B 16384
#define SLOT_B 32768
#define NSTG 2
#define GEMM_LDS 135168
#define EPI_LD 528

__device__ __forceinline__ void gemm_core(const f16* __restrict__ Ab, const unsigned (&pa)[NSTG], const f16* __restrict__ Bb,
                                          const unsigned (&pb)[NSTG], int nt, f32x4 (&acc)[8][4], char* shm) {
  const int tid = opaque_tid(), wid = tid >> 6, lane = tid & 63, wr = wid >> 2, wc = wid & 3, fr = lane & 15, fq = lane >> 4;
  const int nk = nt * 2;
#define SA(s_) (shm + (s_) * SLOT_B)
#define SB(s_) (shm + (s_) * SLOT_B + TILE_B)
#define GLDS_STAGE(slot, kt)                                                                                              \
  do {                                                                                                                    \
    _Pragma("unroll") for (int i = 0; i < NSTG; ++i) {                                                                   \
      __builtin_amdgcn_global_load_lds((const unsigned*)(Ab + pa[i] + (kt) * 32), (unsigned*)(SA(slot) + wid * 1024 + i * 8192), \
                                       16, 0, 0);                                                                         \
      __builtin_amdgcn_global_load_lds((const unsigned*)(Bb + pb[i] + (kt) * 32), (unsigned*)(SB(slot) + wid * 1024 + i * 8192), \
                                       16, 0, 0);                                                                         \
    }                                                                                                                     \
  } while (0)
  GLDS_STAGE(0, 0);
  GLDS_STAGE(1, 1);
  GLDS_STAGE(2, 2);
  const int aoff = lds_byte(wr * 128 + fr, fq * 8), boff = lds_byte(wc * 64 + fr, fq * 8);
  for (int t = 0; t < nk; ++t) {
    if (t + 2 < nk) WAIT_V(8); else if (t + 1 < nk) WAIT_V(4); else WAIT_V(0);
    __builtin_amdgcn_s_barrier();
    if (t + 3 < nk) GLDS_STAGE((t + 3) & 3, t + 3);
    const char* sa = SA(t & 3) + aoff;
    const char* sb = SB(t & 3) + boff;
    f16x8 Bf[4];
#pragma unroll
    for (int n = 0; n < 4; ++n) Bf[n] = *(const f16x8*)(sb + n * 1024);
    f16x8 A0 = *(const f16x8*)(sa), A1 = *(const f16x8*)(sa + 1024);
#pragma unroll
    for (int g = 0; g < 4; ++g) {
      f16x8 N0 = A0, N1 = A1;
      if (g < 3) { N0 = *(const f16x8*)(sa + (2 * g + 2) * 1024); N1 = *(const f16x8*)(sa + (2 * g + 3) * 1024); }
      __builtin_amdgcn_sched_barrier(0);
#pragma unroll
      for (int n = 0; n < 4; ++n) acc[2 * g][n] = __builtin_amdgcn_mfma_f32_16x16x32_f16(A0, Bf[n], acc[2 * g][n], 0, 0, 0);
#pragma unroll
      for (int n = 0; n < 4; ++n) acc[2 * g + 1][n] = __builtin_amdgcn_mfma_f32_16x16x32_f16(A1, Bf[n], acc[2 * g + 1][n], 0, 0, 0);
      __builtin_amdgcn_sched_barrier(0);
      A0 = N0; A1 = N1;
    }
    WAIT_L(0);
  }
  RAW_SYNC();
#undef SA
#undef SB
#undef GLDS_STAGE
}

__device__ __forceinline__ void epi_store_f16(const f32x4 (&acc)[8][4], char* shm) {
  const int tid = opaque_tid(), wid = tid >> 6, lane = tid & 63, wr = wid >> 2, wc = wid & 3, fr = lane & 15, fq = lane >> 4;
#pragma unroll
  for (int m = 0; m < 8; ++m)
#pragma unroll
    for (int n = 0; n < 4; ++n) {
      f16x4 v;
      v[0] = (f16)acc[m][n][0]; v[1] = (f16)acc[m][n][1]; v[2] = (f16)acc[m][n][2]; v[3] = (f16)acc[m][n][3];
      *(f16x4*)(shm + (wc * 64 + n * 16 + fr) * EPI_LD + (wr * 128 + m * 16 + fq * 4) * 2) = v;
    }
}

__device__ __forceinline__ void p_ln_in(const Params& p) {
  f16* h16 = (f16*)(p.ws + OFF_A);
  const int tid = opaque_tid(), lane = tid & 63, wid = tid >> 6;
  const int nw = gridDim.x * 8;
  for (int t = blockIdx.x * 8 + wid; t < T_TOK; t += nw) {
    const float* xr = p.x + (size_t)t * DM;
    float4 v[4];
#pragma unroll
    for (int i = 0; i < 4; ++i) v[i] = *(const float4*)(xr + i * 256 + lane * 4);
    float s = 0.f;
#pragma unroll
    for (int i = 0; i < 4; ++i) s += v[i].x + v[i].y + v[i].z + v[i].w;
    float mu = wave_sum(s) * (1.0f / DM);
    float q = 0.f;
#pragma unroll
    for (int i = 0; i < 4; ++i) {
      v[i].x -= mu; v[i].y -= mu; v[i].z -= mu; v[i].w -= mu;
      q += v[i].x * v[i].x + v[i].y * v[i].y + v[i].z * v[i].z + v[i].w * v[i].w;
    }
    float rs = rsqrtf(wave_sum(q) * (1.0f / DM) + 1e-5f);
#pragma unroll
    for (int i = 0; i < 4; ++i) {
      float4 g = *(const float4*)(p.ln_in_g + i * 256 + lane * 4), b = *(const float4*)(p.ln_in_b + i * 256 + lane * 4);
      f16x4 o;
      o[0] = (f16)(v[i].x * rs * g.x + b.x); o[1] = (f16)(v[i].y * rs * g.y + b.y);
      o[2] = (f16)(v[i].z * rs * g.z + b.z); o[3] = (f16)(v[i].w * rs * g.w + b.w);
      *(f16x4*)(h16 + (size_t)t * DM + i * 256 + lane * 4) = o;
    }
  }
}

template <class RowMap>
__device__ __forceinline__ void conv_tile(const float* __restrict__ src, int ld_src, int nvalid, int k0, int n0, f16* __restrict__ dst,
                                          int ld_dst, RowMap rm, float* sT) {
  const int tid = opaque_tid();
  {
    int k = tid >> 3, n = (tid & 7) * 8;
    const float* sp = src + (size_t)(k0 + k) * ld_src + n0 + n;
#pragma unroll
    for (int j = 0; j < 8; ++j) sT[k * 65 + n + j] = (n0 + n + j < nvalid) ? sp[j] : 0.f;
  }
  __syncthreads();
  {
    int n = tid >> 3, k = (tid & 7) * 8;
    f16x8 o;
#pragma unroll
    for (int j = 0; j < 8; ++j) o[j] = (f16)sT[(k + j) * 65 + n];
    int drow = rm(n0 + n);
    if (drow >= 0) *(f16x8*)(dst + (size_t)drow * ld_dst + k0 + k) = o;
  }
  __syncthreads();
}

struct RowId { __device__ int operator()(int n) const { return n; } };
struct RowGU { int up; __device__ int operator()(int ff) const {
  int tile = ff >> 7, wr = (ff >> 6) & 1, l = ff & 63; return tile * 256 + wr * 128 + up * 64 + l; } };

__device__ __forceinline__ void p_convert(const Params& p, char* shm) {
  float* sT = (float*)shm;
  char* ws = p.ws;
  const int J0 = 16 * 56, J1 = J0 + 16, J2 = J1 + 128, J3 = J2 + 128, J4 = J3 + 256, J5 = J4 + 32 * 64, J6 = J5 + 32 * 64,
            J7 = J6 + 32 * 64;
  for (int job = blockIdx.x; job < J7; job += gridDim.x) {
    if (job < J0) {
      int kt = job / 56, nt = job % 56;
      conv_tile(p.w_in, IN_W, IN_W, kt * 64, nt * 64, (f16*)(ws + OFF_WIN), 1024, RowId(), sT);
    } else if (job < J1) {
      int j = job - J0, g = j >> 2, kt = (j >> 1) & 1, nt = j & 1;
      conv_tile(p.pool_w + g * 128 * 128, 128, 128, kt * 64, nt * 64, (f16*)(ws + OFF_WPOOL) + g * 128 * 128, 128, RowId(), sT);
    } else if (job < J2) {
      int j = job - J1, kt = j >> 4, nt = j & 15;
      conv_tile(p.wpp, 1024, 1024, kt * 64, nt * 64, (f16*)(ws + OFF_WPP), 512, RowId(), sT);
    } else if (job < J3) {
      int j = job - J2, kt = j >> 4, nt = j & 15;
      conv_tile(p.wpa, 1024, 1024, kt * 64, nt * 64, (f16*)(ws + OFF_WPA), 512, RowId(), sT);
    } else if (job < J4) {
      int j = job - J3, kt = j >> 4, nt = j & 15;
      conv_tile(p.w_out, 1024, 1024, kt * 64, nt * 64, (f16*)(ws + OFF_WOUT), 1024, RowId(), sT);
    } else if (job < J6) {
      int up = job >= J5;
      int j = job - (up ? J5 : J4), e = j >> 6, kt = (j >> 2) & 15, nt = j & 3;
      RowGU rm; rm.up = up;
      conv_tile((up ? p.w_up : p.w_gate) + (size_t)e * 1024 * 256, 256, 256, kt * 64, nt * 64,
                (f16*)(ws + OFF_WGU) + (size_t)e * 512 * 1024, 1024, rm, sT);
    } else {
      int j = job - J6, e = j >> 6, kt = (j >> 4) & 3, nt = j & 15;
      conv_tile(p.w_down + (size_t)e * 256 * 1024, 1024, 1024, kt * 64, nt * 64, (f16*)(ws + OFF_WDN) + (size_t)e * 1024 * 256,
                256, RowId(), sT);
    }
  }
  {
    f16* whi = (f16*)(ws + OFF_WRT);
    f16* wlo = whi + 36 * 1024;
    for (int i = blockIdx.x * 512 + threadIdx.x; i < 36 * 1024; i += gridDim.x * 512) {
      int o = i >> 10, k = i & 1023;
      float w = (o < 4) ? p.w_group[k * 4 + o] : p.w_router[k * 32 + (o - 4)];
      f16 h = (f16)w;
      whi[i] = h;
      wlo[i] = (f16)(w - (float)h);
    }
  }
}

__device__ __forceinline__ void phase_skew(int us4) {
  const int k = (blockIdx.x >> 3) & 3;
  if (k) {
    const unsigned long long t0 = __builtin_amdgcn_s_memrealtime();
    const unsigned long long dt = (unsigned long long)(k * us4 * 25);
    while (__builtin_amdgcn_s_memrealtime() - t0 < dt) __builtin_amdgcn_s_sleep(8);
  }
}

__device__ __forceinline__ int xcd_item(int n_items, int r) {
  const int nx = 8, slots = gridDim.x >> 3;
  const int xcd = blockIdx.x & 7, slot = blockIdx.x >> 3;
  const int per = (n_items + nx - 1) / nx;
  const int local = slot + r * slots;
  if (local >= per) return -1;
  const int item = xcd * per + local;
  return (item < n_items) ? item : -2;
}

__device__ __forceinline__ void p_inproj(const Params& p, char* shm) {
  const f16* h16 = (const f16*)(p.ws + OFF_A);
  const f16* wT = (const f16*)(p.ws + OFF_WIN);
  f16* proj16 = (f16*)(p.ws + OFF_B);
  f16* gate16 = (f16*)(p.ws + OFF_C);
  const int tid = opaque_tid(), wid = tid >> 6, lane = tid & 63;
  int sR[NSTG], sC[NSTG];
#pragma unroll
  for (int i = 0; i < NSTG; ++i) stage_rc(wid * 1024 + i * 8192 + lane * 16, sR[i], sC[i]);
  const int NTILES = 128 * 14;
  if (SKEW_P1) phase_skew(SKEW_P1);
  for (int r = 0;; ++r) {
    int tile = xcd_item(NTILES, r);
    if (tile == -1) break;
    if (tile < 0) continue;
    int grp = tile / 56, rem = tile % 56;
    int ft = rem >> 2, tt = grp * 4 + (rem & 3);
    unsigned pa[NSTG], pb[NSTG];
#pragma unroll
    for (int i = 0; i < NSTG; ++i) {
      pa[i] = (unsigned)((ft * 256 + sR[i]) * 1024 + sC[i]);
      pb[i] = (unsigned)((tt * 256 + sR[i]) * 1024 + sC[i]);
    }
    f32x4 acc[8][4];
#pragma unroll
    for (int m = 0; m < 8; ++m)
#pragma unroll
      for (int n = 0; n < 4; ++n) acc[m][n] = (f32x4){0.f, 0.f, 0.f, 0.f};
    gemm_core(wT, pa, h16, pb, 16, acc, shm);
    epi_store_f16(acc, shm);
    RAW_SYNC();
    {
      int ch = tid & 31, r0 = tid >> 5;
      int f0 = ft * 256 + ch * 8;
      float bg[8];
      if (f0 >= PA_W && f0 < IN_W) {
#pragma unroll
        for (int j = 0; j < 8; ++j) bg[j] = p.b_gate[f0 - PA_W + j];
      } else {
#pragma unroll
        for (int j = 0; j < 8; ++j) bg[j] = 0.f;
      }
#pragma unroll 4
      for (int ps = 0; ps < 16; ++ps) {
        int r = ps * 16 + r0;
        f16x8 v = *(const f16x8*)(shm + r * EPI_LD + ch * 16);
        size_t tok = (size_t)tt * 256 + r;
        if (f0 < PA_W) {
          st_nt((f16x8*)(proj16 + tok * PJ_W + f0), v);
        } else if (f0 < IN_W) {
          f16x8 o;
#pragma unroll
          for (int j = 0; j < 8; ++j) o[j] = (f16)__builtin_amdgcn_rcpf(1.0f + __builtin_amdgcn_exp2f(-1.4426950408889634f * ((float)v[j] + bg[j])));
          st_nt((f16x8*)(gate16 + tok * 2048 + (f0 - PA_W)), o);
        }
      }
    }
    RAW_SYNC();
  }
}


__device__ __forceinline__ void zero_acc(f32x4 (&acc)[8][4]) {
#pragma unroll
  for (int m = 0; m < 8; ++m)
#pragma unroll
    for (int n = 0; n < 4; ++n) acc[m][n] = (f32x4){0.f, 0.f, 0.f, 0.f};
}

template <class RowPtr>
__device__ __forceinline__ void epi_rows_out(char* shm, RowPtr rp) {
  const int tid = opaque_tid(), ch = tid & 31, r0 = tid >> 5;
#pragma unroll 4
  for (int ps = 0; ps < 16; ++ps) {
    int r = ps * 16 + r0;
    f16x8 v = *(const f16x8*)(shm + r * EPI_LD + ch * 16);
    f16* d = rp(r);
    if (d) st_nt((f16x8*)(d + ch * 8), v);
  }
}

__device__ __forceinline__ void p_merge(const Params& p, char* shm) {
  const f16* pa16 = (const f16*)(p.ws + OFF_D);
  const f16* gate16 = (const f16*)(p.ws + OFF_C);
  const f16* wpp = (const f16*)(p.ws + OFF_WPP);
  const f16* wpa = (const f16*)(p.ws + OFF_WPA);
  f16* merged16 = (f16*)(p.ws + OFF_B);
  const int tid = opaque_tid(), wid = tid >> 6, lane = tid & 63;
  int sR[NSTG], sC[NSTG];
#pragma unroll
  for (int i = 0; i < NSTG; ++i) stage_rc(wid * 1024 + i * 8192 + lane * 16, sR[i], sC[i]);
  const int ch = tid & 31, r0 = tid >> 5;
  for (int r = 0;; ++r) {
    int tile = xcd_item(512, r);
    if (tile == -1) break;
    if (tile < 0) continue;
    int ft = tile & 3, tt = tile >> 2;
    unsigned pa[NSTG], pb[NSTG];
#pragma unroll
    for (int i = 0; i < NSTG; ++i) {
      pa[i] = (unsigned)((ft * 256 + sR[i]) * 512 + sC[i]);
      pb[i] = (unsigned)((tt * 256 + sR[i]) * 1024 + sC[i]);
    }
    f32x4 acc[8][4];
    zero_acc(acc);
    gemm_core(wpp, pa, pa16, pb, 8, acc, shm);
    epi_store_f16(acc, shm);
    RAW_SYNC();
#pragma unroll 4
    for (int ps = 0; ps < 16; ++ps) {
      const int rr = ps * 16 + r0;
      const size_t tok = (size_t)tt * 256 + rr;
      f16x8 v = *(const f16x8*)(shm + rr * EPI_LD + ch * 16);
      f16x8 g0 = *(const f16x8*)(gate16 + tok * 2048 + ft * 256 + ch * 8);
      f16x8 g1 = *(const f16x8*)(gate16 + tok * 2048 + 1024 + ft * 256 + ch * 8);
      f16x8 o;
#pragma unroll
      for (int e = 0; e < 8; ++e) {
        float rq = fminf((float)g0[e] * __builtin_amdgcn_rcpf(fmaxf((float)g1[e], 6e-5f)), 16384.f);
        o[e] = (f16)fminf(fmaxf((float)v[e] * rq, -60000.f), 60000.f);
      }
      *(f16x8*)(shm + rr * EPI_LD + ch * 16) = o;
    }
    RAW_SYNC();
    {
      const int wid_ = tid >> 6, lane_ = tid & 63, wr = wid_ >> 2, wc = wid_ & 3, fr = lane_ & 15, fq = lane_ >> 4;
#pragma unroll
      for (int m = 0; m < 8; ++m)
#pragma unroll
        for (int n = 0; n < 4; ++n) {
          f16x4 c = *(const f16x4*)(shm + (wc * 64 + n * 16 + fr) * EPI_LD + (wr * 128 + m * 16 + fq * 4) * 2);
          acc[m][n] = (f32x4){(float)c[0], (float)c[1], (float)c[2], (float)c[3]};
        }
    }
    RAW_SYNC();
    gemm_core(wpa, pa, pa16 + 512, pb, 8, acc, shm);
    epi_store_f16(acc, shm);
    RAW_SYNC();
#pragma unroll 4
    for (int ps = 0; ps < 16; ++ps) {
      const int rr = ps * 16 + r0;
      const size_t tok = (size_t)tt * 256 + rr;
      f16x8 v = *(const f16x8*)(shm + rr * EPI_LD + ch * 16);
      f16x8 g1 = *(const f16x8*)(gate16 + tok * 2048 + 1024 + ft * 256 + ch * 8);
      f16x8 o;
#pragma unroll
      for (int e = 0; e < 8; ++e) o[e] = (f16)((float)v[e] * (float)g1[e]);
      *(f16x8*)(merged16 + tok * 1024 + ft * 256 + ch * 8) = o;
    }
    RAW_SYNC();
  }
}

__device__ __forceinline__ void p_resid(const Params& p, char* shm) {
  const f16* merged16 = (const f16*)(p.ws + OFF_B);
  const f16* h16 = (const f16*)(p.ws + OFF_A);
  const f16* wo = (const f16*)(p.ws + OFF_WOUT);
  f16* z16 = (f16*)(p.ws + OFF_C);
  const int tid = opaque_tid(), wid = tid >> 6, lane = tid & 63;
  int sR[NSTG], sC[NSTG];
#pragma unroll
  for (int i = 0; i < NSTG; ++i) stage_rc(wid * 1024 + i * 8192 + lane * 16, sR[i], sC[i]);
  const int ch = tid & 31, r0 = tid >> 5;
  for (int r = 0;; ++r) {
    int tile = xcd_item(512, r);
    if (tile == -1) break;
    if (tile < 0) continue;
    int ft = tile & 3, tt = tile >> 2;
    unsigned pa[NSTG], pb[NSTG];
#pragma unroll
    for (int i = 0; i < NSTG; ++i) {
      pa[i] = (unsigned)((ft * 256 + sR[i]) * 1024 + sC[i]);
      pb[i] = (unsigned)((tt * 256 + sR[i]) * 1024 + sC[i]);
    }
    {
      f32x4 acc[8][4];
      zero_acc(acc);
      gemm_core(wo, pa, merged16, pb, 16, acc, shm);
      epi_store_f16(acc, shm);
    }
    RAW_SYNC();
#pragma unroll 4
    for (int ps = 0; ps < 16; ++ps) {
      const int rr = ps * 16 + r0;
      const size_t o = ((size_t)tt * 256 + rr) * 1024 + ft * 256 + ch * 8;
      f16x8 v = *(const f16x8*)(shm + rr * EPI_LD + ch * 16);
      f16x8 hv = *(const f16x8*)(h16 + o);
      f16x8 zz;
#pragma unroll
      for (int e = 0; e < 8; ++e) zz[e] = (f16)(ALPHA * (float)hv[e] + (float)v[e]);
      *(f16x8*)(z16 + o) = zz;
    }
    RAW_SYNC();
  }
}

#define HID_ROWS 73728
#define MOE_TAB (GEMM_LDS + 2048)
__device__ __forceinline__ void moe_tables(const int* counts, char* shm) {
  int* tab = (int*)(shm + MOE_TAB);
  if (threadIdx.x == 0) {
    int pf = 0, pn = 0, pr = 0;
    for (int e = 0; e < 32; ++e) {
      int n = counts[e * CNT_STRIDE];
      tab[e] = pf; tab[33 + e] = pn; tab[66 + e] = pr;
      pf += min(8, (n + 255) >> 8);
      pn += (max(n - 2048, 0) + 63) >> 6;
      pr += ((n + 255) >> 8) << 8;
    }
    tab[32] = pf; tab[65] = pn; tab[98] = pr;
  }
  __syncthreads();
}
__device__ __forceinline__ void moe_find(const int* pre, int item, int& e, int& mt) {
  e = 0;
  for (int i = 1; i < 32; ++i) if (item >= pre[i]) e = i;
  mt = item - pre[e];
}

#define NSLOT_B 20480
__device__ __forceinline__ void gemm_core_narrow(const f16* __restrict__ Ab, const unsigned (&pa)[NSTG], const f16* __restrict__ Bb,
                                                 unsigned pb, int nt, const int (&ablk)[2], f32x4 (&acc)[2][4], char* shm) {
  const int tid = opaque_tid(), wid = tid >> 6, lane = tid & 63, fr = lane & 15, fq = lane >> 4;
  const int nk = nt * 2;
  const bool hasb = (wid < 4);
#define SA(s_) (shm + (s_) * NSLOT_B)
#define SB(s_) (shm + (s_) * NSLOT_B + TILE_B)
#define NSTAGE(slot, kt)                                                                                                  \
  do {                                                                                                                    \
    _Pragma("unroll") for (int i = 0; i < NSTG; ++i)                                                                     \
      __builtin_amdgcn_global_load_lds((const unsigned*)(Ab + pa[i] + (kt) * 32), (unsigned*)(SA(slot) + wid * 1024 + i * 8192), \
                                       16, 0, 0);                                                                         \
    if (hasb) __builtin_amdgcn_global_load_lds((const unsigned*)(Bb + pb + (kt) * 32), (unsigned*)(SB(slot) + wid * 1024), 16, 0, 0); \
  } while (0)
  NSTAGE(0, 0);
  NSTAGE(1, 1);
  NSTAGE(2, 2);
  const int a0 = lds_byte(ablk[0] * 16 + fr, fq * 8), a1 = lds_byte(ablk[1] * 16 + fr, fq * 8), boff = lds_byte(fr, fq * 8);
  for (int t = 0; t < nk; ++t) {
    if (hasb) { if (t + 2 < nk) WAIT_V(6); else if (t + 1 < nk) WAIT_V(3); else WAIT_V(0); }
    else      { if (t + 2 < nk) WAIT_V(4); else if (t + 1 < nk) WAIT_V(2); else WAIT_V(0); }
    __builtin_amdgcn_s_barrier();
    if (t + 3 < nk) NSTAGE((t + 3) & 3, t + 3);
    const char* sa = SA(t & 3);
    const char* sb = SB(t & 3) + boff;
    f16x8 A0 = *(const f16x8*)(sa + a0), A1 = *(const f16x8*)(sa + a1), Bf[4];
#pragma unroll
    for (int n = 0; n < 4; ++n) Bf[n] = *(const f16x8*)(sb + n * 1024);
#pragma unroll
    for (int n = 0; n < 4; ++n) acc[0][n] = __builtin_amdgcn_mfma_f32_16x16x32_f16(A0, Bf[n], acc[0][n], 0, 0, 0);
#pragma unroll
    for (int n = 0; n < 4; ++n) acc[1][n] = __builtin_amdgcn_mfma_f32_16x16x32_f16(A1, Bf[n], acc[1][n], 0, 0, 0);
    WAIT_L(0);
  }
  RAW_SYNC();
#undef SA
#undef SB
#undef NSTAGE
}

__device__ __forceinline__ void p_moe_a(const Params& p, char* shm) {
  const f16* h1 = (const f16*)(p.ws + OFF_A);
  const f16* wgu = (const f16*)(p.ws + OFF_WGU);
  const int* counts = (const int*)(p.ws + OFF_CNT);
  const int* lists = (const int*)(p.ws + OFF_LISTS);
  f16* hid16 = (f16*)(p.ws + OFF_B);
  const int* tab = (const int*)(shm + MOE_TAB);
  const int tid = opaque_tid(), wid = tid >> 6, lane = tid & 63, wr = wid >> 2, wc = wid & 3, fr = lane & 15, fq = lane >> 4;
  int sR[NSTG], sC[NSTG];
#pragma unroll
  for (int i = 0; i < NSTG; ++i) stage_rc(wid * 1024 + i * 8192 + lane * 16, sR[i], sC[i]);
  moe_tables(counts, shm);
  const int total = tab[32] * 2;
  for (int r = 0;; ++r) {
    int item = xcd_item(total, r);
    if (item == -1) break;
    if (item < 0) continue;
    int e, mt;
    moe_find(tab, item >> 1, e, mt);
    const int fh = item & 1;
    const int cnt_e = counts[e * CNT_STRIDE];
    const int rowbase = tab[66 + e];
    unsigned pa[NSTG], pb[NSTG];
    f32x4 acc[8][4];
    zero_acc(acc);
#pragma unroll
    for (int i = 0; i < NSTG; ++i) {
      pa[i] = (unsigned)((e * 512 + fh * 256 + sR[i]) * 1024 + sC[i]);
      int idx = mt * 256 + sR[i];
      int tok = (idx < cnt_e) ? (lists[(size_t)e * T_TOK + idx] >> 1) : 0;
      pb[i] = (unsigned)(tok * 1024 + sC[i]);
    }
    gemm_core(wgu, pa, h1, pb, 16, acc, shm);
#pragma unroll
    for (int m = 0; m < 4; ++m)
#pragma unroll
      for (int n = 0; n < 4; ++n) {
        f16x4 o;
#pragma unroll
        for (int j = 0; j < 4; ++j) {
          float g = acc[m][n][j], u = acc[m + 4][n][j];
          o[j] = (f16)(g * u * __builtin_amdgcn_rcpf(1.0f + __builtin_amdgcn_exp2f(-1.4426950408889634f * g)));
        }
        size_t row = (size_t)rowbase + mt * 256 + wc * 64 + n * 16 + fr;
        *(f16x4*)(hid16 + row * 256 + fh * 128 + wr * 64 + m * 16 + fq * 4) = o;
      }
  }
  const int totaln = tab[65] * 2;
  for (int r = 0;; ++r) {
    int item = xcd_item(totaln, r);
    if (item == -1) break;
    if (item < 0) continue;
    int e, ntile;
    moe_find(tab + 33, item >> 1, e, ntile);
    const int fh = item & 1;
    const int cnt_e = counts[e * CNT_STRIDE];
    const int rowbase = tab[66 + e];
    const int wrn = wid >> 2, lq = wid & 3;
    const int ablk[2] = {wrn * 8 + lq, wrn * 8 + 4 + lq};
    unsigned pa[NSTG], pb = 0;
#pragma unroll
    for (int i = 0; i < NSTG; ++i) pa[i] = (unsigned)((e * 512 + fh * 256 + sR[i]) * 1024 + sC[i]);
    {
      int idx = 2048 + ntile * 64 + (sR[0] & 63);
      int tok = (idx < cnt_e) ? (lists[(size_t)e * T_TOK + idx] >> 1) : 0;
      pb = (unsigned)(tok * 1024 + sC[0]);
    }
    f32x4 acc[2][4];
#pragma unroll
    for (int m = 0; m < 2; ++m)
#pragma unroll
      for (int n = 0; n < 4; ++n) acc[m][n] = (f32x4){0.f, 0.f, 0.f, 0.f};
    gemm_core_narrow(wgu, pa, h1, pb, 16, ablk, acc, shm);
#pragma unroll
    for (int n = 0; n < 4; ++n) {
      f16x4 o;
#pragma unroll
      for (int j = 0; j < 4; ++j) {
        float g = acc[0][n][j], u = acc[1][n][j];
        o[j] = (f16)(g * u * __builtin_amdgcn_rcpf(1.0f + __builtin_amdgcn_exp2f(-1.4426950408889634f * g)));
      }
      size_t row = (size_t)rowbase + 2048 + ntile * 64 + n * 16 + fr;
      *(f16x4*)(hid16 + row * 256 + fh * 128 + wrn * 64 + lq * 16 + fq * 4) = o;
    }
  }
}

__device__ __forceinline__ void p_moe_b(const Params& p, char* shm) {
  const f16* wdn = (const f16*)(p.ws + OFF_WDN);
  const f16* hid16 = (const f16*)(p.ws + OFF_B);
  const float* route_w = (const float*)(p.ws + OFF_ROUTE_W);
  const int* counts = (const int*)(p.ws + OFF_CNT);
  const int* lists = (const int*)(p.ws + OFF_LISTS);
  f16* y16 = (f16*)(p.ws + OFF_C);
  int* sent = (int*)(shm + 256 * EPI_LD);
  const int* tab = (const int*)(shm + MOE_TAB);
  const int tid = opaque_tid(), wid = tid >> 6, lane = tid & 63, wc = wid & 3, fr = lane & 15, fq = lane >> 4;
  int sR[NSTG], sC[NSTG];
#pragma unroll
  for (int i = 0; i < NSTG; ++i) stage_rc(wid * 1024 + i * 8192 + lane * 16, sR[i], sC[i]);
  moe_tables(counts, shm);
  const int total = tab[32] * 4;
  for (int r = 0;; ++r) {
    int item = xcd_item(total, r);
    if (item == -1) break;
    if (item < 0) continue;
    int e, mt;
    moe_find(tab, item >> 2, e, mt);
    const int ft = item & 3;
    const int cnt_e = counts[e * CNT_STRIDE];
    const int rowbase = tab[66 + e];
    if (tid < 256) {
      int idx = mt * 256 + tid;
      sent[tid] = (idx < cnt_e) ? lists[(size_t)e * T_TOK + idx] : -1;
    }
    unsigned pa[NSTG], pb[NSTG];
    f32x4 acc[8][4];
    zero_acc(acc);
#pragma unroll
    for (int i = 0; i < NSTG; ++i) {
      pa[i] = (unsigned)((e * 1024 + ft * 256 + sR[i]) * 256 + sC[i]);
      pb[i] = (unsigned)((rowbase + mt * 256 + sR[i]) * 256 + sC[i]);
    }
    gemm_core(wdn, pa, hid16, pb, 4, acc, shm);
#pragma unroll
    for (int n = 0; n < 4; ++n) {
      int en = sent[wc * 64 + n * 16 + fr];
      float rw = (en >= 0) ? route_w[en] : 0.f;
#pragma unroll
      for (int m = 0; m < 8; ++m)
#pragma unroll
        for (int j = 0; j < 4; ++j) acc[m][n][j] *= rw;
    }
    epi_store_f16(acc, shm);
    RAW_SYNC();
    epi_rows_out(shm, [&](int rr) -> f16* { int en = sent[rr]; return (en >= 0) ? (y16 + (size_t)en * 1024 + ft * 256) : (f16*)nullptr; });
    RAW_SYNC();
  }
  const int totaln = tab[65] * 4;
  for (int r = 0;; ++r) {
    int item = xcd_item(totaln, r);
    if (item == -1) break;
    if (item < 0) continue;
    int e, ntile;
    moe_find(tab + 33, item >> 2, e, ntile);
    const int ft = item & 3;
    const int cnt_e = counts[e * CNT_STRIDE];
    const int rowbase = tab[66 + e];
    if (tid < 64) {
      int idx = 2048 + ntile * 64 + tid;
      sent[tid] = (idx < cnt_e) ? lists[(size_t)e * T_TOK + idx] : -1;
    }
    const int ablk[2] = {wid * 2, wid * 2 + 1};
    unsigned pa[NSTG], pb;
#pragma unroll
    for (int i = 0; i < NSTG; ++i) pa[i] = (unsigned)((e * 1024 + ft * 256 + sR[i]) * 256 + sC[i]);
    pb = (unsigned)((rowbase + 2048 + ntile * 64 + (sR[0] & 63)) * 256 + sC[0]);
    f32x4 acc[2][4];
#pragma unroll
    for (int m = 0; m < 2; ++m)
#pragma unroll
      for (int n = 0; n < 4; ++n) acc[m][n] = (f32x4){0.f, 0.f, 0.f, 0.f};
    gemm_core_narrow(wdn, pa, hid16, pb, 4, ablk, acc, shm);
#pragma unroll
    for (int n = 0; n < 4; ++n) {
      int en = sent[n * 16 + fr];
      float rw = (en >= 0) ? route_w[en] : 0.f;
#pragma unroll
      for (int m = 0; m < 2; ++m) {
        f16x4 v;
#pragma unroll
        for (int j = 0; j < 4; ++j) v[j] = (f16)(acc[m][n][j] * rw);
        *(f16x4*)(shm + (n * 16 + fr) * EPI_LD + (wid * 32 + m * 16 + fq * 4) * 2) = v;
      }
    }
    RAW_SYNC();
    {
      const int ch = tid & 31, r0 = tid >> 5;
#pragma unroll
      for (int ps = 0; ps < 4; ++ps) {
        int rr = ps * 16 + r0;
        f16x8 v = *(const f16x8*)(shm + rr * EPI_LD + ch * 16);
        int en = sent[rr];
        if (en >= 0) *(f16x8*)(y16 + (size_t)en * 1024 + ft * 256 + ch * 8) = v;
      }
    }
    RAW_SYNC();
  }
}

__device__ __forceinline__ unsigned f2key_(float f) {
  if (f == 0.f) f = 0.f;
  unsigned u = __float_as_uint(f);
  return (u & 0x80000000u) ? ~u : (u | 0x80000000u);
}
__device__ __forceinline__ float key2f_(unsigned k) {
  return __uint_as_float((k & 0x80000000u) ? (k & 0x7fffffffu) : ~k);
}
__device__ __forceinline__ void find_bin(const unsigned* hrow, int need, int lane, int* out_bin, int* out_above) {
  uint4 c = *(const uint4*)(hrow + 4 * lane);
  int tot = (int)(c.x + c.y + c.z + c.w);
  int incl = tot;
#pragma unroll
  for (int o = 1; o < 64; o <<= 1) {
    int v = __shfl_down(incl, o, 64);
    if (lane + o < 64) incl += v;
  }
  int above = incl - tot;
  if (above < need && incl >= need) {
    int b;
    if (above + (int)c.w >= need) b = 3;
    else { above += c.w; if (above + (int)c.z >= need) b = 2;
      else { above += c.z; if (above + (int)c.y >= need) b = 1; else { above += c.y; b = 0; } } }
    *out_bin = 4 * lane + b;
    *out_above = above;
  }
}

typedef short s16x4 __attribute__((ext_vector_type(4)));
#define VROW 160
#define ATT_WAVE_LDS (64 * VROW + 512)
__device__ __forceinline__ f16x8 tr_pair(const char* a, const char* b) {
  s16x4 x = __builtin_amdgcn_ds_read_tr16_b64_v4i16((__attribute__((address_space(3))) s16x4*)(a));
  s16x4 y = __builtin_amdgcn_ds_read_tr16_b64_v4i16((__attribute__((address_space(3))) s16x4*)(b));
  typedef short s16x8 __attribute__((ext_vector_type(8)));
  s16x8 r = __builtin_shufflevector(x, y, 0, 1, 2, 3, 4, 5, 6, 7);
  return __builtin_bit_cast(f16x8, r);
}
__device__ __forceinline__ void attn_one(const f16* __restrict__ proj16, f16* __restrict__ pa16, int t, const unsigned short* ssel,
                                         char* vimg, int lane) {
  const int fr = lane & 15, fq = lane >> 4;
  const int l = t & (SEQ - 1), b0 = t - l, cnt = min(l + 1, 256);
  f16x8 bq0, bq1;
  {
    const f16* qp = proj16 + (size_t)t * PJ_W + C_Q + (fr & 7) * 64 + fq * 8;
    bq0 = *(const f16x8*)qp;
    bq1 = *(const f16x8*)(qp + 32);
#pragma unroll
    for (int e = 0; e < 8; ++e) { bq0[e] = (fr < 8) ? bq0[e] * (f16)0.125f : (f16)0.f; bq1[e] = (fr < 8) ? bq1[e] * (f16)0.125f : (f16)0.f; }
  }
  const char* kbase = (const char*)(proj16 + (size_t)b0 * PJ_W + C_K);
  const char* vbase = (const char*)(proj16 + (size_t)b0 * PJ_W + C_V);
  f32x4 S[16];
#pragma unroll
  for (int kt = 0; kt < 16; ++kt) {
    const unsigned ko = (unsigned)ssel[kt * 16 + fr] * (PJ_W * 2) + fq * 16;
    f16x8 a0 = *(const f16x8*)(kbase + ko), a1 = *(const f16x8*)(kbase + ko + 64);
    f32x4 z = {0.f, 0.f, 0.f, 0.f};
    z = __builtin_amdgcn_mfma_f32_16x16x32_f16(a0, bq0, z, 0, 0, 0);
    z = __builtin_amdgcn_mfma_f32_16x16x32_f16(a1, bq1, z, 0, 0, 0);
#pragma unroll
    for (int j = 0; j < 4; ++j) S[kt][j] = (kt * 16 + fq * 4 + j < cnt) ? z[j] : NEG_BIG;
  }
  f16x8 vv[8];
#pragma unroll
  for (int i = 0; i < 8; ++i) {
    const unsigned vo = (unsigned)ssel[(lane >> 3) + 8 * i] * (PJ_W * 2) + (lane & 7) * 16;
    vv[i] = *(const f16x8*)(vbase + vo);
  }
  float m = NEG_BIG;
#pragma unroll
  for (int kt = 0; kt < 16; ++kt)
#pragma unroll
    for (int j = 0; j < 4; ++j) m = fmaxf(m, S[kt][j]);
  m = fmaxf(m, __shfl_xor(m, 16, 64));
  m = fmaxf(m, __shfl_xor(m, 32, 64));
  float lsum = 0.f;
  f16x8 P[8];
#pragma unroll
  for (int c = 0; c < 8; ++c)
#pragma unroll
    for (int j = 0; j < 4; ++j) {
      float e0 = __expf(S[2 * c][j] - m), e1 = __expf(S[2 * c + 1][j] - m);
      lsum += e0 + e1;
      P[c][j] = (f16)e0;
      P[c][4 + j] = (f16)e1;
    }
  lsum += __shfl_xor(lsum, 16, 64);
  lsum += __shfl_xor(lsum, 32, 64);
  f32x4 O[4];
#pragma unroll
  for (int nt = 0; nt < 4; ++nt) O[nt] = (f32x4){0.f, 0.f, 0.f, 0.f};
#pragma unroll
  for (int rr = 0; rr < 4; ++rr) {
    asm volatile("s_waitcnt lgkmcnt(0)" ::: "memory");
#pragma unroll
    for (int i = 0; i < 8; ++i) *(f16x8*)(vimg + ((lane >> 3) + 8 * i) * VROW + (lane & 7) * 16) = vv[i];
    if (rr < 3) {
#pragma unroll
      for (int i = 0; i < 8; ++i) {
        const unsigned vo = (unsigned)ssel[(rr + 1) * 64 + (lane >> 3) + 8 * i] * (PJ_W * 2) + (lane & 7) * 16;
        vv[i] = *(const f16x8*)(vbase + vo);
      }
    }
    asm volatile("s_waitcnt lgkmcnt(0)" ::: "memory");
#pragma unroll
    for (int cc = 0; cc < 2; ++cc) {
      const char* ra = vimg + (cc * 32 + fq * 4 + (fr >> 2)) * VROW + (fr & 3) * 8;
#pragma unroll
      for (int nt = 0; nt < 4; ++nt) {
        f16x8 B = tr_pair(ra + nt * 32, ra + 16 * VROW + nt * 32);
        O[nt] = __builtin_amdgcn_mfma_f32_16x16x32_f16(P[rr * 2 + cc], B, O[nt], 0, 0, 0);
      }
    }
  }
  asm volatile("s_waitcnt lgkmcnt(0)" ::: "memory");
#pragma unroll
  for (int j = 0; j < 4; ++j) {
    float ls = __shfl(lsum, (fq & 1) * 4 + j, 64);
    float inv = 1.0f / ls;
    if (fq < 2) {
      f16* op = pa16 + (size_t)t * DM + 512 + (fq * 4 + j) * 64 + fr;
#pragma unroll
      for (int nt = 0; nt < 4; ++nt) op[nt * 16] = (f16)(O[nt][j] * inv);
    }
  }
}

__device__ __forceinline__ f32x4 score_tile(const f16x8& a, const f16x8 (&bq)[8], const f16x8& bc_hi, const f16x8& bc_lo,
                                            const float (&wq)[8]) {
  f32x4 L[8];
#pragma unroll
  for (int h = 0; h < 8; ++h) L[h] = __builtin_amdgcn_mfma_f32_16x16x32_f16(a, bq[h], (f32x4){0.f, 0.f, 0.f, 0.f}, 0, 0, 0);
  f32x4 s = __builtin_amdgcn_mfma_f32_16x16x32_f16(a, bc_lo, (f32x4){0.f, 0.f, 0.f, 0.f}, 0, 0, 0);
  s = __builtin_amdgcn_mfma_f32_16x16x32_f16(a, bc_hi, s, 0, 0, 0);
  __builtin_amdgcn_sched_barrier(0);
#pragma unroll
  for (int h = 0; h < 8; ++h)
#pragma unroll
    for (int jj = 0; jj < 4; ++jj) s[jj] = __builtin_fmaf(wq[h], __builtin_fabsf(L[h][jj]), s[jj]);
  return s;
}

#define IDX_KEYS 0
#define IDX_HIST 131072
#define IDX_SSEL (IDX_HIST + 16384)
#define IDX_CAND (IDX_SSEL + 8192)
#define IDX_MISC (IDX_CAND + 2048)
template <int V>
__device__ __forceinline__ void p_index(const Params& p, char* shm) {
  const f16* proj16 = (const f16*)(p.ws + OFF_B);
  f16* pa16 = (V == 0) ? (f16*)(p.ws + OFF_D) : (f16*)p.out;
  unsigned short* keys16 = (unsigned short*)(shm + IDX_KEYS);
  unsigned* hist = (unsigned*)(shm + IDX_HIST);
  unsigned short* ssel = (unsigned short*)(shm + IDX_SSEL);
  unsigned short* scand = (unsigned short*)(shm + IDX_CAND);
  unsigned* smm = (unsigned*)(shm + IDX_MISC);
  int* sbin = (int*)(smm + 32);
  const int tid = opaque_tid(), wid = tid >> 6, lane0 = tid & 63;
  const float NINF = -__builtin_huge_valf(), PINF = __builtin_huge_valf();
  for (int rnd = 0;; ++rnd) {
    int idx = rnd * gridDim.x + ((rnd & 1) ? (gridDim.x - 1 - blockIdx.x) : blockIdx.x);
    if (idx >= 2048) break;
    int lane = lane0;
    asm volatile("" : "+v"(lane));
    const int fr = lane & 15, fq = lane >> 4;
    const unsigned long long lt_mask = (1ull << lane) - 1ull;
    const int b = idx & 7, j = 255 - (idx >> 3);
    const int l0 = j * 16, t0 = b * SEQ + l0;
    if (j < 16) {
#pragma unroll 1
      for (int qq = 0; qq < 2; ++qq) {
        const int q = 2 * wid + qq, lq = l0 + q;
        unsigned short* sl = ssel + q * 256;
        for (int i = lane; i < 256; i += 64) sl[i] = (unsigned short)((i <= lq) ? i : 0);
        asm volatile("s_waitcnt lgkmcnt(0)" ::: "memory");
        attn_one(proj16, pa16, t0 + q, sl, (char*)(keys16 + q * 4096), lane);
      }
      __syncthreads();
      continue;
    }
    for (int i = tid; i < 4096; i += 512) hist[i] = 0;
    if (tid < 16) { smm[tid] = 0xFFFFFFFFu; smm[16 + tid] = 0u; }
    f16x8 bq[8];
    float wq[8];
    {
      const f16* qrow = proj16 + (size_t)(t0 + fr) * PJ_W;
#pragma unroll
      for (int h = 0; h < 8; ++h) bq[h] = *(const f16x8*)(qrow + C_IQ + h * 32 + fq * 8);
      f16x8 wv = *(const f16x8*)(qrow + C_IW);
#pragma unroll
      for (int h = 0; h < 8; ++h) wq[h] = (float)wv[h];
    }
    f16x8 bc_hi, bc_lo;
#pragma unroll
    for (int e = 0; e < 8; ++e) {
      float c = 0.f;
#pragma unroll
      for (int h = 0; h < 8; ++h) c = __builtin_fmaf(wq[h], (float)bq[h][e], c);
      f16 ch_ = (f16)c;
      bc_hi[e] = ch_;
      bc_lo[e] = (f16)(c - (float)ch_);
    }
    __syncthreads();
    const int wids = __builtin_amdgcn_readfirstlane(wid);
    const int klast = (j - 1) - ((j - 1 - wids) & 7);
    const f16* kbase = proj16 + (size_t)(b * SEQ + fr) * PJ_W + C_IK + fq * 8;
#define IK_LOAD(dst, kt0)                                                                   \
  _Pragma("unroll") for (int u = 0; u < 4; ++u) {                                           \
    int ktc = min((kt0) + 8 * u, klast);                                                    \
    dst[u] = *(const f16x8*)(kbase + (size_t)(ktc * 16) * PJ_W);                            \
  }
    {
      float mn = PINF, mx = NINF;
      f16x8 a[4];
      IK_LOAD(a, wids);
      const int astep = (j >= 32) ? 128 : 32;
      for (int kt0 = wids; kt0 < j; kt0 += astep) {
        f16x8 an[4];
        IK_LOAD(an, kt0 + astep);
#pragma unroll
        for (int u = 0; u < 4; ++u) {
          if (kt0 + 8 * u < j) {
            f32x4 sc = score_tile(a[u], bq, bc_hi, bc_lo, wq);
            mn = fminf(fminf(mn, sc[0]), fminf(fminf(sc[1], sc[2]), sc[3]));
            mx = fmaxf(fmaxf(mx, sc[0]), fmaxf(fmaxf(sc[1], sc[2]), sc[3]));
          }
        }
#pragma unroll
        for (int u = 0; u < 4; ++u) a[u] = an[u];
      }
      if ((j & 7) == wids) {
        f16x8 ad = *(const f16x8*)(kbase + (size_t)(j * 16) * PJ_W);
        f32x4 sc = score_tile(ad, bq, bc_hi, bc_lo, wq);
#pragma unroll
        for (int jj = 0; jj < 4; ++jj) {
          bool ok = (fq * 4 + jj <= fr);
          mn = fminf(mn, ok ? sc[jj] : PINF);
          mx = fmaxf(mx, ok ? sc[jj] : NINF);
        }
      }
      mn = fminf(mn, __shfl_xor(mn, 16, 64)); mn = fminf(mn, __shfl_xor(mn, 32, 64));
      mx = fmaxf(mx, __shfl_xor(mx, 16, 64)); mx = fmaxf(mx, __shfl_xor(mx, 32, 64));
      if (fq == 0) {
        if (mn != PINF) atomicMin(&smm[fr], f2key_(mn));
        if (mx != NINF) atomicMax(&smm[16 + fr], f2key_(mx));
      }
    }
    __syncthreads();
    {
      float lo = key2f_(smm[fr]), hi = key2f_(smm[16 + fr]);
      if (j >= 32) { const float mg = 0.125f * (hi - lo); lo -= mg; hi += mg; }
      const float s16 = (hi > lo) ? 65536.0f / (hi - lo) : 0.f;
      const float nlo = -lo * s16;
      unsigned* hq = hist + fr * 256;
      unsigned short* kq = keys16 + fr * 4096 + fq * 4;
      f16x8 a[4];
      IK_LOAD(a, wids);
      for (int kt0 = wids; kt0 < j; kt0 += 32) {
        f16x8 an[4];
        IK_LOAD(an, kt0 + 32);
#pragma unroll
        for (int u = 0; u < 4; ++u) {
          const int kt = kt0 + 8 * u;
          if (kt < j) {
            f32x4 sc = score_tile(a[u], bq, bc_hi, bc_lo, wq);
            unsigned kk[4];
#pragma unroll
            for (int jj = 0; jj < 4; ++jj) {
              int k16 = min(max((int)__builtin_fmaf(sc[jj], s16, nlo), 0), 65535);
              kk[jj] = (unsigned)k16;
              atomicAdd(&hq[k16 >> 8], 1u);
            }
            uint2 pk;
            pk.x = kk[0] | (kk[1] << 16);
            pk.y = kk[2] | (kk[3] << 16);
            *(uint2*)(kq + kt * 16) = pk;
          }
        }
#pragma unroll
        for (int u = 0; u < 4; ++u) a[u] = an[u];
      }
      if ((j & 7) == wids) {
        f16x8 ad = *(const f16x8*)(kbase + (size_t)(j * 16) * PJ_W);
        f32x4 sc = score_tile(ad, bq, bc_hi, bc_lo, wq);
        unsigned kk[4];
#pragma unroll
        for (int jj = 0; jj < 4; ++jj) {
          int k16 = min(max((int)__builtin_fmaf(sc[jj], s16, nlo), 0), 65535);
          kk[jj] = (unsigned)k16;
          if (fq * 4 + jj <= fr) atomicAdd(&hq[k16 >> 8], 1u);
        }
        uint2 pk;
        pk.x = kk[0] | (kk[1] << 16);
        pk.y = kk[2] | (kk[3] << 16);
        *(uint2*)(kq + j * 16) = pk;
      }
    }
#undef IK_LOAD
    __syncthreads();
    if (V == 2) continue;
    {
      const int q0 = 2 * wid, lq0 = l0 + q0;
      const int nmax = lq0 + 2;
      unsigned* hrow0 = hist + q0 * 256;
      const unsigned short* krow0 = keys16 + q0 * 4096;
      if (lane < 4) sbin[2 * q0 + lane] = 0;
      find_bin(hrow0, 256, lane, &sbin[2 * q0], &sbin[2 * q0 + 1]);
      find_bin(hrow0 + 256, 256, lane, &sbin[2 * q0 + 2], &sbin[2 * q0 + 3]);
      asm volatile("s_waitcnt lgkmcnt(0)" ::: "memory");
      const int b1s0 = sbin[2 * q0], ab0 = sbin[2 * q0 + 1], b1s1 = sbin[2 * q0 + 2], ab1 = sbin[2 * q0 + 3];
      asm volatile("s_waitcnt lgkmcnt(0)" ::: "memory");
      *(uint4*)(hrow0 + 4 * lane) = make_uint4(0u, 0u, 0u, 0u);
      *(uint4*)(hrow0 + 256 + 4 * lane) = make_uint4(0u, 0u, 0u, 0u);
      if (lane < 4) sbin[2 * q0 + lane] = 0;
      asm volatile("s_waitcnt lgkmcnt(0)" ::: "memory");
      for (int s4 = lane * 4; s4 < nmax; s4 += 256) {
        uint2 pa_ = *(const uint2*)(krow0 + s4), pb_ = *(const uint2*)(krow0 + 4096 + s4);
        unsigned ka[4] = {pa_.x & 0xffffu, pa_.x >> 16, pa_.y & 0xffffu, pa_.y >> 16};
        unsigned kb[4] = {pb_.x & 0xffffu, pb_.x >> 16, pb_.y & 0xffffu, pb_.y >> 16};
#pragma unroll
        for (int jj = 0; jj < 4; ++jj) {
          if (s4 + jj <= lq0 && (int)(ka[jj] >> 8) == b1s0) atomicAdd(&hrow0[ka[jj] & 255u], 1u);
          if (s4 + jj <= lq0 + 1 && (int)(kb[jj] >> 8) == b1s1) atomicAdd(&hrow0[256 + (kb[jj] & 255u)], 1u);
        }
      }
      asm volatile("s_waitcnt lgkmcnt(0)" ::: "memory");
      find_bin(hrow0, 256 - ab0, lane, &sbin[2 * q0], &sbin[2 * q0 + 1]);
      find_bin(hrow0 + 256, 256 - ab1, lane, &sbin[2 * q0 + 2], &sbin[2 * q0 + 3]);
      asm volatile("s_waitcnt lgkmcnt(0)" ::: "memory");
      const unsigned thr0 = (unsigned)((b1s0 << 8) | sbin[2 * q0]), thr1 = (unsigned)((b1s1 << 8) | sbin[2 * q0 + 2]);
      int base0 = 0, cb0 = 0, base1 = 0, cb1 = 0;
      for (int s0 = 0; s0 < nmax; s0 += 256) {
        const int s4 = s0 + lane * 4;
        uint2 pa_ = make_uint2(0u, 0u), pb_ = make_uint2(0u, 0u);
        if (s4 < nmax) { pa_ = *(const uint2*)(krow0 + s4); pb_ = *(const uint2*)(krow0 + 4096 + s4); }
        unsigned ka[4] = {pa_.x & 0xffffu, pa_.x >> 16, pa_.y & 0xffffu, pa_.y >> 16};
        unsigned kb[4] = {pb_.x & 0xffffu, pb_.x >> 16, pb_.y & 0xffffu, pb_.y >> 16};
#pragma unroll
        for (int jj = 0; jj < 4; ++jj) {
          const bool ok0 = (s4 + jj <= lq0), ok1 = (s4 + jj <= lq0 + 1);
          const bool t0_ = ok0 && (ka[jj] > thr0), c0_ = ok0 && (ka[jj] == thr0);
          const bool t1_ = ok1 && (kb[jj] > thr1), c1_ = ok1 && (kb[jj] == thr1);
          unsigned long long m0 = __ballot(t0_), m1 = __ballot(t1_), cm0 = __ballot(c0_), cm1 = __ballot(c1_);
          if (t0_) ssel[q0 * 256 + base0 + __popcll(m0 & lt_mask)] = (unsigned short)(s4 + jj);
          if (t1_) ssel[q0 * 256 + 256 + base1 + __popcll(m1 & lt_mask)] = (unsigned short)(s4 + jj);
          base0 += __popcll(m0); base1 += __popcll(m1);
          if (cm0 | cm1) {
            int cp0 = cb0 + __popcll(cm0 & lt_mask), cp1 = cb1 + __popcll(cm1 & lt_mask);
            if (c0_ && cp0 < 64) scand[q0 * 64 + cp0] = (unsigned short)(s4 + jj);
            if (c1_ && cp1 < 64) scand[q0 * 64 + 64 + cp1] = (unsigned short)(s4 + jj);
            cb0 += __popcll(cm0); cb1 += __popcll(cm1);
          }
        }
      }
      asm volatile("s_waitcnt lgkmcnt(0)" ::: "memory");
#pragma unroll
      for (int x = 0; x < 2; ++x) {
        const int q = q0 + x;
        const int base = x ? base1 : base0, c = min(x ? cb1 : cb0, 64), r = 256 - base;
        if (lane < c) {
          unsigned short my = scand[q * 64 + lane];
          int rank = 0;
          for (int k = 0; k < c; ++k) rank += (scand[q * 64 + k] < my) ? 1 : 0;
          if (rank < r) ssel[q * 256 + base + rank] = my;
        }
      }
    }
    asm volatile("s_waitcnt lgkmcnt(0)" ::: "memory");
#pragma unroll 1
    for (int qq = 0; qq < 2; ++qq) {
      const int q = 2 * wid + qq, lq = l0 + q;
      unsigned short* sl = ssel + q * 256;
      for (int i = lane; i < 256; i += 64) sl[i] = (unsigned short)min((int)sl[i], lq);
      asm volatile("s_waitcnt lgkmcnt(0)" ::: "memory");
      attn_one(proj16, pa16, t0 + q, sl, (char*)(keys16 + q * 4096), lane);
    }
    __syncthreads();
  }
}

#define DL_LD 1040
template <int W>
__device__ __forceinline__ void pool_delta(const f16* up, int lf, char* dp) {
  f16x8 u[W + 7];
#pragma unroll
  for (int k = 0; k < W + 7; ++k) {
    const int rel = k - (W - 1);
    f16x8 z = {(f16)0.f, (f16)0.f, (f16)0.f, (f16)0.f, (f16)0.f, (f16)0.f, (f16)0.f, (f16)0.f};
    u[k] = (lf + rel >= 0) ? *(const f16x8*)(up + (ptrdiff_t)rel * PJ_W) : z;
  }
  float sum[8];
#pragma unroll
  for (int e = 0; e < 8; ++e) sum[e] = 0.f;
#pragma unroll
  for (int k = 0; k < W - 1; ++k)
#pragma unroll
    for (int e = 0; e < 8; ++e) sum[e] += (float)u[k][e];
#pragma unroll
  for (int i = 0; i < 8; ++i) {
    const float inv = 1.0f / (float)min(lf + i + 1, W);
    f16x8 d;
#pragma unroll
    for (int e = 0; e < 8; ++e) {
      sum[e] += (float)u[W - 1 + i][e];
      d[e] = (f16)(sum[e] * inv - (float)u[W - 1 + i][e]);
      sum[e] -= (float)u[i][e];
    }
    *(f16x8*)(dp + i * DL_LD) = d;
  }
}
__device__ __forceinline__ void p_pool(const Params& p, char* shm) {
  const f16* proj16 = (const f16*)(p.ws + OFF_B);
  const f16* wpl = (const f16*)(p.ws + OFF_WPOOL);
  f16* pa16 = (f16*)(p.ws + OFF_D);
  const int tid = opaque_tid(), wid = tid >> 6, lane = tid & 63, fr = lane & 15, fq = lane >> 4;
  for (int item = blockIdx.x; item < T_TOK / 64; item += gridDim.x) {
    const int t0 = item * 64;
    {
      const int g = wid >> 1;
      const int c = g * 128 + ((wid & 1) * 8 + (lane & 7)) * 8;
      const int tg = lane >> 3;
      const int tf = t0 + tg * 8, lf = tf & (SEQ - 1);
      const f16* up = proj16 + (size_t)tf * PJ_W + c;
      char* dp = shm + (tg * 8) * DL_LD + c * 2;
      if (g == 0) pool_delta<2>(up, lf, dp);
      else if (g == 1) pool_delta<4>(up, lf, dp);
      else if (g == 2) pool_delta<8>(up, lf, dp);
      else pool_delta<16>(up, lf, dp);
    }
    __syncthreads();
    {
      const int g = wid >> 1, eh = wid & 1;
      f32x4 acc[4][4];
#pragma unroll
      for (int m = 0; m < 4; ++m)
#pragma unroll
        for (int n = 0; n < 4; ++n) acc[m][n] = (f32x4){0.f, 0.f, 0.f, 0.f};
#pragma unroll
      for (int ks = 0; ks < 4; ++ks) {
        f16x8 A[4], B[4];
#pragma unroll
        for (int m = 0; m < 4; ++m) A[m] = *(const f16x8*)(wpl + (size_t)(g * 128 + eh * 64 + m * 16 + fr) * 128 + ks * 32 + fq * 8);
#pragma unroll
        for (int n = 0; n < 4; ++n) B[n] = *(const f16x8*)(shm + (n * 16 + fr) * DL_LD + (g * 128 + ks * 32 + fq * 8) * 2);
#pragma unroll
        for (int m = 0; m < 4; ++m)
#pragma unroll
          for (int n = 0; n < 4; ++n) acc[m][n] = __builtin_amdgcn_mfma_f32_16x16x32_f16(A[m], B[n], acc[m][n], 0, 0, 0);
      }
#pragma unroll
      for (int m = 0; m < 4; ++m) {
        const int e0 = g * 128 + eh * 64 + m * 16 + fq * 4;
        float4 sc = *(const float4*)(p.pool_scale + e0);
#pragma unroll
        for (int n = 0; n < 4; ++n) {
          f16x4 o;
          o[0] = (f16)(acc[m][n][0] * sc.x); o[1] = (f16)(acc[m][n][1] * sc.y);
          o[2] = (f16)(acc[m][n][2] * sc.z); o[3] = (f16)(acc[m][n][3] * sc.w);
          *(f16x4*)(pa16 + (size_t)(t0 + n * 16 + fr) * DM + e0) = o;
        }
      }
    }
    __syncthreads();
  }
}

#define RW_LD 2064
#define RT_LDS (2 * 36 * RW_LD)
template <int V>
__device__ __forceinline__ void p_ln1_route(const Params& p, char* shm) {
  const f16* z16 = (const f16*)(p.ws + OFF_C);
  char* dmy = (char*)p.out;
  f16* h1 = (V == 0) ? (f16*)(p.ws + OFF_A) : (f16*)dmy;
  int* route_e = (V == 0) ? (int*)(p.ws + OFF_ROUTE_E) : (int*)(dmy + 68000000);
  float* route_w = (V == 0) ? (float*)(p.ws + OFF_ROUTE_W) : (float*)(dmy + 69000000);
  int* counts = (V == 0) ? (int*)(p.ws + OFF_CNT) : (int*)(dmy + 70000000);
  int* lists = (V == 0) ? (int*)(p.ws + OFF_LISTS) : (int*)(dmy + 71000000);
  int* lcnt = (int*)(shm + RT_LDS);
  int* lent = lcnt + 128;
  const int tid = opaque_tid(), wid = tid >> 6, lane = tid & 63, fr = lane & 15, fq = lane >> 4;
  if (tid < 128) lcnt[tid] = 0;
  {
    const f16* wsrc = (const f16*)(p.ws + OFF_WRT);
    for (int i = tid; i < 2 * 36 * 128; i += 512) {
      int img = i / (36 * 128), rem = i % (36 * 128), o = rem >> 7, c = rem & 127;
      *(f16x8*)(shm + (img * 36 + o) * RW_LD + c * 16) = *(const f16x8*)(wsrc + (size_t)(img * 36 + o) * 1024 + c * 8);
    }
  }
  __syncthreads();
  for (int t0 = (blockIdx.x * 8 + wid) * 16; t0 < T_TOK; t0 += gridDim.x * 8 * 16) {
    const f16* zr = z16 + (size_t)(t0 + fr) * DM + fq * 8;
    float s1 = 0.f, s2 = 0.f;
#pragma unroll 8
    for (int ks = 0; ks < 32; ++ks) {
      f16x8 xz = *(const f16x8*)(zr + ks * 32);
#pragma unroll
      for (int e = 0; e < 8; ++e) { float x = (float)xz[e]; s1 += x; s2 += x * x; }
    }
    s1 += __shfl_xor(s1, 16, 64); s1 += __shfl_xor(s1, 32, 64);
    s2 += __shfl_xor(s2, 16, 64); s2 += __shfl_xor(s2, 32, 64);
    const float mu = s1 * (1.0f / DM);
    const float rs = rsqrtf(fmaxf(s2 * (1.0f / DM) - mu * mu, 0.f) + 1e-5f);
    f32x4 acc[3];
#pragma unroll
    for (int mt = 0; mt < 3; ++mt) acc[mt] = (f32x4){0.f, 0.f, 0.f, 0.f};
    f16* hr = h1 + (size_t)(t0 + fr) * DM + fq * 8;
    const char* wa = shm + fr * RW_LD + fq * 16;
    const char* wa2 = shm + min(32 + fr, 35) * RW_LD + fq * 16;
#pragma unroll 4
    for (int ks = 0; ks < 32; ++ks) {
      f16x8 xz = *(const f16x8*)(zr + ks * 32);
      float4 g0 = *(const float4*)(p.ln1_g + ks * 32 + fq * 8), g1 = *(const float4*)(p.ln1_g + ks * 32 + fq * 8 + 4);
      float4 b0 = *(const float4*)(p.ln1_b + ks * 32 + fq * 8), b1 = *(const float4*)(p.ln1_b + ks * 32 + fq * 8 + 4);
      float hn[8];
      hn[0] = ((float)xz[0] - mu) * rs * g0.x + b0.x; hn[1] = ((float)xz[1] - mu) * rs * g0.y + b0.y;
      hn[2] = ((float)xz[2] - mu) * rs * g0.z + b0.z; hn[3] = ((float)xz[3] - mu) * rs * g0.w + b0.w;
      hn[4] = ((float)xz[4] - mu) * rs * g1.x + b1.x; hn[5] = ((float)xz[5] - mu) * rs * g1.y + b1.y;
      hn[6] = ((float)xz[6] - mu) * rs * g1.z + b1.z; hn[7] = ((float)xz[7] - mu) * rs * g1.w + b1.w;
      f16x8 bh, bl;
#pragma unroll
      for (int e = 0; e < 8; ++e) { bh[e] = (f16)hn[e]; bl[e] = (f16)(hn[e] - (float)bh[e]); }
      *(f16x8*)(hr + ks * 32) = bh;
#pragma unroll
      for (int mt = 0; mt < 3; ++mt) {
        const char* wp = (mt < 2) ? (wa + mt * 16 * RW_LD) : wa2;
        f16x8 ah = *(const f16x8*)(wp + ks * 64), al = *(const f16x8*)(wp + 36 * RW_LD + ks * 64);
        acc[mt] = __builtin_amdgcn_mfma_f32_16x16x32_f16(ah, bh, acc[mt], 0, 0, 0);
        acc[mt] = __builtin_amdgcn_mfma_f32_16x16x32_f16(ah, bl, acc[mt], 0, 0, 0);
        acc[mt] = __builtin_amdgcn_mfma_f32_16x16x32_f16(al, bh, acc[mt], 0, 0, 0);
      }
    }
    float lg[36];
#pragma unroll
    for (int o = 0; o < 36; ++o) lg[o] = __shfl(acc[o >> 4][o & 3], fr + 16 * ((o >> 2) & 3), 64);
    {
      float gl[4];
#pragma unroll
      for (int o = 0; o < 4; ++o) gl[o] = lg[o] + p.b_group[o];
      int g = 0;
      float m = gl[0];
#pragma unroll
      for (int o = 1; o < 4; ++o) if (gl[o] > m) { m = gl[o]; g = o; }
      float se = 0.f;
#pragma unroll
      for (int o = 0; o < 4; ++o) se += __expf(gl[o] - m);
      float pg = 1.0f / se;
      float v1 = -3e38f, v2 = -3e38f;
      int i1 = 0, i2 = 0;
#pragma unroll
      for (int jx = 0; jx < 8; ++jx) {
        float x = (g == 0) ? lg[4 + jx] : (g == 1) ? lg[12 + jx] : (g == 2) ? lg[20 + jx] : lg[28 + jx];
        x += p.b_router[g * 8 + jx];
        if (x > v1) { v2 = v1; i2 = i1; v1 = x; i1 = jx; }
        else if (x > v2) { v2 = x; i2 = jx; }
      }
      if (fq == 0) {
        const int tt = t0 + fr;
        float e2 = __expf(v2 - v1);
        float w1 = pg / (1.0f + e2), w2 = pg * e2 / (1.0f + e2);
        int ea = g * 8 + i1, eb = g * 8 + i2;
        route_e[2 * tt] = ea; route_e[2 * tt + 1] = eb;
        route_w[2 * tt] = w1; route_w[2 * tt + 1] = w2;
        int la = atomicAdd(&lcnt[ea], 1), lb = atomicAdd(&lcnt[eb], 1);
        int slot = atomicAdd(&lcnt[64], 2);
        if (slot + 1 < 512) {
          lent[2 * slot] = (ea << 16) | la; lent[2 * slot + 1] = 2 * tt;
          lent[2 * slot + 2] = (eb << 16) | lb; lent[2 * slot + 3] = 2 * tt + 1;
        }
      }
    }
  }
  __syncthreads();
  if (tid < 32) lcnt[32 + tid] = atomicAdd(&counts[tid * CNT_STRIDE], lcnt[tid]);
  __syncthreads();
  {
    const int n_ent = min(lcnt[64], 512);
    for (int i = tid; i < n_ent; i += 512) {
      int ev = lent[2 * i], id = lent[2 * i + 1];
      int e = ev >> 16, lp = ev & 0xffff;
      lists[(size_t)e * T_TOK + lcnt[32 + e] + lp] = id;
    }
  }
  __syncthreads();
}

__device__ __forceinline__ void p_final(const Params& p) {
  const f16* h1 = (const f16*)(p.ws + OFF_A);
  const f16* y16 = (const f16*)(p.ws + OFF_C);
  const int tid = opaque_tid(), wid = tid >> 6, lane = tid & 63;
  const int nw = gridDim.x * 8;
  int t = blockIdx.x * 8 + wid;
  f16x8 hv[2], y0[2], y1[2];
#define P7_LOAD(tt)                                                                          \
  _Pragma("unroll") for (int i = 0; i < 2; ++i) {                                            \
    hv[i] = *(const f16x8*)(h1 + (size_t)(tt) * DM + i * 512 + lane * 8);                    \
    y0[i] = *(const f16x8*)(y16 + (size_t)(2 * (tt)) * DM + i * 512 + lane * 8);             \
    y1[i] = *(const f16x8*)(y16 + (size_t)(2 * (tt) + 1) * DM + i * 512 + lane * 8);         \
  }
  if (t < T_TOK) { P7_LOAD(t); }
  for (; t < T_TOK; t += nw) {
    float v[16];
#pragma unroll
    for (int i = 0; i < 2; ++i)
#pragma unroll
      for (int e = 0; e < 8; ++e) v[i * 8 + e] = ALPHA * (float)hv[i][e] + ((float)y0[i][e] + (float)y1[i][e]);
    if (t + nw < T_TOK) { P7_LOAD(t + nw); }
    float s = 0.f;
#pragma unroll
    for (int i = 0; i < 16; ++i) s += v[i];
    float mu = wave_sum(s) * (1.0f / DM);
    float q = 0.f;
#pragma unroll
    for (int i = 0; i < 16; ++i) { v[i] -= mu; q += v[i] * v[i]; }
    float rs = rsqrtf(wave_sum(q) * (1.0f / DM) + 1e-5f);
#pragma unroll
    for (int i = 0; i < 2; ++i)
#pragma unroll
      for (int hf = 0; hf < 2; ++hf) {
        const int c = i * 512 + lane * 8 + hf * 4;
        float4 g = *(const float4*)(p.ln2_g + c), b = *(const float4*)(p.ln2_b + c);
        f32x4 o;
        o[0] = v[i * 8 + hf * 4 + 0] * rs * g.x + b.x; o[1] = v[i * 8 + hf * 4 + 1] * rs * g.y + b.y;
        o[2] = v[i * 8 + hf * 4 + 2] * rs * g.z + b.z; o[3] = v[i * 8 + hf * 4 + 3] * rs * g.w + b.w;
        *(f32x4*)(p.out + (size_t)t * DM + c) = o;
      }
  }
#undef P7_LOAD
}

#define MEGA_LDS 158720


#define XB_TMO      128
#define XB_XCNT(j)  (256  + 64 * (j))
#define XB_XSUB(j)  (1280 + 64 * (j))
#define XB_XGEN(j)  (2304 + 64 * (j))
#define XB_TOP      3328
#define XB_TOPGEN   3392
#define XCD_BAR_WORDS 3456
#define XB_SPIN_CAP (1u << 22)
#define LAS __attribute__((address_space(3)))
__device__ __forceinline__ unsigned xb_ld(unsigned* p) { return __hip_atomic_load(p, __ATOMIC_RELAXED, __HIP_MEMORY_SCOPE_AGENT); }
__device__ __forceinline__ unsigned xb_add(unsigned* p, unsigned v) { return __hip_atomic_fetch_add(p, v, __ATOMIC_RELAXED, __HIP_MEMORY_SCOPE_AGENT); }
__device__ __forceinline__ unsigned xb_xcc_id() { return (unsigned)__builtin_amdgcn_s_getreg((3 << 11) | 20) & 0xFu; }
#define XB_SPIN(cond, bar) do { unsigned _sp = 0; while (cond) { __builtin_amdgcn_s_sleep(1); \
    if ((++_sp & 255u) == 0u) { if (xb_ld(&(bar)[XB_TMO])) break; if (_sp > XB_SPIN_CAP) { atomicAdd(&(bar)[XB_TMO], 1u); break; } } } } while (0)
struct XcdBarrier { unsigned* bar; unsigned x; volatile unsigned* st; };
__device__ __forceinline__ XcdBarrier xcd_barrier_post(unsigned* bar, volatile unsigned* st) {
  XcdBarrier b; b.bar = bar; b.x = xb_xcc_id(); b.st = st;
  if (threadIdx.x == 0) (void)xb_add(&bar[XB_XCNT(b.x)], 1u);
  return b;
}
__device__ __forceinline__ void xcd_barrier_complete(unsigned* bar, unsigned x, unsigned& nloc, unsigned& nx) {
  const unsigned G = gridDim.x * gridDim.y * gridDim.z;
  unsigned sum, cnt, mine, sp = 0u;
  for (;;) {
    sum = 0u; cnt = 0u; mine = 0u;
#pragma unroll
    for (unsigned j = 0; j < 16; ++j) { const unsigned c = xb_ld(&bar[XB_XCNT(j)]); sum += c; cnt += (c > 0u) ? 1u : 0u; mine = (j == x) ? c : mine; }
    if (sum == G) break;
    __builtin_amdgcn_s_sleep(1);
    if ((++sp & 255u) == 0u) { if (xb_ld(&bar[XB_TMO])) break; if (sp > XB_SPIN_CAP) { atomicAdd(&bar[XB_TMO], 1u); break; } }
  }
  nloc = mine > 0u ? mine : 1u; nx = cnt > 0u ? cnt : 1u;
}
__device__ __forceinline__ void xcd_barrier(const XcdBarrier& b) {
  asm volatile("s_waitcnt vmcnt(0)" ::: "memory");
  __syncthreads();
  if (threadIdx.x == 0) {
    unsigned* bar = b.bar;
    __builtin_amdgcn_s_waitcnt(0);
    unsigned nloc = b.st[0], nx = b.st[1];
    if (nloc == 0u) { xcd_barrier_complete(bar, b.x, nloc, nx); b.st[0] = nloc; b.st[1] = nx; }
    const unsigned old = xb_add(&bar[XB_XSUB(b.x)], 1u);
    const unsigned gen = old / nloc;
    if (old + 1u == (gen + 1u) * nloc) {
      __builtin_amdgcn_fence(__ATOMIC_RELEASE, "agent");
      asm volatile("s_waitcnt vmcnt(0)" ::: "memory");
      const unsigned og = xb_add(&bar[XB_TOP], 1u);
      const unsigned tg = og / nx;
      if (og + 1u == (tg + 1u) * nx) xb_add(&bar[XB_TOPGEN], 1u);
      else XB_SPIN(xb_ld(&bar[XB_TOPGEN]) == tg, bar);
      __builtin_amdgcn_fence(__ATOMIC_ACQUIRE, "agent");
      xb_add(&bar[XB_XGEN(b.x)], 1u);
      asm volatile("s_waitcnt vmcnt(0)" ::: "memory");
    } else {
      XB_SPIN(xb_ld(&bar[XB_XGEN(b.x)]) == gen, bar);
      __builtin_amdgcn_fence(__ATOMIC_ACQUIRE, "agent");
      asm volatile("s_waitcnt vmcnt(0)" ::: "memory");
    }
  }
  __syncthreads();
}

#ifndef PROBE
#define PROBE 0
#endif
#define GSYNC() do { XcdBarrier xb_; xb_.bar = (unsigned*)(p.ws + OFF_BAR); xb_.x = xb_xcc_id(); xb_.st = (volatile unsigned*)(shm + MEGA_LDS); xcd_barrier(xb_); } while (0)
#define PH(n, code) do { code; if (PROBE == n) { GSYNC(); code; } } while (0)
__global__ __launch_bounds__(512) void mega(Params p) {
  __shared__ __attribute__((aligned(1024))) char shm[MEGA_LDS + 16];
  volatile unsigned* xst = (volatile unsigned*)(shm + MEGA_LDS);
  if (threadIdx.x < 4) xst[threadIdx.x] = 0u;
  __syncthreads();
  (void)xcd_barrier_post((unsigned*)(p.ws + OFF_BAR), xst);
  if (blockIdx.x == 0 && threadIdx.x < 32) ((int*)(p.ws + OFF_CNT))[threadIdx.x * CNT_STRIDE] = 0;
  PH(1, p_ln_in(p));
  PH(2, p_convert(p, shm));
  GSYNC();
  PH(3, p_inproj(p, shm));
  GSYNC();
  PH(4, p_pool(p, shm));
  PH(5, p_index<0>(p, shm));
#if PROBE >= 50 && PROBE < 60
  GSYNC();
  p_index<PROBE - 50>(p, shm);
#endif
  GSYNC();
  PH(7, p_merge(p, shm));
  GSYNC();
  PH(8, p_resid(p, shm));
  GSYNC();
  p_ln1_route<0>(p, shm);
  GSYNC();
#if PROBE == 9
  if (blockIdx.x == 0 && threadIdx.x < 32) ((int*)((char*)p.out + 70000000))[threadIdx.x * CNT_STRIDE] = 0;
  GSYNC();
  p_ln1_route<1>(p, shm);
  GSYNC();
#endif
  PH(10, p_moe_a(p, shm));
  GSYNC();
  PH(11, p_moe_b(p, shm));
  GSYNC();
  PH(12, p_final(p));
}

extern "C" void kernel_launch(void* const* d_in, const int* in_sizes, int n_in, void* d_out, int out_size, void* d_ws,
                              size_t ws_size, hipStream_t stream) {
  if (ws_size < WS_NEEDED) { fprintf(stderr, "ws too small: %zu < %zu\n", ws_size, (size_t)WS_NEEDED); return; }
  static int grid_blocks = 0;
  if (!grid_blocks) {
    int dev = 0, cus = 0, per_cu = 0;
    hipGetDevice(&dev);
    hipDeviceGetAttribute(&cus, hipDeviceAttributeMultiprocessorCount, dev);
    hipOccupancyMaxActiveBlocksPerMultiprocessor(&per_cu, mega, 512, 0);
    if (per_cu > 1) per_cu = 1;
    grid_blocks = cus * per_cu;
    fprintf(stderr, "mega: cus=%d per_cu=%d grid=%d\n", cus, per_cu, grid_blocks);
  }
  Params p{};
  const float** pp = (const float**)&p;
  for (int i = 0; i < 21; ++i) pp[i] = (const float*)d_in[i];
  p.out = (float*)d_out;
  p.ws = (char*)d_ws;
  (void)hipMemsetAsync((char*)d_ws + OFF_BAR, 0, 16384, stream);
  void* args[] = {&p};
  hipError_t e = hipLaunchCooperativeKernel((void*)mega, dim3(grid_blocks), dim3(512), args, 0, stream);
  if (e != hipSuccess) fprintf(stderr, "cooperative launch failed: %s (grid %d)\n", hipGetErrorString(e), grid_blocks);
}
```

```cpp
#include <hip/hip_runtime.h>
#include <hip/hip_fp16.h>
#include <hip/hip_cooperative_groups.h>
#include <stdint.h>
#include <stdio.h>
namespace cg = cooperative_groups;

typedef _Float16 f16;
typedef f16 f16x8 __attribute__((ext_vector_type(8)));
typedef f16 f16x4 __attribute__((ext_vector_type(4)));
typedef f16 f16x2 __attribute__((ext_vector_type(2)));
typedef float f32x4 __attribute__((ext_vector_type(4)));
typedef int i32x4 __attribute__((ext_vector_type(4)));

#define T_TOK 32768
#define DM 1024
#define SEQ 4096
#define PJ_W 1536
#define PA_W 1448
#define IN_W 3496
#define IN_WP 3584
#define C_Q 512
#define C_K 1024
#define C_V 1088
#define C_IQ 1152
#define C_IK 1408
#define C_IW 1440
#define ALPHA 1.189207115002721f
#define NEG_BIG (-1e30f)

#define SZ_A   ((size_t)T_TOK * DM * 2)
#define SZ_B   ((size_t)T_TOK * PJ_W * 2)
#define SZ_C   ((size_t)T_TOK * 2048 * 2)
#define SZ_D   ((size_t)T_TOK * DM * 2)
#define OFF_A  ((size_t)0)
#define OFF_B  (OFF_A + SZ_A)
#define OFF_C  (OFF_B + SZ_B)
#define OFF_D  (OFF_C + SZ_C)
#define OFF_W  (OFF_D + SZ_D)
#define OFF_WIN   (OFF_W)
#define OFF_WPOOL (OFF_WIN + (size_t)IN_WP * 1024 * 2)
#define OFF_WPP   (OFF_WPOOL + (size_t)4 * 128 * 128 * 2)
#define OFF_WPA   (OFF_WPP + (size_t)1024 * 512 * 2)
#define OFF_WOUT  (OFF_WPA + (size_t)1024 * 512 * 2)
#define OFF_WGU   (OFF_WOUT + (size_t)1024 * 1024 * 2)
#define OFF_WDN   (OFF_WGU + (size_t)32 * 512 * 1024 * 2)
#define OFF_MISC  (OFF_WDN + (size_t)32 * 1024 * 256 * 2)
#define OFF_ROUTE_E (OFF_MISC)
#define OFF_ROUTE_W (OFF_ROUTE_E + (size_t)T_TOK * 2 * 4)
#define OFF_COUNTS  (OFF_ROUTE_W + (size_t)T_TOK * 2 * 4)
#define OFF_LISTS   (OFF_COUNTS + 256)
#define OFF_SEL     (OFF_LISTS + (size_t)32 * T_TOK * 4)
#define OFF_CNT      (OFF_SEL + (size_t)T_TOK * 256 * 2)
#define OFF_WRT      (OFF_CNT + 4096)
#define OFF_IKC      (OFF_WRT + 2 * 36 * 1024 * 2)
#define OFF_BAR      (OFF_IKC + (size_t)T_TOK * 32 * 2)
#define WS_NEEDED   (OFF_BAR + 16384)
#define CNT_STRIDE 32

struct Params {
  const float *x, *ln_in_g, *ln_in_b, *w_in, *b_gate, *pool_w, *pool_scale, *wpp, *wpa, *w_out, *ln1_g, *ln1_b, *w_group,
      *b_group, *w_router, *b_router, *w_gate, *w_up, *w_down, *ln2_g, *ln2_b;
  float* out;
  char* ws;
};

__device__ __forceinline__ float wave_sum(float v) {
#pragma unroll
  for (int o = 32; o > 0; o >>= 1) v += __shfl_xor(v, o, 64);
  return v;
}
__device__ __forceinline__ float wave_max(float v) {
#pragma unroll
  for (int o = 32; o > 0; o >>= 1) v = fmaxf(v, __shfl_xor(v, o, 64));
  return v;
}
__device__ __forceinline__ int wave_sum_i(int v) {
#pragma unroll
  for (int o = 32; o > 0; o >>= 1) v += __shfl_xor(v, o, 64);
  return v;
}
__device__ __forceinline__ int opaque_tid() { int t = threadIdx.x; asm volatile("" : "+v"(t)); return t; }
__device__ __forceinline__ float ldf(const float* p) { return *p; }
__device__ __forceinline__ float ldf(const f16* p) { return (float)*p; }

#ifndef SKEW_P1
#define SKEW_P1 0
#endif
#define WAIT_V(n) asm volatile("s_waitcnt vmcnt(%0)" ::"n"(n) : "memory")
#define WAIT_L(n) asm volatile("s_waitcnt lgkmcnt(%0)" ::"n"(n) : "memory")
template <class T> __device__ __forceinline__ void st_nt(T* p, const T& v) { *p = v; }
#define RAW_SYNC() do { asm volatile("s_waitcnt lgkmcnt(0)" ::: "memory"); __builtin_amdgcn_s_barrier(); asm volatile("" ::: "memory"); } while (0)

__device__ __forceinline__ int lds_byte(int r, int c) {
  int ob = (r & 15) * 64 + c * 2;
  return (r >> 4) * 1024 + (ob ^ (((ob >> 9) & 1) << 5));
}
__device__ __forceinline__ void stage_rc(int b, int& R, int& C) {
  int st = b >> 10, sb = b & 1023, swz = sb ^ (((sb >> 9) & 1) << 5);
  R = st * 16 + swz / 64;
  C = (swz % 64) / 2;
}

#define TILE_B 16384
#define SLOT_B 32768
#define NSTG 2
#define GEMM_LDS 135168
#define EPI_LD 528

__device__ __forceinline__ void gemm_core(const f16* __restrict__ Ab, const unsigned (&pa)[NSTG], const f16* __restrict__ Bb,
                                          const unsigned (&pb)[NSTG], int nt, f32x4 (&acc)[8][4], char* shm) {
  const int tid = opaque_tid(), wid = tid >> 6, lane = tid & 63, wr = wid >> 2, wc = wid & 3, fr = lane & 15, fq = lane >> 4;
  const int nk = nt * 2;
#define SA(s_) (shm + (s_) * SLOT_B)
#define SB(s_) (shm + (s_) * SLOT_B + TILE_B)
#define GLDS_STAGE(slot, kt)                                                                                              \
  do {                                                                                                                    \
    _Pragma("unroll") for (int i = 0; i < NSTG; ++i) {                                                                   \
      __builtin_amdgcn_global_load_lds((const unsigned*)(Ab + pa[i] + (kt) * 32), (unsigned*)(SA(slot) + wid * 1024 + i * 8192), \
                                       16, 0, 0);                                                                         \
      __builtin_amdgcn_global_load_lds((const unsigned*)(Bb + pb[i] + (kt) * 32), (unsigned*)(SB(slot) + wid * 1024 + i * 8192), \
                                       16, 0, 0);                                                                         \
    }                                                                                                                     \
  } while (0)
  GLDS_STAGE(0, 0);
  GLDS_STAGE(1, 1);
  GLDS_STAGE(2, 2);
  const int aoff = lds_byte(wr * 128 + fr, fq * 8), boff = lds_byte(wc * 64 + fr, fq * 8);
  WAIT_V(8);
  __builtin_amdgcn_s_barrier();
  if (wr == 1) __builtin_amdgcn_s_barrier();
  for (int t = 0; t < nk; ++t) {
    if (t + 3 < nk) { GLDS_STAGE((t + 3) & 3, t + 3); WAIT_V(8); }
    else if (t + 2 < nk) WAIT_V(4);
    else WAIT_V(0);
    const char* sa = SA(t & 3) + aoff;
    const char* sb = SB(t & 3) + boff;
    f16x8 At[8], Bf[4];
#pragma unroll
    for (int n = 0; n < 4; ++n) Bf[n] = *(const f16x8*)(sb + n * 1024);
#pragma unroll
    for (int m = 0; m < 8; ++m) At[m] = *(const f16x8*)(sa + m * 1024);
    WAIT_L(0);
    __builtin_amdgcn_sched_barrier(0);
    __builtin_amdgcn_s_barrier();
    __builtin_amdgcn_sched_barrier(0);
#pragma unroll
    for (int m = 0; m < 8; ++m)
#pragma unroll
      for (int n = 0; n < 4; ++n) acc[m][n] = __builtin_amdgcn_mfma_f32_16x16x32_f16(At[m], Bf[n], acc[m][n], 0, 0, 0);
    __builtin_amdgcn_sched_barrier(0);
    __builtin_amdgcn_s_barrier();
    __builtin_amdgcn_sched_barrier(0);
  }
  if (wr == 0) __builtin_amdgcn_s_barrier();
  RAW_SYNC();
#undef SA
#undef SB
#undef GLDS_STAGE
}

__device__ __forceinline__ void epi_store_f16(const f32x4 (&acc)[8][4], char* shm) {
  const int tid = opaque_tid(), wid = tid >> 6, lane = tid & 63, wr = wid >> 2, wc = wid & 3, fr = lane & 15, fq = lane >> 4;
#pragma unroll
  for (int m = 0; m < 8; ++m)
#pragma unroll
    for (int n = 0; n < 4; ++n) {
      f16x4 v;
      v[0] = (f16)acc[m][n][0]; v[1] = (f16)acc[m][n][1]; v[2] = (f16)acc[m][n][2]; v[3] = (f16)acc[m][n][3];
      *(f16x4*)(shm + (wc * 64 + n * 16 + fr) * EPI_LD + (wr * 128 + m * 16 + fq * 4) * 2) = v;
    }
}

__device__ __forceinline__ void p_ln_in(const Params& p) {
  f16* h16 = (f16*)(p.ws + OFF_A);
  const int tid = opaque_tid(), lane = tid & 63, wid = tid >> 6;
  const int nw = gridDim.x * 8;
  for (int t = blockIdx.x * 8 + wid; t < T_TOK; t += nw) {
    const float* xr = p.x + (size_t)t * DM;
    float4 v[4];
#pragma unroll
    for (int i = 0; i < 4; ++i) v[i] = *(const float4*)(xr + i * 256 + lane * 4);
    float s = 0.f;
#pragma unroll
    for (int i = 0; i < 4; ++i) s += v[i].x + v[i].y + v[i].z + v[i].w;
    float mu = wave_sum(s) * (1.0f / DM);
    float q = 0.f;
#pragma unroll
    for (int i = 0; i < 4; ++i) {
      v[i].x -= mu; v[i].y -= mu; v[i].z -= mu; v[i].w -= mu;
      q += v[i].x * v[i].x + v[i].y * v[i].y + v[i].z * v[i].z + v[i].w * v[i].w;
    }
    float rs = rsqrtf(wave_sum(q) * (1.0f / DM) + 1e-5f);
#pragma unroll
    for (int i = 0; i < 4; ++i) {
      float4 g = *(const float4*)(p.ln_in_g + i * 256 + lane * 4), b = *(const float4*)(p.ln_in_b + i * 256 + lane * 4);
      f16x4 o;
      o[0] = (f16)(v[i].x * rs * g.x + b.x); o[1] = (f16)(v[i].y * rs * g.y + b.y);
      o[2] = (f16)(v[i].z * rs * g.z + b.z); o[3] = (f16)(v[i].w * rs * g.w + b.w);
      *(f16x4*)(h16 + (size_t)t * DM + i * 256 + lane * 4) = o;
    }
  }
}

template <class RowMap>
__device__ __forceinline__ void conv_tile(const float* __restrict__ src, int ld_src, int nvalid, int k0, int n0, f16* __restrict__ dst,
                                          int ld_dst, RowMap rm, float* sT) {
  const int tid = opaque_tid();
  {
    int k = tid >> 3, n = (tid & 7) * 8;
    const float* sp = src + (size_t)(k0 + k) * ld_src + n0 + n;
#pragma unroll
    for (int j = 0; j < 8; ++j) sT[k * 65 + n + j] = (n0 + n + j < nvalid) ? sp[j] : 0.f;
  }
  __syncthreads();
  {
    int n = tid >> 3, k = (tid & 7) * 8;
    f16x8 o;
#pragma unroll
    for (int j = 0; j < 8; ++j) o[j] = (f16)sT[(k + j) * 65 + n];
    int drow = rm(n0 + n);
    if (drow >= 0) *(f16x8*)(dst + (size_t)drow * ld_dst + k0 + k) = o;
  }
  __syncthreads();
}

struct RowId { __device__ int operator()(int n) const { return n; } };
struct RowGU { int up; __device__ int operator()(int ff) const {
  int tile = ff >> 7, wr = (ff >> 6) & 1, l = ff & 63; return tile * 256 + wr * 128 + up * 64 + l; } };

__device__ __forceinline__ void p_convert(const Params& p, char* shm) {
  float* sT = (float*)shm;
  char* ws = p.ws;
  const int J0 = 16 * 56, J1 = J0 + 16, J2 = J1 + 128, J3 = J2 + 128, J4 = J3 + 256, J5 = J4 + 32 * 64, J6 = J5 + 32 * 64,
            J7 = J6 + 32 * 64;
  for (int job = blockIdx.x; job < J7; job += gridDim.x) {
    if (job < J0) {
      int kt = job / 56, nt = job % 56;
      conv_tile(p.w_in, IN_W, IN_W, kt * 64, nt * 64, (f16*)(ws + OFF_WIN), 1024, RowId(), sT);
    } else if (job < J1) {
      int j = job - J0, g = j >> 2, kt = (j >> 1) & 1, nt = j & 1;
      conv_tile(p.pool_w + g * 128 * 128, 128, 128, kt * 64, nt * 64, (f16*)(ws + OFF_WPOOL) + g * 128 * 128, 128, RowId(), sT);
    } else if (job < J2) {
      int j = job - J1, kt = j >> 4, nt = j & 15;
      conv_tile(p.wpp, 1024, 1024, kt * 64, nt * 64, (f16*)(ws + OFF_WPP), 512, RowId(), sT);
    } else if (job < J3) {
      int j = job - J2, kt = j >> 4, nt = j & 15;
      conv_tile(p.wpa, 1024, 1024, kt * 64, nt * 64, (f16*)(ws + OFF_WPA), 512, RowId(), sT);
    } else if (job < J4) {
      int j = job - J3, kt = j >> 4, nt = j & 15;
      conv_tile(p.w_out, 1024, 1024, kt * 64, nt * 64, (f16*)(ws + OFF_WOUT), 1024, RowId(), sT);
    } else if (job < J6) {
      int up = job >= J5;
      int j = job - (up ? J5 : J4), e = j >> 6, kt = (j >> 2) & 15, nt = j & 3;
      RowGU rm; rm.up = up;
      conv_tile((up ? p.w_up : p.w_gate) + (size_t)e * 1024 * 256, 256, 256, kt * 64, nt * 64,
                (f16*)(ws + OFF_WGU) + (size_t)e * 512 * 1024, 1024, rm, sT);
    } else {
      int j = job - J6, e = j >> 6, kt = (j >> 4) & 3, nt = j & 15;
      conv_tile(p.w_down + (size_t)e * 256 * 1024, 1024, 1024, kt * 64, nt * 64, (f16*)(ws + OFF_WDN) + (size_t)e * 1024 * 256,
                256, RowId(), sT);
    }
  }
  {
    f16* whi = (f16*)(ws + OFF_WRT);
    f16* wlo = whi + 36 * 1024;
    for (int i = blockIdx.x * 512 + threadIdx.x; i < 36 * 1024; i += gridDim.x * 512) {
      int o = i >> 10, k = i & 1023;
      float w = (o < 4) ? p.w_group[k * 4 + o] : p.w_router[k * 32 + (o - 4)];
      f16 h = (f16)w;
      whi[i] = h;
      wlo[i] = (f16)(w - (float)h);
    }
  }
}

__device__ __forceinline__ void phase_skew(int us4) {
  const int k = (blockIdx.x >> 3) & 3;
  if (k) {
    const unsigned long long t0 = __builtin_amdgcn_s_memrealtime();
    const unsigned long long dt = (unsigned long long)(k * us4 * 25);
    while (__builtin_amdgcn_s_memrealtime() - t0 < dt) __builtin_amdgcn_s_sleep(8);
  }
}

__device__ __forceinline__ int xcd_item(int n_items, int r) {
  const int nx = 8, slots = gridDim.x >> 3;
  const int xcd = blockIdx.x & 7, slot = blockIdx.x >> 3;
  const int per = (n_items + nx - 1) / nx;
  const int local = slot + r * slots;
  if (local >= per) return -1;
  const int item = xcd * per + local;
  return (item < n_items) ? item : -2;
}

__device__ __forceinline__ void p_inproj(const Params& p, char* shm) {
  const f16* h16 = (const f16*)(p.ws + OFF_A);
  const f16* wT = (const f16*)(p.ws + OFF_WIN);
  f16* proj16 = (f16*)(p.ws + OFF_B);
  f16* gate16 = (f16*)(p.ws + OFF_C);
  f16* ikc = (f16*)(p.ws + OFF_IKC);
  const int tid = opaque_tid(), wid = tid >> 6, lane = tid & 63;
  int sR[NSTG], sC[NSTG];
#pragma unroll
  for (int i = 0; i < NSTG; ++i) stage_rc(wid * 1024 + i * 8192 + lane * 16, sR[i], sC[i]);
  const int NTILES = 128 * 14;
  if (SKEW_P1) phase_skew(SKEW_P1);
  for (int r = 0;; ++r) {
    int tile = xcd_item(NTILES, r);
    if (tile == -1) break;
    if (tile < 0) continue;
    int grp = tile / 56, rem = tile % 56;
    int ft = rem >> 2, tt = grp * 4 + (rem & 3);
    unsigned pa[NSTG], pb[NSTG];
#pragma unroll
    for (int i = 0; i < NSTG; ++i) {
      pa[i] = (unsigned)((ft * 256 + sR[i]) * 1024 + sC[i]);
      pb[i] = (unsigned)((tt * 256 + sR[i]) * 1024 + sC[i]);
    }
    f32x4 acc[8][4];
#pragma unroll
    for (int m = 0; m < 8; ++m)
#pragma unroll
      for (int n = 0; n < 4; ++n) acc[m][n] = (f32x4){0.f, 0.f, 0.f, 0.f};
    gemm_core(wT, pa, h16, pb, 16, acc, shm);
    epi_store_f16(acc, shm);
    RAW_SYNC();
    {
      int ch = tid & 31, r0 = tid >> 5;
      int f0 = ft * 256 + ch * 8;
      float bg[8];
      if (f0 >= PA_W && f0 < IN_W) {
#pragma unroll
        for (int j = 0; j < 8; ++j) bg[j] = p.b_gate[f0 - PA_W + j];
      } else {
#pragma unroll
        for (int j = 0; j < 8; ++j) bg[j] = 0.f;
      }
#pragma unroll 4
      for (int ps = 0; ps < 16; ++ps) {
        int r = ps * 16 + r0;
        f16x8 v = *(const f16x8*)(shm + r * EPI_LD + ch * 16);
        size_t tok = (size_t)tt * 256 + r;
        if (f0 < PA_W) {
          st_nt((f16x8*)(proj16 + tok * PJ_W + f0), v);
          if (f0 >= C_IK && f0 < C_IW) *(f16x8*)(ikc + tok * 32 + (f0 - C_IK)) = v;
        } else if (f0 < IN_W) {
          f16x8 o;
#pragma unroll
          for (int j = 0; j < 8; ++j) o[j] = (f16)__builtin_amdgcn_rcpf(1.0f + __builtin_amdgcn_exp2f(-1.4426950408889634f * ((float)v[j] + bg[j])));
          st_nt((f16x8*)(gate16 + tok * 2048 + (f0 - PA_W)), o);
        }
      }
    }
    RAW_SYNC();
  }
}


__device__ __forceinline__ void zero_acc(f32x4 (&acc)[8][4]) {
#pragma unroll
  for (int m = 0; m < 8; ++m)
#pragma unroll
    for (int n = 0; n < 4; ++n) acc[m][n] = (f32x4){0.f, 0.f, 0.f, 0.f};
}

template <class RowPtr>
__device__ __forceinline__ void epi_rows_out(char* shm, RowPtr rp) {
  const int tid = opaque_tid(), ch = tid & 31, r0 = tid >> 5;
#pragma unroll 4
  for (int ps = 0; ps < 16; ++ps) {
    int r = ps * 16 + r0;
    f16x8 v = *(const f16x8*)(shm + r * EPI_LD + ch * 16);
    f16* d = rp(r);
    if (d) st_nt((f16x8*)(d + ch * 8), v);
  }
}

__device__ __forceinline__ void p_merge(const Params& p, char* shm) {
  const f16* pa16 = (const f16*)(p.ws + OFF_D);
  const f16* gate16 = (const f16*)(p.ws + OFF_C);
  const f16* wpp = (const f16*)(p.ws + OFF_WPP);
  const f16* wpa = (const f16*)(p.ws + OFF_WPA);
  f16* merged16 = (f16*)(p.ws + OFF_B);
  const int tid = opaque_tid(), wid = tid >> 6, lane = tid & 63;
  int sR[NSTG], sC[NSTG];
#pragma unroll
  for (int i = 0; i < NSTG; ++i) stage_rc(wid * 1024 + i * 8192 + lane * 16, sR[i], sC[i]);
  const int ch = tid & 31, r0 = tid >> 5;
  for (int r = 0;; ++r) {
    int tile = xcd_item(512, r);
    if (tile == -1) break;
    if (tile < 0) continue;
    int ft = tile & 3, tt = tile >> 2;
    unsigned pa[NSTG], pb[NSTG];
#pragma unroll
    for (int i = 0; i < NSTG; ++i) {
      pa[i] = (unsigned)((ft * 256 + sR[i]) * 512 + sC[i]);
      pb[i] = (unsigned)((tt * 256 + sR[i]) * 1024 + sC[i]);
    }
    f32x4 acc[8][4];
    zero_acc(acc);
    gemm_core(wpp, pa, pa16, pb, 8, acc, shm);
    epi_store_f16(acc, shm);
    RAW_SYNC();
#pragma unroll 4
    for (int ps = 0; ps < 16; ++ps) {
      const int rr = ps * 16 + r0;
      const size_t tok = (size_t)tt * 256 + rr;
      f16x8 v = *(const f16x8*)(shm + rr * EPI_LD + ch * 16);
      f16x8 g0 = *(const f16x8*)(gate16 + tok * 2048 + ft * 256 + ch * 8);
      f16x8 g1 = *(const f16x8*)(gate16 + tok * 2048 + 1024 + ft * 256 + ch * 8);
      f16x8 o;
#pragma unroll
      for (int e = 0; e < 8; ++e) {
        float rq = fminf((float)g0[e] * __builtin_amdgcn_rcpf(fmaxf((float)g1[e], 6e-5f)), 16384.f);
        o[e] = (f16)fminf(fmaxf((float)v[e] * rq, -60000.f), 60000.f);
      }
      *(f16x8*)(shm + rr * EPI_LD + ch * 16) = o;
    }
    RAW_SYNC();
    {
      const int wid_ = tid >> 6, lane_ = tid & 63, wr = wid_ >> 2, wc = wid_ & 3, fr = lane_ & 15, fq = lane_ >> 4;
#pragma unroll
      for (int m = 0; m < 8; ++m)
#pragma unroll
        for (int n = 0; n < 4; ++n) {
          f16x4 c = *(const f16x4*)(shm + (wc * 64 + n * 16 + fr) * EPI_LD + (wr * 128 + m * 16 + fq * 4) * 2);
          acc[m][n] = (f32x4){(float)c[0], (float)c[1], (float)c[2], (float)c[3]};
        }
    }
    RAW_SYNC();
    gemm_core(wpa, pa, pa16 + 512, pb, 8, acc, shm);
    epi_store_f16(acc, shm);
    RAW_SYNC();
#pragma unroll 4
    for (int ps = 0; ps < 16; ++ps) {
      const int rr = ps * 16 + r0;
      const size_t tok = (size_t)tt * 256 + rr;
      f16x8 v = *(const f16x8*)(shm + rr * EPI_LD + ch * 16);
      f16x8 g1 = *(const f16x8*)(gate16 + tok * 2048 + 1024 + ft * 256 + ch * 8);
      f16x8 o;
#pragma unroll
      for (int e = 0; e < 8; ++e) o[e] = (f16)((float)v[e] * (float)g1[e]);
      *(f16x8*)(merged16 + tok * 1024 + ft * 256 + ch * 8) = o;
    }
    RAW_SYNC();
  }
}

__device__ __forceinline__ void p_resid(const Params& p, char* shm) {
  const f16* merged16 = (const f16*)(p.ws + OFF_B);
  const f16* h16 = (const f16*)(p.ws + OFF_A);
  const f16* wo = (const f16*)(p.ws + OFF_WOUT);
  f16* z16 = (f16*)(p.ws + OFF_C);
  const int tid = opaque_tid(), wid = tid >> 6, lane = tid & 63;
  int sR[NSTG], sC[NSTG];
#pragma unroll
  for (int i = 0; i < NSTG; ++i) stage_rc(wid * 1024 + i * 8192 + lane * 16, sR[i], sC[i]);
  const int ch = tid & 31, r0 = tid >> 5;
  for (int r = 0;; ++r) {
    int tile = xcd_item(512, r);
    if (tile == -1) break;
    if (tile < 0) continue;
    int ft = tile & 3, tt = tile >> 2;
    unsigned pa[NSTG], pb[NSTG];
#pragma unroll
    for (int i = 0; i < NSTG; ++i) {
      pa[i] = (unsigned)((ft * 256 + sR[i]) * 1024 + sC[i]);
      pb[i] = (unsigned)((tt * 256 + sR[i]) * 1024 + sC[i]);
    }
    {
      f32x4 acc[8][4];
      zero_acc(acc);
      gemm_core(wo, pa, merged16, pb, 16, acc, shm);
      epi_store_f16(acc, shm);
    }
    RAW_SYNC();
#pragma unroll 4
    for (int ps = 0; ps < 16; ++ps) {
      const int rr = ps * 16 + r0;
      const size_t o = ((size_t)tt * 256 + rr) * 1024 + ft * 256 + ch * 8;
      f16x8 v = *(const f16x8*)(shm + rr * EPI_LD + ch * 16);
      f16x8 hv = *(const f16x8*)(h16 + o);
      f16x8 zz;
#pragma unroll
      for (int e = 0; e < 8; ++e) zz[e] = (f16)(ALPHA * (float)hv[e] + (float)v[e]);
      *(f16x8*)(z16 + o) = zz;
    }
    RAW_SYNC();
  }
}

#define HID_ROWS 73728
#define MOE_TAB (GEMM_LDS + 2048)
__device__ __forceinline__ void moe_tables(const int* counts, char* shm) {
  int* tab = (int*)(shm + MOE_TAB);
  if (threadIdx.x == 0) {
    int pf = 0, pn = 0, pr = 0;
    for (int e = 0; e < 32; ++e) {
      int n = counts[e * CNT_STRIDE];
      tab[e] = pf; tab[33 + e] = pn; tab[66 + e] = pr;
      pf += min(8, (n + 255) >> 8);
      pn += (max(n - 2048, 0) + 63) >> 6;
      pr += ((n + 255) >> 8) << 8;
    }
    tab[32] = pf; tab[65] = pn; tab[98] = pr;
  }
  __syncthreads();
}
__device__ __forceinline__ void moe_find(const int* pre, int item, int& e, int& mt) {
  e = 0;
  for (int i = 1; i < 32; ++i) if (item >= pre[i]) e = i;
  mt = item - pre[e];
}

#define NSLOT_B 20480
__device__ __forceinline__ void gemm_core_narrow(const f16* __restrict__ Ab, const unsigned (&pa)[NSTG], const f16* __restrict__ Bb,
                                                 unsigned pb, int nt, const int (&ablk)[2], f32x4 (&acc)[2][4], char* shm) {
  const int tid = opaque_tid(), wid = tid >> 6, lane = tid & 63, fr = lane & 15, fq = lane >> 4;
  const int nk = nt * 2;
  const bool hasb = (wid < 4);
#define SA(s_) (shm + (s_) * NSLOT_B)
#define SB(s_) (shm + (s_) * NSLOT_B + TILE_B)
#define NSTAGE(slot, kt)                                                                                                  \
  do {                                                                                                                    \
    _Pragma("unroll") for (int i = 0; i < NSTG; ++i)                                                                     \
      __builtin_amdgcn_global_load_lds((const unsigned*)(Ab + pa[i] + (kt) * 32), (unsigned*)(SA(slot) + wid * 1024 + i * 8192), \
                                       16, 0, 0);                                                                         \
    if (hasb) __builtin_amdgcn_global_load_lds((const unsigned*)(Bb + pb + (kt) * 32), (unsigned*)(SB(slot) + wid * 1024), 16, 0, 0); \
  } while (0)
  NSTAGE(0, 0);
  NSTAGE(1, 1);
  NSTAGE(2, 2);
  const int a0 = lds_byte(ablk[0] * 16 + fr, fq * 8), a1 = lds_byte(ablk[1] * 16 + fr, fq * 8), boff = lds_byte(fr, fq * 8);
  for (int t = 0; t < nk; ++t) {
    if (hasb) { if (t + 2 < nk) WAIT_V(6); else if (t + 1 < nk) WAIT_V(3); else WAIT_V(0); }
    else      { if (t + 2 < nk) WAIT_V(4); else if (t + 1 < nk) WAIT_V(2); else WAIT_V(0); }
    __builtin_amdgcn_s_barrier();
    if (t + 3 < nk) NSTAGE((t + 3) & 3, t + 3);
    const char* sa = SA(t & 3);
    const char* sb = SB(t & 3) + boff;
    f16x8 A0 = *(const f16x8*)(sa + a0), A1 = *(const f16x8*)(sa + a1), Bf[4];
#pragma unroll
    for (int n = 0; n < 4; ++n) Bf[n] = *(const f16x8*)(sb + n * 1024);
#pragma unroll
    for (int n = 0; n < 4; ++n) acc[0][n] = __builtin_amdgcn_mfma_f32_16x16x32_f16(A0, Bf[n], acc[0][n], 0, 0, 0);
#pragma unroll
    for (int n = 0; n < 4; ++n) acc[1][n] = __builtin_amdgcn_mfma_f32_16x16x32_f16(A1, Bf[n], acc[1][n], 0, 0, 0);
    WAIT_L(0);
  }
  RAW_SYNC();
#undef SA
#undef SB
#undef NSTAGE
}

__device__ __forceinline__ void p_moe_a(const Params& p, char* shm) {
  const f16* h1 = (const f16*)(p.ws + OFF_A);
  const f16* wgu = (const f16*)(p.ws + OFF_WGU);
  const int* counts = (const int*)(p.ws + OFF_CNT);
  const int* lists = (const int*)(p.ws + OFF_LISTS);
  f16* hid16 = (f16*)(p.ws + OFF_B);
  const int* tab = (const int*)(shm + MOE_TAB);
  const int tid = opaque_tid(), wid = tid >> 6, lane = tid & 63, wr = wid >> 2, wc = wid & 3, fr = lane & 15, fq = lane >> 4;
  int sR[NSTG], sC[NSTG];
#pragma unroll
  for (int i = 0; i < NSTG; ++i) stage_rc(wid * 1024 + i * 8192 + lane * 16, sR[i], sC[i]);
  moe_tables(counts, shm);
  const int total = tab[32] * 2;
  for (int r = 0;; ++r) {
    int item = xcd_item(total, r);
    if (item == -1) break;
    if (item < 0) continue;
    int e, mt;
    moe_find(tab, item >> 1, e, mt);
    const int fh = item & 1;
    const int cnt_e = counts[e * CNT_STRIDE];
    const int rowbase = tab[66 + e];
    unsigned pa[NSTG], pb[NSTG];
    f32x4 acc[8][4];
    zero_acc(acc);
#pragma unroll
    for (int i = 0; i < NSTG; ++i) {
      pa[i] = (unsigned)((e * 512 + fh * 256 + sR[i]) * 1024 + sC[i]);
      int idx = mt * 256 + sR[i];
      int tok = (idx < cnt_e) ? (lists[(size_t)e * T_TOK + idx] >> 1) : 0;
      pb[i] = (unsigned)(tok * 1024 + sC[i]);
    }
    gemm_core(wgu, pa, h1, pb, 16, acc, shm);
#pragma unroll
    for (int m = 0; m < 4; ++m)
#pragma unroll
      for (int n = 0; n < 4; ++n) {
        f16x4 o;
#pragma unroll
        for (int j = 0; j < 4; ++j) {
          float g = acc[m][n][j], u = acc[m + 4][n][j];
          o[j] = (f16)(g * u * __builtin_amdgcn_rcpf(1.0f + __builtin_amdgcn_exp2f(-1.4426950408889634f * g)));
        }
        size_t row = (size_t)rowbase + mt * 256 + wc * 64 + n * 16 + fr;
        *(f16x4*)(hid16 + row * 256 + fh * 128 + wr * 64 + m * 16 + fq * 4) = o;
      }
  }
  const int totaln = tab[65] * 2;
  for (int r = 0;; ++r) {
    int item = xcd_item(totaln, r);
    if (item == -1) break;
    if (item < 0) continue;
    int e, ntile;
    moe_find(tab + 33, item >> 1, e, ntile);
    const int fh = item & 1;
    const int cnt_e = counts[e * CNT_STRIDE];
    const int rowbase = tab[66 + e];
    const int wrn = wid >> 2, lq = wid & 3;
    const int ablk[2] = {wrn * 8 + lq, wrn * 8 + 4 + lq};
    unsigned pa[NSTG], pb = 0;
#pragma unroll
    for (int i = 0; i < NSTG; ++i) pa[i] = (unsigned)((e * 512 + fh * 256 + sR[i]) * 1024 + sC[i]);
    {
      int idx = 2048 + ntile * 64 + (sR[0] & 63);
      int tok = (idx < cnt_e) ? (lists[(size_t)e * T_TOK + idx] >> 1) : 0;
      pb = (unsigned)(tok * 1024 + sC[0]);
    }
    f32x4 acc[2][4];
#pragma unroll
    for (int m = 0; m < 2; ++m)
#pragma unroll
      for (int n = 0; n < 4; ++n) acc[m][n] = (f32x4){0.f, 0.f, 0.f, 0.f};
    gemm_core_narrow(wgu, pa, h1, pb, 16, ablk, acc, shm);
#pragma unroll
    for (int n = 0; n < 4; ++n) {
      f16x4 o;
#pragma unroll
      for (int j = 0; j < 4; ++j) {
        float g = acc[0][n][j], u = acc[1][n][j];
        o[j] = (f16)(g * u * __builtin_amdgcn_rcpf(1.0f + __builtin_amdgcn_exp2f(-1.4426950408889634f * g)));
      }
      size_t row = (size_t)rowbase + 2048 + ntile * 64 + n * 16 + fr;
      *(f16x4*)(hid16 + row * 256 + fh * 128 + wrn * 64 + lq * 16 + fq * 4) = o;
    }
  }
}

__device__ __forceinline__ void p_moe_b(const Params& p, char* shm) {
  const f16* wdn = (const f16*)(p.ws + OFF_WDN);
  const f16* hid16 = (const f16*)(p.ws + OFF_B);
  const float* route_w = (const float*)(p.ws + OFF_ROUTE_W);
  const int* counts = (const int*)(p.ws + OFF_CNT);
  const int* lists = (const int*)(p.ws + OFF_LISTS);
  f16* y16 = (f16*)(p.ws + OFF_C);
  int* sent = (int*)(shm + 256 * EPI_LD);
  const int* tab = (const int*)(shm + MOE_TAB);
  const int tid = opaque_tid(), wid = tid >> 6, lane = tid & 63, wc = wid & 3, fr = lane & 15, fq = lane >> 4;
  int sR[NSTG], sC[NSTG];
#pragma unroll
  for (int i = 0; i < NSTG; ++i) stage_rc(wid * 1024 + i * 8192 + lane * 16, sR[i], sC[i]);
  moe_tables(counts, shm);
  const int total = tab[32] * 4;
  for (int r = 0;; ++r) {
    int item = xcd_item(total, r);
    if (item == -1) break;
    if (item < 0) continue;
    int e, mt;
    moe_find(tab, item >> 2, e, mt);
    const int ft = item & 3;
    const int cnt_e = counts[e * CNT_STRIDE];
    const int rowbase = tab[66 + e];
    if (tid < 256) {
      int idx = mt * 256 + tid;
      sent[tid] = (idx < cnt_e) ? lists[(size_t)e * T_TOK + idx] : -1;
    }
    unsigned pa[NSTG], pb[NSTG];
    f32x4 acc[8][4];
    zero_acc(acc);
#pragma unroll
    for (int i = 0; i < NSTG; ++i) {
      pa[i] = (unsigned)((e * 1024 + ft * 256 + sR[i]) * 256 + sC[i]);
      pb[i] = (unsigned)((rowbase + mt * 256 + sR[i]) * 256 + sC[i]);
    }
    gemm_core(wdn, pa, hid16, pb, 4, acc, shm);
#pragma unroll
    for (int n = 0; n < 4; ++n) {
      int en = sent[wc * 64 + n * 16 + fr];
      float rw = (en >= 0) ? route_w[en] : 0.f;
#pragma unroll
      for (int m = 0; m < 8; ++m)
#pragma unroll
        for (int j = 0; j < 4; ++j) acc[m][n][j] *= rw;
    }
    epi_store_f16(acc, shm);
    RAW_SYNC();
    epi_rows_out(shm, [&](int rr) -> f16* { int en = sent[rr]; return (en >= 0) ? (y16 + (size_t)en * 1024 + ft * 256) : (f16*)nullptr; });
    RAW_SYNC();
  }
  const int totaln = tab[65] * 4;
  for (int r = 0;; ++r) {
    int item = xcd_item(totaln, r);
    if (item == -1) break;
    if (item < 0) continue;
    int e, ntile;
    moe_find(tab + 33, item >> 2, e, ntile);
    const int ft = item & 3;
    const int cnt_e = counts[e * CNT_STRIDE];
    const int rowbase = tab[66 + e];
    if (tid < 64) {
      int idx = 2048 + ntile * 64 + tid;
      sent[tid] = (idx < cnt_e) ? lists[(size_t)e * T_TOK + idx] : -1;
    }
    const int ablk[2] = {wid * 2, wid * 2 + 1};
    unsigned pa[NSTG], pb;
#pragma unroll
    for (int i = 0; i < NSTG; ++i) pa[i] = (unsigned)((e * 1024 + ft * 256 + sR[i]) * 256 + sC[i]);
    pb = (unsigned)((rowbase + 2048 + ntile * 64 + (sR[0] & 63)) * 256 + sC[0]);
    f32x4 acc[2][4];
#pragma unroll
    for (int m = 0; m < 2; ++m)
#pragma unroll
      for (int n = 0; n < 4; ++n) acc[m][n] = (f32x4){0.f, 0.f, 0.f, 0.f};
    gemm_core_narrow(wdn, pa, hid16, pb, 4, ablk, acc, shm);
#pragma unroll
    for (int n = 0; n < 4; ++n) {
      int en = sent[n * 16 + fr];
      float rw = (en >= 0) ? route_w[en] : 0.f;
#pragma unroll
      for (int m = 0; m < 2; ++m) {
        f16x4 v;
#pragma unroll
        for (int j = 0; j < 4; ++j) v[j] = (f16)(acc[m][n][j] * rw);
        *(f16x4*)(shm + (n * 16 + fr) * EPI_LD + (wid * 32 + m * 16 + fq * 4) * 2) = v;
      }
    }
    RAW_SYNC();
    {
      const int ch = tid & 31, r0 = tid >> 5;
#pragma unroll
      for (int ps = 0; ps < 4; ++ps) {
        int rr = ps * 16 + r0;
        f16x8 v = *(const f16x8*)(shm + rr * EPI_LD + ch * 16);
        int en = sent[rr];
        if (en >= 0) *(f16x8*)(y16 + (size_t)en * 1024 + ft * 256 + ch * 8) = v;
      }
    }
    RAW_SYNC();
  }
}

__device__ __forceinline__ unsigned f2key_(float f) {
  if (f == 0.f) f = 0.f;
  unsigned u = __float_as_uint(f);
  return (u & 0x80000000u) ? ~u : (u | 0x80000000u);
}
__device__ __forceinline__ float key2f_(unsigned k) {
  return __uint_as_float((k & 0x80000000u) ? (k & 0x7fffffffu) : ~k);
}
__device__ __forceinline__ void find_bin(const unsigned* hrow, int need, int lane, int* out_bin, int* out_above) {
  uint4 c = *(const uint4*)(hrow + 4 * lane);
  int tot = (int)(c.x + c.y + c.z + c.w);
  int incl = tot;
#pragma unroll
  for (int o = 1; o < 64; o <<= 1) {
    int v = __shfl_down(incl, o, 64);
    if (lane + o < 64) incl += v;
  }
  int above = incl - tot;
  if (above < need && incl >= need) {
    int b;
    if (above + (int)c.w >= need) b = 3;
    else { above += c.w; if (above + (int)c.z >= need) b = 2;
      else { above += c.z; if (above + (int)c.y >= need) b = 1; else { above += c.y; b = 0; } } }
    *out_bin = 4 * lane + b;
    *out_above = above;
  }
}

typedef short s16x4 __attribute__((ext_vector_type(4)));
#define VROW 160
#define ATT_WAVE_LDS (64 * VROW + 512)
__device__ __forceinline__ f16x8 tr_pair(const char* a, const char* b) {
  s16x4 x = __builtin_amdgcn_ds_read_tr16_b64_v4i16((__attribute__((address_space(3))) s16x4*)(a));
  s16x4 y = __builtin_amdgcn_ds_read_tr16_b64_v4i16((__attribute__((address_space(3))) s16x4*)(b));
  typedef short s16x8 __attribute__((ext_vector_type(8)));
  s16x8 r = __builtin_shufflevector(x, y, 0, 1, 2, 3, 4, 5, 6, 7);
  return __builtin_bit_cast(f16x8, r);
}
__device__ __forceinline__ void attn_one(const f16* __restrict__ proj16, f16* __restrict__ pa16, int t, const unsigned short* ssel,
                                         char* vimg, int lane) {
  const int fr = lane & 15, fq = lane >> 4;
  const int l = t & (SEQ - 1), b0 = t - l, cnt = min(l + 1, 256);
  f16x8 bq0, bq1;
  {
    const f16* qp = proj16 + (size_t)t * PJ_W + C_Q + (fr & 7) * 64 + fq * 8;
    bq0 = *(const f16x8*)qp;
    bq1 = *(const f16x8*)(qp + 32);
#pragma unroll
    for (int e = 0; e < 8; ++e) { bq0[e] = (fr < 8) ? bq0[e] * (f16)0.125f : (f16)0.f; bq1[e] = (fr < 8) ? bq1[e] * (f16)0.125f : (f16)0.f; }
  }
  const char* kbase = (const char*)(proj16 + (size_t)b0 * PJ_W + C_K);
  const char* vbase = (const char*)(proj16 + (size_t)b0 * PJ_W + C_V);
  f32x4 S[16];
#pragma unroll
  for (int kt = 0; kt < 16; ++kt) {
    const unsigned ko = (unsigned)ssel[kt * 16 + fr] * (PJ_W * 2) + fq * 16;
    f16x8 a0 = *(const f16x8*)(kbase + ko), a1 = *(const f16x8*)(kbase + ko + 64);
    f32x4 z = {0.f, 0.f, 0.f, 0.f};
    z = __builtin_amdgcn_mfma_f32_16x16x32_f16(a0, bq0, z, 0, 0, 0);
    z = __builtin_amdgcn_mfma_f32_16x16x32_f16(a1, bq1, z, 0, 0, 0);
#pragma unroll
    for (int j = 0; j < 4; ++j) S[kt][j] = (kt * 16 + fq * 4 + j < cnt) ? z[j] : NEG_BIG;
  }
  f16x8 vv[8];
#pragma unroll
  for (int i = 0; i < 8; ++i) {
    const unsigned vo = (unsigned)ssel[(lane >> 3) + 8 * i] * (PJ_W * 2) + (lane & 7) * 16;
    vv[i] = *(const f16x8*)(vbase + vo);
  }
  float m = NEG_BIG;
#pragma unroll
  for (int kt = 0; kt < 16; ++kt)
#pragma unroll
    for (int j = 0; j < 4; ++j) m = fmaxf(m, S[kt][j]);
  m = fmaxf(m, __shfl_xor(m, 16, 64));
  m = fmaxf(m, __shfl_xor(m, 32, 64));
  float lsum = 0.f;
  f16x8 P[8];
#pragma unroll
  for (int c = 0; c < 8; ++c)
#pragma unroll
    for (int j = 0; j < 4; ++j) {
      float e0 = __expf(S[2 * c][j] - m), e1 = __expf(S[2 * c + 1][j] - m);
      lsum += e0 + e1;
      P[c][j] = (f16)e0;
      P[c][4 + j] = (f16)e1;
    }
  lsum += __shfl_xor(lsum, 16, 64);
  lsum += __shfl_xor(lsum, 32, 64);
  f32x4 O[4];
#pragma unroll
  for (int nt = 0; nt < 4; ++nt) O[nt] = (f32x4){0.f, 0.f, 0.f, 0.f};
#pragma unroll
  for (int rr = 0; rr < 4; ++rr) {
    asm volatile("s_waitcnt lgkmcnt(0)" ::: "memory");
#pragma unroll
    for (int i = 0; i < 8; ++i) *(f16x8*)(vimg + ((lane >> 3) + 8 * i) * VROW + (lane & 7) * 16) = vv[i];
    if (rr < 3) {
#pragma unroll
      for (int i = 0; i < 8; ++i) {
        const unsigned vo = (unsigned)ssel[(rr + 1) * 64 + (lane >> 3) + 8 * i] * (PJ_W * 2) + (lane & 7) * 16;
        vv[i] = *(const f16x8*)(vbase + vo);
      }
    }
    asm volatile("s_waitcnt lgkmcnt(0)" ::: "memory");
#pragma unroll
    for (int cc = 0; cc < 2; ++cc) {
      const char* ra = vimg + (cc * 32 + fq * 4 + (fr >> 2)) * VROW + (fr & 3) * 8;
#pragma unroll
      for (int nt = 0; nt < 4; ++nt) {
        f16x8 B = tr_pair(ra + nt * 32, ra + 16 * VROW + nt * 32);
        O[nt] = __builtin_amdgcn_mfma_f32_16x16x32_f16(P[rr * 2 + cc], B, O[nt], 0, 0, 0);
      }
    }
  }
  asm volatile("s_waitcnt lgkmcnt(0)" ::: "memory");
#pragma unroll
  for (int j = 0; j < 4; ++j) {
    float ls = __shfl(lsum, (fq & 1) * 4 + j, 64);
    float inv = 1.0f / ls;
    if (fq < 2) {
      f16* op = pa16 + (size_t)t * DM + 512 + (fq * 4 + j) * 64 + fr;
#pragma unroll
      for (int nt = 0; nt < 4; ++nt) op[nt * 16] = (f16)(O[nt][j] * inv);
    }
  }
}

__device__ __forceinline__ f32x4 score_tile(const f16x8& a, const f16x8 (&bq)[8], const f16x8& bc_hi, const f16x8& bc_lo,
                                            const float (&wq)[8]) {
  f32x4 L[8];
#pragma unroll
  for (int h = 0; h < 8; ++h) L[h] = __builtin_amdgcn_mfma_f32_16x16x32_f16(a, bq[h], (f32x4){0.f, 0.f, 0.f, 0.f}, 0, 0, 0);
  f32x4 lin = __builtin_amdgcn_mfma_f32_16x16x32_f16(a, bc_lo, (f32x4){0.f, 0.f, 0.f, 0.f}, 0, 0, 0);
  lin = __builtin_amdgcn_mfma_f32_16x16x32_f16(a, bc_hi, lin, 0, 0, 0);
  __builtin_amdgcn_sched_barrier(0);
  float t0 = 0.f, t1 = 0.f, t2 = 0.f, t3 = 0.f;
#pragma unroll
  for (int h = 0; h < 8; ++h) {
    asm("v_fma_f32 %0, %1, |%2|, %0" : "+v"(t0) : "v"(wq[h]), "v"(L[h][0]));
    asm("v_fma_f32 %0, %1, |%2|, %0" : "+v"(t1) : "v"(wq[h]), "v"(L[h][1]));
    asm("v_fma_f32 %0, %1, |%2|, %0" : "+v"(t2) : "v"(wq[h]), "v"(L[h][2]));
    asm("v_fma_f32 %0, %1, |%2|, %0" : "+v"(t3) : "v"(wq[h]), "v"(L[h][3]));
  }
  f32x4 s = {t0 + lin[0], t1 + lin[1], t2 + lin[2], t3 + lin[3]};
  return s;
}

#define KEYS_LD 4104
#define IDX_KEYS 0
#define IDX_HIST 131584
#define IDX_SSEL (IDX_HIST + 16384)
#define IDX_CAND (IDX_SSEL + 8192)
#define IDX_MISC (IDX_CAND + 2048)
template <int V>
__device__ __forceinline__ void p_index(const Params& p, char* shm) {
  const f16* proj16 = (const f16*)(p.ws + OFF_B);
  f16* pa16 = (V == 0) ? (f16*)(p.ws + OFF_D) : (f16*)p.out;
  unsigned short* keys16 = (unsigned short*)(shm + IDX_KEYS);
  unsigned* hist = (unsigned*)(shm + IDX_HIST);
  unsigned short* ssel = (unsigned short*)(shm + IDX_SSEL);
  unsigned short* scand = (unsigned short*)(shm + IDX_CAND);
  unsigned* smm = (unsigned*)(shm + IDX_MISC);
  int* sbin = (int*)(smm + 32);
  const int tid = opaque_tid(), wid = tid >> 6, lane0 = tid & 63;
  const float NINF = -__builtin_huge_valf(), PINF = __builtin_huge_valf();
  for (int rnd = 0;; ++rnd) {
    int idx = rnd * gridDim.x + ((rnd & 1) ? (gridDim.x - 1 - blockIdx.x) : blockIdx.x);
    if (idx >= 2048) break;
    int lane = lane0;
    asm volatile("" : "+v"(lane));
    const int fr = lane & 15, fq = lane >> 4;
    const unsigned long long lt_mask = (1ull << lane) - 1ull;
    const int b = idx & 7, j = 255 - (idx >> 3);
    const int l0 = j * 16, t0 = b * SEQ + l0;
    if (j < 16) {
#pragma unroll 1
      for (int qq = 0; qq < 2; ++qq) {
        const int q = 2 * wid + qq, lq = l0 + q;
        unsigned short* sl = ssel + q * 256;
        for (int i = lane; i < 256; i += 64) sl[i] = (unsigned short)((i <= lq) ? i : 0);
        asm volatile("s_waitcnt lgkmcnt(0)" ::: "memory");
        attn_one(proj16, pa16, t0 + q, sl, (char*)(keys16 + (2 * wid) * KEYS_LD), lane);
      }
      __syncthreads();
      continue;
    }
    const int wids = __builtin_amdgcn_readfirstlane(wid);
    const int klast = (j - 1) - ((j - 1 - wids) & 7);
    const f16* kbase = (const f16*)(p.ws + OFF_IKC) + (size_t)(b * SEQ + fr) * 32 + fq * 8;
#define NB 8
#define IK_LOAD(dst, kt0)                                                                   \
  _Pragma("unroll") for (int u = 0; u < NB; ++u) {                                          \
    int ktc = min((kt0) + 8 * u, klast);                                                    \
    dst[u] = *(const f16x8*)(kbase + ktc * 512);                                            \
  }
    f16x8 bq[8];
    float wq[8];
    f16x8 afirst[NB];
    f16x8 wv;
    {
      const f16* qrow = proj16 + (size_t)(t0 + fr) * PJ_W;
#pragma unroll
      for (int h = 0; h < 8; ++h) bq[h] = *(const f16x8*)(qrow + C_IQ + h * 32 + fq * 8);
      wv = *(const f16x8*)(qrow + C_IW);
    }
    const f16x8 ad = *(const f16x8*)(kbase + j * 512);
    IK_LOAD(afirst, wids);
    for (int i = tid; i < 4096; i += 512) hist[i] = 0;
    if (tid < 16) { smm[tid] = 0xFFFFFFFFu; smm[16 + tid] = 0u; }
#pragma unroll
    for (int h = 0; h < 8; ++h) wq[h] = (float)wv[h];
    f16x8 bc_hi, bc_lo;
#pragma unroll
    for (int e = 0; e < 8; ++e) {
      float c = 0.f;
#pragma unroll
      for (int h = 0; h < 8; ++h) c = __builtin_fmaf(wq[h], (float)bq[h][e], c);
      f16 ch_ = (f16)c;
      bc_hi[e] = ch_;
      bc_lo[e] = (f16)(c - (float)ch_);
    }
    __syncthreads();
    {
      float mn = PINF, mx = NINF;
      f16x8 a[NB];
#pragma unroll
      for (int u = 0; u < NB; ++u) a[u] = afirst[u];
      const int astep = (j >= 32) ? 4 * 8 * NB : 8 * NB;
      for (int kt0 = wids; kt0 < j; kt0 += astep) {
        f16x8 an[NB];
        IK_LOAD(an, kt0 + astep);
#pragma unroll
        for (int u = 0; u < NB; ++u) {
          if (kt0 + 8 * u < j) {
            f32x4 sc = score_tile(a[u], bq, bc_hi, bc_lo, wq);
            mn = fminf(fminf(mn, sc[0]), fminf(fminf(sc[1], sc[2]), sc[3]));
            mx = fmaxf(fmaxf(mx, sc[0]), fmaxf(fmaxf(sc[1], sc[2]), sc[3]));
          }
        }
#pragma unroll
        for (int u = 0; u < NB; ++u) a[u] = an[u];
      }
      if ((j & 7) == wids) {
        f32x4 sc = score_tile(ad, bq, bc_hi, bc_lo, wq);
#pragma unroll
        for (int jj = 0; jj < 4; ++jj) {
          bool ok = (fq * 4 + jj <= fr);
          mn = fminf(mn, ok ? sc[jj] : PINF);
          mx = fmaxf(mx, ok ? sc[jj] : NINF);
        }
      }
      mn = fminf(mn, __shfl_xor(mn, 16, 64)); mn = fminf(mn, __shfl_xor(mn, 32, 64));
      mx = fmaxf(mx, __shfl_xor(mx, 16, 64)); mx = fmaxf(mx, __shfl_xor(mx, 32, 64));
      if (fq == 0) {
        if (mn != PINF) atomicMin(&smm[fr], f2key_(mn));
        if (mx != NINF) atomicMax(&smm[16 + fr], f2key_(mx));
      }
    }
    __syncthreads();
    {
      float lo = key2f_(smm[fr]), hi = key2f_(smm[16 + fr]);
      if (j >= 32) { const float mg = 0.125f * (hi - lo); lo -= mg; hi += mg; }
      const float s16 = (hi > lo) ? 65536.0f / (hi - lo) : 0.f;
      const float nlo = -lo * s16;
      unsigned* hq = hist + fr * 256;
      unsigned short* kq = keys16 + fr * KEYS_LD + fq * 4;
      f16x8 a[NB];
#pragma unroll
      for (int u = 0; u < NB; ++u) a[u] = afirst[u];
      for (int kt0 = wids; kt0 < j; kt0 += 8 * NB) {
        f16x8 an[NB];
        IK_LOAD(an, kt0 + 8 * NB);
#pragma unroll
        for (int u = 0; u < NB; ++u) {
          const int kt = kt0 + 8 * u;
          if (kt < j) {
            f32x4 sc = score_tile(a[u], bq, bc_hi, bc_lo, wq);
            unsigned kk[4];
#pragma unroll
            for (int jj = 0; jj < 4; ++jj) {
              int k16 = min(max((int)__builtin_fmaf(sc[jj], s16, nlo), 0), 65535);
              kk[jj] = (unsigned)k16;
              atomicAdd(&hq[k16 >> 8], 1u);
            }
            uint2 pk;
            pk.x = kk[0] | (kk[1] << 16);
            pk.y = kk[2] | (kk[3] << 16);
            *(uint2*)(kq + kt * 16) = pk;
          }
        }
#pragma unroll
        for (int u = 0; u < NB; ++u) a[u] = an[u];
      }
      if ((j & 7) == wids) {
        f32x4 sc = score_tile(ad, bq, bc_hi, bc_lo, wq);
        unsigned kk[4];
#pragma unroll
        for (int jj = 0; jj < 4; ++jj) {
          int k16 = min(max((int)__builtin_fmaf(sc[jj], s16, nlo), 0), 65535);
          kk[jj] = (unsigned)k16;
          if (fq * 4 + jj <= fr) atomicAdd(&hq[k16 >> 8], 1u);
        }
        uint2 pk;
        pk.x = kk[0] | (kk[1] << 16);
        pk.y = kk[2] | (kk[3] << 16);
        *(uint2*)(kq + j * 16) = pk;
      }
    }
#undef IK_LOAD
#undef NB
    __syncthreads();
    if (V == 2) continue;
    {
      const int q0 = 2 * wid, lq0 = l0 + q0;
      const int nmax = lq0 + 2;
      unsigned* hrow0 = hist + q0 * 256;
      const unsigned short* krow0 = keys16 + q0 * KEYS_LD;
      if (lane < 4) sbin[2 * q0 + lane] = 0;
      find_bin(hrow0, 256, lane, &sbin[2 * q0], &sbin[2 * q0 + 1]);
      find_bin(hrow0 + 256, 256, lane, &sbin[2 * q0 + 2], &sbin[2 * q0 + 3]);
      asm volatile("s_waitcnt lgkmcnt(0)" ::: "memory");
      const int b1s0 = sbin[2 * q0], ab0 = sbin[2 * q0 + 1], b1s1 = sbin[2 * q0 + 2], ab1 = sbin[2 * q0 + 3];
      asm volatile("s_waitcnt lgkmcnt(0)" ::: "memory");
      *(uint4*)(hrow0 + 4 * lane) = make_uint4(0u, 0u, 0u, 0u);
      *(uint4*)(hrow0 + 256 + 4 * lane) = make_uint4(0u, 0u, 0u, 0u);
      if (lane < 4) sbin[2 * q0 + lane] = 0;
      asm volatile("s_waitcnt lgkmcnt(0)" ::: "memory");
      for (int s4 = lane * 4; s4 < nmax; s4 += 256) {
        uint2 pa_ = *(const uint2*)(krow0 + s4), pb_ = *(const uint2*)(krow0 + KEYS_LD + s4);
        unsigned ka[4] = {pa_.x & 0xffffu, pa_.x >> 16, pa_.y & 0xffffu, pa_.y >> 16};
        unsigned kb[4] = {pb_.x & 0xffffu, pb_.x >> 16, pb_.y & 0xffffu, pb_.y >> 16};
#pragma unroll
        for (int jj = 0; jj < 4; ++jj) {
          if (s4 + jj <= lq0 && (int)(ka[jj] >> 8) == b1s0) atomicAdd(&hrow0[ka[jj] & 255u], 1u);
          if (s4 + jj <= lq0 + 1 && (int)(kb[jj] >> 8) == b1s1) atomicAdd(&hrow0[256 + (kb[jj] & 255u)], 1u);
        }
      }
      asm volatile("s_waitcnt lgkmcnt(0)" ::: "memory");
      find_bin(hrow0, 256 - ab0, lane, &sbin[2 * q0], &sbin[2 * q0 + 1]);
      find_bin(hrow0 + 256, 256 - ab1, lane, &sbin[2 * q0 + 2], &sbin[2 * q0 + 3]);
      asm volatile("s_waitcnt lgkmcnt(0)" ::: "memory");
      const unsigned thr0 = (unsigned)((b1s0 << 8) | sbin[2 * q0]), thr1 = (unsigned)((b1s1 << 8) | sbin[2 * q0 + 2]);
      int base0 = 0, cb0 = 0, base1 = 0, cb1 = 0;
      for (int s0 = 0; s0 < nmax; s0 += 256) {
        const int s4 = s0 + lane * 4;
        uint2 pa_ = make_uint2(0u, 0u), pb_ = make_uint2(0u, 0u);
        if (s4 < nmax) { pa_ = *(const uint2*)(krow0 + s4); pb_ = *(const uint2*)(krow0 + KEYS_LD + s4); }
        unsigned ka[4] = {pa_.x & 0xffffu, pa_.x >> 16, pa_.y & 0xffffu, pa_.y >> 16};
        unsigned kb[4] = {pb_.x & 0xffffu, pb_.x >> 16, pb_.y & 0xffffu, pb_.y >> 16};
#pragma unroll
        for (int jj = 0; jj < 4; ++jj) {
          const bool ok0 = (s4 + jj <= lq0), ok1 = (s4 + jj <= lq0 + 1);
          const bool t0_ = ok0 && (ka[jj] > thr0), c0_ = ok0 && (ka[jj] == thr0);
          const bool t1_ = ok1 && (kb[jj] > thr1), c1_ = ok1 && (kb[jj] == thr1);
          unsigned long long m0 = __ballot(t0_), m1 = __ballot(t1_), cm0 = __ballot(c0_), cm1 = __ballot(c1_);
          if (t0_) ssel[q0 * 256 + base0 + __popcll(m0 & lt_mask)] = (unsigned short)(s4 + jj);
          if (t1_) ssel[q0 * 256 + 256 + base1 + __popcll(m1 & lt_mask)] = (unsigned short)(s4 + jj);
          base0 += __popcll(m0); base1 += __popcll(m1);
          if (cm0 | cm1) {
            int cp0 = cb0 + __popcll(cm0 & lt_mask), cp1 = cb1 + __popcll(cm1 & lt_mask);
            if (c0_ && cp0 < 64) scand[q0 * 64 + cp0] = (unsigned short)(s4 + jj);
            if (c1_ && cp1 < 64) scand[q0 * 64 + 64 + cp1] = (unsigned short)(s4 + jj);
            cb0 += __popcll(cm0); cb1 += __popcll(cm1);
          }
        }
      }
      asm volatile("s_waitcnt lgkmcnt(0)" ::: "memory");
#pragma unroll
      for (int x = 0; x < 2; ++x) {
        const int q = q0 + x;
        const int base = x ? base1 : base0, c = min(x ? cb1 : cb0, 64), r = 256 - base;
        if (lane < c) {
          unsigned short my = scand[q * 64 + lane];
          int rank = 0;
          for (int k = 0; k < c; ++k) rank += (scand[q * 64 + k] < my) ? 1 : 0;
          if (rank < r) ssel[q * 256 + base + rank] = my;
        }
      }
    }
    asm volatile("s_waitcnt lgkmcnt(0)" ::: "memory");
#pragma unroll 1
    for (int qq = 0; qq < 2; ++qq) {
      const int q = 2 * wid + qq, lq = l0 + q;
      unsigned short* sl = ssel + q * 256;
      for (int i = lane; i < 256; i += 64) sl[i] = (unsigned short)min((int)sl[i], lq);
      asm volatile("s_waitcnt lgkmcnt(0)" ::: "memory");
      attn_one(proj16, pa16, t0 + q, sl, (char*)(keys16 + (2 * wid) * KEYS_LD), lane);
    }
    __syncthreads();
  }
}

#define DL_LD 1040
template <int W>
__device__ __forceinline__ void pool_delta(const f16* up, int lf, char* dp) {
  f16x8 u[W + 7];
#pragma unroll
  for (int k = 0; k < W + 7; ++k) {
    const int rel = k - (W - 1);
    f16x8 z = {(f16)0.f, (f16)0.f, (f16)0.f, (f16)0.f, (f16)0.f, (f16)0.f, (f16)0.f, (f16)0.f};
    u[k] = (lf + rel >= 0) ? *(const f16x8*)(up + (ptrdiff_t)rel * PJ_W) : z;
  }
  float sum[8];
#pragma unroll
  for (int e = 0; e < 8; ++e) sum[e] = 0.f;
#pragma unroll
  for (int k = 0; k < W - 1; ++k)
#pragma unroll
    for (int e = 0; e < 8; ++e) sum[e] += (float)u[k][e];
#pragma unroll
  for (int i = 0; i < 8; ++i) {
    const float inv = 1.0f / (float)min(lf + i + 1, W);
    f16x8 d;
#pragma unroll
    for (int e = 0; e < 8; ++e) {
      sum[e] += (float)u[W - 1 + i][e];
      d[e] = (f16)(sum[e] * inv - (float)u[W - 1 + i][e]);
      sum[e] -= (float)u[i][e];
    }
    *(f16x8*)(dp + i * DL_LD) = d;
  }
}
__device__ __forceinline__ void p_pool(const Params& p, char* shm) {
  const f16* proj16 = (const f16*)(p.ws + OFF_B);
  const f16* wpl = (const f16*)(p.ws + OFF_WPOOL);
  f16* pa16 = (f16*)(p.ws + OFF_D);
  const int tid = opaque_tid(), wid = tid >> 6, lane = tid & 63, fr = lane & 15, fq = lane >> 4;
  for (int item = blockIdx.x; item < T_TOK / 64; item += gridDim.x) {
    const int t0 = item * 64;
    {
      const int g = wid >> 1;
      const int c = g * 128 + ((wid & 1) * 8 + (lane & 7)) * 8;
      const int tg = lane >> 3;
      const int tf = t0 + tg * 8, lf = tf & (SEQ - 1);
      const f16* up = proj16 + (size_t)tf * PJ_W + c;
      char* dp = shm + (tg * 8) * DL_LD + c * 2;
      if (g == 0) pool_delta<2>(up, lf, dp);
      else if (g == 1) pool_delta<4>(up, lf, dp);
      else if (g == 2) pool_delta<8>(up, lf, dp);
      else pool_delta<16>(up, lf, dp);
    }
    __syncthreads();
    {
      const int g = wid >> 1, eh = wid & 1;
      f32x4 acc[4][4];
#pragma unroll
      for (int m = 0; m < 4; ++m)
#pragma unroll
        for (int n = 0; n < 4; ++n) acc[m][n] = (f32x4){0.f, 0.f, 0.f, 0.f};
#pragma unroll
      for (int ks = 0; ks < 4; ++ks) {
        f16x8 A[4], B[4];
#pragma unroll
        for (int m = 0; m < 4; ++m) A[m] = *(const f16x8*)(wpl + (size_t)(g * 128 + eh * 64 + m * 16 + fr) * 128 + ks * 32 + fq * 8);
#pragma unroll
        for (int n = 0; n < 4; ++n) B[n] = *(const f16x8*)(shm + (n * 16 + fr) * DL_LD + (g * 128 + ks * 32 + fq * 8) * 2);
#pragma unroll
        for (int m = 0; m < 4; ++m)
#pragma unroll
          for (int n = 0; n < 4; ++n) acc[m][n] = __builtin_amdgcn_mfma_f32_16x16x32_f16(A[m], B[n], acc[m][n], 0, 0, 0);
      }
#pragma unroll
      for (int m = 0; m < 4; ++m) {
        const int e0 = g * 128 + eh * 64 + m * 16 + fq * 4;
        float4 sc = *(const float4*)(p.pool_scale + e0);
#pragma unroll
        for (int n = 0; n < 4; ++n) {
          f16x4 o;
          o[0] = (f16)(acc[m][n][0] * sc.x); o[1] = (f16)(acc[m][n][1] * sc.y);
          o[2] = (f16)(acc[m][n][2] * sc.z); o[3] = (f16)(acc[m][n][3] * sc.w);
          *(f16x4*)(pa16 + (size_t)(t0 + n * 16 + fr) * DM + e0) = o;
        }
      }
    }
    __syncthreads();
  }
}

#define RW_LD 2064
#define RT_LDS (2 * 36 * RW_LD)
template <int V>
__device__ __forceinline__ void p_ln1_route(const Params& p, char* shm) {
  const f16* z16 = (const f16*)(p.ws + OFF_C);
  char* dmy = (char*)p.out;
  f16* h1 = (V == 0) ? (f16*)(p.ws + OFF_A) : (f16*)dmy;
  int* route_e = (V == 0) ? (int*)(p.ws + OFF_ROUTE_E) : (int*)(dmy + 68000000);
  float* route_w = (V == 0) ? (float*)(p.ws + OFF_ROUTE_W) : (float*)(dmy + 69000000);
  int* counts = (V == 0) ? (int*)(p.ws + OFF_CNT) : (int*)(dmy + 70000000);
  int* lists = (V == 0) ? (int*)(p.ws + OFF_LISTS) : (int*)(dmy + 71000000);
  int* lcnt = (int*)(shm + RT_LDS);
  int* lent = lcnt + 128;
  const int tid = opaque_tid(), wid = tid >> 6, lane = tid & 63, fr = lane & 15, fq = lane >> 4;
  if (tid < 128) lcnt[tid] = 0;
  {
    const f16* wsrc = (const f16*)(p.ws + OFF_WRT);
    for (int i = tid; i < 2 * 36 * 128; i += 512) {
      int img = i / (36 * 128), rem = i % (36 * 128), o = rem >> 7, c = rem & 127;
      *(f16x8*)(shm + (img * 36 + o) * RW_LD + c * 16) = *(const f16x8*)(wsrc + (size_t)(img * 36 + o) * 1024 + c * 8);
    }
  }
  __syncthreads();
  for (int t0 = (blockIdx.x * 8 + wid) * 16; t0 < T_TOK; t0 += gridDim.x * 8 * 16) {
    const f16* zr = z16 + (size_t)(t0 + fr) * DM + fq * 8;
    float s1 = 0.f, s2 = 0.f;
#pragma unroll 8
    for (int ks = 0; ks < 32; ++ks) {
      f16x8 xz = *(const f16x8*)(zr + ks * 32);
#pragma unroll
      for (int e = 0; e < 8; ++e) { float x = (float)xz[e]; s1 += x; s2 += x * x; }
    }
    s1 += __shfl_xor(s1, 16, 64); s1 += __shfl_xor(s1, 32, 64);
    s2 += __shfl_xor(s2, 16, 64); s2 += __shfl_xor(s2, 32, 64);
    const float mu = s1 * (1.0f / DM);
    const float rs = rsqrtf(fmaxf(s2 * (1.0f / DM) - mu * mu, 0.f) + 1e-5f);
    f32x4 acc[3];
#pragma unroll
    for (int mt = 0; mt < 3; ++mt) acc[mt] = (f32x4){0.f, 0.f, 0.f, 0.f};
    f16* hr = h1 + (size_t)(t0 + fr) * DM + fq * 8;
    const char* wa = shm + fr * RW_LD + fq * 16;
    const char* wa2 = shm + min(32 + fr, 35) * RW_LD + fq * 16;
#pragma unroll 4
    for (int ks = 0; ks < 32; ++ks) {
      f16x8 xz = *(const f16x8*)(zr + ks * 32);
      float4 g0 = *(const float4*)(p.ln1_g + ks * 32 + fq * 8), g1 = *(const float4*)(p.ln1_g + ks * 32 + fq * 8 + 4);
      float4 b0 = *(const float4*)(p.ln1_b + ks * 32 + fq * 8), b1 = *(const float4*)(p.ln1_b + ks * 32 + fq * 8 + 4);
      float hn[8];
      hn[0] = ((float)xz[0] - mu) * rs * g0.x + b0.x; hn[1] = ((float)xz[1] - mu) * rs * g0.y + b0.y;
      hn[2] = ((float)xz[2] - mu) * rs * g0.z + b0.z; hn[3] = ((float)xz[3] - mu) * rs * g0.w + b0.w;
      hn[4] = ((float)xz[4] - mu) * rs * g1.x + b1.x; hn[5] = ((float)xz[5] - mu) * rs * g1.y + b1.y;
      hn[6] = ((float)xz[6] - mu) * rs * g1.z + b1.z; hn[7] = ((float)xz[7] - mu) * rs * g1.w + b1.w;
      f16x8 bh, bl;
#pragma unroll
      for (int e = 0; e < 8; ++e) { bh[e] = (f16)hn[e]; bl[e] = (f16)(hn[e] - (float)bh[e]); }
      *(f16x8*)(hr + ks * 32) = bh;
#pragma unroll
      for (int mt = 0; mt < 3; ++mt) {
        const char* wp = (mt < 2) ? (wa + mt * 16 * RW_LD) : wa2;
        f16x8 ah = *(const f16x8*)(wp + ks * 64), al = *(const f16x8*)(wp + 36 * RW_LD + ks * 64);
        acc[mt] = __builtin_amdgcn_mfma_f32_16x16x32_f16(ah, bh, acc[mt], 0, 0, 0);
        acc[mt] = __builtin_amdgcn_mfma_f32_16x16x32_f16(ah, bl, acc[mt], 0, 0, 0);
        acc[mt] = __builtin_amdgcn_mfma_f32_16x16x32_f16(al, bh, acc[mt], 0, 0, 0);
      }
    }
    float lg[36];
#pragma unroll
    for (int o = 0; o < 36; ++o) lg[o] = __shfl(acc[o >> 4][o & 3], fr + 16 * ((o >> 2) & 3), 64);
    {
      float gl[4];
#pragma unroll
      for (int o = 0; o < 4; ++o) gl[o] = lg[o] + p.b_group[o];
      int g = 0;
      float m = gl[0];
#pragma unroll
      for (int o = 1; o < 4; ++o) if (gl[o] > m) { m = gl[o]; g = o; }
      float se = 0.f;
#pragma unroll
      for (int o = 0; o < 4; ++o) se += __expf(gl[o] - m);
      float pg = 1.0f / se;
      float v1 = -3e38f, v2 = -3e38f;
      int i1 = 0, i2 = 0;
#pragma unroll
      for (int jx = 0; jx < 8; ++jx) {
        float x = (g == 0) ? lg[4 + jx] : (g == 1) ? lg[12 + jx] : (g == 2) ? lg[20 + jx] : lg[28 + jx];
        x += p.b_router[g * 8 + jx];
        if (x > v1) { v2 = v1; i2 = i1; v1 = x; i1 = jx; }
        else if (x > v2) { v2 = x; i2 = jx; }
      }
      if (fq == 0) {
        const int tt = t0 + fr;
        float e2 = __expf(v2 - v1);
        float w1 = pg / (1.0f + e2), w2 = pg * e2 / (1.0f + e2);
        int ea = g * 8 + i1, eb = g * 8 + i2;
        route_e[2 * tt] = ea; route_e[2 * tt + 1] = eb;
        route_w[2 * tt] = w1; route_w[2 * tt + 1] = w2;
        int la = atomicAdd(&lcnt[ea], 1), lb = atomicAdd(&lcnt[eb], 1);
        int slot = atomicAdd(&lcnt[64], 2);
        if (slot + 1 < 512) {
          lent[2 * slot] = (ea << 16) | la; lent[2 * slot + 1] = 2 * tt;
          lent[2 * slot + 2] = (eb << 16) | lb; lent[2 * slot + 3] = 2 * tt + 1;
        }
      }
    }
  }
  __syncthreads();
  if (tid < 32) lcnt[32 + tid] = atomicAdd(&counts[tid * CNT_STRIDE], lcnt[tid]);
  __syncthreads();
  {
    const int n_ent = min(lcnt[64], 512);
    for (int i = tid; i < n_ent; i += 512) {
      int ev = lent[2 * i], id = lent[2 * i + 1];
      int e = ev >> 16, lp = ev & 0xffff;
      lists[(size_t)e * T_TOK + lcnt[32 + e] + lp] = id;
    }
  }
  __syncthreads();
}

__device__ __forceinline__ void p_final(const Params& p) {
  const f16* h1 = (const f16*)(p.ws + OFF_A);
  const f16* y16 = (const f16*)(p.ws + OFF_C);
  const int tid = opaque_tid(), wid = tid >> 6, lane = tid & 63;
  const int nw = gridDim.x * 8;
  int t = blockIdx.x * 8 + wid;
  f16x8 hv[2], y0[2], y1[2];
#define P7_LOAD(tt)                                                                          \
  _Pragma("unroll") for (int i = 0; i < 2; ++i) {                                            \
    hv[i] = *(const f16x8*)(h1 + (size_t)(tt) * DM + i * 512 + lane * 8);                    \
    y0[i] = *(const f16x8*)(y16 + (size_t)(2 * (tt)) * DM + i * 512 + lane * 8);             \
    y1[i] = *(const f16x8*)(y16 + (size_t)(2 * (tt) + 1) * DM + i * 512 + lane * 8);         \
  }
  if (t < T_TOK) { P7_LOAD(t); }
  for (; t < T_TOK; t += nw) {
    float v[16];
#pragma unroll
    for (int i = 0; i < 2; ++i)
#pragma unroll
      for (int e = 0; e < 8; ++e) v[i * 8 + e] = ALPHA * (float)hv[i][e] + ((float)y0[i][e] + (float)y1[i][e]);
    if (t + nw < T_TOK) { P7_LOAD(t + nw); }
    float s = 0.f;
#pragma unroll
    for (int i = 0; i < 16; ++i) s += v[i];
    float mu = wave_sum(s) * (1.0f / DM);
    float q = 0.f;
#pragma unroll
    for (int i = 0; i < 16; ++i) { v[i] -= mu; q += v[i] * v[i]; }
    float rs = rsqrtf(wave_sum(q) * (1.0f / DM) + 1e-5f);
#pragma unroll
    for (int i = 0; i < 2; ++i)
#pragma unroll
      for (int hf = 0; hf < 2; ++hf) {
        const int c = i * 512 + lane * 8 + hf * 4;
        float4 g = *(const float4*)(p.ln2_g + c), b = *(const float4*)(p.ln2_b + c);
        f32x4 o;
        o[0] = v[i * 8 + hf * 4 + 0] * rs * g.x + b.x; o[1] = v[i * 8 + hf * 4 + 1] * rs * g.y + b.y;
        o[2] = v[i * 8 + hf * 4 + 2] * rs * g.z + b.z; o[3] = v[i * 8 + hf * 4 + 3] * rs * g.w + b.w;
        *(f32x4*)(p.out + (size_t)t * DM + c) = o;
      }
  }
#undef P7_LOAD
}

#define MEGA_LDS 159232


#define XB_TMO      128
#define XB_XCNT(j)  (256  + 64 * (j))
#define XB_XSUB(j)  (1280 + 64 * (j))
#define XB_XGEN(j)  (2304 + 64 * (j))
#define XB_TOP      3328
#define XB_TOPGEN   3392
#define XCD_BAR_WORDS 3456
#define XB_SPIN_CAP (1u << 22)
#define LAS __attribute__((address_space(3)))
__device__ __forceinline__ unsigned xb_ld(unsigned* p) { return __hip_atomic_load(p, __ATOMIC_RELAXED, __HIP_MEMORY_SCOPE_AGENT); }
__device__ __forceinline__ unsigned xb_add(unsigned* p, unsigned v) { return __hip_atomic_fetch_add(p, v, __ATOMIC_RELAXED, __HIP_MEMORY_SCOPE_AGENT); }
__device__ __forceinline__ unsigned xb_xcc_id() { return (unsigned)__builtin_amdgcn_s_getreg((3 << 11) | 20) & 0xFu; }
#define XB_SPIN(cond, bar) do { unsigned _sp = 0; while (cond) { __builtin_amdgcn_s_sleep(1); \
    if ((++_sp & 255u) == 0u) { if (xb_ld(&(bar)[XB_TMO])) break; if (_sp > XB_SPIN_CAP) { atomicAdd(&(bar)[XB_TMO], 1u); break; } } } } while (0)
struct XcdBarrier { unsigned* bar; unsigned x; volatile unsigned* st; };
__device__ __forceinline__ XcdBarrier xcd_barrier_post(unsigned* bar, volatile unsigned* st) {
  XcdBarrier b; b.bar = bar; b.x = xb_xcc_id(); b.st = st;
  if (threadIdx.x == 0) (void)xb_add(&bar[XB_XCNT(b.x)], 1u);
  return b;
}
__device__ __forceinline__ void xcd_barrier_complete(unsigned* bar, unsigned x, unsigned& nloc, unsigned& nx) {
  const unsigned G = gridDim.x * gridDim.y * gridDim.z;
  unsigned sum, cnt, mine, sp = 0u;
  for (;;) {
    sum = 0u; cnt = 0u; mine = 0u;
#pragma unroll
    for (unsigned j = 0; j < 16; ++j) { const unsigned c = xb_ld(&bar[XB_XCNT(j)]); sum += c; cnt += (c > 0u) ? 1u : 0u; mine = (j == x) ? c : mine; }
    if (sum == G) break;
    __builtin_amdgcn_s_sleep(1);
    if ((++sp & 255u) == 0u) { if (xb_ld(&bar[XB_TMO])) break; if (sp > XB_SPIN_CAP) { atomicAdd(&bar[XB_TMO], 1u); break; } }
  }
  nloc = mine > 0u ? mine : 1u; nx = cnt > 0u ? cnt : 1u;
}
__device__ __forceinline__ void xcd_barrier(const XcdBarrier& b) {
  asm volatile("s_waitcnt vmcnt(0)" ::: "memory");
  __syncthreads();
  if (threadIdx.x == 0) {
    unsigned* bar = b.bar;
    __builtin_amdgcn_s_waitcnt(0);
    unsigned nloc = b.st[0], nx = b.st[1];
    if (nloc == 0u) { xcd_barrier_complete(bar, b.x, nloc, nx); b.st[0] = nloc; b.st[1] = nx; }
    const unsigned old = xb_add(&bar[XB_XSUB(b.x)], 1u);
    const unsigned gen = old / nloc;
    if (old + 1u == (gen + 1u) * nloc) {
      __builtin_amdgcn_fence(__ATOMIC_RELEASE, "agent");
      asm volatile("s_waitcnt vmcnt(0)" ::: "memory");
      const unsigned og = xb_add(&bar[XB_TOP], 1u);
      const unsigned tg = og / nx;
      if (og + 1u == (tg + 1u) * nx) xb_add(&bar[XB_TOPGEN], 1u);
      else XB_SPIN(xb_ld(&bar[XB_TOPGEN]) == tg, bar);
      __builtin_amdgcn_fence(__ATOMIC_ACQUIRE, "agent");
      xb_add(&bar[XB_XGEN(b.x)], 1u);
      asm volatile("s_waitcnt vmcnt(0)" ::: "memory");
    } else {
      XB_SPIN(xb_ld(&bar[XB_XGEN(b.x)]) == gen, bar);
      __builtin_amdgcn_fence(__ATOMIC_ACQUIRE, "agent");
      asm volatile("s_waitcnt vmcnt(0)" ::: "memory");
    }
  }
  __syncthreads();
}

#ifndef PROBE
#define PROBE 0
#endif
#define GSYNC() do { XcdBarrier xb_; xb_.bar = (unsigned*)(p.ws + OFF_BAR); xb_.x = xb_xcc_id(); xb_.st = (volatile unsigned*)(shm + MEGA_LDS); xcd_barrier(xb_); } while (0)
#define PH(n, code) do { code; if (PROBE == n) { GSYNC(); code; } } while (0)
__global__ __launch_bounds__(512) void mega(Params p) {
  __shared__ __attribute__((aligned(1024))) char shm[MEGA_LDS + 16];
  volatile unsigned* xst = (volatile unsigned*)(shm + MEGA_LDS);
  if (threadIdx.x < 4) xst[threadIdx.x] = 0u;
  __syncthreads();
  (void)xcd_barrier_post((unsigned*)(p.ws + OFF_BAR), xst);
  if (blockIdx.x == 0 && threadIdx.x < 32) ((int*)(p.ws + OFF_CNT))[threadIdx.x * CNT_STRIDE] = 0;
  PH(1, p_ln_in(p));
  PH(2, p_convert(p, shm));
  GSYNC();
  PH(3, p_inproj(p, shm));
  GSYNC();
  PH(4, p_pool(p, shm));
  PH(5, p_index<0>(p, shm));
#if PROBE >= 50 && PROBE < 60
  GSYNC();
  p_index<PROBE - 50>(p, shm);
#endif
  GSYNC();
  PH(7, p_merge(p, shm));
  GSYNC();
  PH(8, p_resid(p, shm));
  GSYNC();
  p_ln1_route<0>(p, shm);
  GSYNC();
#if PROBE == 9
  if (blockIdx.x == 0 && threadIdx.x < 32) ((int*)((char*)p.out + 70000000))[threadIdx.x * CNT_STRIDE] = 0;
  GSYNC();
  p_ln1_route<1>(p, shm);
  GSYNC();
#endif
  PH(10, p_moe_a(p, shm));
  GSYNC();
  PH(11, p_moe_b(p, shm));
  GSYNC();
  PH(12, p_final(p));
}

extern "C" void kernel_launch(void* const* d_in, const int* in_sizes, int n_in, void* d_out, int out_size, void* d_ws,
                              size_t ws_size, hipStream_t stream) {
  if (ws_size < WS_NEEDED) { fprintf(stderr, "ws too small: %zu < %zu\n", ws_size, (size_t)WS_NEEDED); return; }
  static int grid_blocks = 0;
  if (!grid_blocks) {
    int dev = 0, cus = 0, per_cu = 0;
    hipGetDevice(&dev);
    hipDeviceGetAttribute(&cus, hipDeviceAttributeMultiprocessorCount, dev);
    hipOccupancyMaxActiveBlocksPerMultiprocessor(&per_cu, mega, 512, 0);
    if (per_cu > 1) per_cu = 1;
    grid_blocks = cus * per_cu;
    fprintf(stderr, "mega: cus=%d per_cu=%d grid=%d\n", cus, per_cu, grid_blocks);
  }
  Params p{};
  const float** pp = (const float**)&p;
  for (int i = 0; i < 21; ++i) pp[i] = (const float*)d_in[i];
  p.out = (float*)d_out;
  p.ws = (char*)d_ws;
  (void)hipMemsetAsync((char*)d_ws + OFF_BAR, 0, 16384, stream);
  void* args[] = {&p};
  hipError_t e = hipLaunchCooperativeKernel((void*)mega, dim3(grid_blocks), dim3(512), args, 0, stream);
  if (e != hipSuccess) fprintf(stderr, "cooperative launch failed: %s (grid %d)\n", hipGetErrorString(e), grid_blocks);
}
```

```cpp
#include <hip/hip_runtime.h>
#include <hip/hip_fp16.h>
#include <hip/hip_cooperative_groups.h>
#include <stdint.h>
#include <stdio.h>
namespace cg = cooperative_groups;

typedef _Float16 f16;
typedef f16 f16x8 __attribute__((ext_vector_type(8)));
typedef f16 f16x4 __attribute__((ext_vector_type(4)));
typedef f16 f16x2 __attribute__((ext_vector_type(2)));
typedef float f32x4 __attribute__((ext_vector_type(4)));
typedef int i32x4 __attribute__((ext_vector_type(4)));

#define T_TOK 32768
#define DM 1024
#define SEQ 4096
#define PJ_W 1536
#define PA_W 1448
#define IN_W 3496
#define IN_WP 3584
#define C_Q 512
#define C_K 1024
#define C_V 1088
#define C_IQ 1152
#define C_IK 1408
#define C_IW 1440
#define ALPHA 1.189207115002721f
#define NEG_BIG (-1e30f)

#define SZ_A   ((size_t)T_TOK * DM * 2)
#define SZ_B   ((size_t)T_TOK * PJ_W * 2)
#define SZ_C   ((size_t)T_TOK * 2048 * 2)
#define SZ_D   ((size_t)T_TOK * DM * 2)
#define OFF_A  ((size_t)0)
#define OFF_B  (OFF_A + SZ_A)
#define OFF_C  (OFF_B + SZ_B)
#define OFF_D  (OFF_C + SZ_C)
#define OFF_W  (OFF_D + SZ_D)
#define OFF_WIN   (OFF_W)
#define OFF_WPOOL (OFF_WIN + (size_t)IN_WP * 1024 * 2)
#define OFF_WPP   (OFF_WPOOL + (size_t)4 * 128 * 128 * 2)
#define OFF_WPA   (OFF_WPP + (size_t)1024 * 512 * 2)
#define OFF_WOUT  (OFF_WPA + (size_t)1024 * 512 * 2)
#define OFF_WGU   (OFF_WOUT + (size_t)1024 * 1024 * 2)
#define OFF_WDN   (OFF_WGU + (size_t)32 * 512 * 1024 * 2)
#define OFF_MISC  (OFF_WDN + (size_t)32 * 1024 * 256 * 2)
#define OFF_ROUTE_E (OFF_MISC)
#define OFF_ROUTE_W (OFF_ROUTE_E + (size_t)T_TOK * 2 * 4)
#define OFF_COUNTS  (OFF_ROUTE_W + (size_t)T_TOK * 2 * 4)
#define OFF_LISTS   (OFF_COUNTS + 256)
#define OFF_SEL     (OFF_LISTS + (size_t)32 * T_TOK * 4)
#define OFF_CNT      (OFF_SEL + (size_t)T_TOK * 256 * 2)
#define OFF_WRT      (OFF_CNT + 4096)
#define OFF_IKC      (OFF_WRT + 2 * 36 * 1024 * 2)
#define OFF_BAR      (OFF_IKC + (size_t)T_TOK * 32 * 2)
#define WS_NEEDED   (OFF_BAR + 16384)
#define CNT_STRIDE 32

struct Params {
  const float *x, *ln_in_g, *ln_in_b, *w_in, *b_gate, *pool_w, *pool_scale, *wpp, *wpa, *w_out, *ln1_g, *ln1_b, *w_group,
      *b_group, *w_router, *b_router, *w_gate, *w_up, *w_down, *ln2_g, *ln2_b;
  float* out;
  char* ws;
};

__device__ __forceinline__ float wave_sum(float v) {
#pragma unroll
  for (int o = 32; o > 0; o >>= 1) v += __shfl_xor(v, o, 64);
  return v;
}
__device__ __forceinline__ float wave_max(float v) {
#pragma unroll
  for (int o = 32; o > 0; o >>= 1) v = fmaxf(v, __shfl_xor(v, o, 64));
  return v;
}
__device__ __forceinline__ int wave_sum_i(int v) {
#pragma unroll
  for (int o = 32; o > 0; o >>= 1) v += __shfl_xor(v, o, 64);
  return v;
}
__device__ __forceinline__ int opaque_tid() { int t = threadIdx.x; asm volatile("" : "+v"(t)); return t; }
__device__ __forceinline__ float ldf(const float* p) { return *p; }
__device__ __forceinline__ float ldf(const f16* p) { return (float)*p; }

#ifndef SKEW_P1
#define SKEW_P1 0
#endif
#define WAIT_V(n) asm volatile("s_waitcnt vmcnt(%0)" ::"n"(n) : "memory")
#define WAIT_L(n) asm volatile("s_waitcnt lgkmcnt(%0)" ::"n"(n) : "memory")
template <class T> __device__ __forceinline__ void st_nt(T* p, const T& v) { *p = v; }
#define RAW_SYNC() do { asm volatile("s_waitcnt lgkmcnt(0)" ::: "memory"); __builtin_amdgcn_s_barrier(); asm volatile("" ::: "memory"); } while (0)

__device__ __forceinline__ int lds_byte(int r, int c) {
  int ob = (r & 15) * 64 + c * 2;
  return (r >> 4) * 1024 + (ob ^ (((ob >> 9) & 1) << 5));
}
__device__ __forceinline__ void stage_rc(int b, int& R, int& C) {
  int st = b >> 10, sb = b & 1023, swz = sb ^ (((sb >> 9) & 1) << 5);
  R = st * 16 + swz / 64;
  C = (swz % 64) / 2;
}

#define TILE_B 16384
#define SLOT_B 32768
#define NSTG 2
#define GEMM_LDS 135168
#define EPI_LD 528

__device__ __forceinline__ void gemm_core(const f16* __restrict__ Ab, const unsigned (&pa)[NSTG], const f16* __restrict__ Bb,
                                          const unsigned (&pb)[NSTG], int nt, f32x4 (&acc)[8][4], char* shm) {
  const int tid = opaque_tid(), wid = tid >> 6, lane = tid & 63, wr = wid >> 2, wc = wid & 3, fr = lane & 15, fq = lane >> 4;
  const int nk = nt * 2;
#define SA(s_) (shm + (s_) * SLOT_B)
#define SB(s_) (shm + (s_) * SLOT_B + TILE_B)
#define GLDS_STAGE(slot, kt)                                                                                              \
  do {                                                                                                                    \
    _Pragma("unroll") for (int i = 0; i < NSTG; ++i) {                                                                   \
      __builtin_amdgcn_global_load_lds((const unsigned*)(Ab + pa[i] + (kt) * 32), (unsigned*)(SA(slot) + wid * 1024 + i * 8192), \
                                       16, 0, 0);                                                                         \
      __builtin_amdgcn_global_load_lds((const unsigned*)(Bb + pb[i] + (kt) * 32), (unsigned*)(SB(slot) + wid * 1024 + i * 8192), \
                                       16, 0, 0);                                                                         \
    }                                                                                                                     \
  } while (0)
  GLDS_STAGE(0, 0);
  GLDS_STAGE(1, 1);
  GLDS_STAGE(2, 2);
  const int aoff = lds_byte(wr * 128 + fr, fq * 8), boff = lds_byte(wc * 64 + fr, fq * 8);
  WAIT_V(8);
  __builtin_amdgcn_s_barrier();
  if (wr == 1) __builtin_amdgcn_s_barrier();
  for (int t = 0; t < nk; ++t) {
    if (t + 3 < nk) { GLDS_STAGE((t + 3) & 3, t + 3); WAIT_V(8); }
    else if (t + 2 < nk) WAIT_V(4);
    else WAIT_V(0);
    const char* sa = SA(t & 3) + aoff;
    const char* sb = SB(t & 3) + boff;
    f16x8 At[8], Bf[4];
#pragma unroll
    for (int n = 0; n < 4; ++n) Bf[n] = *(const f16x8*)(sb + n * 1024);
#pragma unroll
    for (int m = 0; m < 8; ++m) At[m] = *(const f16x8*)(sa + m * 1024);
    WAIT_L(0);
    __builtin_amdgcn_sched_barrier(0);
    __builtin_amdgcn_s_barrier();
    __builtin_amdgcn_sched_barrier(0);
#pragma unroll
    for (int m = 0; m < 8; ++m)
#pragma unroll
      for (int n = 0; n < 4; ++n) acc[m][n] = __builtin_amdgcn_mfma_f32_16x16x32_f16(At[m], Bf[n], acc[m][n], 0, 0, 0);
    __builtin_amdgcn_sched_barrier(0);
    __builtin_amdgcn_s_barrier();
    __builtin_amdgcn_sched_barrier(0);
  }
  if (wr == 0) __builtin_amdgcn_s_barrier();
  RAW_SYNC();
#undef SA
#undef SB
#undef GLDS_STAGE
}

__device__ __forceinline__ void epi_store_f16(const f32x4 (&acc)[8][4], char* shm) {
  const int tid = opaque_tid(), wid = tid >> 6, lane = tid & 63, wr = wid >> 2, wc = wid & 3, fr = lane & 15, fq = lane >> 4;
#pragma unroll
  for (int m = 0; m < 8; ++m)
#pragma unroll
    for (int n = 0; n < 4; ++n) {
      f16x4 v;
      v[0] = (f16)acc[m][n][0]; v[1] = (f16)acc[m][n][1]; v[2] = (f16)acc[m][n][2]; v[3] = (f16)acc[m][n][3];
      *(f16x4*)(shm + (wc * 64 + n * 16 + fr) * EPI_LD + (wr * 128 + m * 16 + fq * 4) * 2) = v;
    }
}

__device__ __forceinline__ void p_ln_in(const Params& p) {
  f16* h16 = (f16*)(p.ws + OFF_A);
  const int tid = opaque_tid(), lane = tid & 63, wid = tid >> 6;
  const int nw = gridDim.x * 8;
  for (int t = blockIdx.x * 8 + wid; t < T_TOK; t += nw) {
    const float* xr = p.x + (size_t)t * DM;
    float4 v[4];
#pragma unroll
    for (int i = 0; i < 4; ++i) v[i] = *(const float4*)(xr + i * 256 + lane * 4);
    float s = 0.f;
#pragma unroll
    for (int i = 0; i < 4; ++i) s += v[i].x + v[i].y + v[i].z + v[i].w;
    float mu = wave_sum(s) * (1.0f / DM);
    float q = 0.f;
#pragma unroll
    for (int i = 0; i < 4; ++i) {
      v[i].x -= mu; v[i].y -= mu; v[i].z -= mu; v[i].w -= mu;
      q += v[i].x * v[i].x + v[i].y * v[i].y + v[i].z * v[i].z + v[i].w * v[i].w;
    }
    float rs = rsqrtf(wave_sum(q) * (1.0f / DM) + 1e-5f);
#pragma unroll
    for (int i = 0; i < 4; ++i) {
      float4 g = *(const float4*)(p.ln_in_g + i * 256 + lane * 4), b = *(const float4*)(p.ln_in_b + i * 256 + lane * 4);
      f16x4 o;
      o[0] = (f16)(v[i].x * rs * g.x + b.x); o[1] = (f16)(v[i].y * rs * g.y + b.y);
      o[2] = (f16)(v[i].z * rs * g.z + b.z); o[3] = (f16)(v[i].w * rs * g.w + b.w);
      *(f16x4*)(h16 + (size_t)t * DM + i * 256 + lane * 4) = o;
    }
  }
}

template <class RowMap>
__device__ __forceinline__ void conv_tile(const float* __restrict__ src, int ld_src, int nvalid, int k0, int n0, f16* __restrict__ dst,
                                          int ld_dst, RowMap rm, float* sT) {
  const int tid = opaque_tid();
  {
    int k = tid >> 3, n = (tid & 7) * 8;
    const float* sp = src + (size_t)(k0 + k) * ld_src + n0 + n;
#pragma unroll
    for (int j = 0; j < 8; ++j) sT[k * 65 + n + j] = (n0 + n + j < nvalid) ? sp[j] : 0.f;
  }
  __syncthreads();
  {
    int n = tid >> 3, k = (tid & 7) * 8;
    f16x8 o;
#pragma unroll
    for (int j = 0; j < 8; ++j) o[j] = (f16)sT[(k + j) * 65 + n];
    int drow = rm(n0 + n);
    if (drow >= 0) *(f16x8*)(dst + (size_t)drow * ld_dst + k0 + k) = o;
  }
  __syncthreads();
}

struct RowId { __device__ int operator()(int n) const { return n; } };
struct RowGU { int up; __device__ int operator()(int ff) const {
  int tile = ff >> 7, wr = (ff >> 6) & 1, l = ff & 63; return tile * 256 + wr * 128 + up * 64 + l; } };

__device__ __forceinline__ void p_convert(const Params& p, char* shm) {
  float* sT = (float*)shm;
  char* ws = p.ws;
  const int J0 = 16 * 56, J1 = J0 + 16, J2 = J1 + 128, J3 = J2 + 128, J4 = J3 + 256, J5 = J4 + 32 * 64, J6 = J5 + 32 * 64,
            J7 = J6 + 32 * 64;
  for (int job = blockIdx.x; job < J7; job += gridDim.x) {
    if (job < J0) {
      int kt = job / 56, nt = job % 56;
      conv_tile(p.w_in, IN_W, IN_W, kt * 64, nt * 64, (f16*)(ws + OFF_WIN), 1024, RowId(), sT);
    } else if (job < J1) {
      int j = job - J0, g = j >> 2, kt = (j >> 1) & 1, nt = j & 1;
      conv_tile(p.pool_w + g * 128 * 128, 128, 128, kt * 64, nt * 64, (f16*)(ws + OFF_WPOOL) + g * 128 * 128, 128, RowId(), sT);
    } else if (job < J2) {
      int j = job - J1, kt = j >> 4, nt = j & 15;
      conv_tile(p.wpp, 1024, 1024, kt * 64, nt * 64, (f16*)(ws + OFF_WPP), 512, RowId(), sT);
    } else if (job < J3) {
      int j = job - J2, kt = j >> 4, nt = j & 15;
      conv_tile(p.wpa, 1024, 1024, kt * 64, nt * 64, (f16*)(ws + OFF_WPA), 512, RowId(), sT);
    } else if (job < J4) {
      int j = job - J3, kt = j >> 4, nt = j & 15;
      conv_tile(p.w_out, 1024, 1024, kt * 64, nt * 64, (f16*)(ws + OFF_WOUT), 1024, RowId(), sT);
    } else if (job < J6) {
      int up = job >= J5;
      int j = job - (up ? J5 : J4), e = j >> 6, kt = (j >> 2) & 15, nt = j & 3;
      RowGU rm; rm.up = up;
      conv_tile((up ? p.w_up : p.w_gate) + (size_t)e * 1024 * 256, 256, 256, kt * 64, nt * 64,
                (f16*)(ws + OFF_WGU) + (size_t)e * 512 * 1024, 1024, rm, sT);
    } else {
      int j = job - J6, e = j >> 6, kt = (j >> 4) & 3, nt = j & 15;
      conv_tile(p.w_down + (size_t)e * 256 * 1024, 1024, 1024, kt * 64, nt * 64, (f16*)(ws + OFF_WDN) + (size_t)e * 1024 * 256,
                256, RowId(), sT);
    }
  }
  {
    f16* whi = (f16*)(ws + OFF_WRT);
    f16* wlo = whi + 36 * 1024;
    for (int i = blockIdx.x * 512 + threadIdx.x; i < 36 * 1024; i += gridDim.x * 512) {
      int o = i >> 10, k = i & 1023;
      float w = (o < 4) ? p.w_group[k * 4 + o] : p.w_router[k * 32 + (o - 4)];
      f16 h = (f16)w;
      whi[i] = h;
      wlo[i] = (f16)(w - (float)h);
    }
  }
}

__device__ __forceinline__ void phase_skew(int us4) {
  const int k = (blockIdx.x >> 3) & 3;
  if (k) {
    const unsigned long long t0 = __builtin_amdgcn_s_memrealtime();
    const unsigned long long dt = (unsigned long long)(k * us4 * 25);
    while (__builtin_amdgcn_s_memrealtime() - t0 < dt) __builtin_amdgcn_s_sleep(8);
  }
}

__device__ __forceinline__ int xcd_item(int n_items, int r) {
  const int nx = 8, slots = gridDim.x >> 3;
  const int xcd = blockIdx.x & 7, slot = blockIdx.x >> 3;
  const int per = (n_items + nx - 1) / nx;
  const int local = slot + r * slots;
  if (local >= per) return -1;
  const int item = xcd * per + local;
  return (item < n_items) ? item : -2;
}

__device__ __forceinline__ void p_inproj(const Params& p, char* shm) {
  const f16* h16 = (const f16*)(p.ws + OFF_A);
  const f16* wT = (const f16*)(p.ws + OFF_WIN);
  f16* proj16 = (f16*)(p.ws + OFF_B);
  f16* gate16 = (f16*)(p.ws + OFF_C);
  f16* ikc = (f16*)(p.ws + OFF_IKC);
  const int tid = opaque_tid(), wid = tid >> 6, lane = tid & 63;
  int sR[NSTG], sC[NSTG];
#pragma unroll
  for (int i = 0; i < NSTG; ++i) stage_rc(wid * 1024 + i * 8192 + lane * 16, sR[i], sC[i]);
  const int NTILES = 128 * 14;
  if (SKEW_P1) phase_skew(SKEW_P1);
  for (int r = 0;; ++r) {
    int tile = xcd_item(NTILES, r);
    if (tile == -1) break;
    if (tile < 0) continue;
    int grp = tile / 56, rem = tile % 56;
    int ft = rem >> 2, tt = grp * 4 + (rem & 3);
    unsigned pa[NSTG], pb[NSTG];
#pragma unroll
    for (int i = 0; i < NSTG; ++i) {
      pa[i] = (unsigned)((ft * 256 + sR[i]) * 1024 + sC[i]);
      pb[i] = (unsigned)((tt * 256 + sR[i]) * 1024 + sC[i]);
    }
    f32x4 acc[8][4];
#pragma unroll
    for (int m = 0; m < 8; ++m)
#pragma unroll
      for (int n = 0; n < 4; ++n) acc[m][n] = (f32x4){0.f, 0.f, 0.f, 0.f};
    gemm_core(wT, pa, h16, pb, 16, acc, shm);
    epi_store_f16(acc, shm);
    RAW_SYNC();
    {
      int ch = tid & 31, r0 = tid >> 5;
      int f0 = ft * 256 + ch * 8;
      float bg[8];
      if (f0 >= PA_W && f0 < IN_W) {
#pragma unroll
        for (int j = 0; j < 8; ++j) bg[j] = p.b_gate[f0 - PA_W + j];
      } else {
#pragma unroll
        for (int j = 0; j < 8; ++j) bg[j] = 0.f;
      }
#pragma unroll 4
      for (int ps = 0; ps < 16; ++ps) {
        int r = ps * 16 + r0;
        f16x8 v = *(const f16x8*)(shm + r * EPI_LD + ch * 16);
        size_t tok = (size_t)tt * 256 + r;
        if (f0 < PA_W) {
          st_nt((f16x8*)(proj16 + tok * PJ_W + f0), v);
          if (f0 >= C_IK && f0 < C_IW) *(f16x8*)(ikc + tok * 32 + (f0 - C_IK)) = v;
        } else if (f0 < IN_W) {
          f16x8 o;
#pragma unroll
          for (int j = 0; j < 8; ++j) o[j] = (f16)__builtin_amdgcn_rcpf(1.0f + __builtin_amdgcn_exp2f(-1.4426950408889634f * ((float)v[j] + bg[j])));
          st_nt((f16x8*)(gate16 + tok * 2048 + (f0 - PA_W)), o);
        }
      }
    }
    RAW_SYNC();
  }
}


__device__ __forceinline__ void zero_acc(f32x4 (&acc)[8][4]) {
#pragma unroll
  for (int m = 0; m < 8; ++m)
#pragma unroll
    for (int n = 0; n < 4; ++n) acc[m][n] = (f32x4){0.f, 0.f, 0.f, 0.f};
}

template <class RowPtr>
__device__ __forceinline__ void epi_rows_out(char* shm, RowPtr rp) {
  const int tid = opaque_tid(), ch = tid & 31, r0 = tid >> 5;
#pragma unroll 4
  for (int ps = 0; ps < 16; ++ps) {
    int r = ps * 16 + r0;
    f16x8 v = *(const f16x8*)(shm + r * EPI_LD + ch * 16);
    f16* d = rp(r);
    if (d) st_nt((f16x8*)(d + ch * 8), v);
  }
}

__device__ __forceinline__ void p_merge(const Params& p, char* shm) {
  const f16* pa16 = (const f16*)(p.ws + OFF_D);
  const f16* gate16 = (const f16*)(p.ws + OFF_C);
  const f16* wpp = (const f16*)(p.ws + OFF_WPP);
  const f16* wpa = (const f16*)(p.ws + OFF_WPA);
  f16* merged16 = (f16*)(p.ws + OFF_B);
  const int tid = opaque_tid(), wid = tid >> 6, lane = tid & 63;
  int sR[NSTG], sC[NSTG];
#pragma unroll
  for (int i = 0; i < NSTG; ++i) stage_rc(wid * 1024 + i * 8192 + lane * 16, sR[i], sC[i]);
  const int ch = tid & 31, r0 = tid >> 5;
  for (int r = 0;; ++r) {
    int tile = xcd_item(512, r);
    if (tile == -1) break;
    if (tile < 0) continue;
    int ft = tile & 3, tt = tile >> 2;
    unsigned pa[NSTG], pb[NSTG];
#pragma unroll
    for (int i = 0; i < NSTG; ++i) {
      pa[i] = (unsigned)((ft * 256 + sR[i]) * 512 + sC[i]);
      pb[i] = (unsigned)((tt * 256 + sR[i]) * 1024 + sC[i]);
    }
    f32x4 acc[8][4];
    zero_acc(acc);
    gemm_core(wpp, pa, pa16, pb, 8, acc, shm);
    epi_store_f16(acc, shm);
    RAW_SYNC();
#pragma unroll 4
    for (int ps = 0; ps < 16; ++ps) {
      const int rr = ps * 16 + r0;
      const size_t tok = (size_t)tt * 256 + rr;
      f16x8 v = *(const f16x8*)(shm + rr * EPI_LD + ch * 16);
      f16x8 g0 = *(const f16x8*)(gate16 + tok * 2048 + ft * 256 + ch * 8);
      f16x8 g1 = *(const f16x8*)(gate16 + tok * 2048 + 1024 + ft * 256 + ch * 8);
      f16x8 o;
#pragma unroll
      for (int e = 0; e < 8; ++e) {
        float rq = fminf((float)g0[e] * __builtin_amdgcn_rcpf(fmaxf((float)g1[e], 6e-5f)), 16384.f);
        o[e] = (f16)fminf(fmaxf((float)v[e] * rq, -60000.f), 60000.f);
      }
      *(f16x8*)(shm + rr * EPI_LD + ch * 16) = o;
    }
    RAW_SYNC();
    {
      const int wid_ = tid >> 6, lane_ = tid & 63, wr = wid_ >> 2, wc = wid_ & 3, fr = lane_ & 15, fq = lane_ >> 4;
#pragma unroll
      for (int m = 0; m < 8; ++m)
#pragma unroll
        for (int n = 0; n < 4; ++n) {
          f16x4 c = *(const f16x4*)(shm + (wc * 64 + n * 16 + fr) * EPI_LD + (wr * 128 + m * 16 + fq * 4) * 2);
          acc[m][n] = (f32x4){(float)c[0], (float)c[1], (float)c[2], (float)c[3]};
        }
    }
    RAW_SYNC();
    gemm_core(wpa, pa, pa16 + 512, pb, 8, acc, shm);
    epi_store_f16(acc, shm);
    RAW_SYNC();
#pragma unroll 4
    for (int ps = 0; ps < 16; ++ps) {
      const int rr = ps * 16 + r0;
      const size_t tok = (size_t)tt * 256 + rr;
      f16x8 v = *(const f16x8*)(shm + rr * EPI_LD + ch * 16);
      f16x8 g1 = *(const f16x8*)(gate16 + tok * 2048 + 1024 + ft * 256 + ch * 8);
      f16x8 o;
#pragma unroll
      for (int e = 0; e < 8; ++e) o[e] = (f16)((float)v[e] * (float)g1[e]);
      *(f16x8*)(merged16 + tok * 1024 + ft * 256 + ch * 8) = o;
    }
    RAW_SYNC();
  }
}

__device__ __forceinline__ void p_resid(const Params& p, char* shm) {
  const f16* merged16 = (const f16*)(p.ws + OFF_B);
  const f16* h16 = (const f16*)(p.ws + OFF_A);
  const f16* wo = (const f16*)(p.ws + OFF_WOUT);
  f16* z16 = (f16*)(p.ws + OFF_C);
  const int tid = opaque_tid(), wid = tid >> 6, lane = tid & 63;
  int sR[NSTG], sC[NSTG];
#pragma unroll
  for (int i = 0; i < NSTG; ++i) stage_rc(wid * 1024 + i * 8192 + lane * 16, sR[i], sC[i]);
  const int ch = tid & 31, r0 = tid >> 5;
  for (int r = 0;; ++r) {
    int tile = xcd_item(512, r);
    if (tile == -1) break;
    if (tile < 0) continue;
    int ft = tile & 3, tt = tile >> 2;
    unsigned pa[NSTG], pb[NSTG];
#pragma unroll
    for (int i = 0; i < NSTG; ++i) {
      pa[i] = (unsigned)((ft * 256 + sR[i]) * 1024 + sC[i]);
      pb[i] = (unsigned)((tt * 256 + sR[i]) * 1024 + sC[i]);
    }
    {
      f32x4 acc[8][4];
      zero_acc(acc);
      gemm_core(wo, pa, merged16, pb, 16, acc, shm);
      epi_store_f16(acc, shm);
    }
    RAW_SYNC();
#pragma unroll 4
    for (int ps = 0; ps < 16; ++ps) {
      const int rr = ps * 16 + r0;
      const size_t o = ((size_t)tt * 256 + rr) * 1024 + ft * 256 + ch * 8;
      f16x8 v = *(const f16x8*)(shm + rr * EPI_LD + ch * 16);
      f16x8 hv = *(const f16x8*)(h16 + o);
      f16x8 zz;
#pragma unroll
      for (int e = 0; e < 8; ++e) zz[e] = (f16)(ALPHA * (float)hv[e] + (float)v[e]);
      *(f16x8*)(z16 + o) = zz;
    }
    RAW_SYNC();
  }
}

#define HID_ROWS 73728
#define MOE_TAB (GEMM_LDS + 2048)
__device__ __forceinline__ void moe_tables(const int* counts, char* shm) {
  int* tab = (int*)(shm + MOE_TAB);
  if (threadIdx.x == 0) {
    int pf = 0, pn = 0, pr = 0;
    for (int e = 0; e < 32; ++e) {
      int n = counts[e * CNT_STRIDE];
      tab[e] = pf; tab[33 + e] = pn; tab[66 + e] = pr;
      pf += min(8, (n + 255) >> 8);
      pn += (max(n - 2048, 0) + 63) >> 6;
      pr += ((n + 255) >> 8) << 8;
    }
    tab[32] = pf; tab[65] = pn; tab[98] = pr;
  }
  __syncthreads();
}
__device__ __forceinline__ void moe_find(const int* pre, int item, int& e, int& mt) {
  e = 0;
  for (int i = 1; i < 32; ++i) if (item >= pre[i]) e = i;
  mt = item - pre[e];
}

#define NSLOT_B 20480
__device__ __forceinline__ void gemm_core_narrow(const f16* __restrict__ Ab, const unsigned (&pa)[NSTG], const f16* __restrict__ Bb,
                                                 unsigned pb, int nt, const int (&ablk)[2], f32x4 (&acc)[2][4], char* shm) {
  const int tid = opaque_tid(), wid = tid >> 6, lane = tid & 63, fr = lane & 15, fq = lane >> 4;
  const int nk = nt * 2;
  const bool hasb = (wid < 4);
#define SA(s_) (shm + (s_) * NSLOT_B)
#define SB(s_) (shm + (s_) * NSLOT_B + TILE_B)
#define NSTAGE(slot, kt)                                                                                                  \
  do {                                                                                                                    \
    _Pragma("unroll") for (int i = 0; i < NSTG; ++i)                                                                     \
      __builtin_amdgcn_global_load_lds((const unsigned*)(Ab + pa[i] + (kt) * 32), (unsigned*)(SA(slot) + wid * 1024 + i * 8192), \
                                       16, 0, 0);                                                                         \
    if (hasb) __builtin_amdgcn_global_load_lds((const unsigned*)(Bb + pb + (kt) * 32), (unsigned*)(SB(slot) + wid * 1024), 16, 0, 0); \
  } while (0)
  NSTAGE(0, 0);
  NSTAGE(1, 1);
  NSTAGE(2, 2);
  const int a0 = lds_byte(ablk[0] * 16 + fr, fq * 8), a1 = lds_byte(ablk[1] * 16 + fr, fq * 8), boff = lds_byte(fr, fq * 8);
  for (int t = 0; t < nk; ++t) {
    if (hasb) { if (t + 2 < nk) WAIT_V(6); else if (t + 1 < nk) WAIT_V(3); else WAIT_V(0); }
    else      { if (t + 2 < nk) WAIT_V(4); else if (t + 1 < nk) WAIT_V(2); else WAIT_V(0); }
    __builtin_amdgcn_s_barrier();
    if (t + 3 < nk) NSTAGE((t + 3) & 3, t + 3);
    const char* sa = SA(t & 3);
    const char* sb = SB(t & 3) + boff;
    f16x8 A0 = *(const f16x8*)(sa + a0), A1 = *(const f16x8*)(sa + a1), Bf[4];
#pragma unroll
    for (int n = 0; n < 4; ++n) Bf[n] = *(const f16x8*)(sb + n * 1024);
#pragma unroll
    for (int n = 0; n < 4; ++n) acc[0][n] = __builtin_amdgcn_mfma_f32_16x16x32_f16(A0, Bf[n], acc[0][n], 0, 0, 0);
#pragma unroll
    for (int n = 0; n < 4; ++n) acc[1][n] = __builtin_amdgcn_mfma_f32_16x16x32_f16(A1, Bf[n], acc[1][n], 0, 0, 0);
    WAIT_L(0);
  }
  RAW_SYNC();
#undef SA
#undef SB
#undef NSTAGE
}

__device__ __forceinline__ void p_moe_a(const Params& p, char* shm) {
  const f16* h1 = (const f16*)(p.ws + OFF_A);
  const f16* wgu = (const f16*)(p.ws + OFF_WGU);
  const int* counts = (const int*)(p.ws + OFF_CNT);
  const int* lists = (const int*)(p.ws + OFF_LISTS);
  f16* hid16 = (f16*)(p.ws + OFF_B);
  const int* tab = (const int*)(shm + MOE_TAB);
  const int tid = opaque_tid(), wid = tid >> 6, lane = tid & 63, wr = wid >> 2, wc = wid & 3, fr = lane & 15, fq = lane >> 4;
  int sR[NSTG], sC[NSTG];
#pragma unroll
  for (int i = 0; i < NSTG; ++i) stage_rc(wid * 1024 + i * 8192 + lane * 16, sR[i], sC[i]);
  moe_tables(counts, shm);
  const int total = tab[32] * 2;
  for (int r = 0;; ++r) {
    int item = xcd_item(total, r);
    if (item == -1) break;
    if (item < 0) continue;
    int e, mt;
    moe_find(tab, item >> 1, e, mt);
    const int fh = item & 1;
    const int cnt_e = counts[e * CNT_STRIDE];
    const int rowbase = tab[66 + e];
    unsigned pa[NSTG], pb[NSTG];
    f32x4 acc[8][4];
    zero_acc(acc);
#pragma unroll
    for (int i = 0; i < NSTG; ++i) {
      pa[i] = (unsigned)((e * 512 + fh * 256 + sR[i]) * 1024 + sC[i]);
      int idx = mt * 256 + sR[i];
      int tok = (idx < cnt_e) ? (lists[(size_t)e * T_TOK + idx] >> 1) : 0;
      pb[i] = (unsigned)(tok * 1024 + sC[i]);
    }
    gemm_core(wgu, pa, h1, pb, 16, acc, shm);
#pragma unroll
    for (int m = 0; m < 4; ++m)
#pragma unroll
      for (int n = 0; n < 4; ++n) {
        f16x4 o;
#pragma unroll
        for (int j = 0; j < 4; ++j) {
          float g = acc[m][n][j], u = acc[m + 4][n][j];
          o[j] = (f16)(g * u * __builtin_amdgcn_rcpf(1.0f + __builtin_amdgcn_exp2f(-1.4426950408889634f * g)));
        }
        size_t row = (size_t)rowbase + mt * 256 + wc * 64 + n * 16 + fr;
        *(f16x4*)(hid16 + row * 256 + fh * 128 + wr * 64 + m * 16 + fq * 4) = o;
      }
  }
  const int totaln = tab[65] * 2;
  for (int r = 0;; ++r) {
    int item = xcd_item(totaln, r);
    if (item == -1) break;
    if (item < 0) continue;
    int e, ntile;
    moe_find(tab + 33, item >> 1, e, ntile);
    const int fh = item & 1;
    const int cnt_e = counts[e * CNT_STRIDE];
    const int rowbase = tab[66 + e];
    const int wrn = wid >> 2, lq = wid & 3;
    const int ablk[2] = {wrn * 8 + lq, wrn * 8 + 4 + lq};
    unsigned pa[NSTG], pb = 0;
#pragma unroll
    for (int i = 0; i < NSTG; ++i) pa[i] = (unsigned)((e * 512 + fh * 256 + sR[i]) * 1024 + sC[i]);
    {
      int idx = 2048 + ntile * 64 + (sR[0] & 63);
      int tok = (idx < cnt_e) ? (lists[(size_t)e * T_TOK + idx] >> 1) : 0;
      pb = (unsigned)(tok * 1024 + sC[0]);
    }
    f32x4 acc[2][4];
#pragma unroll
    for (int m = 0; m < 2; ++m)
#pragma unroll
      for (int n = 0; n < 4; ++n) acc[m][n] = (f32x4){0.f, 0.f, 0.f, 0.f};
    gemm_core_narrow(wgu, pa, h1, pb, 16, ablk, acc, shm);
#pragma unroll
    for (int n = 0; n < 4; ++n) {
      f16x4 o;
#pragma unroll
      for (int j = 0; j < 4; ++j) {
        float g = acc[0][n][j], u = acc[1][n][j];
        o[j] = (f16)(g * u * __builtin_amdgcn_rcpf(1.0f + __builtin_amdgcn_exp2f(-1.4426950408889634f * g)));
      }
      size_t row = (size_t)rowbase + 2048 + ntile * 64 + n * 16 + fr;
      *(f16x4*)(hid16 + row * 256 + fh * 128 + wrn * 64 + lq * 16 + fq * 4) = o;
    }
  }
}

__device__ __forceinline__ void p_moe_b(const Params& p, char* shm) {
  const f16* wdn = (const f16*)(p.ws + OFF_WDN);
  const f16* hid16 = (const f16*)(p.ws + OFF_B);
  const float* route_w = (const float*)(p.ws + OFF_ROUTE_W);
  const int* counts = (const int*)(p.ws + OFF_CNT);
  const int* lists = (const int*)(p.ws + OFF_LISTS);
  f16* y16 = (f16*)(p.ws + OFF_C);
  int* sent = (int*)(shm + 256 * EPI_LD);
  const int* tab = (const int*)(shm + MOE_TAB);
  const int tid = opaque_tid(), wid = tid >> 6, lane = tid & 63, wc = wid & 3, fr = lane & 15, fq = lane >> 4;
  int sR[NSTG], sC[NSTG];
#pragma unroll
  for (int i = 0; i < NSTG; ++i) stage_rc(wid * 1024 + i * 8192 + lane * 16, sR[i], sC[i]);
  moe_tables(counts, shm);
  const int total = tab[32] * 4;
  for (int r = 0;; ++r) {
    int item = xcd_item(total, r);
    if (item == -1) break;
    if (item < 0) continue;
    int e, mt;
    moe_find(tab, item >> 2, e, mt);
    const int ft = item & 3;
    const int cnt_e = counts[e * CNT_STRIDE];
    const int rowbase = tab[66 + e];
    if (tid < 256) {
      int idx = mt * 256 + tid;
      sent[tid] = (idx < cnt_e) ? lists[(size_t)e * T_TOK + idx] : -1;
    }
    unsigned pa[NSTG], pb[NSTG];
    f32x4 acc[8][4];
    zero_acc(acc);
#pragma unroll
    for (int i = 0; i < NSTG; ++i) {
      pa[i] = (unsigned)((e * 1024 + ft * 256 + sR[i]) * 256 + sC[i]);
      pb[i] = (unsigned)((rowbase + mt * 256 + sR[i]) * 256 + sC[i]);
    }
    gemm_core(wdn, pa, hid16, pb, 4, acc, shm);
#pragma unroll
    for (int n = 0; n < 4; ++n) {
      int en = sent[wc * 64 + n * 16 + fr];
      float rw = (en >= 0) ? route_w[en] : 0.f;
#pragma unroll
      for (int m = 0; m < 8; ++m)
#pragma unroll
        for (int j = 0; j < 4; ++j) acc[m][n][j] *= rw;
    }
    epi_store_f16(acc, shm);
    RAW_SYNC();
    epi_rows_out(shm, [&](int rr) -> f16* { int en = sent[rr]; return (en >= 0) ? (y16 + (size_t)en * 1024 + ft * 256) : (f16*)nullptr; });
    RAW_SYNC();
  }
  const int totaln = tab[65] * 4;
  for (int r = 0;; ++r) {
    int item = xcd_item(totaln, r);
    if (item == -1) break;
    if (item < 0) continue;
    int e, ntile;
    moe_find(tab + 33, item >> 2, e, ntile);
    const int ft = item & 3;
    const int cnt_e = counts[e * CNT_STRIDE];
    const int rowbase = tab[66 + e];
    if (tid < 64) {
      int idx = 2048 + ntile * 64 + tid;
      sent[tid] = (idx < cnt_e) ? lists[(size_t)e * T_TOK + idx] : -1;
    }
    const int ablk[2] = {wid * 2, wid * 2 + 1};
    unsigned pa[NSTG], pb;
#pragma unroll
    for (int i = 0; i < NSTG; ++i) pa[i] = (unsigned)((e * 1024 + ft * 256 + sR[i]) * 256 + sC[i]);
    pb = (unsigned)((rowbase + 2048 + ntile * 64 + (sR[0] & 63)) * 256 + sC[0]);
    f32x4 acc[2][4];
#pragma unroll
    for (int m = 0; m < 2; ++m)
#pragma unroll
      for (int n = 0; n < 4; ++n) acc[m][n] = (f32x4){0.f, 0.f, 0.f, 0.f};
    gemm_core_narrow(wdn, pa, hid16, pb, 4, ablk, acc, shm);
#pragma unroll
    for (int n = 0; n < 4; ++n) {
      int en = sent[n * 16 + fr];
      float rw = (en >= 0) ? route_w[en] : 0.f;
#pragma unroll
      for (int m = 0; m < 2; ++m) {
        f16x4 v;
#pragma unroll
        for (int j = 0; j < 4; ++j) v[j] = (f16)(acc[m][n][j] * rw);
        *(f16x4*)(shm + (n * 16 + fr) * EPI_LD + (wid * 32 + m * 16 + fq * 4) * 2) = v;
      }
    }
    RAW_SYNC();
    {
      const int ch = tid & 31, r0 = tid >> 5;
#pragma unroll
      for (int ps = 0; ps < 4; ++ps) {
        int rr = ps * 16 + r0;
        f16x8 v = *(const f16x8*)(shm + rr * EPI_LD + ch * 16);
        int en = sent[rr];
        if (en >= 0) *(f16x8*)(y16 + (size_t)en * 1024 + ft * 256 + ch * 8) = v;
      }
    }
    RAW_SYNC();
  }
}

__device__ __forceinline__ unsigned f2key_(float f) {
  if (f == 0.f) f = 0.f;
  unsigned u = __float_as_uint(f);
  return (u & 0x80000000u) ? ~u : (u | 0x80000000u);
}
__device__ __forceinline__ float key2f_(unsigned k) {
  return __uint_as_float((k & 0x80000000u) ? (k & 0x7fffffffu) : ~k);
}
__device__ __forceinline__ void find_bin(const unsigned* hrow, int need, int lane, int* out_bin, int* out_above) {
  uint4 c = *(const uint4*)(hrow + 4 * lane);
  int tot = (int)(c.x + c.y + c.z + c.w);
  int incl = tot;
#pragma unroll
  for (int o = 1; o < 64; o <<= 1) {
    int v = __shfl_down(incl, o, 64);
    if (lane + o < 64) incl += v;
  }
  int above = incl - tot;
  if (above < need && incl >= need) {
    int b;
    if (above + (int)c.w >= need) b = 3;
    else { above += c.w; if (above + (int)c.z >= need) b = 2;
      else { above += c.z; if (above + (int)c.y >= need) b = 1; else { above += c.y; b = 0; } } }
    *out_bin = 4 * lane + b;
    *out_above = above;
  }
}

typedef short s16x4 __attribute__((ext_vector_type(4)));
#define VROW 160
#define ATT_WAVE_LDS (64 * VROW + 512)
__device__ __forceinline__ f16x8 tr_pair(const char* a, const char* b) {
  s16x4 x = __builtin_amdgcn_ds_read_tr16_b64_v4i16((__attribute__((address_space(3))) s16x4*)(a));
  s16x4 y = __builtin_amdgcn_ds_read_tr16_b64_v4i16((__attribute__((address_space(3))) s16x4*)(b));
  typedef short s16x8 __attribute__((ext_vector_type(8)));
  s16x8 r = __builtin_shufflevector(x, y, 0, 1, 2, 3, 4, 5, 6, 7);
  return __builtin_bit_cast(f16x8, r);
}
__device__ __forceinline__ void attn_one(const f16* __restrict__ proj16, f16* __restrict__ pa16, int t, const unsigned short* ssel,
                                         char* vimg, int lane) {
  const int fr = lane & 15, fq = lane >> 4;
  const int l = t & (SEQ - 1), b0 = t - l, cnt = min(l + 1, 256);
  f16x8 bq0, bq1, ones;
  {
    const f16* qp = proj16 + (size_t)t * PJ_W + C_Q + (fr & 7) * 64 + fq * 8;
    bq0 = *(const f16x8*)qp;
    bq1 = *(const f16x8*)(qp + 32);
    const f16 qs = (f16)0.18033688011112042f;
#pragma unroll
    for (int e = 0; e < 8; ++e) {
      bq0[e] = (fr < 8) ? bq0[e] * qs : (f16)0.f;
      bq1[e] = (fr < 8) ? bq1[e] * qs : (f16)0.f;
      ones[e] = (fr == 0) ? (f16)1.f : (f16)0.f;
    }
  }
  const char* kbase = (const char*)(proj16 + (size_t)b0 * PJ_W + C_K);
  const char* vbase = (const char*)(proj16 + (size_t)b0 * PJ_W + C_V);
  f32x4 S[16];
  if (cnt == 256) {
#pragma unroll
    for (int kt = 0; kt < 16; ++kt) {
      const unsigned ko = (unsigned)ssel[kt * 16 + fr] * (PJ_W * 2) + fq * 16;
      f16x8 a0 = *(const f16x8*)(kbase + ko), a1 = *(const f16x8*)(kbase + ko + 64);
      f32x4 z = {0.f, 0.f, 0.f, 0.f};
      z = __builtin_amdgcn_mfma_f32_16x16x32_f16(a0, bq0, z, 0, 0, 0);
      S[kt] = __builtin_amdgcn_mfma_f32_16x16x32_f16(a1, bq1, z, 0, 0, 0);
    }
  } else {
#pragma unroll
    for (int kt = 0; kt < 16; ++kt) {
      const unsigned ko = (unsigned)ssel[kt * 16 + fr] * (PJ_W * 2) + fq * 16;
      f16x8 a0 = *(const f16x8*)(kbase + ko), a1 = *(const f16x8*)(kbase + ko + 64);
      f32x4 z = {0.f, 0.f, 0.f, 0.f};
      z = __builtin_amdgcn_mfma_f32_16x16x32_f16(a0, bq0, z, 0, 0, 0);
      z = __builtin_amdgcn_mfma_f32_16x16x32_f16(a1, bq1, z, 0, 0, 0);
#pragma unroll
      for (int j = 0; j < 4; ++j) S[kt][j] = (kt * 16 + fq * 4 + j < cnt) ? z[j] : NEG_BIG;
    }
  }
  f16x8 vv[8];
#pragma unroll
  for (int i = 0; i < 8; ++i) {
    const unsigned vo = (unsigned)ssel[(lane >> 3) + 8 * i] * (PJ_W * 2) + (lane & 7) * 16;
    vv[i] = *(const f16x8*)(vbase + vo);
  }
  float m = NEG_BIG;
#pragma unroll
  for (int kt = 0; kt < 16; ++kt)
#pragma unroll
    for (int j = 0; j < 4; ++j) m = fmaxf(m, S[kt][j]);
  m = fmaxf(m, __shfl_xor(m, 16, 64));
  m = fmaxf(m, __shfl_xor(m, 32, 64));
  f16x8 P[8];
#pragma unroll
  for (int c = 0; c < 8; ++c)
#pragma unroll
    for (int j = 0; j < 4; ++j) {
      P[c][j] = (f16)__builtin_amdgcn_exp2f(S[2 * c][j] - m);
      P[c][4 + j] = (f16)__builtin_amdgcn_exp2f(S[2 * c + 1][j] - m);
    }
  f32x4 O[4], Ol = {0.f, 0.f, 0.f, 0.f};
#pragma unroll
  for (int nt = 0; nt < 4; ++nt) O[nt] = (f32x4){0.f, 0.f, 0.f, 0.f};
#pragma unroll
  for (int rr = 0; rr < 4; ++rr) {
    asm volatile("s_waitcnt lgkmcnt(0)" ::: "memory");
#pragma unroll
    for (int i = 0; i < 8; ++i) *(f16x8*)(vimg + ((lane >> 3) + 8 * i) * VROW + (lane & 7) * 16) = vv[i];
    if (rr < 3) {
#pragma unroll
      for (int i = 0; i < 8; ++i) {
        const unsigned vo = (unsigned)ssel[(rr + 1) * 64 + (lane >> 3) + 8 * i] * (PJ_W * 2) + (lane & 7) * 16;
        vv[i] = *(const f16x8*)(vbase + vo);
      }
    }
    asm volatile("s_waitcnt lgkmcnt(0)" ::: "memory");
#pragma unroll
    for (int cc = 0; cc < 2; ++cc) {
      const char* ra = vimg + (cc * 32 + fq * 4 + (fr >> 2)) * VROW + (fr & 3) * 8;
#pragma unroll
      for (int nt = 0; nt < 4; ++nt) {
        f16x8 B = tr_pair(ra + nt * 32, ra + 16 * VROW + nt * 32);
        O[nt] = __builtin_amdgcn_mfma_f32_16x16x32_f16(P[rr * 2 + cc], B, O[nt], 0, 0, 0);
      }
      Ol = __builtin_amdgcn_mfma_f32_16x16x32_f16(P[rr * 2 + cc], ones, Ol, 0, 0, 0);
    }
  }
  asm volatile("s_waitcnt lgkmcnt(0)" ::: "memory");
#pragma unroll
  for (int j = 0; j < 4; ++j) {
    float ls = __shfl(Ol[j], lane & 48, 64);
    float inv = __builtin_amdgcn_rcpf(ls);
    if (fq < 2) {
      f16* op = pa16 + (size_t)t * DM + 512 + (fq * 4 + j) * 64 + fr;
#pragma unroll
      for (int nt = 0; nt < 4; ++nt) op[nt * 16] = (f16)(O[nt][j] * inv);
    }
  }
}

__device__ __forceinline__ f32x4 score_tile(const f16x8& a, const f16x8 (&bq)[8], const f16x8& bc_hi, const f16x8& bc_lo,
                                            const float (&wq)[8]) {
  f32x4 L[8];
#pragma unroll
  for (int h = 0; h < 8; ++h) L[h] = __builtin_amdgcn_mfma_f32_16x16x32_f16(a, bq[h], (f32x4){0.f, 0.f, 0.f, 0.f}, 0, 0, 0);
  f32x4 lin = __builtin_amdgcn_mfma_f32_16x16x32_f16(a, bc_lo, (f32x4){0.f, 0.f, 0.f, 0.f}, 0, 0, 0);
  lin = __builtin_amdgcn_mfma_f32_16x16x32_f16(a, bc_hi, lin, 0, 0, 0);
  __builtin_amdgcn_sched_barrier(0);
  float t0 = 0.f, t1 = 0.f, t2 = 0.f, t3 = 0.f;
#pragma unroll
  for (int h = 0; h < 8; ++h) {
    asm("v_fma_f32 %0, %1, |%2|, %0" : "+v"(t0) : "v"(wq[h]), "v"(L[h][0]));
    asm("v_fma_f32 %0, %1, |%2|, %0" : "+v"(t1) : "v"(wq[h]), "v"(L[h][1]));
    asm("v_fma_f32 %0, %1, |%2|, %0" : "+v"(t2) : "v"(wq[h]), "v"(L[h][2]));
    asm("v_fma_f32 %0, %1, |%2|, %0" : "+v"(t3) : "v"(wq[h]), "v"(L[h][3]));
  }
  f32x4 s = {t0 + lin[0], t1 + lin[1], t2 + lin[2], t3 + lin[3]};
  return s;
}

#define KEYS_LD 4104
#define IDX_KEYS 0
#define IDX_HIST 131584
#define IDX_SSEL (IDX_HIST + 16384)
#define IDX_CAND (IDX_SSEL + 8192)
#define IDX_MISC (IDX_CAND + 2048)
template <int V>
__device__ __forceinline__ void p_index(const Params& p, char* shm) {
  const f16* proj16 = (const f16*)(p.ws + OFF_B);
  f16* pa16 = (V == 0) ? (f16*)(p.ws + OFF_D) : (f16*)p.out;
  unsigned short* keys16 = (unsigned short*)(shm + IDX_KEYS);
  unsigned* hist = (unsigned*)(shm + IDX_HIST);
  unsigned short* ssel = (unsigned short*)(shm + IDX_SSEL);
  unsigned short* scand = (unsigned short*)(shm + IDX_CAND);
  unsigned* smm = (unsigned*)(shm + IDX_MISC);
  int* sbin = (int*)(smm + 32);
  const int tid = opaque_tid(), wid = tid >> 6, lane0 = tid & 63;
  const float NINF = -__builtin_huge_valf(), PINF = __builtin_huge_valf();
  for (int rnd = 0;; ++rnd) {
    int idx = rnd * gridDim.x + ((rnd & 1) ? (gridDim.x - 1 - blockIdx.x) : blockIdx.x);
    if (idx >= 2048) break;
    int lane = lane0;
    asm volatile("" : "+v"(lane));
    const int fr = lane & 15, fq = lane >> 4;
    const unsigned long long lt_mask = (1ull << lane) - 1ull;
    const int b = idx & 7, j = 255 - (idx >> 3);
    const int l0 = j * 16, t0 = b * SEQ + l0;
    if (j < 16) {
#pragma unroll 1
      for (int qq = 0; qq < 2; ++qq) {
        const int q = 2 * wid + qq, lq = l0 + q;
        unsigned short* sl = ssel + q * 256;
        for (int i = lane; i < 256; i += 64) sl[i] = (unsigned short)((i <= lq) ? i : 0);
        asm volatile("s_waitcnt lgkmcnt(0)" ::: "memory");
        attn_one(proj16, pa16, t0 + q, sl, (char*)(keys16 + (2 * wid) * KEYS_LD), lane);
      }
      __syncthreads();
      continue;
    }
    const int wids = __builtin_amdgcn_readfirstlane(wid);
    const int klast = (j - 1) - ((j - 1 - wids) & 7);
    const f16* kbase = (const f16*)(p.ws + OFF_IKC) + (size_t)(b * SEQ + fr) * 32 + fq * 8;
#define NB 8
#define IK_LOAD(dst, kt0)                                                                   \
  _Pragma("unroll") for (int u = 0; u < NB; ++u) {                                          \
    int ktc = min((kt0) + 8 * u, klast);                                                    \
    dst[u] = *(const f16x8*)(kbase + ktc * 512);                                            \
  }
    f16x8 bq[8];
    float wq[8];
    f16x8 afirst[NB];
    f16x8 wv;
    {
      const f16* qrow = proj16 + (size_t)(t0 + fr) * PJ_W;
#pragma unroll
      for (int h = 0; h < 8; ++h) bq[h] = *(const f16x8*)(qrow + C_IQ + h * 32 + fq * 8);
      wv = *(const f16x8*)(qrow + C_IW);
    }
    const f16x8 ad = *(const f16x8*)(kbase + j * 512);
    IK_LOAD(afirst, wids);
    for (int i = tid; i < 4096; i += 512) hist[i] = 0;
    if (tid < 16) { smm[tid] = 0xFFFFFFFFu; smm[16 + tid] = 0u; }
#pragma unroll
    for (int h = 0; h < 8; ++h) wq[h] = (float)wv[h];
    f16x8 bc_hi, bc_lo;
#pragma unroll
    for (int e = 0; e < 8; ++e) {
      float c = 0.f;
#pragma unroll
      for (int h = 0; h < 8; ++h) c = __builtin_fmaf(wq[h], (float)bq[h][e], c);
      f16 ch_ = (f16)c;
      bc_hi[e] = ch_;
      bc_lo[e] = (f16)(c - (float)ch_);
    }
    __syncthreads();
    {
      float mn = PINF, mx = NINF;
      f16x8 a[NB];
#pragma unroll
      for (int u = 0; u < NB; ++u) a[u] = afirst[u];
      const int astep = (j >= 32) ? 4 * 8 * NB : 8 * NB;
      for (int kt0 = wids; kt0 < j; kt0 += astep) {
        f16x8 an[NB];
        IK_LOAD(an, kt0 + astep);
#pragma unroll
        for (int u = 0; u < NB; ++u) {
          if (kt0 + 8 * u < j) {
            f32x4 sc = score_tile(a[u], bq, bc_hi, bc_lo, wq);
            mn = fminf(fminf(mn, sc[0]), fminf(fminf(sc[1], sc[2]), sc[3]));
            mx = fmaxf(fmaxf(mx, sc[0]), fmaxf(fmaxf(sc[1], sc[2]), sc[3]));
          }
        }
#pragma unroll
        for (int u = 0; u < NB; ++u) a[u] = an[u];
      }
      if ((j & 7) == wids) {
        f32x4 sc = score_tile(ad, bq, bc_hi, bc_lo, wq);
#pragma unroll
        for (int jj = 0; jj < 4; ++jj) {
          bool ok = (fq * 4 + jj <= fr);
          mn = fminf(mn, ok ? sc[jj] : PINF);
          mx = fmaxf(mx, ok ? sc[jj] : NINF);
        }
      }
      mn = fminf(mn, __shfl_xor(mn, 16, 64)); mn = fminf(mn, __shfl_xor(mn, 32, 64));
      mx = fmaxf(mx, __shfl_xor(mx, 16, 64)); mx = fmaxf(mx, __shfl_xor(mx, 32, 64));
      if (fq == 0) {
        if (mn != PINF) atomicMin(&smm[fr], f2key_(mn));
        if (mx != NINF) atomicMax(&smm[16 + fr], f2key_(mx));
      }
    }
    __syncthreads();
    {
      float lo = key2f_(smm[fr]), hi = key2f_(smm[16 + fr]);
      if (j >= 32) { const float mg = 0.125f * (hi - lo); lo -= mg; hi += mg; }
      const float s16 = (hi > lo) ? 65536.0f / (hi - lo) : 0.f;
      const float nlo = -lo * s16;
      unsigned* hq = hist + fr * 256;
      unsigned short* kq = keys16 + fr * KEYS_LD + fq * 4;
      f16x8 a[NB];
#pragma unroll
      for (int u = 0; u < NB; ++u) a[u] = afirst[u];
      for (int kt0 = wids; kt0 < j; kt0 += 8 * NB) {
        f16x8 an[NB];
        IK_LOAD(an, kt0 + 8 * NB);
#pragma unroll
        for (int u = 0; u < NB; ++u) {
          const int kt = kt0 + 8 * u;
          if (kt < j) {
            f32x4 sc = score_tile(a[u], bq, bc_hi, bc_lo, wq);
            unsigned kk[4];
#pragma unroll
            for (int jj = 0; jj < 4; ++jj) {
              int k16 = min(max((int)__builtin_fmaf(sc[jj], s16, nlo), 0), 65535);
              kk[jj] = (unsigned)k16;
              atomicAdd(&hq[k16 >> 8], 1u);
            }
            uint2 pk;
            pk.x = kk[0] | (kk[1] << 16);
            pk.y = kk[2] | (kk[3] << 16);
            *(uint2*)(kq + kt * 16) = pk;
          }
        }
#pragma unroll
        for (int u = 0; u < NB; ++u) a[u] = an[u];
      }
      if ((j & 7) == wids) {
        f32x4 sc = score_tile(ad, bq, bc_hi, bc_lo, wq);
        unsigned kk[4];
#pragma unroll
        for (int jj = 0; jj < 4; ++jj) {
          int k16 = min(max((int)__builtin_fmaf(sc[jj], s16, nlo), 0), 65535);
          kk[jj] = (unsigned)k16;
          if (fq * 4 + jj <= fr) atomicAdd(&hq[k16 >> 8], 1u);
        }
        uint2 pk;
        pk.x = kk[0] | (kk[1] << 16);
        pk.y = kk[2] | (kk[3] << 16);
        *(uint2*)(kq + j * 16) = pk;
      }
    }
#undef IK_LOAD
#undef NB
    __syncthreads();
    if (V == 2) continue;
    {
      const int q0 = 2 * wid, lq0 = l0 + q0;
      const int nmax = lq0 + 2;
      unsigned* hrow0 = hist + q0 * 256;
      const unsigned short* krow0 = keys16 + q0 * KEYS_LD;
      if (lane < 4) sbin[2 * q0 + lane] = 0;
      find_bin(hrow0, 256, lane, &sbin[2 * q0], &sbin[2 * q0 + 1]);
      find_bin(hrow0 + 256, 256, lane, &sbin[2 * q0 + 2], &sbin[2 * q0 + 3]);
      asm volatile("s_waitcnt lgkmcnt(0)" ::: "memory");
      const int b1s0 = sbin[2 * q0], ab0 = sbin[2 * q0 + 1], b1s1 = sbin[2 * q0 + 2], ab1 = sbin[2 * q0 + 3];
      asm volatile("s_waitcnt lgkmcnt(0)" ::: "memory");
      *(uint4*)(hrow0 + 4 * lane) = make_uint4(0u, 0u, 0u, 0u);
      *(uint4*)(hrow0 + 256 + 4 * lane) = make_uint4(0u, 0u, 0u, 0u);
      if (lane < 4) sbin[2 * q0 + lane] = 0;
      asm volatile("s_waitcnt lgkmcnt(0)" ::: "memory");
      for (int s4 = lane * 4; s4 < nmax; s4 += 256) {
        uint2 pa_ = *(const uint2*)(krow0 + s4), pb_ = *(const uint2*)(krow0 + KEYS_LD + s4);
        unsigned ka[4] = {pa_.x & 0xffffu, pa_.x >> 16, pa_.y & 0xffffu, pa_.y >> 16};
        unsigned kb[4] = {pb_.x & 0xffffu, pb_.x >> 16, pb_.y & 0xffffu, pb_.y >> 16};
#pragma unroll
        for (int jj = 0; jj < 4; ++jj) {
          if (s4 + jj <= lq0 && (int)(ka[jj] >> 8) == b1s0) atomicAdd(&hrow0[ka[jj] & 255u], 1u);
          if (s4 + jj <= lq0 + 1 && (int)(kb[jj] >> 8) == b1s1) atomicAdd(&hrow0[256 + (kb[jj] & 255u)], 1u);
        }
      }
      asm volatile("s_waitcnt lgkmcnt(0)" ::: "memory");
      find_bin(hrow0, 256 - ab0, lane, &sbin[2 * q0], &sbin[2 * q0 + 1]);
      find_bin(hrow0 + 256, 256 - ab1, lane, &sbin[2 * q0 + 2], &sbin[2 * q0 + 3]);
      asm volatile("s_waitcnt lgkmcnt(0)" ::: "memory");
      const unsigned thr0 = (unsigned)((b1s0 << 8) | sbin[2 * q0]), thr1 = (unsigned)((b1s1 << 8) | sbin[2 * q0 + 2]);
      int base0 = 0, cb0 = 0, base1 = 0, cb1 = 0;
      for (int s0 = 0; s0 < nmax; s0 += 256) {
        const int s4 = s0 + lane * 4;
        uint2 pa_ = make_uint2(0u, 0u), pb_ = make_uint2(0u, 0u);
        if (s4 < nmax) { pa_ = *(const uint2*)(krow0 + s4); pb_ = *(const uint2*)(krow0 + KEYS_LD + s4); }
        unsigned ka[4] = {pa_.x & 0xffffu, pa_.x >> 16, pa_.y & 0xffffu, pa_.y >> 16};
        unsigned kb[4] = {pb_.x & 0xffffu, pb_.x >> 16, pb_.y & 0xffffu, pb_.y >> 16};
#pragma unroll
        for (int jj = 0; jj < 4; ++jj) {
          const bool ok0 = (s4 + jj <= lq0), ok1 = (s4 + jj <= lq0 + 1);
          const bool t0_ = ok0 && (ka[jj] > thr0), c0_ = ok0 && (ka[jj] == thr0);
          const bool t1_ = ok1 && (kb[jj] > thr1), c1_ = ok1 && (kb[jj] == thr1);
          unsigned long long m0 = __ballot(t0_), m1 = __ballot(t1_), cm0 = __ballot(c0_), cm1 = __ballot(c1_);
          if (t0_) ssel[q0 * 256 + base0 + __popcll(m0 & lt_mask)] = (unsigned short)(s4 + jj);
          if (t1_) ssel[q0 * 256 + 256 + base1 + __popcll(m1 & lt_mask)] = (unsigned short)(s4 + jj);
          base0 += __popcll(m0); base1 += __popcll(m1);
          if (cm0 | cm1) {
            int cp0 = cb0 + __popcll(cm0 & lt_mask), cp1 = cb1 + __popcll(cm1 & lt_mask);
            if (c0_ && cp0 < 64) scand[q0 * 64 + cp0] = (unsigned short)(s4 + jj);
            if (c1_ && cp1 < 64) scand[q0 * 64 + 64 + cp1] = (unsigned short)(s4 + jj);
            cb0 += __popcll(cm0); cb1 += __popcll(cm1);
          }
        }
      }
      asm volatile("s_waitcnt lgkmcnt(0)" ::: "memory");
#pragma unroll
      for (int x = 0; x < 2; ++x) {
        const int q = q0 + x;
        const int base = x ? base1 : base0, c = min(x ? cb1 : cb0, 64), r = 256 - base;
        if (lane < c) {
          unsigned short my = scand[q * 64 + lane];
          int rank = 0;
          for (int k = 0; k < c; ++k) rank += (scand[q * 64 + k] < my) ? 1 : 0;
          if (rank < r) ssel[q * 256 + base + rank] = my;
        }
      }
    }
    asm volatile("s_waitcnt lgkmcnt(0)" ::: "memory");
#pragma unroll 1
    for (int qq = 0; qq < 2; ++qq) {
      const int q = 2 * wid + qq, lq = l0 + q;
      unsigned short* sl = ssel + q * 256;
      for (int i = lane; i < 256; i += 64) sl[i] = (unsigned short)min((int)sl[i], lq);
      asm volatile("s_waitcnt lgkmcnt(0)" ::: "memory");
      attn_one(proj16, pa16, t0 + q, sl, (char*)(keys16 + (2 * wid) * KEYS_LD), lane);
    }
    __syncthreads();
  }
}

#define DL_LD 1040
template <int W>
__device__ __forceinline__ void pool_delta(const f16* up, int lf, char* dp) {
  f16x8 u[W + 7];
#pragma unroll
  for (int k = 0; k < W + 7; ++k) {
    const int rel = k - (W - 1);
    f16x8 z = {(f16)0.f, (f16)0.f, (f16)0.f, (f16)0.f, (f16)0.f, (f16)0.f, (f16)0.f, (f16)0.f};
    u[k] = (lf + rel >= 0) ? *(const f16x8*)(up + (ptrdiff_t)rel * PJ_W) : z;
  }
  float sum[8];
#pragma unroll
  for (int e = 0; e < 8; ++e) sum[e] = 0.f;
#pragma unroll
  for (int k = 0; k < W - 1; ++k)
#pragma unroll
    for (int e = 0; e < 8; ++e) sum[e] += (float)u[k][e];
#pragma unroll
  for (int i = 0; i < 8; ++i) {
    const float inv = 1.0f / (float)min(lf + i + 1, W);
    f16x8 d;
#pragma unroll
    for (int e = 0; e < 8; ++e) {
      sum[e] += (float)u[W - 1 + i][e];
      d[e] = (f16)(sum[e] * inv - (float)u[W - 1 + i][e]);
      sum[e] -= (float)u[i][e];
    }
    *(f16x8*)(dp + i * DL_LD) = d;
  }
}
__device__ __forceinline__ void p_pool(const Params& p, char* shm) {
  const f16* proj16 = (const f16*)(p.ws + OFF_B);
  const f16* wpl = (const f16*)(p.ws + OFF_WPOOL);
  f16* pa16 = (f16*)(p.ws + OFF_D);
  const int tid = opaque_tid(), wid = tid >> 6, lane = tid & 63, fr = lane & 15, fq = lane >> 4;
  for (int item = blockIdx.x; item < T_TOK / 64; item += gridDim.x) {
    const int t0 = item * 64;
    {
      const int g = wid >> 1;
      const int c = g * 128 + ((wid & 1) * 8 + (lane & 7)) * 8;
      const int tg = lane >> 3;
      const int tf = t0 + tg * 8, lf = tf & (SEQ - 1);
      const f16* up = proj16 + (size_t)tf * PJ_W + c;
      char* dp = shm + (tg * 8) * DL_LD + c * 2;
      if (g == 0) pool_delta<2>(up, lf, dp);
      else if (g == 1) pool_delta<4>(up, lf, dp);
      else if (g == 2) pool_delta<8>(up, lf, dp);
      else pool_delta<16>(up, lf, dp);
    }
    __syncthreads();
    {
      const int g = wid >> 1, eh = wid & 1;
      f32x4 acc[4][4];
#pragma unroll
      for (int m = 0; m < 4; ++m)
#pragma unroll
        for (int n = 0; n < 4; ++n) acc[m][n] = (f32x4){0.f, 0.f, 0.f, 0.f};
#pragma unroll
      for (int ks = 0; ks < 4; ++ks) {
        f16x8 A[4], B[4];
#pragma unroll
        for (int m = 0; m < 4; ++m) A[m] = *(const f16x8*)(wpl + (size_t)(g * 128 + eh * 64 + m * 16 + fr) * 128 + ks * 32 + fq * 8);
#pragma unroll
        for (int n = 0; n < 4; ++n) B[n] = *(const f16x8*)(shm + (n * 16 + fr) * DL_LD + (g * 128 + ks * 32 + fq * 8) * 2);
#pragma unroll
        for (int m = 0; m < 4; ++m)
#pragma unroll
          for (int n = 0; n < 4; ++n) acc[m][n] = __builtin_amdgcn_mfma_f32_16x16x32_f16(A[m], B[n], acc[m][n], 0, 0, 0);
      }
#pragma unroll
      for (int m = 0; m < 4; ++m) {
        const int e0 = g * 128 + eh * 64 + m * 16 + fq * 4;
        float4 sc = *(const float4*)(p.pool_scale + e0);
#pragma unroll
        for (int n = 0; n < 4; ++n) {
          f16x4 o;
          o[0] = (f16)(acc[m][n][0] * sc.x); o[1] = (f16)(acc[m][n][1] * sc.y);
          o[2] = (f16)(acc[m][n][2] * sc.z); o[3] = (f16)(acc[m][n][3] * sc.w);
          *(f16x4*)(pa16 + (size_t)(t0 + n * 16 + fr) * DM + e0) = o;
        }
      }
    }
    __syncthreads();
  }
}

#define RW_LD 2064
#define RT_LDS (2 * 36 * RW_LD)
template <int V>
__device__ __forceinline__ void p_ln1_route(const Params& p, char* shm) {
  const f16* z16 = (const f16*)(p.ws + OFF_C);
  char* dmy = (char*)p.out;
  f16* h1 = (V == 0) ? (f16*)(p.ws + OFF_A) : (f16*)dmy;
  int* route_e = (V == 0) ? (int*)(p.ws + OFF_ROUTE_E) : (int*)(dmy + 68000000);
  float* route_w = (V == 0) ? (float*)(p.ws + OFF_ROUTE_W) : (float*)(dmy + 69000000);
  int* counts = (V == 0) ? (int*)(p.ws + OFF_CNT) : (int*)(dmy + 70000000);
  int* lists = (V == 0) ? (int*)(p.ws + OFF_LISTS) : (int*)(dmy + 71000000);
  int* lcnt = (int*)(shm + RT_LDS);
  int* lent = lcnt + 128;
  const int tid = opaque_tid(), wid = tid >> 6, lane = tid & 63, fr = lane & 15, fq = lane >> 4;
  if (tid < 128) lcnt[tid] = 0;
  {
    const f16* wsrc = (const f16*)(p.ws + OFF_WRT);
    for (int i = tid; i < 2 * 36 * 128; i += 512) {
      int img = i / (36 * 128), rem = i % (36 * 128), o = rem >> 7, c = rem & 127;
      *(f16x8*)(shm + (img * 36 + o) * RW_LD + c * 16) = *(const f16x8*)(wsrc + (size_t)(img * 36 + o) * 1024 + c * 8);
    }
  }
  __syncthreads();
  for (int t0 = (blockIdx.x * 8 + wid) * 16; t0 < T_TOK; t0 += gridDim.x * 8 * 16) {
    const f16* zr = z16 + (size_t)(t0 + fr) * DM + fq * 8;
    float s1 = 0.f, s2 = 0.f;
#pragma unroll 8
    for (int ks = 0; ks < 32; ++ks) {
      f16x8 xz = *(const f16x8*)(zr + ks * 32);
#pragma unroll
      for (int e = 0; e < 8; ++e) { float x = (float)xz[e]; s1 += x; s2 += x * x; }
    }
    s1 += __shfl_xor(s1, 16, 64); s1 += __shfl_xor(s1, 32, 64);
    s2 += __shfl_xor(s2, 16, 64); s2 += __shfl_xor(s2, 32, 64);
    const float mu = s1 * (1.0f / DM);
    const float rs = rsqrtf(fmaxf(s2 * (1.0f / DM) - mu * mu, 0.f) + 1e-5f);
    f32x4 acc[3];
#pragma unroll
    for (int mt = 0; mt < 3; ++mt) acc[mt] = (f32x4){0.f, 0.f, 0.f, 0.f};
    f16* hr = h1 + (size_t)(t0 + fr) * DM + fq * 8;
    const char* wa = shm + fr * RW_LD + fq * 16;
    const char* wa2 = shm + min(32 + fr, 35) * RW_LD + fq * 16;
#pragma unroll 4
    for (int ks = 0; ks < 32; ++ks) {
      f16x8 xz = *(const f16x8*)(zr + ks * 32);
      float4 g0 = *(const float4*)(p.ln1_g + ks * 32 + fq * 8), g1 = *(const float4*)(p.ln1_g + ks * 32 + fq * 8 + 4);
      float4 b0 = *(const float4*)(p.ln1_b + ks * 32 + fq * 8), b1 = *(const float4*)(p.ln1_b + ks * 32 + fq * 8 + 4);
      float hn[8];
      hn[0] = ((float)xz[0] - mu) * rs * g0.x + b0.x; hn[1] = ((float)xz[1] - mu) * rs * g0.y + b0.y;
      hn[2] = ((float)xz[2] - mu) * rs * g0.z + b0.z; hn[3] = ((float)xz[3] - mu) * rs * g0.w + b0.w;
      hn[4] = ((float)xz[4] - mu) * rs * g1.x + b1.x; hn[5] = ((float)xz[5] - mu) * rs * g1.y + b1.y;
      hn[6] = ((float)xz[6] - mu) * rs * g1.z + b1.z; hn[7] = ((float)xz[7] - mu) * rs * g1.w + b1.w;
      f16x8 bh, bl;
#pragma unroll
      for (int e = 0; e < 8; ++e) { bh[e] = (f16)hn[e]; bl[e] = (f16)(hn[e] - (float)bh[e]); }
      *(f16x8*)(hr + ks * 32) = bh;
#pragma unroll
      for (int mt = 0; mt < 3; ++mt) {
        const char* wp = (mt < 2) ? (wa + mt * 16 * RW_LD) : wa2;
        f16x8 ah = *(const f16x8*)(wp + ks * 64), al = *(const f16x8*)(wp + 36 * RW_LD + ks * 64);
        acc[mt] = __builtin_amdgcn_mfma_f32_16x16x32_f16(ah, bh, acc[mt], 0, 0, 0);
        acc[mt] = __builtin_amdgcn_mfma_f32_16x16x32_f16(ah, bl, acc[mt], 0, 0, 0);
        acc[mt] = __builtin_amdgcn_mfma_f32_16x16x32_f16(al, bh, acc[mt], 0, 0, 0);
      }
    }
    float lg[36];
#pragma unroll
    for (int o = 0; o < 36; ++o) lg[o] = __shfl(acc[o >> 4][o & 3], fr + 16 * ((o >> 2) & 3), 64);
    {
      float gl[4];
#pragma unroll
      for (int o = 0; o < 4; ++o) gl[o] = lg[o] + p.b_group[o];
      int g = 0;
      float m = gl[0];
#pragma unroll
      for (int o = 1; o < 4; ++o) if (gl[o] > m) { m = gl[o]; g = o; }
      float se = 0.f;
#pragma unroll
      for (int o = 0; o < 4; ++o) se += __expf(gl[o] - m);
      float pg = 1.0f / se;
      float v1 = -3e38f, v2 = -3e38f;
      int i1 = 0, i2 = 0;
#pragma unroll
      for (int jx = 0; jx < 8; ++jx) {
        float x = (g == 0) ? lg[4 + jx] : (g == 1) ? lg[12 + jx] : (g == 2) ? lg[20 + jx] : lg[28 + jx];
        x += p.b_router[g * 8 + jx];
        if (x > v1) { v2 = v1; i2 = i1; v1 = x; i1 = jx; }
        else if (x > v2) { v2 = x; i2 = jx; }
      }
      if (fq == 0) {
        const int tt = t0 + fr;
        float e2 = __expf(v2 - v1);
        float w1 = pg / (1.0f + e2), w2 = pg * e2 / (1.0f + e2);
        int ea = g * 8 + i1, eb = g * 8 + i2;
        route_e[2 * tt] = ea; route_e[2 * tt + 1] = eb;
        route_w[2 * tt] = w1; route_w[2 * tt + 1] = w2;
        int la = atomicAdd(&lcnt[ea], 1), lb = atomicAdd(&lcnt[eb], 1);
        int slot = atomicAdd(&lcnt[64], 2);
        if (slot + 1 < 512) {
          lent[2 * slot] = (ea << 16) | la; lent[2 * slot + 1] = 2 * tt;
          lent[2 * slot + 2] = (eb << 16) | lb; lent[2 * slot + 3] = 2 * tt + 1;
        }
      }
    }
  }
  __syncthreads();
  if (tid < 32) lcnt[32 + tid] = atomicAdd(&counts[tid * CNT_STRIDE], lcnt[tid]);
  __syncthreads();
  {
    const int n_ent = min(lcnt[64], 512);
    for (int i = tid; i < n_ent; i += 512) {
      int ev = lent[2 * i], id = lent[2 * i + 1];
      int e = ev >> 16, lp = ev & 0xffff;
      lists[(size_t)e * T_TOK + lcnt[32 + e] + lp] = id;
    }
  }
  __syncthreads();
}

__device__ __forceinline__ void p_final(const Params& p) {
  const f16* h1 = (const f16*)(p.ws + OFF_A);
  const f16* y16 = (const f16*)(p.ws + OFF_C);
  const int tid = opaque_tid(), wid = tid >> 6, lane = tid & 63;
  const int nw = gridDim.x * 8;
  int t = blockIdx.x * 8 + wid;
  f16x8 hv[2], y0[2], y1[2];
#define P7_LOAD(tt)                                                                          \
  _Pragma("unroll") for (int i = 0; i < 2; ++i) {                                            \
    hv[i] = *(const f16x8*)(h1 + (size_t)(tt) * DM + i * 512 + lane * 8);                    \
    y0[i] = *(const f16x8*)(y16 + (size_t)(2 * (tt)) * DM + i * 512 + lane * 8);             \
    y1[i] = *(const f16x8*)(y16 + (size_t)(2 * (tt) + 1) * DM + i * 512 + lane * 8);         \
  }
  if (t < T_TOK) { P7_LOAD(t); }
  for (; t < T_TOK; t += nw) {
    float v[16];
#pragma unroll
    for (int i = 0; i < 2; ++i)
#pragma unroll
      for (int e = 0; e < 8; ++e) v[i * 8 + e] = ALPHA * (float)hv[i][e] + ((float)y0[i][e] + (float)y1[i][e]);
    if (t + nw < T_TOK) { P7_LOAD(t + nw); }
    float s = 0.f;
#pragma unroll
    for (int i = 0; i < 16; ++i) s += v[i];
    float mu = wave_sum(s) * (1.0f / DM);
    float q = 0.f;
#pragma unroll
    for (int i = 0; i < 16; ++i) { v[i] -= mu; q += v[i] * v[i]; }
    float rs = rsqrtf(wave_sum(q) * (1.0f / DM) + 1e-5f);
#pragma unroll
    for (int i = 0; i < 2; ++i)
#pragma unroll
      for (int hf = 0; hf < 2; ++hf) {
        const int c = i * 512 + lane * 8 + hf * 4;
        float4 g = *(const float4*)(p.ln2_g + c), b = *(const float4*)(p.ln2_b + c);
        f32x4 o;
        o[0] = v[i * 8 + hf * 4 + 0] * rs * g.x + b.x; o[1] = v[i * 8 + hf * 4 + 1] * rs * g.y + b.y;
        o[2] = v[i * 8 + hf * 4 + 2] * rs * g.z + b.z; o[3] = v[i * 8 + hf * 4 + 3] * rs * g.w + b.w;
        *(f32x4*)(p.out + (size_t)t * DM + c) = o;
      }
  }
#undef P7_LOAD
}

#define MEGA_LDS 159232


#define XB_TMO      128
#define XB_XCNT(j)  (256  + 64 * (j))
#define XB_XSUB(j)  (1280 + 64 * (j))
#define XB_XGEN(j)  (2304 + 64 * (j))
#define XB_TOP      3328
#define XB_TOPGEN   3392
#define XCD_BAR_WORDS 3456
#define XB_SPIN_CAP (1u << 22)
#define LAS __attribute__((address_space(3)))
__device__ __forceinline__ unsigned xb_ld(unsigned* p) { return __hip_atomic_load(p, __ATOMIC_RELAXED, __HIP_MEMORY_SCOPE_AGENT); }
__device__ __forceinline__ unsigned xb_add(unsigned* p, unsigned v) { return __hip_atomic_fetch_add(p, v, __ATOMIC_RELAXED, __HIP_MEMORY_SCOPE_AGENT); }
__device__ __forceinline__ unsigned xb_xcc_id() { return (unsigned)__builtin_amdgcn_s_getreg((3 << 11) | 20) & 0xFu; }
#define XB_SPIN(cond, bar) do { unsigned _sp = 0; while (cond) { __builtin_amdgcn_s_sleep(1); \
    if ((++_sp & 255u) == 0u) { if (xb_ld(&(bar)[XB_TMO])) break; if (_sp > XB_SPIN_CAP) { atomicAdd(&(bar)[XB_TMO], 1u); break; } } } } while (0)
struct XcdBarrier { unsigned* bar; unsigned x; volatile unsigned* st; };
__device__ __forceinline__ XcdBarrier xcd_barrier_post(unsigned* bar, volatile unsigned* st) {
  XcdBarrier b; b.bar = bar; b.x = xb_xcc_id(); b.st = st;
  if (threadIdx.x == 0) (void)xb_add(&bar[XB_XCNT(b.x)], 1u);
  return b;
}
__device__ __forceinline__ void xcd_barrier_complete(unsigned* bar, unsigned x, unsigned& nloc, unsigned& nx) {
  const unsigned G = gridDim.x * gridDim.y * gridDim.z;
  unsigned sum, cnt, mine, sp = 0u;
  for (;;) {
    sum = 0u; cnt = 0u; mine = 0u;
#pragma unroll
    for (unsigned j = 0; j < 16; ++j) { const unsigned c = xb_ld(&bar[XB_XCNT(j)]); sum += c; cnt += (c > 0u) ? 1u : 0u; mine = (j == x) ? c : mine; }
    if (sum == G) break;
    __builtin_amdgcn_s_sleep(1);
    if ((++sp & 255u) == 0u) { if (xb_ld(&bar[XB_TMO])) break; if (sp > XB_SPIN_CAP) { atomicAdd(&bar[XB_TMO], 1u); break; } }
  }
  nloc = mine > 0u ? mine : 1u; nx = cnt > 0u ? cnt : 1u;
}
__device__ __forceinline__ void xcd_barrier(const XcdBarrier& b) {
  asm volatile("s_waitcnt vmcnt(0)" ::: "memory");
  __syncthreads();
  if (threadIdx.x == 0) {
    unsigned* bar = b.bar;
    __builtin_amdgcn_s_waitcnt(0);
    unsigned nloc = b.st[0], nx = b.st[1];
    if (nloc == 0u) { xcd_barrier_complete(bar, b.x, nloc, nx); b.st[0] = nloc; b.st[1] = nx; }
    const unsigned old = xb_add(&bar[XB_XSUB(b.x)], 1u);
    const unsigned gen = old / nloc;
    if (old + 1u == (gen + 1u) * nloc) {
      __builtin_amdgcn_fence(__ATOMIC_RELEASE, "agent");
      asm volatile("s_waitcnt vmcnt(0)" ::: "memory");
      const unsigned og = xb_add(&bar[XB_TOP], 1u);
      const unsigned tg = og / nx;
      if (og + 1u == (tg + 1u) * nx) xb_add(&bar[XB_TOPGEN], 1u);
      else XB_SPIN(xb_ld(&bar[XB_TOPGEN]) == tg, bar);
      __builtin_amdgcn_fence(__ATOMIC_ACQUIRE, "agent");
      xb_add(&bar[XB_XGEN(b.x)], 1u);
      asm volatile("s_waitcnt vmcnt(0)" ::: "memory");
    } else {
      XB_SPIN(xb_ld(&bar[XB_XGEN(b.x)]) == gen, bar);
      __builtin_amdgcn_fence(__ATOMIC_ACQUIRE, "agent");
      asm volatile("s_waitcnt vmcnt(0)" ::: "memory");
    }
  }
  __syncthreads();
}

#ifndef PROBE
#define PROBE 0
#endif
#define GSYNC() do { XcdBarrier xb_; xb_.bar = (unsigned*)(p.ws + OFF_BAR); xb_.x = xb_xcc_id(); xb_.st = (volatile unsigned*)(shm + MEGA_LDS); xcd_barrier(xb_); } while (0)
#define PH(n, code) do { code; if (PROBE == n) { GSYNC(); code; } } while (0)
__global__ __launch_bounds__(512) void mega(Params p) {
  __shared__ __attribute__((aligned(1024))) char shm[MEGA_LDS + 16];
  volatile unsigned* xst = (volatile unsigned*)(shm + MEGA_LDS);
  if (threadIdx.x < 4) xst[threadIdx.x] = 0u;
  __syncthreads();
  (void)xcd_barrier_post((unsigned*)(p.ws + OFF_BAR), xst);
  if (blockIdx.x == 0 && threadIdx.x < 32) ((int*)(p.ws + OFF_CNT))[threadIdx.x * CNT_STRIDE] = 0;
  PH(1, p_ln_in(p));
  PH(2, p_convert(p, shm));
  GSYNC();
  PH(3, p_inproj(p, shm));
  GSYNC();
  PH(4, p_pool(p, shm));
  PH(5, p_index<0>(p, shm));
#if PROBE >= 50 && PROBE < 60
  GSYNC();
  p_index<PROBE - 50>(p, shm);
#endif
  GSYNC();
  PH(7, p_merge(p, shm));
  GSYNC();
  PH(8, p_resid(p, shm));
  GSYNC();
  p_ln1_route<0>(p, shm);
  GSYNC();
#if PROBE == 9
  if (blockIdx.x == 0 && threadIdx.x < 32) ((int*)((char*)p.out + 70000000))[threadIdx.x * CNT_STRIDE] = 0;
  GSYNC();
  p_ln1_route<1>(p, shm);
  GSYNC();
#endif
  PH(10, p_moe_a(p, shm));
  GSYNC();
  PH(11, p_moe_b(p, shm));
  GSYNC();
  PH(12, p_final(p));
}

extern "C" void kernel_launch(void* const* d_in, const int* in_sizes, int n_in, void* d_out, int out_size, void* d_ws,
                              size_t ws_size, hipStream_t stream) {
  if (ws_size < WS_NEEDED) { fprintf(stderr, "ws too small: %zu < %zu\n", ws_size, (size_t)WS_NEEDED); return; }
  static int grid_blocks = 0;
  if (!grid_blocks) {
    int dev = 0, cus = 0, per_cu = 0;
    hipGetDevice(&dev);
    hipDeviceGetAttribute(&cus, hipDeviceAttributeMultiprocessorCount, dev);
    hipOccupancyMaxActiveBlocksPerMultiprocessor(&per_cu, mega, 512, 0);
    if (per_cu > 1) per_cu = 1;
    grid_blocks = cus * per_cu;
    fprintf(stderr, "mega: cus=%d per_cu=%d grid=%d\n", cus, per_cu, grid_blocks);
  }
  Params p{};
  const float** pp = (const float**)&p;
  for (int i = 0; i < 21; ++i) pp[i] = (const float*)d_in[i];
  p.out = (float*)d_out;
  p.ws = (char*)d_ws;
  (void)hipMemsetAsync((char*)d_ws + OFF_BAR, 0, 16384, stream);
  void* args[] = {&p};
  hipError_t e = hipLaunchCooperativeKernel((void*)mega, dim3(grid_blocks), dim3(512), args, 0, stream);
  if (e != hipSuccess) fprintf(stderr, "cooperative launch failed: %s (grid %d)\n", hipGetErrorString(e), grid_blocks);
}
```

```cpp
#include <hip/hip_runtime.h>
#include <hip/hip_fp16.h>
#include <hip/hip_cooperative_groups.h>
#include <stdint.h>
#include <stdio.h>
namespace cg = cooperative_groups;

typedef _Float16 f16;
typedef f16 f16x8 __attribute__((ext_vector_type(8)));
typedef f16 f16x4 __attribute__((ext_vector_type(4)));
typedef f16 f16x2 __attribute__((ext_vector_type(2)));
typedef float f32x4 __attribute__((ext_vector_type(4)));
typedef int i32x4 __attribute__((ext_vector_type(4)));

#define T_TOK 32768
#define DM 1024
#define SEQ 4096
#define PJ_W 1536
#define PA_W 1448
#define IN_W 3496
#define IN_WP 3584
#define C_Q 512
#define C_K 1024
#define C_V 1088
#define C_IQ 1152
#define C_IK 1408
#define C_IW 1440
#define ALPHA 1.189207115002721f
#define NEG_BIG (-1e30f)

#define SZ_A   ((size_t)T_TOK * DM * 2)
#define SZ_B   ((size_t)T_TOK * PJ_W * 2)
#define SZ_C   ((size_t)T_TOK * 2048 * 2)
#define SZ_D   ((size_t)T_TOK * DM * 2)
#define OFF_A  ((size_t)0)
#define OFF_B  (OFF_A + SZ_A)
#define OFF_C  (OFF_B + SZ_B)
#define OFF_D  (OFF_C + SZ_C)
#define OFF_W  (OFF_D + SZ_D)
#define OFF_WIN   (OFF_W)
#define OFF_WPOOL (OFF_WIN + (size_t)IN_WP * 1024 * 2)
#define OFF_WPP   (OFF_WPOOL + (size_t)4 * 128 * 128 * 2)
#define OFF_WPA   (OFF_WPP + (size_t)1024 * 512 * 2)
#define OFF_WOUT  (OFF_WPA + (size_t)1024 * 512 * 2)
#define OFF_WGU   (OFF_WOUT + (size_t)1024 * 1024 * 2)
#define OFF_WDN   (OFF_WGU + (size_t)32 * 512 * 1024 * 2)
#define OFF_MISC  (OFF_WDN + (size_t)32 * 1024 * 256 * 2)
#define OFF_ROUTE_E (OFF_MISC)
#define OFF_ROUTE_W (OFF_ROUTE_E + (size_t)T_TOK * 2 * 4)
#define OFF_COUNTS  (OFF_ROUTE_W + (size_t)T_TOK * 2 * 4)
#define OFF_LISTS   (OFF_COUNTS + 256)
#define OFF_SEL     (OFF_LISTS + (size_t)32 * T_TOK * 4)
#define OFF_CNT      (OFF_SEL + (size_t)T_TOK * 256 * 2)
#define OFF_WRT      (OFF_CNT + 4096)
#define OFF_IKC      (OFF_WRT + 2 * 36 * 1024 * 2)
#define OFF_BAR      (OFF_IKC + (size_t)T_TOK * 32 * 2)
#define WS_NEEDED   (OFF_BAR + 16384)
#define CNT_STRIDE 32

struct Params {
  const float *x, *ln_in_g, *ln_in_b, *w_in, *b_gate, *pool_w, *pool_scale, *wpp, *wpa, *w_out, *ln1_g, *ln1_b, *w_group,
      *b_group, *w_router, *b_router, *w_gate, *w_up, *w_down, *ln2_g, *ln2_b;
  float* out;
  char* ws;
};

__device__ __forceinline__ float wave_sum(float v) {
#pragma unroll
  for (int o = 32; o > 0; o >>= 1) v += __shfl_xor(v, o, 64);
  return v;
}
__device__ __forceinline__ float wave_max(float v) {
#pragma unroll
  for (int o = 32; o > 0; o >>= 1) v = fmaxf(v, __shfl_xor(v, o, 64));
  return v;
}
__device__ __forceinline__ int wave_sum_i(int v) {
#pragma unroll
  for (int o = 32; o > 0; o >>= 1) v += __shfl_xor(v, o, 64);
  return v;
}
__device__ __forceinline__ int opaque_tid() { int t = threadIdx.x; asm volatile("" : "+v"(t)); return t; }
__device__ __forceinline__ float ldf(const float* p) { return *p; }
__device__ __forceinline__ float ldf(const f16* p) { return (float)*p; }

#ifndef SKEW_P1
#define SKEW_P1 0
#endif
#define WAIT_V(n) asm volatile("s_waitcnt vmcnt(%0)" ::"n"(n) : "memory")
#define WAIT_L(n) asm volatile("s_waitcnt lgkmcnt(%0)" ::"n"(n) : "memory")
template <class T> __device__ __forceinline__ void st_nt(T* p, const T& v) { *p = v; }
#define RAW_SYNC() do { asm volatile("s_waitcnt lgkmcnt(0)" ::: "memory"); __builtin_amdgcn_s_barrier(); asm volatile("" ::: "memory"); } while (0)

__device__ __forceinline__ int lds_byte(int r, int c) {
  int ob = (r & 15) * 64 + c * 2;
  return (r >> 4) * 1024 + (ob ^ (((ob >> 9) & 1) << 5));
}
__device__ __forceinline__ void stage_rc(int b, int& R, int& C) {
  int st = b >> 10, sb = b & 1023, swz = sb ^ (((sb >> 9) & 1) << 5);
  R = st * 16 + swz / 64;
  C = (swz % 64) / 2;
}

#define TILE_B 16384
#define SLOT_B 32768
#define NSTG 2
#define GEMM_LDS 135168
#define EPI_LD 528

__device__ __forceinline__ void gemm_core(const f16* __restrict__ Ab, const unsigned (&pa)[NSTG], const f16* __restrict__ Bb,
                                          const unsigned (&pb)[NSTG], int nt, f32x4 (&acc)[8][4], char* shm) {
  const int tid = opaque_tid(), wid = tid >> 6, lane = tid & 63, wr = wid >> 2, wc = wid & 3, fr = lane & 15, fq = lane >> 4;
  const int nk = nt * 2;
#define SA(s_) (shm + (s_) * SLOT_B)
#define SB(s_) (shm + (s_) * SLOT_B + TILE_B)
#define GLDS_STAGE(slot, kt)                                                                                              \
  do {                                                                                                                    \
    _Pragma("unroll") for (int i = 0; i < NSTG; ++i) {                                                                   \
      __builtin_amdgcn_global_load_lds((const unsigned*)(Ab + pa[i] + (kt) * 32), (unsigned*)(SA(slot) + wid * 1024 + i * 8192), \
                                       16, 0, 0);                                                                         \
      __builtin_amdgcn_global_load_lds((const unsigned*)(Bb + pb[i] + (kt) * 32), (unsigned*)(SB(slot) + wid * 1024 + i * 8192), \
                                       16, 0, 0);                                                                         \
    }                                                                                                                     \
  } while (0)
  GLDS_STAGE(0, 0);
  GLDS_STAGE(1, 1);
  GLDS_STAGE(2, 2);
  const int aoff = lds_byte(wr * 128 + fr, fq * 8), boff = lds_byte(wc * 64 + fr, fq * 8);
  WAIT_V(8);
  __builtin_amdgcn_s_barrier();
  if (wr == 1) __builtin_amdgcn_s_barrier();
  for (int t = 0; t < nk; ++t) {
    if (t + 3 < nk) { GLDS_STAGE((t + 3) & 3, t + 3); WAIT_V(8); }
    else if (t + 2 < nk) WAIT_V(4);
    else WAIT_V(0);
    const char* sa = SA(t & 3) + aoff;
    const char* sb = SB(t & 3) + boff;
    f16x8 At[8], Bf[4];
#pragma unroll
    for (int n = 0; n < 4; ++n) Bf[n] = *(const f16x8*)(sb + n * 1024);
#pragma unroll
    for (int m = 0; m < 8; ++m) At[m] = *(const f16x8*)(sa + m * 1024);
    WAIT_L(0);
    __builtin_amdgcn_sched_barrier(0);
    __builtin_amdgcn_s_barrier();
    __builtin_amdgcn_sched_barrier(0);
#pragma unroll
    for (int m = 0; m < 8; ++m)
#pragma unroll
      for (int n = 0; n < 4; ++n) acc[m][n] = __builtin_amdgcn_mfma_f32_16x16x32_f16(At[m], Bf[n], acc[m][n], 0, 0, 0);
    __builtin_amdgcn_sched_barrier(0);
    __builtin_amdgcn_s_barrier();
    __builtin_amdgcn_sched_barrier(0);
  }
  if (wr == 0) __builtin_amdgcn_s_barrier();
  RAW_SYNC();
#undef SA
#undef SB
#undef GLDS_STAGE
}

__device__ __forceinline__ void epi_store_f16(const f32x4 (&acc)[8][4], char* shm) {
  const int tid = opaque_tid(), wid = tid >> 6, lane = tid & 63, wr = wid >> 2, wc = wid & 3, fr = lane & 15, fq = lane >> 4;
#pragma unroll
  for (int m = 0; m < 8; ++m)
#pragma unroll
    for (int n = 0; n < 4; ++n) {
      f16x4 v;
      v[0] = (f16)acc[m][n][0]; v[1] = (f16)acc[m][n][1]; v[2] = (f16)acc[m][n][2]; v[3] = (f16)acc[m][n][3];
      *(f16x4*)(shm + (wc * 64 + n * 16 + fr) * EPI_LD + (wr * 128 + m * 16 + fq * 4) * 2) = v;
    }
}

__device__ __forceinline__ void p_ln_in(const Params& p) {
  f16* h16 = (f16*)(p.ws + OFF_A);
  const int tid = opaque_tid(), lane = tid & 63, wid = tid >> 6;
  const int nw = gridDim.x * 8;
  for (int t = blockIdx.x * 8 + wid; t < T_TOK; t += nw) {
    const float* xr = p.x + (size_t)t * DM;
    float4 v[4];
#pragma unroll
    for (int i = 0; i < 4; ++i) v[i] = *(const float4*)(xr + i * 256 + lane * 4);
    float s = 0.f;
#pragma unroll
    for (int i = 0; i < 4; ++i) s += v[i].x + v[i].y + v[i].z + v[i].w;
    float mu = wave_sum(s) * (1.0f / DM);
    float q = 0.f;
#pragma unroll
    for (int i = 0; i < 4; ++i) {
      v[i].x -= mu; v[i].y -= mu; v[i].z -= mu; v[i].w -= mu;
      q += v[i].x * v[i].x + v[i].y * v[i].y + v[i].z * v[i].z + v[i].w * v[i].w;
    }
    float rs = rsqrtf(wave_sum(q) * (1.0f / DM) + 1e-5f);
#pragma unroll
    for (int i = 0; i < 4; ++i) {
      float4 g = *(const float4*)(p.ln_in_g + i * 256 + lane * 4), b = *(const float4*)(p.ln_in_b + i * 256 + lane * 4);
      f16x4 o;
      o[0] = (f16)(v[i].x * rs * g.x + b.x); o[1] = (f16)(v[i].y * rs * g.y + b.y);
      o[2] = (f16)(v[i].z * rs * g.z + b.z); o[3] = (f16)(v[i].w * rs * g.w + b.w);
      *(f16x4*)(h16 + (size_t)t * DM + i * 256 + lane * 4) = o;
    }
  }
}

template <class RowMap>
__device__ __forceinline__ void conv_tile(const float* __restrict__ src, int ld_src, int nvalid, int k0, int n0, f16* __restrict__ dst,
                                          int ld_dst, RowMap rm, float* sT) {
  const int tid = opaque_tid();
  {
    int k = tid >> 3, n = (tid & 7) * 8;
    const float* sp = src + (size_t)(k0 + k) * ld_src + n0 + n;
#pragma unroll
    for (int j = 0; j < 8; ++j) sT[k * 65 + n + j] = (n0 + n + j < nvalid) ? sp[j] : 0.f;
  }
  __syncthreads();
  {
    int n = tid >> 3, k = (tid & 7) * 8;
    f16x8 o;
#pragma unroll
    for (int j = 0; j < 8; ++j) o[j] = (f16)sT[(k + j) * 65 + n];
    int drow = rm(n0 + n);
    if (drow >= 0) *(f16x8*)(dst + (size_t)drow * ld_dst + k0 + k) = o;
  }
  __syncthreads();
}

struct RowId { __device__ int operator()(int n) const { return n; } };
struct RowGU { int up; __device__ int operator()(int ff) const {
  int tile = ff >> 7, wr = (ff >> 6) & 1, l = ff & 63; return tile * 256 + wr * 128 + up * 64 + l; } };

__device__ __forceinline__ void p_convert(const Params& p, char* shm) {
  float* sT = (float*)shm;
  char* ws = p.ws;
  const int J0 = 16 * 56, J1 = J0 + 16, J2 = J1 + 128, J3 = J2 + 128, J4 = J3 + 256, J5 = J4 + 32 * 64, J6 = J5 + 32 * 64,
            J7 = J6 + 32 * 64;
  for (int job = blockIdx.x; job < J7; job += gridDim.x) {
    if (job < J0) {
      int kt = job / 56, nt = job % 56;
      conv_tile(p.w_in, IN_W, IN_W, kt * 64, nt * 64, (f16*)(ws + OFF_WIN), 1024, RowId(), sT);
    } else if (job < J1) {
      int j = job - J0, g = j >> 2, kt = (j >> 1) & 1, nt = j & 1;
      conv_tile(p.pool_w + g * 128 * 128, 128, 128, kt * 64, nt * 64, (f16*)(ws + OFF_WPOOL) + g * 128 * 128, 128, RowId(), sT);
    } else if (job < J2) {
      int j = job - J1, kt = j >> 4, nt = j & 15;
      conv_tile(p.wpp, 1024, 1024, kt * 64, nt * 64, (f16*)(ws + OFF_WPP), 512, RowId(), sT);
    } else if (job < J3) {
      int j = job - J2, kt = j >> 4, nt = j & 15;
      conv_tile(p.wpa, 1024, 1024, kt * 64, nt * 64, (f16*)(ws + OFF_WPA), 512, RowId(), sT);
    } else if (job < J4) {
      int j = job - J3, kt = j >> 4, nt = j & 15;
      conv_tile(p.w_out, 1024, 1024, kt * 64, nt * 64, (f16*)(ws + OFF_WOUT), 1024, RowId(), sT);
    } else if (job < J6) {
      int up = job >= J5;
      int j = job - (up ? J5 : J4), e = j >> 6, kt = (j >> 2) & 15, nt = j & 3;
      RowGU rm; rm.up = up;
      conv_tile((up ? p.w_up : p.w_gate) + (size_t)e * 1024 * 256, 256, 256, kt * 64, nt * 64,
                (f16*)(ws + OFF_WGU) + (size_t)e * 512 * 1024, 1024, rm, sT);
    } else {
      int j = job - J6, e = j >> 6, kt = (j >> 4) & 3, nt = j & 15;
      conv_tile(p.w_down + (size_t)e * 256 * 1024, 1024, 1024, kt * 64, nt * 64, (f16*)(ws + OFF_WDN) + (size_t)e * 1024 * 256,
                256, RowId(), sT);
    }
  }
  {
    f16* whi = (f16*)(ws + OFF_WRT);
    f16* wlo = whi + 36 * 1024;
    for (int i = blockIdx.x * 512 + threadIdx.x; i < 36 * 1024; i += gridDim.x * 512) {
      int o = i >> 10, k = i & 1023;
      float w = (o < 4) ? p.w_group[k * 4 + o] : p.w_router[k * 32 + (o - 4)];
      f16 h = (f16)w;
      whi[i] = h;
      wlo[i] = (f16)(w - (float)h);
    }
  }
}

__device__ __forceinline__ void phase_skew(int us4) {
  const int k = (blockIdx.x >> 3) & 3;
  if (k) {
    const unsigned long long t0 = __builtin_amdgcn_s_memrealtime();
    const unsigned long long dt = (unsigned long long)(k * us4 * 25);
    while (__builtin_amdgcn_s_memrealtime() - t0 < dt) __builtin_amdgcn_s_sleep(8);
  }
}

__device__ __forceinline__ int xcd_item(int n_items, int r) {
  const int nx = 8, slots = gridDim.x >> 3;
  const int xcd = blockIdx.x & 7, slot = blockIdx.x >> 3;
  const int per = (n_items + nx - 1) / nx;
  const int local = slot + r * slots;
  if (local >= per) return -1;
  const int item = xcd * per + local;
  return (item < n_items) ? item : -2;
}

__device__ __forceinline__ void p_inproj(const Params& p, char* shm) {
  const f16* h16 = (const f16*)(p.ws + OFF_A);
  const f16* wT = (const f16*)(p.ws + OFF_WIN);
  f16* proj16 = (f16*)(p.ws + OFF_B);
  f16* gate16 = (f16*)(p.ws + OFF_C);
  f16* ikc = (f16*)(p.ws + OFF_IKC);
  const int tid = opaque_tid(), wid = tid >> 6, lane = tid & 63;
  int sR[NSTG], sC[NSTG];
#pragma unroll
  for (int i = 0; i < NSTG; ++i) stage_rc(wid * 1024 + i * 8192 + lane * 16, sR[i], sC[i]);
  const int NTILES = 128 * 14;
  if (SKEW_P1) phase_skew(SKEW_P1);
  for (int r = 0;; ++r) {
    int tile = xcd_item(NTILES, r);
    if (tile == -1) break;
    if (tile < 0) continue;
    int grp = tile / 56, rem = tile % 56;
    int ft = rem >> 2, tt = grp * 4 + (rem & 3);
    unsigned pa[NSTG], pb[NSTG];
#pragma unroll
    for (int i = 0; i < NSTG; ++i) {
      pa[i] = (unsigned)((ft * 256 + sR[i]) * 1024 + sC[i]);
      pb[i] = (unsigned)((tt * 256 + sR[i]) * 1024 + sC[i]);
    }
    f32x4 acc[8][4];
#pragma unroll
    for (int m = 0; m < 8; ++m)
#pragma unroll
      for (int n = 0; n < 4; ++n) acc[m][n] = (f32x4){0.f, 0.f, 0.f, 0.f};
    gemm_core(wT, pa, h16, pb, 16, acc, shm);
    epi_store_f16(acc, shm);
    RAW_SYNC();
    {
      int ch = tid & 31, r0 = tid >> 5;
      int f0 = ft * 256 + ch * 8;
      float bg[8];
      if (f0 >= PA_W && f0 < IN_W) {
#pragma unroll
        for (int j = 0; j < 8; ++j) bg[j] = p.b_gate[f0 - PA_W + j];
      } else {
#pragma unroll
        for (int j = 0; j < 8; ++j) bg[j] = 0.f;
      }
#pragma unroll 4
      for (int ps = 0; ps < 16; ++ps) {
        int r = ps * 16 + r0;
        f16x8 v = *(const f16x8*)(shm + r * EPI_LD + ch * 16);
        size_t tok = (size_t)tt * 256 + r;
        if (f0 < PA_W) {
          st_nt((f16x8*)(proj16 + tok * PJ_W + f0), v);
          if (f0 >= C_IK && f0 < C_IW) *(f16x8*)(ikc + tok * 32 + (f0 - C_IK)) = v;
        } else if (f0 < IN_W) {
          f16x8 o;
#pragma unroll
          for (int j = 0; j < 8; ++j) o[j] = (f16)__builtin_amdgcn_rcpf(1.0f + __builtin_amdgcn_exp2f(-1.4426950408889634f * ((float)v[j] + bg[j])));
          st_nt((f16x8*)(gate16 + tok * 2048 + (f0 - PA_W)), o);
        }
      }
    }
    RAW_SYNC();
  }
}


__device__ __forceinline__ void zero_acc(f32x4 (&acc)[8][4]) {
#pragma unroll
  for (int m = 0; m < 8; ++m)
#pragma unroll
    for (int n = 0; n < 4; ++n) acc[m][n] = (f32x4){0.f, 0.f, 0.f, 0.f};
}

template <class RowPtr>
__device__ __forceinline__ void epi_rows_out(char* shm, RowPtr rp) {
  const int tid = opaque_tid(), ch = tid & 31, r0 = tid >> 5;
#pragma unroll 4
  for (int ps = 0; ps < 16; ++ps) {
    int r = ps * 16 + r0;
    f16x8 v = *(const f16x8*)(shm + r * EPI_LD + ch * 16);
    f16* d = rp(r);
    if (d) st_nt((f16x8*)(d + ch * 8), v);
  }
}

__device__ __forceinline__ void p_merge(const Params& p, char* shm) {
  const f16* pa16 = (const f16*)(p.ws + OFF_D);
  const f16* gate16 = (const f16*)(p.ws + OFF_C);
  const f16* wpp = (const f16*)(p.ws + OFF_WPP);
  const f16* wpa = (const f16*)(p.ws + OFF_WPA);
  f16* merged16 = (f16*)(p.ws + OFF_B);
  const int tid = opaque_tid(), wid = tid >> 6, lane = tid & 63;
  int sR[NSTG], sC[NSTG];
#pragma unroll
  for (int i = 0; i < NSTG; ++i) stage_rc(wid * 1024 + i * 8192 + lane * 16, sR[i], sC[i]);
  const int ch = tid & 31, r0 = tid >> 5;
  for (int r = 0;; ++r) {
    int tile = xcd_item(512, r);
    if (tile == -1) break;
    if (tile < 0) continue;
    int ft = tile & 3, tt = tile >> 2;
    unsigned pa[NSTG], pb[NSTG];
#pragma unroll
    for (int i = 0; i < NSTG; ++i) {
      pa[i] = (unsigned)((ft * 256 + sR[i]) * 512 + sC[i]);
      pb[i] = (unsigned)((tt * 256 + sR[i]) * 1024 + sC[i]);
    }
    f32x4 acc[8][4];
    zero_acc(acc);
    gemm_core(wpp, pa, pa16, pb, 8, acc, shm);
    epi_store_f16(acc, shm);
    RAW_SYNC();
#pragma unroll 4
    for (int ps = 0; ps < 16; ++ps) {
      const int rr = ps * 16 + r0;
      const size_t tok = (size_t)tt * 256 + rr;
      f16x8 v = *(const f16x8*)(shm + rr * EPI_LD + ch * 16);
      f16x8 g0 = *(const f16x8*)(gate16 + tok * 2048 + ft * 256 + ch * 8);
      f16x8 g1 = *(const f16x8*)(gate16 + tok * 2048 + 1024 + ft * 256 + ch * 8);
      f16x8 o;
#pragma unroll
      for (int e = 0; e < 8; ++e) {
        float rq = fminf((float)g0[e] * __builtin_amdgcn_rcpf(fmaxf((float)g1[e], 6e-5f)), 16384.f);
        o[e] = (f16)fminf(fmaxf((float)v[e] * rq, -60000.f), 60000.f);
      }
      *(f16x8*)(shm + rr * EPI_LD + ch * 16) = o;
    }
    RAW_SYNC();
    {
      const int wid_ = tid >> 6, lane_ = tid & 63, wr = wid_ >> 2, wc = wid_ & 3, fr = lane_ & 15, fq = lane_ >> 4;
#pragma unroll
      for (int m = 0; m < 8; ++m)
#pragma unroll
        for (int n = 0; n < 4; ++n) {
          f16x4 c = *(const f16x4*)(shm + (wc * 64 + n * 16 + fr) * EPI_LD + (wr * 128 + m * 16 + fq * 4) * 2);
          acc[m][n] = (f32x4){(float)c[0], (float)c[1], (float)c[2], (float)c[3]};
        }
    }
    RAW_SYNC();
    gemm_core(wpa, pa, pa16 + 512, pb, 8, acc, shm);
    epi_store_f16(acc, shm);
    RAW_SYNC();
#pragma unroll 4
    for (int ps = 0; ps < 16; ++ps) {
      const int rr = ps * 16 + r0;
      const size_t tok = (size_t)tt * 256 + rr;
      f16x8 v = *(const f16x8*)(shm + rr * EPI_LD + ch * 16);
      f16x8 g1 = *(const f16x8*)(gate16 + tok * 2048 + 1024 + ft * 256 + ch * 8);
      f16x8 o;
#pragma unroll
      for (int e = 0; e < 8; ++e) o[e] = (f16)((float)v[e] * (float)g1[e]);
      *(f16x8*)(merged16 + tok * 1024 + ft * 256 + ch * 8) = o;
    }
    RAW_SYNC();
  }
}

__device__ __forceinline__ void p_resid(const Params& p, char* shm) {
  const f16* merged16 = (const f16*)(p.ws + OFF_B);
  const f16* h16 = (const f16*)(p.ws + OFF_A);
  const f16* wo = (const f16*)(p.ws + OFF_WOUT);
  f16* z16 = (f16*)(p.ws + OFF_C);
  const int tid = opaque_tid(), wid = tid >> 6, lane = tid & 63;
  int sR[NSTG], sC[NSTG];
#pragma unroll
  for (int i = 0; i < NSTG; ++i) stage_rc(wid * 1024 + i * 8192 + lane * 16, sR[i], sC[i]);
  const int ch = tid & 31, r0 = tid >> 5;
  for (int r = 0;; ++r) {
    int tile = xcd_item(512, r);
    if (tile == -1) break;
    if (tile < 0) continue;
    int ft = tile & 3, tt = tile >> 2;
    unsigned pa[NSTG], pb[NSTG];
#pragma unroll
    for (int i = 0; i < NSTG; ++i) {
      pa[i] = (unsigned)((ft * 256 + sR[i]) * 1024 + sC[i]);
      pb[i] = (unsigned)((tt * 256 + sR[i]) * 1024 + sC[i]);
    }
    {
      f32x4 acc[8][4];
      zero_acc(acc);
      gemm_core(wo, pa, merged16, pb, 16, acc, shm);
      epi_store_f16(acc, shm);
    }
    RAW_SYNC();
#pragma unroll 4
    for (int ps = 0; ps < 16; ++ps) {
      const int rr = ps * 16 + r0;
      const size_t o = ((size_t)tt * 256 + rr) * 1024 + ft * 256 + ch * 8;
      f16x8 v = *(const f16x8*)(shm + rr * EPI_LD + ch * 16);
      f16x8 hv = *(const f16x8*)(h16 + o);
      f16x8 zz;
#pragma unroll
      for (int e = 0; e < 8; ++e) zz[e] = (f16)(ALPHA * (float)hv[e] + (float)v[e]);
      *(f16x8*)(z16 + o) = zz;
    }
    RAW_SYNC();
  }
}

#define HID_ROWS 73728
#define MOE_TAB (GEMM_LDS + 2048)
__device__ __forceinline__ void moe_tables(const int* counts, char* shm) {
  int* tab = (int*)(shm + MOE_TAB);
  if (threadIdx.x == 0) {
    int pf = 0, pn = 0, pr = 0;
    for (int e = 0; e < 32; ++e) {
      int n = counts[e * CNT_STRIDE];
      tab[e] = pf; tab[33 + e] = pn; tab[66 + e] = pr;
      pf += min(8, (n + 255) >> 8);
      pn += (max(n - 2048, 0) + 63) >> 6;
      pr += ((n + 255) >> 8) << 8;
    }
    tab[32] = pf; tab[65] = pn; tab[98] = pr;
  }
  __syncthreads();
}
__device__ __forceinline__ void moe_find(const int* pre, int item, int& e, int& mt) {
  e = 0;
  for (int i = 1; i < 32; ++i) if (item >= pre[i]) e = i;
  mt = item - pre[e];
}

#define NSLOT_B 20480
__device__ __forceinline__ void gemm_core_narrow(const f16* __restrict__ Ab, const unsigned (&pa)[NSTG], const f16* __restrict__ Bb,
                                                 unsigned pb, int nt, const int (&ablk)[2], f32x4 (&acc)[2][4], char* shm) {
  const int tid = opaque_tid(), wid = tid >> 6, lane = tid & 63, fr = lane & 15, fq = lane >> 4;
  const int nk = nt * 2;
  const bool hasb = (wid < 4);
#define SA(s_) (shm + (s_) * NSLOT_B)
#define SB(s_) (shm + (s_) * NSLOT_B + TILE_B)
#define NSTAGE(slot, kt)                                                                                                  \
  do {                                                                                                                    \
    _Pragma("unroll") for (int i = 0; i < NSTG; ++i)                                                                     \
      __builtin_amdgcn_global_load_lds((const unsigned*)(Ab + pa[i] + (kt) * 32), (unsigned*)(SA(slot) + wid * 1024 + i * 8192), \
                                       16, 0, 0);                                                                         \
    if (hasb) __builtin_amdgcn_global_load_lds((const unsigned*)(Bb + pb + (kt) * 32), (unsigned*)(SB(slot) + wid * 1024), 16, 0, 0); \
  } while (0)
  NSTAGE(0, 0);
  NSTAGE(1, 1);
  NSTAGE(2, 2);
  const int a0 = lds_byte(ablk[0] * 16 + fr, fq * 8), a1 = lds_byte(ablk[1] * 16 + fr, fq * 8), boff = lds_byte(fr, fq * 8);
  for (int t = 0; t < nk; ++t) {
    if (hasb) { if (t + 2 < nk) WAIT_V(6); else if (t + 1 < nk) WAIT_V(3); else WAIT_V(0); }
    else      { if (t + 2 < nk) WAIT_V(4); else if (t + 1 < nk) WAIT_V(2); else WAIT_V(0); }
    __builtin_amdgcn_s_barrier();
    if (t + 3 < nk) NSTAGE((t + 3) & 3, t + 3);
    const char* sa = SA(t & 3);
    const char* sb = SB(t & 3) + boff;
    f16x8 A0 = *(const f16x8*)(sa + a0), A1 = *(const f16x8*)(sa + a1), Bf[4];
#pragma unroll
    for (int n = 0; n < 4; ++n) Bf[n] = *(const f16x8*)(sb + n * 1024);
#pragma unroll
    for (int n = 0; n < 4; ++n) acc[0][n] = __builtin_amdgcn_mfma_f32_16x16x32_f16(A0, Bf[n], acc[0][n], 0, 0, 0);
#pragma unroll
    for (int n = 0; n < 4; ++n) acc[1][n] = __builtin_amdgcn_mfma_f32_16x16x32_f16(A1, Bf[n], acc[1][n], 0, 0, 0);
    WAIT_L(0);
  }
  RAW_SYNC();
#undef SA
#undef SB
#undef NSTAGE
}

__device__ __forceinline__ void p_moe_a(const Params& p, char* shm) {
  const f16* h1 = (const f16*)(p.ws + OFF_A);
  const f16* wgu = (const f16*)(p.ws + OFF_WGU);
  const int* counts = (const int*)(p.ws + OFF_CNT);
  const int* lists = (const int*)(p.ws + OFF_LISTS);
  f16* hid16 = (f16*)(p.ws + OFF_B);
  const int* tab = (const int*)(shm + MOE_TAB);
  const int tid = opaque_tid(), wid = tid >> 6, lane = tid & 63, wr = wid >> 2, wc = wid & 3, fr = lane & 15, fq = lane >> 4;
  int sR[NSTG], sC[NSTG];
#pragma unroll
  for (int i = 0; i < NSTG; ++i) stage_rc(wid * 1024 + i * 8192 + lane * 16, sR[i], sC[i]);
  moe_tables(counts, shm);
  const int total = tab[32] * 2;
  for (int r = 0;; ++r) {
    int item = xcd_item(total, r);
    if (item == -1) break;
    if (item < 0) continue;
    int e, mt;
    moe_find(tab, item >> 1, e, mt);
    const int fh = item & 1;
    const int cnt_e = counts[e * CNT_STRIDE];
    const int rowbase = tab[66 + e];
    unsigned pa[NSTG], pb[NSTG];
    f32x4 acc[8][4];
    zero_acc(acc);
#pragma unroll
    for (int i = 0; i < NSTG; ++i) {
      pa[i] = (unsigned)((e * 512 + fh * 256 + sR[i]) * 1024 + sC[i]);
      int idx = mt * 256 + sR[i];
      int tok = (idx < cnt_e) ? (lists[(size_t)e * T_TOK + idx] >> 1) : 0;
      pb[i] = (unsigned)(tok * 1024 + sC[i]);
    }
    gemm_core(wgu, pa, h1, pb, 16, acc, shm);
#pragma unroll
    for (int m = 0; m < 4; ++m)
#pragma unroll
      for (int n = 0; n < 4; ++n) {
        f16x4 o;
#pragma unroll
        for (int j = 0; j < 4; ++j) {
          float g = acc[m][n][j], u = acc[m + 4][n][j];
          o[j] = (f16)(g * u * __builtin_amdgcn_rcpf(1.0f + __builtin_amdgcn_exp2f(-1.4426950408889634f * g)));
        }
        size_t row = (size_t)rowbase + mt * 256 + wc * 64 + n * 16 + fr;
        *(f16x4*)(hid16 + row * 256 + fh * 128 + wr * 64 + m * 16 + fq * 4) = o;
      }
  }
  const int totaln = tab[65] * 2;
  for (int r = 0;; ++r) {
    int item = xcd_item(totaln, r);
    if (item == -1) break;
    if (item < 0) continue;
    int e, ntile;
    moe_find(tab + 33, item >> 1, e, ntile);
    const int fh = item & 1;
    const int cnt_e = counts[e * CNT_STRIDE];
    const int rowbase = tab[66 + e];
    const int wrn = wid >> 2, lq = wid & 3;
    const int ablk[2] = {wrn * 8 + lq, wrn * 8 + 4 + lq};
    unsigned pa[NSTG], pb = 0;
#pragma unroll
    for (int i = 0; i < NSTG; ++i) pa[i] = (unsigned)((e * 512 + fh * 256 + sR[i]) * 1024 + sC[i]);
    {
      int idx = 2048 + ntile * 64 + (sR[0] & 63);
      int tok = (idx < cnt_e) ? (lists[(size_t)e * T_TOK + idx] >> 1) : 0;
      pb = (unsigned)(tok * 1024 + sC[0]);
    }
    f32x4 acc[2][4];
#pragma unroll
    for (int m = 0; m < 2; ++m)
#pragma unroll
      for (int n = 0; n < 4; ++n) acc[m][n] = (f32x4){0.f, 0.f, 0.f, 0.f};
    gemm_core_narrow(wgu, pa, h1, pb, 16, ablk, acc, shm);
#pragma unroll
    for (int n = 0; n < 4; ++n) {
      f16x4 o;
#pragma unroll
      for (int j = 0; j < 4; ++j) {
        float g = acc[0][n][j], u = acc[1][n][j];
        o[j] = (f16)(g * u * __builtin_amdgcn_rcpf(1.0f + __builtin_amdgcn_exp2f(-1.4426950408889634f * g)));
      }
      size_t row = (size_t)rowbase + 2048 + ntile * 64 + n * 16 + fr;
      *(f16x4*)(hid16 + row * 256 + fh * 128 + wrn * 64 + lq * 16 + fq * 4) = o;
    }
  }
}

__device__ __forceinline__ void p_moe_b(const Params& p, char* shm) {
  const f16* wdn = (const f16*)(p.ws + OFF_WDN);
  const f16* hid16 = (const f16*)(p.ws + OFF_B);
  const float* route_w = (const float*)(p.ws + OFF_ROUTE_W);
  const int* counts = (const int*)(p.ws + OFF_CNT);
  const int* lists = (const int*)(p.ws + OFF_LISTS);
  f16* y16 = (f16*)(p.ws + OFF_C);
  int* sent = (int*)(shm + 256 * EPI_LD);
  const int* tab = (const int*)(shm + MOE_TAB);
  const int tid = opaque_tid(), wid = tid >> 6, lane = tid & 63, wc = wid & 3, fr = lane & 15, fq = lane >> 4;
  int sR[NSTG], sC[NSTG];
#pragma unroll
  for (int i = 0; i < NSTG; ++i) stage_rc(wid * 1024 + i * 8192 + lane * 16, sR[i], sC[i]);
  moe_tables(counts, shm);
  const int total = tab[32] * 4;
  for (int r = 0;; ++r) {
    int item = xcd_item(total, r);
    if (item == -1) break;
    if (item < 0) continue;
    int e, mt;
    moe_find(tab, item >> 2, e, mt);
    const int ft = item & 3;
    const int cnt_e = counts[e * CNT_STRIDE];
    const int rowbase = tab[66 + e];
    if (tid < 256) {
      int idx = mt * 256 + tid;
      sent[tid] = (idx < cnt_e) ? lists[(size_t)e * T_TOK + idx] : -1;
    }
    unsigned pa[NSTG], pb[NSTG];
    f32x4 acc[8][4];
    zero_acc(acc);
#pragma unroll
    for (int i = 0; i < NSTG; ++i) {
      pa[i] = (unsigned)((e * 1024 + ft * 256 + sR[i]) * 256 + sC[i]);
      pb[i] = (unsigned)((rowbase + mt * 256 + sR[i]) * 256 + sC[i]);
    }
    gemm_core(wdn, pa, hid16, pb, 4, acc, shm);
#pragma unroll
    for (int n = 0; n < 4; ++n) {
      int en = sent[wc * 64 + n * 16 + fr];
      float rw = (en >= 0) ? route_w[en] : 0.f;
#pragma unroll
      for (int m = 0; m < 8; ++m)
#pragma unroll
        for (int j = 0; j < 4; ++j) acc[m][n][j] *= rw;
    }
    epi_store_f16(acc, shm);
    RAW_SYNC();
    epi_rows_out(shm, [&](int rr) -> f16* { int en = sent[rr]; return (en >= 0) ? (y16 + (size_t)en * 1024 + ft * 256) : (f16*)nullptr; });
    RAW_SYNC();
  }
  const int totaln = tab[65] * 4;
  for (int r = 0;; ++r) {
    int item = xcd_item(totaln, r);
    if (item == -1) break;
    if (item < 0) continue;
    int e, ntile;
    moe_find(tab + 33, item >> 2, e, ntile);
    const int ft = item & 3;
    const int cnt_e = counts[e * CNT_STRIDE];
    const int rowbase = tab[66 + e];
    if (tid < 64) {
      int idx = 2048 + ntile * 64 + tid;
      sent[tid] = (idx < cnt_e) ? lists[(size_t)e * T_TOK + idx] : -1;
    }
    const int ablk[2] = {wid * 2, wid * 2 + 1};
    unsigned pa[NSTG], pb;
#pragma unroll
    for (int i = 0; i < NSTG; ++i) pa[i] = (unsigned)((e * 1024 + ft * 256 + sR[i]) * 256 + sC[i]);
    pb = (unsigned)((rowbase + 2048 + ntile * 64 + (sR[0] & 63)) * 256 + sC[0]);
    f32x4 acc[2][4];
#pragma unroll
    for (int m = 0; m < 2; ++m)
#pragma unroll
      for (int n = 0; n < 4; ++n) acc[m][n] = (f32x4){0.f, 0.f, 0.f, 0.f};
    gemm_core_narrow(wdn, pa, hid16, pb, 4, ablk, acc, shm);
#pragma unroll
    for (int n = 0; n < 4; ++n) {
      int en = sent[n * 16 + fr];
      float rw = (en >= 0) ? route_w[en] : 0.f;
#pragma unroll
      for (int m = 0; m < 2; ++m) {
        f16x4 v;
#pragma unroll
        for (int j = 0; j < 4; ++j) v[j] = (f16)(acc[m][n][j] * rw);
        *(f16x4*)(shm + (n * 16 + fr) * EPI_LD + (wid * 32 + m * 16 + fq * 4) * 2) = v;
      }
    }
    RAW_SYNC();
    {
      const int ch = tid & 31, r0 = tid >> 5;
#pragma unroll
      for (int ps = 0; ps < 4; ++ps) {
        int rr = ps * 16 + r0;
        f16x8 v = *(const f16x8*)(shm + rr * EPI_LD + ch * 16);
        int en = sent[rr];
        if (en >= 0) *(f16x8*)(y16 + (size_t)en * 1024 + ft * 256 + ch * 8) = v;
      }
    }
    RAW_SYNC();
  }
}

__device__ __forceinline__ unsigned f2key_(float f) {
  if (f == 0.f) f = 0.f;
  unsigned u = __float_as_uint(f);
  return (u & 0x80000000u) ? ~u : (u | 0x80000000u);
}
__device__ __forceinline__ float key2f_(unsigned k) {
  return __uint_as_float((k & 0x80000000u) ? (k & 0x7fffffffu) : ~k);
}
__device__ __forceinline__ void find_bin(const unsigned* hrow, int need, int lane, int* out_bin, int* out_above) {
  uint4 c = *(const uint4*)(hrow + 4 * lane);
  int tot = (int)(c.x + c.y + c.z + c.w);
  int incl = tot;
#pragma unroll
  for (int o = 1; o < 64; o <<= 1) {
    int v = __shfl_down(incl, o, 64);
    if (lane + o < 64) incl += v;
  }
  int above = incl - tot;
  if (above < need && incl >= need) {
    int b;
    if (above + (int)c.w >= need) b = 3;
    else { above += c.w; if (above + (int)c.z >= need) b = 2;
      else { above += c.z; if (above + (int)c.y >= need) b = 1; else { above += c.y; b = 0; } } }
    *out_bin = 4 * lane + b;
    *out_above = above;
  }
}

typedef short s16x4 __attribute__((ext_vector_type(4)));
#define VROW 160
#define ATT_WAVE_LDS (64 * VROW + 512)
__device__ __forceinline__ f16x8 tr_pair(const char* a, const char* b) {
  s16x4 x = __builtin_amdgcn_ds_read_tr16_b64_v4i16((__attribute__((address_space(3))) s16x4*)(a));
  s16x4 y = __builtin_amdgcn_ds_read_tr16_b64_v4i16((__attribute__((address_space(3))) s16x4*)(b));
  typedef short s16x8 __attribute__((ext_vector_type(8)));
  s16x8 r = __builtin_shufflevector(x, y, 0, 1, 2, 3, 4, 5, 6, 7);
  return __builtin_bit_cast(f16x8, r);
}
__device__ __forceinline__ void attn_one(const f16* __restrict__ proj16, f16* __restrict__ pa16, int t, const unsigned short* ssel,
                                         char* vimg, int lane) {
  const int fr = lane & 15, fq = lane >> 4;
  const int l = t & (SEQ - 1), b0 = t - l, cnt = min(l + 1, 256);
  f16x8 bq0, bq1, ones;
  {
    const f16* qp = proj16 + (size_t)t * PJ_W + C_Q + (fr & 7) * 64 + fq * 8;
    bq0 = *(const f16x8*)qp;
    bq1 = *(const f16x8*)(qp + 32);
    const f16 qs = (f16)0.18033688011112042f;
#pragma unroll
    for (int e = 0; e < 8; ++e) {
      bq0[e] = (fr < 8) ? bq0[e] * qs : (f16)0.f;
      bq1[e] = (fr < 8) ? bq1[e] * qs : (f16)0.f;
      ones[e] = (fr == 0) ? (f16)1.f : (f16)0.f;
    }
  }
  const char* kbase = (const char*)(proj16 + (size_t)b0 * PJ_W + C_K);
  const char* vbase = (const char*)(proj16 + (size_t)b0 * PJ_W + C_V);
  f32x4 S[16];
  if (cnt == 256) {
#pragma unroll
    for (int kt = 0; kt < 16; ++kt) {
      const unsigned ko = (unsigned)ssel[kt * 16 + fr] * (PJ_W * 2) + fq * 16;
      f16x8 a0 = *(const f16x8*)(kbase + ko), a1 = *(const f16x8*)(kbase + ko + 64);
      f32x4 z = {0.f, 0.f, 0.f, 0.f};
      z = __builtin_amdgcn_mfma_f32_16x16x32_f16(a0, bq0, z, 0, 0, 0);
      S[kt] = __builtin_amdgcn_mfma_f32_16x16x32_f16(a1, bq1, z, 0, 0, 0);
    }
  } else {
#pragma unroll
    for (int kt = 0; kt < 16; ++kt) {
      const unsigned ko = (unsigned)ssel[kt * 16 + fr] * (PJ_W * 2) + fq * 16;
      f16x8 a0 = *(const f16x8*)(kbase + ko), a1 = *(const f16x8*)(kbase + ko + 64);
      f32x4 z = {0.f, 0.f, 0.f, 0.f};
      z = __builtin_amdgcn_mfma_f32_16x16x32_f16(a0, bq0, z, 0, 0, 0);
      z = __builtin_amdgcn_mfma_f32_16x16x32_f16(a1, bq1, z, 0, 0, 0);
#pragma unroll
      for (int j = 0; j < 4; ++j) S[kt][j] = (kt * 16 + fq * 4 + j < cnt) ? z[j] : NEG_BIG;
    }
  }
  f16x8 vv[8];
#pragma unroll
  for (int i = 0; i < 8; ++i) {
    const unsigned vo = (unsigned)ssel[(lane >> 3) + 8 * i] * (PJ_W * 2) + (lane & 7) * 16;
    vv[i] = *(const f16x8*)(vbase + vo);
  }
  float m = NEG_BIG;
#pragma unroll
  for (int kt = 0; kt < 16; ++kt)
#pragma unroll
    for (int j = 0; j < 4; ++j) m = fmaxf(m, S[kt][j]);
  m = fmaxf(m, __shfl_xor(m, 16, 64));
  m = fmaxf(m, __shfl_xor(m, 32, 64));
  f16x8 P[8];
#pragma unroll
  for (int c = 0; c < 8; ++c)
#pragma unroll
    for (int j = 0; j < 4; ++j) {
      P[c][j] = (f16)__builtin_amdgcn_exp2f(S[2 * c][j] - m);
      P[c][4 + j] = (f16)__builtin_amdgcn_exp2f(S[2 * c + 1][j] - m);
    }
  f32x4 O[4], Ol = {0.f, 0.f, 0.f, 0.f};
#pragma unroll
  for (int nt = 0; nt < 4; ++nt) O[nt] = (f32x4){0.f, 0.f, 0.f, 0.f};
#pragma unroll
  for (int rr = 0; rr < 4; ++rr) {
    asm volatile("s_waitcnt lgkmcnt(0)" ::: "memory");
#pragma unroll
    for (int i = 0; i < 8; ++i) *(f16x8*)(vimg + ((lane >> 3) + 8 * i) * VROW + (lane & 7) * 16) = vv[i];
    if (rr < 3) {
#pragma unroll
      for (int i = 0; i < 8; ++i) {
        const unsigned vo = (unsigned)ssel[(rr + 1) * 64 + (lane >> 3) + 8 * i] * (PJ_W * 2) + (lane & 7) * 16;
        vv[i] = *(const f16x8*)(vbase + vo);
      }
    }
    asm volatile("s_waitcnt lgkmcnt(0)" ::: "memory");
#pragma unroll
    for (int cc = 0; cc < 2; ++cc) {
      const char* ra = vimg + (cc * 32 + fq * 4 + (fr >> 2)) * VROW + (fr & 3) * 8;
#pragma unroll
      for (int nt = 0; nt < 4; ++nt) {
        f16x8 B = tr_pair(ra + nt * 32, ra + 16 * VROW + nt * 32);
        O[nt] = __builtin_amdgcn_mfma_f32_16x16x32_f16(P[rr * 2 + cc], B, O[nt], 0, 0, 0);
      }
      Ol = __builtin_amdgcn_mfma_f32_16x16x32_f16(P[rr * 2 + cc], ones, Ol, 0, 0, 0);
    }
  }
  asm volatile("s_waitcnt lgkmcnt(0)" ::: "memory");
#pragma unroll
  for (int j = 0; j < 4; ++j) {
    float ls = __shfl(Ol[j], lane & 48, 64);
    float inv = __builtin_amdgcn_rcpf(ls);
    if (fq < 2) {
      f16* op = pa16 + (size_t)t * DM + 512 + (fq * 4 + j) * 64 + fr;
#pragma unroll
      for (int nt = 0; nt < 4; ++nt) op[nt * 16] = (f16)(O[nt][j] * inv);
    }
  }
}

__device__ __forceinline__ f32x4 score_tile(const f16x8& a, const f16x8 (&bq)[8], const f16x8& bc_hi, const f16x8& bc_lo,
                                            const float (&wq)[8]) {
  f32x4 L[8];
#pragma unroll
  for (int h = 0; h < 8; ++h) L[h] = __builtin_amdgcn_mfma_f32_16x16x32_f16(a, bq[h], (f32x4){0.f, 0.f, 0.f, 0.f}, 0, 0, 0);
  f32x4 lin = __builtin_amdgcn_mfma_f32_16x16x32_f16(a, bc_lo, (f32x4){0.f, 0.f, 0.f, 0.f}, 0, 0, 0);
  lin = __builtin_amdgcn_mfma_f32_16x16x32_f16(a, bc_hi, lin, 0, 0, 0);
  __builtin_amdgcn_sched_barrier(0);
  float t0 = 0.f, t1 = 0.f, t2 = 0.f, t3 = 0.f;
#pragma unroll
  for (int h = 0; h < 8; ++h) {
    asm("v_fma_f32 %0, %1, |%2|, %0" : "+v"(t0) : "v"(wq[h]), "v"(L[h][0]));
    asm("v_fma_f32 %0, %1, |%2|, %0" : "+v"(t1) : "v"(wq[h]), "v"(L[h][1]));
    asm("v_fma_f32 %0, %1, |%2|, %0" : "+v"(t2) : "v"(wq[h]), "v"(L[h][2]));
    asm("v_fma_f32 %0, %1, |%2|, %0" : "+v"(t3) : "v"(wq[h]), "v"(L[h][3]));
  }
  f32x4 s = {t0 + lin[0], t1 + lin[1], t2 + lin[2], t3 + lin[3]};
  return s;
}

#define KEYS_LD 4104
#define IDX_KEYS 0
#define IDX_HIST 131584
#define IDX_SSEL (IDX_HIST + 16384)
#define IDX_CAND (IDX_SSEL + 8192)
#define IDX_MISC (IDX_CAND + 2048)
template <int V>
__device__ __forceinline__ void p_index(const Params& p, char* shm) {
  const f16* proj16 = (const f16*)(p.ws + OFF_B);
  f16* pa16 = (V == 0) ? (f16*)(p.ws + OFF_D) : (f16*)p.out;
  unsigned short* keys16 = (unsigned short*)(shm + IDX_KEYS);
  unsigned* hist = (unsigned*)(shm + IDX_HIST);
  unsigned short* ssel = (unsigned short*)(shm + IDX_SSEL);
  unsigned short* scand = (unsigned short*)(shm + IDX_CAND);
  unsigned* smm = (unsigned*)(shm + IDX_MISC);
  int* sbin = (int*)(smm + 32);
  const int tid = opaque_tid(), wid = tid >> 6, lane0 = tid & 63;
  const float NINF = -__builtin_huge_valf(), PINF = __builtin_huge_valf();
  unsigned* qhead = (unsigned*)(p.ws + OFF_BAR + 15360) + (blockIdx.x & 7) * 16 + ((V == 0) ? 0 : 8);
  int* qslot = (int*)(shm + IDX_MISC + 512);
  for (;;) {
    __syncthreads();
    if (tid == 0) *qslot = (int)atomicAdd(qhead, 1u);
    __syncthreads();
    const int qi = *qslot;
    if (qi >= 256) break;
    const int idx = qi * 8 + (blockIdx.x & 7);
    int lane = lane0;
    asm volatile("" : "+v"(lane));
    const int fr = lane & 15, fq = lane >> 4;
    const unsigned long long lt_mask = (1ull << lane) - 1ull;
    const int b = idx & 7, j = 255 - (idx >> 3);
    const int l0 = j * 16, t0 = b * SEQ + l0;
    if (j < 16) {
#pragma unroll 1
      for (int qq = 0; qq < 2; ++qq) {
        const int q = 2 * wid + qq, lq = l0 + q;
        unsigned short* sl = ssel + q * 256;
        for (int i = lane; i < 256; i += 64) sl[i] = (unsigned short)((i <= lq) ? i : 0);
        asm volatile("s_waitcnt lgkmcnt(0)" ::: "memory");
        attn_one(proj16, pa16, t0 + q, sl, (char*)(keys16 + (2 * wid) * KEYS_LD), lane);
      }
      __syncthreads();
      continue;
    }
    const int wids = __builtin_amdgcn_readfirstlane(wid);
    const int klast = (j - 1) - ((j - 1 - wids) & 7);
    const f16* kbase = (const f16*)(p.ws + OFF_IKC) + (size_t)(b * SEQ + fr) * 32 + fq * 8;
#define NB 8
#define IK_LOAD(dst, kt0)                                                                   \
  _Pragma("unroll") for (int u = 0; u < NB; ++u) {                                          \
    int ktc = min((kt0) + 8 * u, klast);                                                    \
    dst[u] = *(const f16x8*)(kbase + ktc * 512);                                            \
  }
    f16x8 bq[8];
    float wq[8];
    f16x8 afirst[NB];
    f16x8 wv;
    {
      const f16* qrow = proj16 + (size_t)(t0 + fr) * PJ_W;
#pragma unroll
      for (int h = 0; h < 8; ++h) bq[h] = *(const f16x8*)(qrow + C_IQ + h * 32 + fq * 8);
      wv = *(const f16x8*)(qrow + C_IW);
    }
    const f16x8 ad = *(const f16x8*)(kbase + j * 512);
    IK_LOAD(afirst, wids);
    for (int i = tid; i < 4096; i += 512) hist[i] = 0;
    if (tid < 16) { smm[tid] = 0xFFFFFFFFu; smm[16 + tid] = 0u; }
#pragma unroll
    for (int h = 0; h < 8; ++h) wq[h] = (float)wv[h];
    f16x8 bc_hi, bc_lo;
#pragma unroll
    for (int e = 0; e < 8; ++e) {
      float c = 0.f;
#pragma unroll
      for (int h = 0; h < 8; ++h) c = __builtin_fmaf(wq[h], (float)bq[h][e], c);
      f16 ch_ = (f16)c;
      bc_hi[e] = ch_;
      bc_lo[e] = (f16)(c - (float)ch_);
    }
    __syncthreads();
    {
      float mn = PINF, mx = NINF;
      f16x8 a[NB];
#pragma unroll
      for (int u = 0; u < NB; ++u) a[u] = afirst[u];
      const int astep = (j >= 32) ? 4 * 8 * NB : 8 * NB;
      for (int kt0 = wids; kt0 < j; kt0 += astep) {
        f16x8 an[NB];
        IK_LOAD(an, kt0 + astep);
#pragma unroll
        for (int u = 0; u < NB; ++u) {
          if (kt0 + 8 * u < j) {
            f32x4 sc = score_tile(a[u], bq, bc_hi, bc_lo, wq);
            mn = fminf(fminf(mn, sc[0]), fminf(fminf(sc[1], sc[2]), sc[3]));
            mx = fmaxf(fmaxf(mx, sc[0]), fmaxf(fmaxf(sc[1], sc[2]), sc[3]));
          }
        }
#pragma unroll
        for (int u = 0; u < NB; ++u) a[u] = an[u];
      }
      if ((j & 7) == wids) {
        f32x4 sc = score_tile(ad, bq, bc_hi, bc_lo, wq);
#pragma unroll
        for (int jj = 0; jj < 4; ++jj) {
          bool ok = (fq * 4 + jj <= fr);
          mn = fminf(mn, ok ? sc[jj] : PINF);
          mx = fmaxf(mx, ok ? sc[jj] : NINF);
        }
      }
      mn = fminf(mn, __shfl_xor(mn, 16, 64)); mn = fminf(mn, __shfl_xor(mn, 32, 64));
      mx = fmaxf(mx, __shfl_xor(mx, 16, 64)); mx = fmaxf(mx, __shfl_xor(mx, 32, 64));
      if (fq == 0) {
        if (mn != PINF) atomicMin(&smm[fr], f2key_(mn));
        if (mx != NINF) atomicMax(&smm[16 + fr], f2key_(mx));
      }
    }
    __syncthreads();
    {
      float lo = key2f_(smm[fr]), hi = key2f_(smm[16 + fr]);
      if (j >= 32) { const float mg = 0.125f * (hi - lo); lo -= mg; hi += mg; }
      const float s16 = (hi > lo) ? 65536.0f / (hi - lo) : 0.f;
      const float nlo = -lo * s16;
      unsigned* hq = hist + fr * 256;
      unsigned short* kq = keys16 + fr * KEYS_LD + fq * 4;
      f16x8 a[NB];
#pragma unroll
      for (int u = 0; u < NB; ++u) a[u] = afirst[u];
      for (int kt0 = wids; kt0 < j; kt0 += 8 * NB) {
        f16x8 an[NB];
        IK_LOAD(an, kt0 + 8 * NB);
#pragma unroll
        for (int u = 0; u < NB; ++u) {
          const int kt = kt0 + 8 * u;
          if (kt < j) {
            f32x4 sc = score_tile(a[u], bq, bc_hi, bc_lo, wq);
            unsigned kk[4];
#pragma unroll
            for (int jj = 0; jj < 4; ++jj) {
              int k16 = min(max((int)__builtin_fmaf(sc[jj], s16, nlo), 0), 65535);
              kk[jj] = (unsigned)k16;
              atomicAdd(&hq[k16 >> 8], 1u);
            }
            uint2 pk;
            pk.x = kk[0] | (kk[1] << 16);
            pk.y = kk[2] | (kk[3] << 16);
            *(uint2*)(kq + kt * 16) = pk;
          }
        }
#pragma unroll
        for (int u = 0; u < NB; ++u) a[u] = an[u];
      }
      if ((j & 7) == wids) {
        f32x4 sc = score_tile(ad, bq, bc_hi, bc_lo, wq);
        unsigned kk[4];
#pragma unroll
        for (int jj = 0; jj < 4; ++jj) {
          int k16 = min(max((int)__builtin_fmaf(sc[jj], s16, nlo), 0), 65535);
          kk[jj] = (unsigned)k16;
          if (fq * 4 + jj <= fr) atomicAdd(&hq[k16 >> 8], 1u);
        }
        uint2 pk;
        pk.x = kk[0] | (kk[1] << 16);
        pk.y = kk[2] | (kk[3] << 16);
        *(uint2*)(kq + j * 16) = pk;
      }
    }
#undef IK_LOAD
#undef NB
    __syncthreads();
    if (V == 2) continue;
    {
      const int q0 = 2 * wid, lq0 = l0 + q0;
      const int nmax = lq0 + 2;
      unsigned* hrow0 = hist + q0 * 256;
      const unsigned short* krow0 = keys16 + q0 * KEYS_LD;
      if (lane < 4) sbin[2 * q0 + lane] = 0;
      find_bin(hrow0, 256, lane, &sbin[2 * q0], &sbin[2 * q0 + 1]);
      find_bin(hrow0 + 256, 256, lane, &sbin[2 * q0 + 2], &sbin[2 * q0 + 3]);
      asm volatile("s_waitcnt lgkmcnt(0)" ::: "memory");
      const int b1s0 = sbin[2 * q0], ab0 = sbin[2 * q0 + 1], b1s1 = sbin[2 * q0 + 2], ab1 = sbin[2 * q0 + 3];
      asm volatile("s_waitcnt lgkmcnt(0)" ::: "memory");
      *(uint4*)(hrow0 + 4 * lane) = make_uint4(0u, 0u, 0u, 0u);
      *(uint4*)(hrow0 + 256 + 4 * lane) = make_uint4(0u, 0u, 0u, 0u);
      if (lane < 4) sbin[2 * q0 + lane] = 0;
      asm volatile("s_waitcnt lgkmcnt(0)" ::: "memory");
      for (int s4 = lane * 4; s4 < nmax; s4 += 256) {
        uint2 pa_ = *(const uint2*)(krow0 + s4), pb_ = *(const uint2*)(krow0 + KEYS_LD + s4);
        unsigned ka[4] = {pa_.x & 0xffffu, pa_.x >> 16, pa_.y & 0xffffu, pa_.y >> 16};
        unsigned kb[4] = {pb_.x & 0xffffu, pb_.x >> 16, pb_.y & 0xffffu, pb_.y >> 16};
#pragma unroll
        for (int jj = 0; jj < 4; ++jj) {
          if (s4 + jj <= lq0 && (int)(ka[jj] >> 8) == b1s0) atomicAdd(&hrow0[ka[jj] & 255u], 1u);
          if (s4 + jj <= lq0 + 1 && (int)(kb[jj] >> 8) == b1s1) atomicAdd(&hrow0[256 + (kb[jj] & 255u)], 1u);
        }
      }
      asm volatile("s_waitcnt lgkmcnt(0)" ::: "memory");
      find_bin(hrow0, 256 - ab0, lane, &sbin[2 * q0], &sbin[2 * q0 + 1]);
      find_bin(hrow0 + 256, 256 - ab1, lane, &sbin[2 * q0 + 2], &sbin[2 * q0 + 3]);
      asm volatile("s_waitcnt lgkmcnt(0)" ::: "memory");
      const unsigned thr0 = (unsigned)((b1s0 << 8) | sbin[2 * q0]), thr1 = (unsigned)((b1s1 << 8) | sbin[2 * q0 + 2]);
      int base0 = 0, cb0 = 0, base1 = 0, cb1 = 0;
      for (int s0 = 0; s0 < nmax; s0 += 256) {
        const int s4 = s0 + lane * 4;
        uint2 pa_ = make_uint2(0u, 0u), pb_ = make_uint2(0u, 0u);
        if (s4 < nmax) { pa_ = *(const uint2*)(krow0 + s4); pb_ = *(const uint2*)(krow0 + KEYS_LD + s4); }
        unsigned ka[4] = {pa_.x & 0xffffu, pa_.x >> 16, pa_.y & 0xffffu, pa_.y >> 16};
        unsigned kb[4] = {pb_.x & 0xffffu, pb_.x >> 16, pb_.y & 0xffffu, pb_.y >> 16};
#pragma unroll
        for (int jj = 0; jj < 4; ++jj) {
          const bool ok0 = (s4 + jj <= lq0), ok1 = (s4 + jj <= lq0 + 1);
          const bool t0_ = ok0 && (ka[jj] > thr0), c0_ = ok0 && (ka[jj] == thr0);
          const bool t1_ = ok1 && (kb[jj] > thr1), c1_ = ok1 && (kb[jj] == thr1);
          unsigned long long m0 = __ballot(t0_), m1 = __ballot(t1_), cm0 = __ballot(c0_), cm1 = __ballot(c1_);
          if (t0_) ssel[q0 * 256 + base0 + __popcll(m0 & lt_mask)] = (unsigned short)(s4 + jj);
          if (t1_) ssel[q0 * 256 + 256 + base1 + __popcll(m1 & lt_mask)] = (unsigned short)(s4 + jj);
          base0 += __popcll(m0); base1 += __popcll(m1);
          if (cm0 | cm1) {
            int cp0 = cb0 + __popcll(cm0 & lt_mask), cp1 = cb1 + __popcll(cm1 & lt_mask);
            if (c0_ && cp0 < 64) scand[q0 * 64 + cp0] = (unsigned short)(s4 + jj);
            if (c1_ && cp1 < 64) scand[q0 * 64 + 64 + cp1] = (unsigned short)(s4 + jj);
            cb0 += __popcll(cm0); cb1 += __popcll(cm1);
          }
        }
      }
      asm volatile("s_waitcnt lgkmcnt(0)" ::: "memory");
#pragma unroll
      for (int x = 0; x < 2; ++x) {
        const int q = q0 + x;
        const int base = x ? base1 : base0, c = min(x ? cb1 : cb0, 64), r = 256 - base;
        if (lane < c) {
          unsigned short my = scand[q * 64 + lane];
          int rank = 0;
          for (int k = 0; k < c; ++k) rank += (scand[q * 64 + k] < my) ? 1 : 0;
          if (rank < r) ssel[q * 256 + base + rank] = my;
        }
      }
    }
    asm volatile("s_waitcnt lgkmcnt(0)" ::: "memory");
#pragma unroll 1
    for (int qq = 0; qq < 2; ++qq) {
      const int q = 2 * wid + qq, lq = l0 + q;
      unsigned short* sl = ssel + q * 256;
      for (int i = lane; i < 256; i += 64) sl[i] = (unsigned short)min((int)sl[i], lq);
      asm volatile("s_waitcnt lgkmcnt(0)" ::: "memory");
      attn_one(proj16, pa16, t0 + q, sl, (char*)(keys16 + (2 * wid) * KEYS_LD), lane);
    }
    __syncthreads();
  }
}

#define DL_LD 1040
template <int W>
__device__ __forceinline__ void pool_delta(const f16* up, int lf, char* dp) {
  f16x8 u[W + 7];
#pragma unroll
  for (int k = 0; k < W + 7; ++k) {
    const int rel = k - (W - 1);
    f16x8 z = {(f16)0.f, (f16)0.f, (f16)0.f, (f16)0.f, (f16)0.f, (f16)0.f, (f16)0.f, (f16)0.f};
    u[k] = (lf + rel >= 0) ? *(const f16x8*)(up + (ptrdiff_t)rel * PJ_W) : z;
  }
  float sum[8];
#pragma unroll
  for (int e = 0; e < 8; ++e) sum[e] = 0.f;
#pragma unroll
  for (int k = 0; k < W - 1; ++k)
#pragma unroll
    for (int e = 0; e < 8; ++e) sum[e] += (float)u[k][e];
#pragma unroll
  for (int i = 0; i < 8; ++i) {
    const float inv = 1.0f / (float)min(lf + i + 1, W);
    f16x8 d;
#pragma unroll
    for (int e = 0; e < 8; ++e) {
      sum[e] += (float)u[W - 1 + i][e];
      d[e] = (f16)(sum[e] * inv - (float)u[W - 1 + i][e]);
      sum[e] -= (float)u[i][e];
    }
    *(f16x8*)(dp + i * DL_LD) = d;
  }
}
__device__ __forceinline__ void p_pool(const Params& p, char* shm) {
  const f16* proj16 = (const f16*)(p.ws + OFF_B);
  const f16* wpl = (const f16*)(p.ws + OFF_WPOOL);
  f16* pa16 = (f16*)(p.ws + OFF_D);
  const int tid = opaque_tid(), wid = tid >> 6, lane = tid & 63, fr = lane & 15, fq = lane >> 4;
  for (int item = blockIdx.x; item < T_TOK / 64; item += gridDim.x) {
    const int t0 = item * 64;
    {
      const int g = wid >> 1;
      const int c = g * 128 + ((wid & 1) * 8 + (lane & 7)) * 8;
      const int tg = lane >> 3;
      const int tf = t0 + tg * 8, lf = tf & (SEQ - 1);
      const f16* up = proj16 + (size_t)tf * PJ_W + c;
      char* dp = shm + (tg * 8) * DL_LD + c * 2;
      if (g == 0) pool_delta<2>(up, lf, dp);
      else if (g == 1) pool_delta<4>(up, lf, dp);
      else if (g == 2) pool_delta<8>(up, lf, dp);
      else pool_delta<16>(up, lf, dp);
    }
    __syncthreads();
    {
      const int g = wid >> 1, eh = wid & 1;
      f32x4 acc[4][4];
#pragma unroll
      for (int m = 0; m < 4; ++m)
#pragma unroll
        for (int n = 0; n < 4; ++n) acc[m][n] = (f32x4){0.f, 0.f, 0.f, 0.f};
#pragma unroll
      for (int ks = 0; ks < 4; ++ks) {
        f16x8 A[4], B[4];
#pragma unroll
        for (int m = 0; m < 4; ++m) A[m] = *(const f16x8*)(wpl + (size_t)(g * 128 + eh * 64 + m * 16 + fr) * 128 + ks * 32 + fq * 8);
#pragma unroll
        for (int n = 0; n < 4; ++n) B[n] = *(const f16x8*)(shm + (n * 16 + fr) * DL_LD + (g * 128 + ks * 32 + fq * 8) * 2);
#pragma unroll
        for (int m = 0; m < 4; ++m)
#pragma unroll
          for (int n = 0; n < 4; ++n) acc[m][n] = __builtin_amdgcn_mfma_f32_16x16x32_f16(A[m], B[n], acc[m][n], 0, 0, 0);
      }
#pragma unroll
      for (int m = 0; m < 4; ++m) {
        const int e0 = g * 128 + eh * 64 + m * 16 + fq * 4;
        float4 sc = *(const float4*)(p.pool_scale + e0);
#pragma unroll
        for (int n = 0; n < 4; ++n) {
          f16x4 o;
          o[0] = (f16)(acc[m][n][0] * sc.x); o[1] = (f16)(acc[m][n][1] * sc.y);
          o[2] = (f16)(acc[m][n][2] * sc.z); o[3] = (f16)(acc[m][n][3] * sc.w);
          *(f16x4*)(pa16 + (size_t)(t0 + n * 16 + fr) * DM + e0) = o;
        }
      }
    }
    __syncthreads();
  }
}

#define RW_LD 2064
#define RT_LDS (2 * 36 * RW_LD)
template <int V>
__device__ __forceinline__ void p_ln1_route(const Params& p, char* shm) {
  const f16* z16 = (const f16*)(p.ws + OFF_C);
  char* dmy = (char*)p.out;
  f16* h1 = (V == 0) ? (f16*)(p.ws + OFF_A) : (f16*)dmy;
  int* route_e = (V == 0) ? (int*)(p.ws + OFF_ROUTE_E) : (int*)(dmy + 68000000);
  float* route_w = (V == 0) ? (float*)(p.ws + OFF_ROUTE_W) : (float*)(dmy + 69000000);
  int* counts = (V == 0) ? (int*)(p.ws + OFF_CNT) : (int*)(dmy + 70000000);
  int* lists = (V == 0) ? (int*)(p.ws + OFF_LISTS) : (int*)(dmy + 71000000);
  int* lcnt = (int*)(shm + RT_LDS);
  int* lent = lcnt + 128;
  const int tid = opaque_tid(), wid = tid >> 6, lane = tid & 63, fr = lane & 15, fq = lane >> 4;
  if (tid < 128) lcnt[tid] = 0;
  {
    const f16* wsrc = (const f16*)(p.ws + OFF_WRT);
    for (int i = tid; i < 2 * 36 * 128; i += 512) {
      int img = i / (36 * 128), rem = i % (36 * 128), o = rem >> 7, c = rem & 127;
      *(f16x8*)(shm + (img * 36 + o) * RW_LD + c * 16) = *(const f16x8*)(wsrc + (size_t)(img * 36 + o) * 1024 + c * 8);
    }
  }
  __syncthreads();
  for (int t0 = (blockIdx.x * 8 + wid) * 16; t0 < T_TOK; t0 += gridDim.x * 8 * 16) {
    const f16* zr = z16 + (size_t)(t0 + fr) * DM + fq * 8;
    float s1 = 0.f, s2 = 0.f;
#pragma unroll 8
    for (int ks = 0; ks < 32; ++ks) {
      f16x8 xz = *(const f16x8*)(zr + ks * 32);
#pragma unroll
      for (int e = 0; e < 8; ++e) { float x = (float)xz[e]; s1 += x; s2 += x * x; }
    }
    s1 += __shfl_xor(s1, 16, 64); s1 += __shfl_xor(s1, 32, 64);
    s2 += __shfl_xor(s2, 16, 64); s2 += __shfl_xor(s2, 32, 64);
    const float mu = s1 * (1.0f / DM);
    const float rs = rsqrtf(fmaxf(s2 * (1.0f / DM) - mu * mu, 0.f) + 1e-5f);
    f32x4 acc[3];
#pragma unroll
    for (int mt = 0; mt < 3; ++mt) acc[mt] = (f32x4){0.f, 0.f, 0.f, 0.f};
    f16* hr = h1 + (size_t)(t0 + fr) * DM + fq * 8;
    const char* wa = shm + fr * RW_LD + fq * 16;
    const char* wa2 = shm + min(32 + fr, 35) * RW_LD + fq * 16;
#pragma unroll 4
    for (int ks = 0; ks < 32; ++ks) {
      f16x8 xz = *(const f16x8*)(zr + ks * 32);
      float4 g0 = *(const float4*)(p.ln1_g + ks * 32 + fq * 8), g1 = *(const float4*)(p.ln1_g + ks * 32 + fq * 8 + 4);
      float4 b0 = *(const float4*)(p.ln1_b + ks * 32 + fq * 8), b1 = *(const float4*)(p.ln1_b + ks * 32 + fq * 8 + 4);
      float hn[8];
      hn[0] = ((float)xz[0] - mu) * rs * g0.x + b0.x; hn[1] = ((float)xz[1] - mu) * rs * g0.y + b0.y;
      hn[2] = ((float)xz[2] - mu) * rs * g0.z + b0.z; hn[3] = ((float)xz[3] - mu) * rs * g0.w + b0.w;
      hn[4] = ((float)xz[4] - mu) * rs * g1.x + b1.x; hn[5] = ((float)xz[5] - mu) * rs * g1.y + b1.y;
      hn[6] = ((float)xz[6] - mu) * rs * g1.z + b1.z; hn[7] = ((float)xz[7] - mu) * rs * g1.w + b1.w;
      f16x8 bh, bl;
#pragma unroll
      for (int e = 0; e < 8; ++e) { bh[e] = (f16)hn[e]; bl[e] = (f16)(hn[e] - (float)bh[e]); }
      *(f16x8*)(hr + ks * 32) = bh;
#pragma unroll
      for (int mt = 0; mt < 3; ++mt) {
        const char* wp = (mt < 2) ? (wa + mt * 16 * RW_LD) : wa2;
        f16x8 ah = *(const f16x8*)(wp + ks * 64), al = *(const f16x8*)(wp + 36 * RW_LD + ks * 64);
        acc[mt] = __builtin_amdgcn_mfma_f32_16x16x32_f16(ah, bh, acc[mt], 0, 0, 0);
        acc[mt] = __builtin_amdgcn_mfma_f32_16x16x32_f16(ah, bl, acc[mt], 0, 0, 0);
        acc[mt] = __builtin_amdgcn_mfma_f32_16x16x32_f16(al, bh, acc[mt], 0, 0, 0);
      }
    }
    float lg[36];
#pragma unroll
    for (int o = 0; o < 36; ++o) lg[o] = __shfl(acc[o >> 4][o & 3], fr + 16 * ((o >> 2) & 3), 64);
    {
      float gl[4];
#pragma unroll
      for (int o = 0; o < 4; ++o) gl[o] = lg[o] + p.b_group[o];
      int g = 0;
      float m = gl[0];
#pragma unroll
      for (int o = 1; o < 4; ++o) if (gl[o] > m) { m = gl[o]; g = o; }
      float se = 0.f;
#pragma unroll
      for (int o = 0; o < 4; ++o) se += __expf(gl[o] - m);
      float pg = 1.0f / se;
      float v1 = -3e38f, v2 = -3e38f;
      int i1 = 0, i2 = 0;
#pragma unroll
      for (int jx = 0; jx < 8; ++jx) {
        float x = (g == 0) ? lg[4 + jx] : (g == 1) ? lg[12 + jx] : (g == 2) ? lg[20 + jx] : lg[28 + jx];
        x += p.b_router[g * 8 + jx];
        if (x > v1) { v2 = v1; i2 = i1; v1 = x; i1 = jx; }
        else if (x > v2) { v2 = x; i2 = jx; }
      }
      if (fq == 0) {
        const int tt = t0 + fr;
        float e2 = __expf(v2 - v1);
        float w1 = pg / (1.0f + e2), w2 = pg * e2 / (1.0f + e2);
        int ea = g * 8 + i1, eb = g * 8 + i2;
        route_e[2 * tt] = ea; route_e[2 * tt + 1] = eb;
        route_w[2 * tt] = w1; route_w[2 * tt + 1] = w2;
        int la = atomicAdd(&lcnt[ea], 1), lb = atomicAdd(&lcnt[eb], 1);
        int slot = atomicAdd(&lcnt[64], 2);
        if (slot + 1 < 512) {
          lent[2 * slot] = (ea << 16) | la; lent[2 * slot + 1] = 2 * tt;
          lent[2 * slot + 2] = (eb << 16) | lb; lent[2 * slot + 3] = 2 * tt + 1;
        }
      }
    }
  }
  __syncthreads();
  if (tid < 32) lcnt[32 + tid] = atomicAdd(&counts[tid * CNT_STRIDE], lcnt[tid]);
  __syncthreads();
  {
    const int n_ent = min(lcnt[64], 512);
    for (int i = tid; i < n_ent; i += 512) {
      int ev = lent[2 * i], id = lent[2 * i + 1];
      int e = ev >> 16, lp = ev & 0xffff;
      lists[(size_t)e * T_TOK + lcnt[32 + e] + lp] = id;
    }
  }
  __syncthreads();
}

__device__ __forceinline__ void p_final(const Params& p) {
  const f16* h1 = (const f16*)(p.ws + OFF_A);
  const f16* y16 = (const f16*)(p.ws + OFF_C);
  const int tid = opaque_tid(), wid = tid >> 6, lane = tid & 63;
  const int nw = gridDim.x * 8;
  int t = blockIdx.x * 8 + wid;
  f16x8 hv[2], y0[2], y1[2];
#define P7_LOAD(tt)                                                                          \
  _Pragma("unroll") for (int i = 0; i < 2; ++i) {                                            \
    hv[i] = *(const f16x8*)(h1 + (size_t)(tt) * DM + i * 512 + lane * 8);                    \
    y0[i] = *(const f16x8*)(y16 + (size_t)(2 * (tt)) * DM + i * 512 + lane * 8);             \
    y1[i] = *(const f16x8*)(y16 + (size_t)(2 * (tt) + 1) * DM + i * 512 + lane * 8);         \
  }
  if (t < T_TOK) { P7_LOAD(t); }
  for (; t < T_TOK; t += nw) {
    float v[16];
#pragma unroll
    for (int i = 0; i < 2; ++i)
#pragma unroll
      for (int e = 0; e < 8; ++e) v[i * 8 + e] = ALPHA * (float)hv[i][e] + ((float)y0[i][e] + (float)y1[i][e]);
    if (t + nw < T_TOK) { P7_LOAD(t + nw); }
    float s = 0.f;
#pragma unroll
    for (int i = 0; i < 16; ++i) s += v[i];
    float mu = wave_sum(s) * (1.0f / DM);
    float q = 0.f;
#pragma unroll
    for (int i = 0; i < 16; ++i) { v[i] -= mu; q += v[i] * v[i]; }
    float rs = rsqrtf(wave_sum(q) * (1.0f / DM) + 1e-5f);
#pragma unroll
    for (int i = 0; i < 2; ++i)
#pragma unroll
      for (int hf = 0; hf < 2; ++hf) {
        const int c = i * 512 + lane * 8 + hf * 4;
        float4 g = *(const float4*)(p.ln2_g + c), b = *(const float4*)(p.ln2_b + c);
        f32x4 o;
        o[0] = v[i * 8 + hf * 4 + 0] * rs * g.x + b.x; o[1] = v[i * 8 + hf * 4 + 1] * rs * g.y + b.y;
        o[2] = v[i * 8 + hf * 4 + 2] * rs * g.z + b.z; o[3] = v[i * 8 + hf * 4 + 3] * rs * g.w + b.w;
        *(f32x4*)(p.out + (size_t)t * DM + c) = o;
      }
  }
#undef P7_LOAD
}

#define MEGA_LDS 159232


#define XB_TMO      128
#define XB_XCNT(j)  (256  + 64 * (j))
#define XB_XSUB(j)  (1280 + 64 * (j))
#define XB_XGEN(j)  (2304 + 64 * (j))
#define XB_TOP      3328
#define XB_TOPGEN   3392
#define XCD_BAR_WORDS 3456
#define XB_SPIN_CAP (1u << 22)
#define LAS __attribute__((address_space(3)))
__device__ __forceinline__ unsigned xb_ld(unsigned* p) { return __hip_atomic_load(p, __ATOMIC_RELAXED, __HIP_MEMORY_SCOPE_AGENT); }
__device__ __forceinline__ unsigned xb_add(unsigned* p, unsigned v) { return __hip_atomic_fetch_add(p, v, __ATOMIC_RELAXED, __HIP_MEMORY_SCOPE_AGENT); }
__device__ __forceinline__ unsigned xb_xcc_id() { return (unsigned)__builtin_amdgcn_s_getreg((3 << 11) | 20) & 0xFu; }
#define XB_SPIN(cond, bar) do { unsigned _sp = 0; while (cond) { __builtin_amdgcn_s_sleep(1); \
    if ((++_sp & 255u) == 0u) { if (xb_ld(&(bar)[XB_TMO])) break; if (_sp > XB_SPIN_CAP) { atomicAdd(&(bar)[XB_TMO], 1u); break; } } } } while (0)
struct XcdBarrier { unsigned* bar; unsigned x; volatile unsigned* st; };
__device__ __forceinline__ XcdBarrier xcd_barrier_post(unsigned* bar, volatile unsigned* st) {
  XcdBarrier b; b.bar = bar; b.x = xb_xcc_id(); b.st = st;
  if (threadIdx.x == 0) (void)xb_add(&bar[XB_XCNT(b.x)], 1u);
  return b;
}
__device__ __forceinline__ void xcd_barrier_complete(unsigned* bar, unsigned x, unsigned& nloc, unsigned& nx) {
  const unsigned G = gridDim.x * gridDim.y * gridDim.z;
  unsigned sum, cnt, mine, sp = 0u;
  for (;;) {
    sum = 0u; cnt = 0u; mine = 0u;
#pragma unroll
    for (unsigned j = 0; j < 16; ++j) { const unsigned c = xb_ld(&bar[XB_XCNT(j)]); sum += c; cnt += (c > 0u) ? 1u : 0u; mine = (j == x) ? c : mine; }
    if (sum == G) break;
    __builtin_amdgcn_s_sleep(1);
    if ((++sp & 255u) == 0u) { if (xb_ld(&bar[XB_TMO])) break; if (sp > XB_SPIN_CAP) { atomicAdd(&bar[XB_TMO], 1u); break; } }
  }
  nloc = mine > 0u ? mine : 1u; nx = cnt > 0u ? cnt : 1u;
}
__device__ __forceinline__ void xcd_barrier(const XcdBarrier& b) {
  asm volatile("s_waitcnt vmcnt(0)" ::: "memory");
  __syncthreads();
  if (threadIdx.x == 0) {
    unsigned* bar = b.bar;
    __builtin_amdgcn_s_waitcnt(0);
    unsigned nloc = b.st[0], nx = b.st[1];
    if (nloc == 0u) { xcd_barrier_complete(bar, b.x, nloc, nx); b.st[0] = nloc; b.st[1] = nx; }
    const unsigned old = xb_add(&bar[XB_XSUB(b.x)], 1u);
    const unsigned gen = old / nloc;
    if (old + 1u == (gen + 1u) * nloc) {
      __builtin_amdgcn_fence(__ATOMIC_RELEASE, "agent");
      asm volatile("s_waitcnt vmcnt(0)" ::: "memory");
      const unsigned og = xb_add(&bar[XB_TOP], 1u);
      const unsigned tg = og / nx;
      if (og + 1u == (tg + 1u) * nx) xb_add(&bar[XB_TOPGEN], 1u);
      else XB_SPIN(xb_ld(&bar[XB_TOPGEN]) == tg, bar);
      __builtin_amdgcn_fence(__ATOMIC_ACQUIRE, "agent");
      xb_add(&bar[XB_XGEN(b.x)], 1u);
      asm volatile("s_waitcnt vmcnt(0)" ::: "memory");
    } else {
      XB_SPIN(xb_ld(&bar[XB_XGEN(b.x)]) == gen, bar);
      __builtin_amdgcn_fence(__ATOMIC_ACQUIRE, "agent");
      asm volatile("s_waitcnt vmcnt(0)" ::: "memory");
    }
  }
  __syncthreads();
}

#ifndef PROBE
#define PROBE 0
#endif
#define GSYNC() do { XcdBarrier xb_; xb_.bar = (unsigned*)(p.ws + OFF_BAR); xb_.x = xb_xcc_id(); xb_.st = (volatile unsigned*)(shm + MEGA_LDS); xcd_barrier(xb_); } while (0)
#define PH(n, code) do { code; if (PROBE == n) { GSYNC(); code; } } while (0)
__global__ __launch_bounds__(512) void mega(Params p) {
  __shared__ __attribute__((aligned(1024))) char shm[MEGA_LDS + 16];
  volatile unsigned* xst = (volatile unsigned*)(shm + MEGA_LDS);
  if (threadIdx.x < 4) xst[threadIdx.x] = 0u;
  __syncthreads();
  (void)xcd_barrier_post((unsigned*)(p.ws + OFF_BAR), xst);
  if (blockIdx.x == 0 && threadIdx.x < 32) ((int*)(p.ws + OFF_CNT))[threadIdx.x * CNT_STRIDE] = 0;
  PH(1, p_ln_in(p));
  PH(2, p_convert(p, shm));
  GSYNC();
  PH(3, p_inproj(p, shm));
  GSYNC();
  PH(4, p_pool(p, shm));
  PH(5, p_index<0>(p, shm));
#if PROBE >= 50 && PROBE < 60
  GSYNC();
  p_index<PROBE - 50>(p, shm);
#endif
  GSYNC();
  PH(7, p_merge(p, shm));
  GSYNC();
  PH(8, p_resid(p, shm));
  GSYNC();
  p_ln1_route<0>(p, shm);
  GSYNC();
#if PROBE == 9
  if (blockIdx.x == 0 && threadIdx.x < 32) ((int*)((char*)p.out + 70000000))[threadIdx.x * CNT_STRIDE] = 0;
  GSYNC();
  p_ln1_route<1>(p, shm);
  GSYNC();
#endif
  PH(10, p_moe_a(p, shm));
  GSYNC();
  PH(11, p_moe_b(p, shm));
  GSYNC();
  PH(12, p_final(p));
}

extern "C" void kernel_launch(void* const* d_in, const int* in_sizes, int n_in, void* d_out, int out_size, void* d_ws,
                              size_t ws_size, hipStream_t stream) {
  if (ws_size < WS_NEEDED) { fprintf(stderr, "ws too small: %zu < %zu\n", ws_size, (size_t)WS_NEEDED); return; }
  static int grid_blocks = 0;
  if (!grid_blocks) {
    int dev = 0, cus = 0, per_cu = 0;
    hipGetDevice(&dev);
    hipDeviceGetAttribute(&cus, hipDeviceAttributeMultiprocessorCount, dev);
    hipOccupancyMaxActiveBlocksPerMultiprocessor(&per_cu, mega, 512, 0);
    if (per_cu > 1) per_cu = 1;
    grid_blocks = cus * per_cu;
    fprintf(stderr, "mega: cus=%d per_cu=%d grid=%d\n", cus, per_cu, grid_blocks);
  }
  Params p{};
  const float** pp = (const float**)&p;
  for (int i = 0; i < 21; ++i) pp[i] = (const float*)d_in[i];
  p.out = (float*)d_out;
  p.ws = (char*)d_ws;
  (void)hipMemsetAsync((char*)d_ws + OFF_BAR, 0, 16384, stream);
  void* args[] = {&p};
  hipError_t e = hipLaunchCooperativeKernel((void*)mega, dim3(grid_blocks), dim3(512), args, 0, stream);
  if (e != hipSuccess) fprintf(stderr, "cooperative launch failed: %s (grid %d)\n", hipGetErrorString(e), grid_blocks);
}
```

```cpp
#include <hip/hip_runtime.h>
#include <hip/hip_fp16.h>
#include <hip/hip_cooperative_groups.h>
#include <stdint.h>
#include <stdio.h>
namespace cg = cooperative_groups;

typedef _Float16 f16;
typedef f16 f16x8 __attribute__((ext_vector_type(8)));
typedef f16 f16x4 __attribute__((ext_vector_type(4)));
typedef f16 f16x2 __attribute__((ext_vector_type(2)));
typedef float f32x4 __attribute__((ext_vector_type(4)));
typedef int i32x4 __attribute__((ext_vector_type(4)));

#define T_TOK 32768
#define DM 1024
#define SEQ 4096
#define PJ_W 1536
#define PA_W 1448
#define IN_W 3496
#define IN_WP 3584
#define C_Q 512
#define C_K 1024
#define C_V 1088
#define C_IQ 1152
#define C_IK 1408
#define C_IW 1440
#define ALPHA 1.189207115002721f
#define NEG_BIG (-1e30f)

#define SZ_A   ((size_t)T_TOK * DM * 2)
#define SZ_B   ((size_t)T_TOK * PJ_W * 2)
#define SZ_C   ((size_t)T_TOK * 2048 * 2)
#define SZ_D   ((size_t)T_TOK * DM * 2)
#define OFF_A  ((size_t)0)
#define OFF_B  (OFF_A + SZ_A)
#define OFF_C  (OFF_B + SZ_B)
#define OFF_D  (OFF_C + SZ_C)
#define OFF_W  (OFF_D + SZ_D)
#define OFF_WIN   (OFF_W)
#define OFF_WPOOL (OFF_WIN + (size_t)IN_WP * 1024 * 2)
#define OFF_WPP   (OFF_WPOOL + (size_t)4 * 128 * 128 * 2)
#define OFF_WPA   (OFF_WPP + (size_t)1024 * 512 * 2)
#define OFF_WOUT  (OFF_WPA + (size_t)1024 * 512 * 2)
#define OFF_WGU   (OFF_WOUT + (size_t)1024 * 1024 * 2)
#define OFF_WDN   (OFF_WGU + (size_t)32 * 512 * 1024 * 2)
#define OFF_MISC  (OFF_WDN + (size_t)32 * 1024 * 256 * 2)
#define OFF_ROUTE_E (OFF_MISC)
#define OFF_ROUTE_W (OFF_ROUTE_E + (size_t)T_TOK * 2 * 4)
#define OFF_COUNTS  (OFF_ROUTE_W + (size_t)T_TOK * 2 * 4)
#define OFF_LISTS   (OFF_COUNTS + 256)
#define OFF_SEL     (OFF_LISTS + (size_t)32 * T_TOK * 4)
#define OFF_CNT      (OFF_SEL + (size_t)T_TOK * 256 * 2)
#define OFF_WRT      (OFF_CNT + 4096)
#define OFF_IKC      (OFF_WRT + 2 * 36 * 1024 * 2)
#define OFF_BAR      (OFF_IKC + (size_t)T_TOK * 32 * 2)
#define OFF_RC       (OFF_BAR + 16384)
#define OFF_KV8      (OFF_RC + 4096)
#define WS_NEEDED   (OFF_KV8 + (size_t)T_TOK * 128)
#define CNT_STRIDE 32

struct Params {
  const float *x, *ln_in_g, *ln_in_b, *w_in, *b_gate, *pool_w, *pool_scale, *wpp, *wpa, *w_out, *ln1_g, *ln1_b, *w_group,
      *b_group, *w_router, *b_router, *w_gate, *w_up, *w_down, *ln2_g, *ln2_b;
  float* out;
  char* ws;
};

__device__ __forceinline__ float wave_sum(float v) {
#pragma unroll
  for (int o = 32; o > 0; o >>= 1) v += __shfl_xor(v, o, 64);
  return v;
}
__device__ __forceinline__ float wave_max(float v) {
#pragma unroll
  for (int o = 32; o > 0; o >>= 1) v = fmaxf(v, __shfl_xor(v, o, 64));
  return v;
}
__device__ __forceinline__ int wave_sum_i(int v) {
#pragma unroll
  for (int o = 32; o > 0; o >>= 1) v += __shfl_xor(v, o, 64);
  return v;
}
__device__ __forceinline__ int opaque_tid() { int t = threadIdx.x; asm volatile("" : "+v"(t)); return t; }
__device__ __forceinline__ float ldf(const float* p) { return *p; }
__device__ __forceinline__ float ldf(const f16* p) { return (float)*p; }

#ifndef SKEW_P1
#define SKEW_P1 0
#endif
#define WAIT_V(n) asm volatile("s_waitcnt vmcnt(%0)" ::"n"(n) : "memory")
#define WAIT_L(n) asm volatile("s_waitcnt lgkmcnt(%0)" ::"n"(n) : "memory")
template <class T> __device__ __forceinline__ void st_nt(T* p, const T& v) { *p = v; }
#define RAW_SYNC() do { asm volatile("s_waitcnt lgkmcnt(0)" ::: "memory"); __builtin_amdgcn_s_barrier(); asm volatile("" ::: "memory"); } while (0)

__device__ __forceinline__ int lds_byte(int r, int c) {
  int ob = (r & 15) * 64 + c * 2;
  return (r >> 4) * 1024 + (ob ^ (((ob >> 9) & 1) << 5));
}
__device__ __forceinline__ void stage_rc(int b, int& R, int& C) {
  int st = b >> 10, sb = b & 1023, swz = sb ^ (((sb >> 9) & 1) << 5);
  R = st * 16 + swz / 64;
  C = (swz % 64) / 2;
}

#define TILE_B 16384
#define SLOT_B 32768
#define NSTG 2
#define GEMM_LDS 135168
#define EPI_LD 528

__device__ __forceinline__ void gemm_core(const f16* __restrict__ Ab, const unsigned (&pa)[NSTG], const f16* __restrict__ Bb,
                                          const unsigned (&pb)[NSTG], int nt, f32x4 (&acc)[8][4], char* shm) {
  const int tid = opaque_tid(), wid = tid >> 6, lane = tid & 63, wr = wid >> 2, wc = wid & 3, fr = lane & 15, fq = lane >> 4;
  const int nk = nt * 2;
#define SA(s_) (shm + (s_) * SLOT_B)
#define SB(s_) (shm + (s_) * SLOT_B + TILE_B)
#define GLDS_STAGE(slot, kt)                                                                                              \
  do {                                                                                                                    \
    _Pragma("unroll") for (int i = 0; i < NSTG; ++i) {                                                                   \
      __builtin_amdgcn_global_load_lds((const unsigned*)(Ab + pa[i] + (kt) * 32), (unsigned*)(SA(slot) + wid * 1024 + i * 8192), \
                                       16, 0, 0);                                                                         \
      __builtin_amdgcn_global_load_lds((const unsigned*)(Bb + pb[i] + (kt) * 32), (unsigned*)(SB(slot) + wid * 1024 + i * 8192), \
                                       16, 0, 0);                                                                         \
    }                                                                                                                     \
  } while (0)
  GLDS_STAGE(0, 0);
  GLDS_STAGE(1, 1);
  GLDS_STAGE(2, 2);
  const int aoff = lds_byte(wr * 128 + fr, fq * 8), boff = lds_byte(wc * 64 + fr, fq * 8);
  WAIT_V(8);
  __builtin_amdgcn_s_barrier();
  if (wr == 1) __builtin_amdgcn_s_barrier();
  for (int t = 0; t < nk; ++t) {
    if (t + 3 < nk) { GLDS_STAGE((t + 3) & 3, t + 3); WAIT_V(8); }
    else if (t + 2 < nk) WAIT_V(4);
    else WAIT_V(0);
    const char* sa = SA(t & 3) + aoff;
    const char* sb = SB(t & 3) + boff;
    f16x8 At[8], Bf[4];
#pragma unroll
    for (int n = 0; n < 4; ++n) Bf[n] = *(const f16x8*)(sb + n * 1024);
#pragma unroll
    for (int m = 0; m < 8; ++m) At[m] = *(const f16x8*)(sa + m * 1024);
    WAIT_L(0);
    __builtin_amdgcn_sched_barrier(0);
    __builtin_amdgcn_s_barrier();
    __builtin_amdgcn_sched_barrier(0);
#pragma unroll
    for (int m = 0; m < 8; ++m)
#pragma unroll
      for (int n = 0; n < 4; ++n) acc[m][n] = __builtin_amdgcn_mfma_f32_16x16x32_f16(At[m], Bf[n], acc[m][n], 0, 0, 0);
    __builtin_amdgcn_sched_barrier(0);
    __builtin_amdgcn_s_barrier();
    __builtin_amdgcn_sched_barrier(0);
  }
  if (wr == 0) __builtin_amdgcn_s_barrier();
  RAW_SYNC();
#undef SA
#undef SB
#undef GLDS_STAGE
}

__device__ __forceinline__ void epi_store_f16(const f32x4 (&acc)[8][4], char* shm) {
  const int tid = opaque_tid(), wid = tid >> 6, lane = tid & 63, wr = wid >> 2, wc = wid & 3, fr = lane & 15, fq = lane >> 4;
#pragma unroll
  for (int m = 0; m < 8; ++m)
#pragma unroll
    for (int n = 0; n < 4; ++n) {
      f16x4 v;
      v[0] = (f16)acc[m][n][0]; v[1] = (f16)acc[m][n][1]; v[2] = (f16)acc[m][n][2]; v[3] = (f16)acc[m][n][3];
      *(f16x4*)(shm + (wc * 64 + n * 16 + fr) * EPI_LD + (wr * 128 + m * 16 + fq * 4) * 2) = v;
    }
}

__device__ __forceinline__ void p_ln_in(const Params& p) {
  f16* h16 = (f16*)(p.ws + OFF_A);
  const int tid = opaque_tid(), lane = tid & 63, wid = tid >> 6;
  const int nw = gridDim.x * 8;
  for (int t = blockIdx.x * 8 + wid; t < T_TOK; t += nw) {
    const float* xr = p.x + (size_t)t * DM;
    float4 v[4];
#pragma unroll
    for (int i = 0; i < 4; ++i) v[i] = *(const float4*)(xr + i * 256 + lane * 4);
    float s = 0.f;
#pragma unroll
    for (int i = 0; i < 4; ++i) s += v[i].x + v[i].y + v[i].z + v[i].w;
    float mu = wave_sum(s) * (1.0f / DM);
    float q = 0.f;
#pragma unroll
    for (int i = 0; i < 4; ++i) {
      v[i].x -= mu; v[i].y -= mu; v[i].z -= mu; v[i].w -= mu;
      q += v[i].x * v[i].x + v[i].y * v[i].y + v[i].z * v[i].z + v[i].w * v[i].w;
    }
    float rs = rsqrtf(wave_sum(q) * (1.0f / DM) + 1e-5f);
#pragma unroll
    for (int i = 0; i < 4; ++i) {
      float4 g = *(const float4*)(p.ln_in_g + i * 256 + lane * 4), b = *(const float4*)(p.ln_in_b + i * 256 + lane * 4);
      f16x4 o;
      o[0] = (f16)(v[i].x * rs * g.x + b.x); o[1] = (f16)(v[i].y * rs * g.y + b.y);
      o[2] = (f16)(v[i].z * rs * g.z + b.z); o[3] = (f16)(v[i].w * rs * g.w + b.w);
      *(f16x4*)(h16 + (size_t)t * DM + i * 256 + lane * 4) = o;
    }
  }
}

template <class RowMap>
__device__ __forceinline__ void conv_tile(const float* __restrict__ src, int ld_src, int nvalid, int k0, int n0, f16* __restrict__ dst,
                                          int ld_dst, RowMap rm, float* sT) {
  const int tid = opaque_tid();
  {
    int k = tid >> 3, n = (tid & 7) * 8;
    const float* sp = src + (size_t)(k0 + k) * ld_src + n0 + n;
#pragma unroll
    for (int j = 0; j < 8; ++j) sT[k * 65 + n + j] = (n0 + n + j < nvalid) ? sp[j] : 0.f;
  }
  __syncthreads();
  {
    int n = tid >> 3, k = (tid & 7) * 8;
    f16x8 o;
#pragma unroll
    for (int j = 0; j < 8; ++j) o[j] = (f16)sT[(k + j) * 65 + n];
    int drow = rm(n0 + n);
    if (drow >= 0) *(f16x8*)(dst + (size_t)drow * ld_dst + k0 + k) = o;
  }
  __syncthreads();
}

struct RowId { __device__ int operator()(int n) const { return n; } };
struct RowGU { int up; __device__ int operator()(int ff) const {
  int tile = ff >> 7, wr = (ff >> 6) & 1, l = ff & 63; return tile * 256 + wr * 128 + up * 64 + l; } };

__device__ __forceinline__ void p_convert(const Params& p, char* shm) {
  float* sT = (float*)shm;
  char* ws = p.ws;
  const int J0 = 16 * 56, J1 = J0 + 16, J2 = J1 + 128, J3 = J2 + 128, J4 = J3 + 256, J5 = J4 + 32 * 64, J6 = J5 + 32 * 64,
            J7 = J6 + 32 * 64;
  for (int job = blockIdx.x; job < J7; job += gridDim.x) {
    if (job < J0) {
      int kt = job / 56, nt = job % 56;
      conv_tile(p.w_in, IN_W, IN_W, kt * 64, nt * 64, (f16*)(ws + OFF_WIN), 1024, RowId(), sT);
    } else if (job < J1) {
      int j = job - J0, g = j >> 2, kt = (j >> 1) & 1, nt = j & 1;
      conv_tile(p.pool_w + g * 128 * 128, 128, 128, kt * 64, nt * 64, (f16*)(ws + OFF_WPOOL) + g * 128 * 128, 128, RowId(), sT);
    } else if (job < J2) {
      int j = job - J1, kt = j >> 4, nt = j & 15;
      conv_tile(p.wpp, 1024, 1024, kt * 64, nt * 64, (f16*)(ws + OFF_WPP), 512, RowId(), sT);
    } else if (job < J3) {
      int j = job - J2, kt = j >> 4, nt = j & 15;
      conv_tile(p.wpa, 1024, 1024, kt * 64, nt * 64, (f16*)(ws + OFF_WPA), 512, RowId(), sT);
    } else if (job < J4) {
      int j = job - J3, kt = j >> 4, nt = j & 15;
      conv_tile(p.w_out, 1024, 1024, kt * 64, nt * 64, (f16*)(ws + OFF_WOUT), 1024, RowId(), sT);
    } else if (job < J6) {
      int up = job >= J5;
      int j = job - (up ? J5 : J4), e = j >> 6, kt = (j >> 2) & 15, nt = j & 3;
      RowGU rm; rm.up = up;
      conv_tile((up ? p.w_up : p.w_gate) + (size_t)e * 1024 * 256, 256, 256, kt * 64, nt * 64,
                (f16*)(ws + OFF_WGU) + (size_t)e * 512 * 1024, 1024, rm, sT);
    } else {
      int j = job - J6, e = j >> 6, kt = (j >> 4) & 3, nt = j & 15;
      conv_tile(p.w_down + (size_t)e * 256 * 1024, 1024, 1024, kt * 64, nt * 64, (f16*)(ws + OFF_WDN) + (size_t)e * 1024 * 256,
                256, RowId(), sT);
    }
  }
  {
    f16* whi = (f16*)(ws + OFF_WRT);
    f16* wlo = whi + 36 * 1024;
    for (int i = blockIdx.x * 512 + threadIdx.x; i < 36 * 1024; i += gridDim.x * 512) {
      int o = i >> 10, k = i & 1023;
      float w = ((o < 4) ? p.w_group[k * 4 + o] : p.w_router[k * 32 + (o - 4)]) * p.ln1_g[k];
      f16 h = (f16)w;
      whi[i] = h;
      wlo[i] = (f16)(w - (float)h);
    }
  }
  if (blockIdx.x < 48) {
    float* rc = (float*)(ws + OFF_RC);
    const int o = blockIdx.x, tid = threadIdx.x;
    float a = 0.f, b = 0.f;
    if (o < 36) {
      for (int k = tid; k < 1024; k += 512) {
        float w0 = (o < 4) ? p.w_group[k * 4 + o] : p.w_router[k * 32 + (o - 4)];
        float w = w0 * p.ln1_g[k];
        f16 h = (f16)w, l = (f16)(w - (float)h);
        a += (float)h + (float)l;
        b += w0 * p.ln1_b[k];
      }
    }
    a = wave_sum(a);
    b = wave_sum(b);
    if ((tid & 63) == 0) { sT[tid >> 6] = a; sT[8 + (tid >> 6)] = b; }
    __syncthreads();
    if (tid == 0) {
      float sa = 0.f, sb = 0.f;
      for (int w = 0; w < 8; ++w) { sa += sT[w]; sb += sT[8 + w]; }
      float bias = (o < 4) ? p.b_group[o] : ((o < 36) ? p.b_router[o - 4] : 0.f);
      rc[o] = sa;
      rc[48 + o] = sb + bias;
    }
    __syncthreads();
  }
}

__device__ __forceinline__ void phase_skew(int us4) {
  const int k = (blockIdx.x >> 3) & 3;
  if (k) {
    const unsigned long long t0 = __builtin_amdgcn_s_memrealtime();
    const unsigned long long dt = (unsigned long long)(k * us4 * 25);
    while (__builtin_amdgcn_s_memrealtime() - t0 < dt) __builtin_amdgcn_s_sleep(8);
  }
}

__device__ __forceinline__ int xcd_item(int n_items, int r) {
  const int nx = 8, slots = gridDim.x >> 3;
  const int xcd = blockIdx.x & 7, slot = blockIdx.x >> 3;
  const int per = (n_items + nx - 1) / nx;
  const int local = slot + r * slots;
  if (local >= per) return -1;
  const int item = xcd * per + local;
  return (item < n_items) ? item : -2;
}

__device__ __forceinline__ void p_inproj(const Params& p, char* shm) {
  const f16* h16 = (const f16*)(p.ws + OFF_A);
  const f16* wT = (const f16*)(p.ws + OFF_WIN);
  f16* proj16 = (f16*)(p.ws + OFF_B);
  f16* gate16 = (f16*)(p.ws + OFF_C);
  f16* ikc = (f16*)(p.ws + OFF_IKC);
  char* kv8 = p.ws + OFF_KV8;
  const int tid = opaque_tid(), wid = tid >> 6, lane = tid & 63;
  int sR[NSTG], sC[NSTG];
#pragma unroll
  for (int i = 0; i < NSTG; ++i) stage_rc(wid * 1024 + i * 8192 + lane * 16, sR[i], sC[i]);
  const int NTILES = 128 * 14;
  if (SKEW_P1) phase_skew(SKEW_P1);
  for (int r = 0;; ++r) {
    int tile = xcd_item(NTILES, r);
    if (tile == -1) break;
    if (tile < 0) continue;
    int grp = tile / 56, rem = tile % 56;
    int ft = rem >> 2, tt = grp * 4 + (rem & 3);
    unsigned pa[NSTG], pb[NSTG];
#pragma unroll
    for (int i = 0; i < NSTG; ++i) {
      pa[i] = (unsigned)((ft * 256 + sR[i]) * 1024 + sC[i]);
      pb[i] = (unsigned)((tt * 256 + sR[i]) * 1024 + sC[i]);
    }
    f32x4 acc[8][4];
#pragma unroll
    for (int m = 0; m < 8; ++m)
#pragma unroll
      for (int n = 0; n < 4; ++n) acc[m][n] = (f32x4){0.f, 0.f, 0.f, 0.f};
    gemm_core(wT, pa, h16, pb, 16, acc, shm);
    epi_store_f16(acc, shm);
    RAW_SYNC();
    {
      int ch = tid & 31, r0 = tid >> 5;
      int f0 = ft * 256 + ch * 8;
      float bg[8];
      if (f0 >= PA_W && f0 < IN_W) {
#pragma unroll
        for (int j = 0; j < 8; ++j) bg[j] = p.b_gate[f0 - PA_W + j];
      } else {
#pragma unroll
        for (int j = 0; j < 8; ++j) bg[j] = 0.f;
      }
#pragma unroll 4
      for (int ps = 0; ps < 16; ++ps) {
        int r = ps * 16 + r0;
        f16x8 v = *(const f16x8*)(shm + r * EPI_LD + ch * 16);
        size_t tok = (size_t)tt * 256 + r;
        if (f0 < PA_W) {
          st_nt((f16x8*)(proj16 + tok * PJ_W + f0), v);
          if (f0 >= C_IK && f0 < C_IW) *(f16x8*)(ikc + tok * 32 + (f0 - C_IK)) = v;
          if (f0 >= C_K && f0 < C_IQ) {
            float c[8];
#pragma unroll
            for (int j = 0; j < 8; ++j) c[j] = fminf(fmaxf((float)v[j], -448.f), 448.f);
            int p0 = __builtin_amdgcn_cvt_pk_fp8_f32(c[0], c[1], 0, false);
            p0 = __builtin_amdgcn_cvt_pk_fp8_f32(c[2], c[3], p0, true);
            int p1 = __builtin_amdgcn_cvt_pk_fp8_f32(c[4], c[5], 0, false);
            p1 = __builtin_amdgcn_cvt_pk_fp8_f32(c[6], c[7], p1, true);
            *(uint2*)(kv8 + tok * 128 + (f0 - C_K)) = make_uint2((unsigned)p0, (unsigned)p1);
          }
        } else if (f0 < IN_W) {
          f16x8 o;
#pragma unroll
          for (int j = 0; j < 8; ++j) o[j] = (f16)__builtin_amdgcn_rcpf(1.0f + __builtin_amdgcn_exp2f(-1.4426950408889634f * ((float)v[j] + bg[j])));
          st_nt((f16x8*)(gate16 + tok * 2048 + (f0 - PA_W)), o);
        }
      }
    }
    RAW_SYNC();
  }
}


__device__ __forceinline__ void zero_acc(f32x4 (&acc)[8][4]) {
#pragma unroll
  for (int m = 0; m < 8; ++m)
#pragma unroll
    for (int n = 0; n < 4; ++n) acc[m][n] = (f32x4){0.f, 0.f, 0.f, 0.f};
}

template <class RowPtr>
__device__ __forceinline__ void epi_rows_out(char* shm, RowPtr rp) {
  const int tid = opaque_tid(), ch = tid & 31, r0 = tid >> 5;
#pragma unroll 4
  for (int ps = 0; ps < 16; ++ps) {
    int r = ps * 16 + r0;
    f16x8 v = *(const f16x8*)(shm + r * EPI_LD + ch * 16);
    f16* d = rp(r);
    if (d) st_nt((f16x8*)(d + ch * 8), v);
  }
}

__device__ __forceinline__ void p_merge(const Params& p, char* shm) {
  const f16* pa16 = (const f16*)(p.ws + OFF_D);
  const f16* gate16 = (const f16*)(p.ws + OFF_C);
  const f16* wpp = (const f16*)(p.ws + OFF_WPP);
  const f16* wpa = (const f16*)(p.ws + OFF_WPA);
  f16* merged16 = (f16*)(p.ws + OFF_B);
  const int tid = opaque_tid(), wid = tid >> 6, lane = tid & 63;
  int sR[NSTG], sC[NSTG];
#pragma unroll
  for (int i = 0; i < NSTG; ++i) stage_rc(wid * 1024 + i * 8192 + lane * 16, sR[i], sC[i]);
  const int ch = tid & 31, r0 = tid >> 5;
  for (int r = 0;; ++r) {
    int tile = xcd_item(512, r);
    if (tile == -1) break;
    if (tile < 0) continue;
    int ft = tile & 3, tt = tile >> 2;
    unsigned pa[NSTG], pb[NSTG];
#pragma unroll
    for (int i = 0; i < NSTG; ++i) {
      pa[i] = (unsigned)((ft * 256 + sR[i]) * 512 + sC[i]);
      pb[i] = (unsigned)((tt * 256 + sR[i]) * 1024 + sC[i]);
    }
    f32x4 acc[8][4];
    zero_acc(acc);
    gemm_core(wpp, pa, pa16, pb, 8, acc, shm);
    const unsigned gofs = (unsigned)((((tt * 256 + r0) * 2048) + ft * 256 + ch * 8) * 2);
    const char* gb = (const char*)gate16;
    const unsigned mofs = (unsigned)((((tt * 256 + r0) * 1024) + ft * 256 + ch * 8) * 2);
    f16x8 G0[4], G1[4];
    epi_store_f16(acc, shm);
    __builtin_amdgcn_sched_barrier(0);
#pragma unroll
    for (int u = 0; u < 4; ++u) { G0[u] = *(const f16x8*)(gb + (gofs + (unsigned)(u * 16 * 4096))); G1[u] = *(const f16x8*)(gb + (gofs + (unsigned)(u * 16 * 4096 + 2048))); }
    RAW_SYNC();
#pragma unroll
    for (int bt = 0; bt < 4; ++bt) {
      f16x8 N0[4], N1[4];
      if (bt < 3) {
#pragma unroll
        for (int u = 0; u < 4; ++u) {
          N0[u] = *(const f16x8*)(gb + (gofs + (unsigned)(((bt + 1) * 4 + u) * 16 * 4096)));
          N1[u] = *(const f16x8*)(gb + (gofs + (unsigned)(((bt + 1) * 4 + u) * 16 * 4096 + 2048)));
        }
      }
#pragma unroll
      for (int u = 0; u < 4; ++u) {
        const int rr = (bt * 4 + u) * 16 + r0;
        f16x8 v = *(const f16x8*)(shm + rr * EPI_LD + ch * 16);
        f16x8 o;
#pragma unroll
        for (int e = 0; e < 8; ++e) {
          float rq = fminf((float)G0[u][e] * __builtin_amdgcn_rcpf(fmaxf((float)G1[u][e], 6e-5f)), 16384.f);
          o[e] = (f16)fminf(fmaxf((float)v[e] * rq, -60000.f), 60000.f);
        }
        *(f16x8*)(shm + rr * EPI_LD + ch * 16) = o;
      }
      if (bt < 3) {
#pragma unroll
        for (int u = 0; u < 4; ++u) { G0[u] = N0[u]; G1[u] = N1[u]; }
      }
    }
    RAW_SYNC();
    {
      const int wid_ = tid >> 6, lane_ = tid & 63, wr = wid_ >> 2, wc = wid_ & 3, fr = lane_ & 15, fq = lane_ >> 4;
#pragma unroll
      for (int m = 0; m < 8; ++m)
#pragma unroll
        for (int n = 0; n < 4; ++n) {
          f16x4 c = *(const f16x4*)(shm + (wc * 64 + n * 16 + fr) * EPI_LD + (wr * 128 + m * 16 + fq * 4) * 2);
          acc[m][n] = (f32x4){(float)c[0], (float)c[1], (float)c[2], (float)c[3]};
        }
    }
    RAW_SYNC();
    gemm_core(wpa, pa, pa16 + 512, pb, 8, acc, shm);
    epi_store_f16(acc, shm);
    __builtin_amdgcn_sched_barrier(0);
#pragma unroll
    for (int u = 0; u < 4; ++u) G1[u] = *(const f16x8*)(gb + (gofs + (unsigned)(u * 16 * 4096 + 2048)));
    RAW_SYNC();
#pragma unroll
    for (int bt = 0; bt < 4; ++bt) {
      f16x8 N1[4];
      if (bt < 3) {
#pragma unroll
        for (int u = 0; u < 4; ++u) N1[u] = *(const f16x8*)(gb + (gofs + (unsigned)(((bt + 1) * 4 + u) * 16 * 4096 + 2048)));
      }
#pragma unroll
      for (int u = 0; u < 4; ++u) {
        const int rr = (bt * 4 + u) * 16 + r0;
        f16x8 v = *(const f16x8*)(shm + rr * EPI_LD + ch * 16);
        f16x8 o;
#pragma unroll
        for (int e = 0; e < 8; ++e) o[e] = (f16)((float)v[e] * (float)G1[u][e]);
        *(f16x8*)((char*)merged16 + (mofs + (unsigned)((bt * 4 + u) * 16 * 2048))) = o;
      }
      if (bt < 3) {
#pragma unroll
        for (int u = 0; u < 4; ++u) G1[u] = N1[u];
      }
    }
    RAW_SYNC();
  }
}

__device__ __forceinline__ void p_resid(const Params& p, char* shm) {
  const f16* merged16 = (const f16*)(p.ws + OFF_B);
  const f16* h16 = (const f16*)(p.ws + OFF_A);
  const f16* wo = (const f16*)(p.ws + OFF_WOUT);
  f16* z16 = (f16*)(p.ws + OFF_C);
  const int tid = opaque_tid(), wid = tid >> 6, lane = tid & 63;
  int sR[NSTG], sC[NSTG];
#pragma unroll
  for (int i = 0; i < NSTG; ++i) stage_rc(wid * 1024 + i * 8192 + lane * 16, sR[i], sC[i]);
  const int ch = tid & 31, r0 = tid >> 5;
  for (int r = 0;; ++r) {
    int tile = xcd_item(512, r);
    if (tile == -1) break;
    if (tile < 0) continue;
    int ft = tile & 3, tt = tile >> 2;
    unsigned pa[NSTG], pb[NSTG];
#pragma unroll
    for (int i = 0; i < NSTG; ++i) {
      pa[i] = (unsigned)((ft * 256 + sR[i]) * 1024 + sC[i]);
      pb[i] = (unsigned)((tt * 256 + sR[i]) * 1024 + sC[i]);
    }
    {
      f32x4 acc[8][4];
      zero_acc(acc);
      gemm_core(wo, pa, merged16, pb, 16, acc, shm);
      epi_store_f16(acc, shm);
    }
    const unsigned oofs = (unsigned)((((tt * 256 + r0) * 1024) + ft * 256 + ch * 8) * 2);
    f16x8 H[4];
#pragma unroll
    for (int u = 0; u < 4; ++u) H[u] = *(const f16x8*)((const char*)h16 + (oofs + (unsigned)(u * 16 * 2048)));
    RAW_SYNC();
#pragma unroll
    for (int bt = 0; bt < 4; ++bt) {
      f16x8 NH[4];
      if (bt < 3) {
#pragma unroll
        for (int u = 0; u < 4; ++u) NH[u] = *(const f16x8*)((const char*)h16 + (oofs + (unsigned)(((bt + 1) * 4 + u) * 16 * 2048)));
      }
#pragma unroll
      for (int u = 0; u < 4; ++u) {
        const int rr = (bt * 4 + u) * 16 + r0;
        f16x8 v = *(const f16x8*)(shm + rr * EPI_LD + ch * 16);
        f16x8 zz;
#pragma unroll
        for (int e = 0; e < 8; ++e) zz[e] = (f16)(ALPHA * (float)H[u][e] + (float)v[e]);
        *(f16x8*)((char*)z16 + (oofs + (unsigned)((bt * 4 + u) * 16 * 2048))) = zz;
      }
      if (bt < 3) {
#pragma unroll
        for (int u = 0; u < 4; ++u) H[u] = NH[u];
      }
    }
    RAW_SYNC();
  }
}

#define HID_ROWS 73728
#define MOE_TAB (GEMM_LDS + 2048)
__device__ __forceinline__ void moe_tables(const int* counts, char* shm) {
  int* tab = (int*)(shm + MOE_TAB);
  if (threadIdx.x == 0) {
    int pf = 0, pn = 0, pr = 0;
    for (int e = 0; e < 32; ++e) {
      int n = counts[e * CNT_STRIDE];
      tab[e] = pf; tab[33 + e] = pn; tab[66 + e] = pr;
      pf += min(8, (n + 255) >> 8);
      pn += (max(n - 2048, 0) + 63) >> 6;
      pr += ((n + 255) >> 8) << 8;
    }
    tab[32] = pf; tab[65] = pn; tab[98] = pr;
  }
  __syncthreads();
}
__device__ __forceinline__ void moe_find(const int* pre, int item, int& e, int& mt) {
  e = 0;
  for (int i = 1; i < 32; ++i) if (item >= pre[i]) e = i;
  mt = item - pre[e];
}

#define NSLOT_B 20480
__device__ __forceinline__ void gemm_core_narrow(const f16* __restrict__ Ab, const unsigned (&pa)[NSTG], const f16* __restrict__ Bb,
                                                 unsigned pb, int nt, const int (&ablk)[2], f32x4 (&acc)[2][4], char* shm) {
  const int tid = opaque_tid(), wid = tid >> 6, lane = tid & 63, fr = lane & 15, fq = lane >> 4;
  const int nk = nt * 2;
  const bool hasb = (wid < 4);
#define SA(s_) (shm + (s_) * NSLOT_B)
#define SB(s_) (shm + (s_) * NSLOT_B + TILE_B)
#define NSTAGE(slot, kt)                                                                                                  \
  do {                                                                                                                    \
    _Pragma("unroll") for (int i = 0; i < NSTG; ++i)                                                                     \
      __builtin_amdgcn_global_load_lds((const unsigned*)(Ab + pa[i] + (kt) * 32), (unsigned*)(SA(slot) + wid * 1024 + i * 8192), \
                                       16, 0, 0);                                                                         \
    if (hasb) __builtin_amdgcn_global_load_lds((const unsigned*)(Bb + pb + (kt) * 32), (unsigned*)(SB(slot) + wid * 1024), 16, 0, 0); \
  } while (0)
  NSTAGE(0, 0);
  NSTAGE(1, 1);
  NSTAGE(2, 2);
  const int a0 = lds_byte(ablk[0] * 16 + fr, fq * 8), a1 = lds_byte(ablk[1] * 16 + fr, fq * 8), boff = lds_byte(fr, fq * 8);
  for (int t = 0; t < nk; ++t) {
    if (hasb) { if (t + 2 < nk) WAIT_V(6); else if (t + 1 < nk) WAIT_V(3); else WAIT_V(0); }
    else      { if (t + 2 < nk) WAIT_V(4); else if (t + 1 < nk) WAIT_V(2); else WAIT_V(0); }
    __builtin_amdgcn_s_barrier();
    if (t + 3 < nk) NSTAGE((t + 3) & 3, t + 3);
    const char* sa = SA(t & 3);
    const char* sb = SB(t & 3) + boff;
    f16x8 A0 = *(const f16x8*)(sa + a0), A1 = *(const f16x8*)(sa + a1), Bf[4];
#pragma unroll
    for (int n = 0; n < 4; ++n) Bf[n] = *(const f16x8*)(sb + n * 1024);
#pragma unroll
    for (int n = 0; n < 4; ++n) acc[0][n] = __builtin_amdgcn_mfma_f32_16x16x32_f16(A0, Bf[n], acc[0][n], 0, 0, 0);
#pragma unroll
    for (int n = 0; n < 4; ++n) acc[1][n] = __builtin_amdgcn_mfma_f32_16x16x32_f16(A1, Bf[n], acc[1][n], 0, 0, 0);
    WAIT_L(0);
  }
  RAW_SYNC();
#undef SA
#undef SB
#undef NSTAGE
}

__device__ __forceinline__ void p_moe_a(const Params& p, char* shm) {
  const f16* h1 = (const f16*)(p.ws + OFF_A);
  const f16* wgu = (const f16*)(p.ws + OFF_WGU);
  const int* counts = (const int*)(p.ws + OFF_CNT);
  const int* lists = (const int*)(p.ws + OFF_LISTS);
  f16* hid16 = (f16*)(p.ws + OFF_B);
  const int* tab = (const int*)(shm + MOE_TAB);
  const int tid = opaque_tid(), wid = tid >> 6, lane = tid & 63, wr = wid >> 2, wc = wid & 3, fr = lane & 15, fq = lane >> 4;
  int sR[NSTG], sC[NSTG];
#pragma unroll
  for (int i = 0; i < NSTG; ++i) stage_rc(wid * 1024 + i * 8192 + lane * 16, sR[i], sC[i]);
  moe_tables(counts, shm);
  const int total = tab[32] * 2;
  for (int r = 0;; ++r) {
    int item = xcd_item(total, r);
    if (item == -1) break;
    if (item < 0) continue;
    int e, mt;
    moe_find(tab, item >> 1, e, mt);
    const int fh = item & 1;
    const int cnt_e = counts[e * CNT_STRIDE];
    const int rowbase = tab[66 + e];
    unsigned pa[NSTG], pb[NSTG];
    f32x4 acc[8][4];
    zero_acc(acc);
#pragma unroll
    for (int i = 0; i < NSTG; ++i) {
      pa[i] = (unsigned)((e * 512 + fh * 256 + sR[i]) * 1024 + sC[i]);
      int idx = mt * 256 + sR[i];
      int tok = (idx < cnt_e) ? (lists[(size_t)e * T_TOK + idx] >> 1) : 0;
      pb[i] = (unsigned)(tok * 1024 + sC[i]);
    }
    gemm_core(wgu, pa, h1, pb, 16, acc, shm);
#pragma unroll
    for (int m = 0; m < 4; ++m)
#pragma unroll
      for (int n = 0; n < 4; ++n) {
        f16x4 o;
#pragma unroll
        for (int j = 0; j < 4; ++j) {
          float g = acc[m][n][j], u = acc[m + 4][n][j];
          o[j] = (f16)(g * u * __builtin_amdgcn_rcpf(1.0f + __builtin_amdgcn_exp2f(-1.4426950408889634f * g)));
        }
        size_t row = (size_t)rowbase + mt * 256 + wc * 64 + n * 16 + fr;
        *(f16x4*)(hid16 + row * 256 + fh * 128 + wr * 64 + m * 16 + fq * 4) = o;
      }
  }
  const int totaln = tab[65] * 2;
  for (int r = 0;; ++r) {
    int item = xcd_item(totaln, r);
    if (item == -1) break;
    if (item < 0) continue;
    int e, ntile;
    moe_find(tab + 33, item >> 1, e, ntile);
    const int fh = item & 1;
    const int cnt_e = counts[e * CNT_STRIDE];
    const int rowbase = tab[66 + e];
    const int wrn = wid >> 2, lq = wid & 3;
    const int ablk[2] = {wrn * 8 + lq, wrn * 8 + 4 + lq};
    unsigned pa[NSTG], pb = 0;
#pragma unroll
    for (int i = 0; i < NSTG; ++i) pa[i] = (unsigned)((e * 512 + fh * 256 + sR[i]) * 1024 + sC[i]);
    {
      int idx = 2048 + ntile * 64 + (sR[0] & 63);
      int tok = (idx < cnt_e) ? (lists[(size_t)e * T_TOK + idx] >> 1) : 0;
      pb = (unsigned)(tok * 1024 + sC[0]);
    }
    f32x4 acc[2][4];
#pragma unroll
    for (int m = 0; m < 2; ++m)
#pragma unroll
      for (int n = 0; n < 4; ++n) acc[m][n] = (f32x4){0.f, 0.f, 0.f, 0.f};
    gemm_core_narrow(wgu, pa, h1, pb, 16, ablk, acc, shm);
#pragma unroll
    for (int n = 0; n < 4; ++n) {
      f16x4 o;
#pragma unroll
      for (int j = 0; j < 4; ++j) {
        float g = acc[0][n][j], u = acc[1][n][j];
        o[j] = (f16)(g * u * __builtin_amdgcn_rcpf(1.0f + __builtin_amdgcn_exp2f(-1.4426950408889634f * g)));
      }
      size_t row = (size_t)rowbase + 2048 + ntile * 64 + n * 16 + fr;
      *(f16x4*)(hid16 + row * 256 + fh * 128 + wrn * 64 + lq * 16 + fq * 4) = o;
    }
  }
}

__device__ __forceinline__ void p_moe_b(const Params& p, char* shm) {
  const f16* wdn = (const f16*)(p.ws + OFF_WDN);
  const f16* hid16 = (const f16*)(p.ws + OFF_B);
  const float* route_w = (const float*)(p.ws + OFF_ROUTE_W);
  const int* counts = (const int*)(p.ws + OFF_CNT);
  const int* lists = (const int*)(p.ws + OFF_LISTS);
  f16* y16 = (f16*)(p.ws + OFF_C);
  int* sent = (int*)(shm + 256 * EPI_LD);
  const int* tab = (const int*)(shm + MOE_TAB);
  const int tid = opaque_tid(), wid = tid >> 6, lane = tid & 63, wc = wid & 3, fr = lane & 15, fq = lane >> 4;
  int sR[NSTG], sC[NSTG];
#pragma unroll
  for (int i = 0; i < NSTG; ++i) stage_rc(wid * 1024 + i * 8192 + lane * 16, sR[i], sC[i]);
  moe_tables(counts, shm);
  const int total = tab[32] * 4;
  for (int r = 0;; ++r) {
    int item = xcd_item(total, r);
    if (item == -1) break;
    if (item < 0) continue;
    int e, mt;
    moe_find(tab, item >> 2, e, mt);
    const int ft = item & 3;
    const int cnt_e = counts[e * CNT_STRIDE];
    const int rowbase = tab[66 + e];
    if (tid < 256) {
      int idx = mt * 256 + tid;
      sent[tid] = (idx < cnt_e) ? lists[(size_t)e * T_TOK + idx] : -1;
    }
    unsigned pa[NSTG], pb[NSTG];
    f32x4 acc[8][4];
    zero_acc(acc);
#pragma unroll
    for (int i = 0; i < NSTG; ++i) {
      pa[i] = (unsigned)((e * 1024 + ft * 256 + sR[i]) * 256 + sC[i]);
      pb[i] = (unsigned)((rowbase + mt * 256 + sR[i]) * 256 + sC[i]);
    }
    gemm_core(wdn, pa, hid16, pb, 4, acc, shm);
#pragma unroll
    for (int n = 0; n < 4; ++n) {
      int en = sent[wc * 64 + n * 16 + fr];
      float rw = (en >= 0) ? route_w[en] : 0.f;
#pragma unroll
      for (int m = 0; m < 8; ++m)
#pragma unroll
        for (int j = 0; j < 4; ++j) acc[m][n][j] *= rw;
    }
    epi_store_f16(acc, shm);
    RAW_SYNC();
    epi_rows_out(shm, [&](int rr) -> f16* { int en = sent[rr]; return (en >= 0) ? (y16 + (size_t)en * 1024 + ft * 256) : (f16*)nullptr; });
    RAW_SYNC();
  }
  const int totaln = tab[65] * 4;
  for (int r = 0;; ++r) {
    int item = xcd_item(totaln, r);
    if (item == -1) break;
    if (item < 0) continue;
    int e, ntile;
    moe_find(tab + 33, item >> 2, e, ntile);
    const int ft = item & 3;
    const int cnt_e = counts[e * CNT_STRIDE];
    const int rowbase = tab[66 + e];
    if (tid < 64) {
      int idx = 2048 + ntile * 64 + tid;
      sent[tid] = (idx < cnt_e) ? lists[(size_t)e * T_TOK + idx] : -1;
    }
    const int ablk[2] = {wid * 2, wid * 2 + 1};
    unsigned pa[NSTG], pb;
#pragma unroll
    for (int i = 0; i < NSTG; ++i) pa[i] = (unsigned)((e * 1024 + ft * 256 + sR[i]) * 256 + sC[i]);
    pb = (unsigned)((rowbase + 2048 + ntile * 64 + (sR[0] & 63)) * 256 + sC[0]);
    f32x4 acc[2][4];
#pragma unroll
    for (int m = 0; m < 2; ++m)
#pragma unroll
      for (int n = 0; n < 4; ++n) acc[m][n] = (f32x4){0.f, 0.f, 0.f, 0.f};
    gemm_core_narrow(wdn, pa, hid16, pb, 4, ablk, acc, shm);
#pragma unroll
    for (int n = 0; n < 4; ++n) {
      int en = sent[n * 16 + fr];
      float rw = (en >= 0) ? route_w[en] : 0.f;
#pragma unroll
      for (int m = 0; m < 2; ++m) {
        f16x4 v;
#pragma unroll
        for (int j = 0; j < 4; ++j) v[j] = (f16)(acc[m][n][j] * rw);
        *(f16x4*)(shm + (n * 16 + fr) * EPI_LD + (wid * 32 + m * 16 + fq * 4) * 2) = v;
      }
    }
    RAW_SYNC();
    {
      const int ch = tid & 31, r0 = tid >> 5;
#pragma unroll
      for (int ps = 0; ps < 4; ++ps) {
        int rr = ps * 16 + r0;
        f16x8 v = *(const f16x8*)(shm + rr * EPI_LD + ch * 16);
        int en = sent[rr];
        if (en >= 0) *(f16x8*)(y16 + (size_t)en * 1024 + ft * 256 + ch * 8) = v;
      }
    }
    RAW_SYNC();
  }
}

__device__ __forceinline__ unsigned f2key_(float f) {
  if (f == 0.f) f = 0.f;
  unsigned u = __float_as_uint(f);
  return (u & 0x80000000u) ? ~u : (u | 0x80000000u);
}
__device__ __forceinline__ float key2f_(unsigned k) {
  return __uint_as_float((k & 0x80000000u) ? (k & 0x7fffffffu) : ~k);
}
__device__ __forceinline__ void find_bin(const unsigned* hrow, int need, int lane, int* out_bin, int* out_above) {
  uint4 c = *(const uint4*)(hrow + 4 * lane);
  int tot = (int)(c.x + c.y + c.z + c.w);
  int incl = tot;
#pragma unroll
  for (int o = 1; o < 64; o <<= 1) {
    int v = __shfl_down(incl, o, 64);
    if (lane + o < 64) incl += v;
  }
  int above = incl - tot;
  if (above < need && incl >= need) {
    int b;
    if (above + (int)c.w >= need) b = 3;
    else { above += c.w; if (above + (int)c.z >= need) b = 2;
      else { above += c.z; if (above + (int)c.y >= need) b = 1; else { above += c.y; b = 0; } } }
    *out_bin = 4 * lane + b;
    *out_above = above;
  }
}

typedef short s16x4 __attribute__((ext_vector_type(4)));
#define VROW 160
#define ATT_WAVE_LDS (64 * VROW + 512)
__device__ __forceinline__ f16x8 tr_pair(const char* a, const char* b) {
  s16x4 x = __builtin_amdgcn_ds_read_tr16_b64_v4i16((__attribute__((address_space(3))) s16x4*)(a));
  s16x4 y = __builtin_amdgcn_ds_read_tr16_b64_v4i16((__attribute__((address_space(3))) s16x4*)(b));
  typedef short s16x8 __attribute__((ext_vector_type(8)));
  s16x8 r = __builtin_shufflevector(x, y, 0, 1, 2, 3, 4, 5, 6, 7);
  return __builtin_bit_cast(f16x8, r);
}
__device__ __forceinline__ void attn_load_q(const f16* __restrict__ proj16, int t, int lane, f16x8& q0, f16x8& q1) {
  const f16* qp = proj16 + (size_t)t * PJ_W + C_Q + (lane & 7) * 64 + (lane >> 4) * 16;
  q0 = *(const f16x8*)qp;
  q1 = *(const f16x8*)(qp + 8);
}
__device__ __forceinline__ f16x8 widen8(unsigned lo, unsigned hi) {
  f16x2 a = __builtin_amdgcn_cvt_scalef32_pk_f16_fp8(lo, 1.0f, false), b = __builtin_amdgcn_cvt_scalef32_pk_f16_fp8(lo, 1.0f, true);
  f16x2 c = __builtin_amdgcn_cvt_scalef32_pk_f16_fp8(hi, 1.0f, false), d = __builtin_amdgcn_cvt_scalef32_pk_f16_fp8(hi, 1.0f, true);
  f16x8 r = {a[0], a[1], b[0], b[1], c[0], c[1], d[0], d[1]};
  return r;
}
__device__ __forceinline__ void attn_one(f16x8 bq0, f16x8 bq1, const f16* __restrict__ proj16, f16x8& nq0, f16x8& nq1,
                                         const char* __restrict__ kv8, f16* __restrict__ pa16, int t,
                                         const unsigned short* ssel, char* vimg, int lane) {
  const int fr = lane & 15, fq = lane >> 4;
  const int l = t & (SEQ - 1), b0 = t - l, cnt = min(l + 1, 256);
  f16x8 ones;
  const char* kvb = kv8 + (size_t)__builtin_amdgcn_readfirstlane(b0) * 128;
  f32x4 S[16];
  uint4 kraw[16], vraw[16];
  {
    int ki[16];
#pragma unroll
    for (int kt = 0; kt < 16; ++kt) ki[kt] = ssel[kt * 16 + fr];
    __builtin_amdgcn_sched_barrier(0);
#pragma unroll
    for (int kt = 0; kt < 16; ++kt) {
      const unsigned ko = (unsigned)min(ki[kt], l) * 128u + fq * 16;
      kraw[kt] = *(const uint4*)(kvb + ko);
      vraw[kt] = *(const uint4*)(kvb + ko + 64);
    }
  }
  __builtin_amdgcn_sched_barrier(0);
  {
    const f16 qs = (f16)0.18033688011112042f;
#pragma unroll
    for (int e = 0; e < 8; ++e) {
      bq0[e] = (fr < 8) ? bq0[e] * qs : (f16)0.f;
      bq1[e] = (fr < 8) ? bq1[e] * qs : (f16)0.f;
      ones[e] = (fr == 0) ? (f16)1.f : (f16)0.f;
    }
  }
#pragma unroll
  for (int kt = 0; kt < 16; kt += 2) {
    f32x4 z0 = {0.f, 0.f, 0.f, 0.f}, z1 = {0.f, 0.f, 0.f, 0.f};
    z0 = __builtin_amdgcn_mfma_f32_16x16x32_f16(widen8(kraw[kt].x, kraw[kt].y), bq0, z0, 0, 0, 0);
    z1 = __builtin_amdgcn_mfma_f32_16x16x32_f16(widen8(kraw[kt + 1].x, kraw[kt + 1].y), bq0, z1, 0, 0, 0);
    S[kt] = __builtin_amdgcn_mfma_f32_16x16x32_f16(widen8(kraw[kt].z, kraw[kt].w), bq1, z0, 0, 0, 0);
    S[kt + 1] = __builtin_amdgcn_mfma_f32_16x16x32_f16(widen8(kraw[kt + 1].z, kraw[kt + 1].w), bq1, z1, 0, 0, 0);
    __builtin_amdgcn_sched_barrier(0);
  }
  if (cnt < 256) {
    int cl = cnt - fq * 4;
    asm volatile("" : "+v"(cl));
#pragma unroll
    for (int kt = 0; kt < 16; ++kt)
#pragma unroll
      for (int j = 0; j < 4; ++j) S[kt][j] = (kt * 16 + j < cl) ? S[kt][j] : NEG_BIG;
  }
  attn_load_q(proj16, min(t + 1, T_TOK - 1), lane, nq0, nq1);
  __builtin_amdgcn_sched_barrier(0);
  float m = NEG_BIG;
#pragma unroll
  for (int kt = 0; kt < 16; ++kt)
#pragma unroll
    for (int j = 0; j < 4; ++j) m = fmaxf(m, S[kt][j]);
  m = fmaxf(m, __shfl_xor(m, 16, 64));
  m = fmaxf(m, __shfl_xor(m, 32, 64));
  f16x8 P[8];
#pragma unroll
  for (int c = 0; c < 8; ++c)
#pragma unroll
    for (int j = 0; j < 4; ++j) {
      P[c][j] = (f16)__builtin_amdgcn_exp2f(S[2 * c][j] - m);
      P[c][4 + j] = (f16)__builtin_amdgcn_exp2f(S[2 * c + 1][j] - m);
    }
  f32x4 O[4], Ol = {0.f, 0.f, 0.f, 0.f};
#pragma unroll
  for (int nt = 0; nt < 4; ++nt) O[nt] = (f32x4){0.f, 0.f, 0.f, 0.f};
#pragma unroll
  for (int rr = 0; rr < 4; ++rr) {
#pragma unroll
    for (int q = 0; q < 4; ++q) {
      const uint4 vr = vraw[rr * 4 + q];
      char* wp = vimg + (q * 16 + fr) * VROW + fq * 32;
      *(f16x8*)wp = widen8(vr.x, vr.y);
      *(f16x8*)(wp + 16) = widen8(vr.z, vr.w);
    }
    asm volatile("" ::: "memory");
#pragma unroll
    for (int cc = 0; cc < 2; ++cc) {
      const char* ra = vimg + (cc * 32 + fq * 4 + (fr >> 2)) * VROW + (fr & 3) * 8;
#pragma unroll
      for (int nt = 0; nt < 4; ++nt) {
        f16x8 B = tr_pair(ra + nt * 32, ra + 16 * VROW + nt * 32);
        O[nt] = __builtin_amdgcn_mfma_f32_16x16x32_f16(P[rr * 2 + cc], B, O[nt], 0, 0, 0);
      }
      Ol = __builtin_amdgcn_mfma_f32_16x16x32_f16(P[rr * 2 + cc], ones, Ol, 0, 0, 0);
    }
  }
  asm volatile("s_waitcnt lgkmcnt(0)" ::: "memory");
#pragma unroll
  for (int j = 0; j < 4; ++j) {
    float ls = __shfl(Ol[j], lane & 48, 64);
    float inv = __builtin_amdgcn_rcpf(ls);
    if (fq < 2) {
      f16* op = pa16 + (size_t)t * DM + 512 + (fq * 4 + j) * 64 + fr;
#pragma unroll
      for (int nt = 0; nt < 4; ++nt) op[nt * 16] = (f16)(O[nt][j] * inv);
    }
  }
}

__device__ __forceinline__ f32x4 score_tile(const f16x8& a, const f16x8 (&bq)[8], const f16x8& bc_hi, const f16x8& bc_lo,
                                            const float (&wq)[8]) {
  f32x4 L[8];
#pragma unroll
  for (int h = 0; h < 8; ++h) L[h] = __builtin_amdgcn_mfma_f32_16x16x32_f16(a, bq[h], (f32x4){0.f, 0.f, 0.f, 0.f}, 0, 0, 0);
  f32x4 lin = __builtin_amdgcn_mfma_f32_16x16x32_f16(a, bc_lo, (f32x4){0.f, 0.f, 0.f, 0.f}, 0, 0, 0);
  lin = __builtin_amdgcn_mfma_f32_16x16x32_f16(a, bc_hi, lin, 0, 0, 0);
  __builtin_amdgcn_sched_barrier(0);
  asm volatile("s_nop 7\n\ts_nop 7" ::: "memory");
  __builtin_amdgcn_sched_barrier(0);
  float t0 = 0.f, t1 = 0.f, t2 = 0.f, t3 = 0.f;
#pragma unroll
  for (int h = 0; h < 8; ++h) {
    asm("v_fma_f32 %0, %1, |%2|, %0" : "+v"(t0) : "v"(wq[h]), "v"(L[h][0]));
    asm("v_fma_f32 %0, %1, |%2|, %0" : "+v"(t1) : "v"(wq[h]), "v"(L[h][1]));
    asm("v_fma_f32 %0, %1, |%2|, %0" : "+v"(t2) : "v"(wq[h]), "v"(L[h][2]));
    asm("v_fma_f32 %0, %1, |%2|, %0" : "+v"(t3) : "v"(wq[h]), "v"(L[h][3]));
  }
  f32x4 s = {t0 + lin[0], t1 + lin[1], t2 + lin[2], t3 + lin[3]};
  return s;
}

#define KEYS_LD 4104
#define IDX_KEYS 0
#define IDX_HIST 131584
#define IDX_SSEL (IDX_HIST + 16384)
#define IDX_CAND (IDX_SSEL + 8192)
#define IDX_MISC (IDX_CAND + 2048)
template <int V>
__device__ __forceinline__ void p_index(const Params& p, char* shm) {
  const f16* proj16 = (const f16*)(p.ws + OFF_B);
  f16* pa16 = (V == 0) ? (f16*)(p.ws + OFF_D) : (f16*)p.out;
  unsigned short* keys16 = (unsigned short*)(shm + IDX_KEYS);
  unsigned* hist = (unsigned*)(shm + IDX_HIST);
  unsigned short* ssel = (unsigned short*)(shm + IDX_SSEL);
  unsigned short* scand = (unsigned short*)(shm + IDX_CAND);
  unsigned* smm = (unsigned*)(shm + IDX_MISC);
  int* sbin = (int*)(smm + 32);
  const int tid = opaque_tid();
  const float NINF = -__builtin_huge_valf(), PINF = __builtin_huge_valf();
  unsigned* qhead = (unsigned*)(p.ws + OFF_BAR + 15360) + (blockIdx.x & 7) * 16 + ((V == 0) ? 0 : 8);
  int* qslot = (int*)(shm + IDX_MISC + 512);
#define NLONG 240
#define NTICK 272
  int qcur = 0, qnxt = 0;
  if (tid == 0) { qcur = (int)atomicAdd(qhead, 1u); qnxt = (int)atomicAdd(qhead, 1u); }
  int pf_for = -1;
  for (;;) {
    __syncthreads();
    if (opaque_tid() == 0) { qslot[0] = qcur; qslot[1] = qnxt; }
    __syncthreads();
    const int qi = qslot[0], qn = qslot[1];
    if (qi >= NTICK) break;
    const int tidr = opaque_tid();
    int lane = tidr & 63;
    asm volatile("" : "+v"(lane));
    const int wids = __builtin_amdgcn_readfirstlane(tidr >> 6);
    const int fr = lane & 15, fq = lane >> 4;
    const unsigned long long lt_mask = (1ull << lane) - 1ull;
    const int b = blockIdx.x & 7;
    if (qi >= NLONG) {
      if (opaque_tid() == 0) { const int tk = (int)atomicAdd(qhead, 1u); qcur = qnxt; qnxt = tk; }
      const int hs = qi - NLONG, l0 = (15 - (hs >> 1)) * 16, t0 = b * SEQ + l0;
      const int q = (hs & 1) * 8 + wids, lq = l0 + q;
      f16x8 qc0, qc1, qn0, qn1;
      attn_load_q(proj16, t0 + q, lane, qc0, qc1);
      unsigned short* sl = ssel + q * 256;
      for (int i = lane; i < 256; i += 64) sl[i] = (unsigned short)((i <= lq) ? i : 0);
      asm volatile("s_waitcnt lgkmcnt(0)" ::: "memory");
      attn_one(qc0, qc1, proj16, qn0, qn1, p.ws + OFF_KV8, pa16, t0 + q, sl, (char*)(keys16 + (2 * wids) * KEYS_LD), lane);
      continue;
    }
    const int j = 255 - qi;
    const int l0 = j * 16, t0 = b * SEQ + l0;
    const int klast = (j - 1) - ((j - 1 - wids) & 7);
    const f16* kbase = (const f16*)(p.ws + OFF_IKC) + (size_t)(b * SEQ + fr) * 32 + fq * 8;
#define NB 8
#define IK_LOAD(dst, kt0)                                                                   \
  _Pragma("unroll") for (int u = 0; u < NB; ++u) {                                          \
    int ktc = min((kt0) + 8 * u, klast);                                                    \
    dst[u] = *(const f16x8*)(kbase + ktc * 512);                                            \
  }
    f16x8 bq[8];
    float wq[8];
    f16x8 afirst[NB];
    f16x8 wv;
    if (pf_for == qi) {
      const char* qimg = shm + IDX_HIST + fr * 1024 + fq * 16;
#pragma unroll
      for (int h = 0; h < 8; ++h) bq[h] = *(const f16x8*)(qimg + h * 64);
      wv = *(const f16x8*)(shm + IDX_HIST + fr * 1024 + 512);
    } else {
      const f16* qrow = proj16 + (size_t)(t0 + fr) * PJ_W;
#pragma unroll
      for (int h = 0; h < 8; ++h) bq[h] = *(const f16x8*)(qrow + C_IQ + h * 32 + fq * 8);
      wv = *(const f16x8*)(qrow + C_IW);
    }
    const f16x8 ad = *(const f16x8*)(kbase + j * 512);
    IK_LOAD(afirst, wids);
    if (opaque_tid() == 0) { const int tk = (int)atomicAdd(qhead, 1u); qcur = qnxt; qnxt = tk; }
    if (tidr < 16) { smm[tidr] = 0xFFFFFFFFu; smm[16 + tidr] = 0u; }
#pragma unroll
    for (int h = 0; h < 8; ++h) wq[h] = (float)wv[h];
    f16x8 bc_hi, bc_lo;
#pragma unroll
    for (int e = 0; e < 8; ++e) {
      float c = 0.f;
#pragma unroll
      for (int h = 0; h < 8; ++h) c = __builtin_fmaf(wq[h], (float)bq[h][e], c);
      f16 ch_ = (f16)c;
      bc_hi[e] = ch_;
      bc_lo[e] = (f16)(c - (float)ch_);
    }
    __syncthreads();
    if (V == 4) {
      float d = (float)bc_hi[0] + (float)bc_lo[1] + (float)ad[0];
#pragma unroll
      for (int u = 0; u < 8; ++u) d += (float)afirst[u][0];
      if (d == 12345.678f) smm[0] = 1u;
      continue;
    }
    {
      float mn = PINF, mx = NINF;
      f16x8 a[NB];
#pragma unroll
      for (int u = 0; u < NB; ++u) a[u] = afirst[u];
      const int astep = (j >= 32) ? (1 << 20) : 8 * NB;
      for (int kt0 = wids; kt0 < j; kt0 += astep) {
        f16x8 an[NB];
        if (j < 32) { IK_LOAD(an, kt0 + astep); }
        else {
#pragma unroll
          for (int u = 0; u < NB; ++u) an[u] = a[u];
        }
#pragma unroll
        for (int u = 0; u < NB; ++u) {
          if (kt0 + 8 * u < j) {
            f32x4 sc = score_tile(a[u], bq, bc_hi, bc_lo, wq);
            mn = fminf(fminf(mn, sc[0]), fminf(fminf(sc[1], sc[2]), sc[3]));
            mx = fmaxf(fmaxf(mx, sc[0]), fmaxf(fmaxf(sc[1], sc[2]), sc[3]));
          }
        }
#pragma unroll
        for (int u = 0; u < NB; ++u) a[u] = an[u];
      }
      if ((j & 7) == wids) {
        f32x4 sc = score_tile(ad, bq, bc_hi, bc_lo, wq);
#pragma unroll
        for (int jj = 0; jj < 4; ++jj) {
          bool ok = (fq * 4 + jj <= fr);
          mn = fminf(mn, ok ? sc[jj] : PINF);
          mx = fmaxf(mx, ok ? sc[jj] : NINF);
        }
      }
      mn = fminf(mn, __shfl_xor(mn, 16, 64)); mn = fminf(mn, __shfl_xor(mn, 32, 64));
      mx = fmaxf(mx, __shfl_xor(mx, 16, 64)); mx = fmaxf(mx, __shfl_xor(mx, 32, 64));
      if (fq == 0) {
        if (mn != PINF) atomicMin(&smm[fr], f2key_(mn));
        if (mx != NINF) atomicMax(&smm[16 + fr], f2key_(mx));
      }
    }
    for (int i = tidr; i < 4096; i += 512) hist[i] = 0;
    __syncthreads();
    if (V == 3) continue;
    {
      float lo = key2f_(smm[fr]), hi = key2f_(smm[16 + fr]);
      if (j >= 32) { const float mg = 0.125f * (hi - lo); lo -= mg; hi += mg; }
      const float s16 = (hi > lo) ? 65536.0f / (hi - lo) : 0.f;
      const float nlo = -lo * s16;
      unsigned* hq = hist + fr * 256;
      unsigned short* kq = keys16 + fr * KEYS_LD + fq * 4;
      f16x8 a[NB];
#pragma unroll
      for (int u = 0; u < NB; ++u) a[u] = afirst[u];
      for (int kt0 = wids; kt0 < j; kt0 += 8 * NB) {
        f16x8 an[NB];
        IK_LOAD(an, kt0 + 8 * NB);
#pragma unroll
        for (int u = 0; u < NB; ++u) {
          const int kt = kt0 + 8 * u;
          if (kt < j) {
            f32x4 sc = score_tile(a[u], bq, bc_hi, bc_lo, wq);
            unsigned kk[4];
#pragma unroll
            for (int jj = 0; jj < 4; ++jj) {
              int k16 = min(max((int)__builtin_fmaf(sc[jj], s16, nlo), 0), 65535);
              kk[jj] = (unsigned)k16;
              atomicAdd(&hq[k16 >> 8], 1u);
            }
            uint2 pk;
            pk.x = kk[0] | (kk[1] << 16);
            pk.y = kk[2] | (kk[3] << 16);
            *(uint2*)(kq + kt * 16) = pk;
          }
        }
#pragma unroll
        for (int u = 0; u < NB; ++u) a[u] = an[u];
      }
      if ((j & 7) == wids) {
        f32x4 sc = score_tile(ad, bq, bc_hi, bc_lo, wq);
        unsigned kk[4];
#pragma unroll
        for (int jj = 0; jj < 4; ++jj) {
          int k16 = min(max((int)__builtin_fmaf(sc[jj], s16, nlo), 0), 65535);
          kk[jj] = (unsigned)k16;
          if (fq * 4 + jj <= fr) atomicAdd(&hq[k16 >> 8], 1u);
        }
        uint2 pk;
        pk.x = kk[0] | (kk[1] << 16);
        pk.y = kk[2] | (kk[3] << 16);
        *(uint2*)(kq + j * 16) = pk;
      }
    }
#undef IK_LOAD
#undef NB
    __syncthreads();
    if (V == 2) continue;
    f16x8 qc0, qc1;
    attn_load_q(proj16, t0 + 2 * wids, lane, qc0, qc1);
    {
      const int q0 = 2 * wids, lq0 = l0 + q0;
      const int nmax = lq0 + 2;
      unsigned* hrow0 = hist + q0 * 256;
      const unsigned short* krow0 = keys16 + q0 * KEYS_LD;
      if (lane < 4) sbin[2 * q0 + lane] = 0;
      find_bin(hrow0, 256, lane, &sbin[2 * q0], &sbin[2 * q0 + 1]);
      find_bin(hrow0 + 256, 256, lane, &sbin[2 * q0 + 2], &sbin[2 * q0 + 3]);
      asm volatile("s_waitcnt lgkmcnt(0)" ::: "memory");
      const unsigned b1s0 = (unsigned)sbin[2 * q0], b1s1 = (unsigned)sbin[2 * q0 + 2];
      const int r0n = 256 - sbin[2 * q0 + 1], r1n = 256 - sbin[2 * q0 + 3];
      asm volatile("s_waitcnt lgkmcnt(0)" ::: "memory");
      int base0 = 0, cb0 = 0, base1 = 0, cb1 = 0;
      for (int s0 = 0; s0 < nmax; s0 += 256) {
        const int s4 = s0 + lane * 4;
        uint2 pa_ = make_uint2(0u, 0u), pb_ = make_uint2(0u, 0u);
        if (s4 < nmax) { pa_ = *(const uint2*)(krow0 + s4); pb_ = *(const uint2*)(krow0 + KEYS_LD + s4); }
        unsigned ka[4] = {pa_.x & 0xffffu, pa_.x >> 16, pa_.y & 0xffffu, pa_.y >> 16};
        unsigned kb[4] = {pb_.x & 0xffffu, pb_.x >> 16, pb_.y & 0xffffu, pb_.y >> 16};
#pragma unroll
        for (int jj = 0; jj < 4; ++jj) {
          const bool ok0 = (s4 + jj <= lq0), ok1 = (s4 + jj <= lq0 + 1);
          const unsigned ba = ka[jj] >> 8, bb = kb[jj] >> 8;
          const bool t0_ = ok0 && (ba > b1s0), c0_ = ok0 && (ba == b1s0);
          const bool t1_ = ok1 && (bb > b1s1), c1_ = ok1 && (bb == b1s1);
          unsigned long long m0 = __ballot(t0_), m1 = __ballot(t1_), cm0 = __ballot(c0_), cm1 = __ballot(c1_);
          if (t0_) ssel[q0 * 256 + base0 + __popcll(m0 & lt_mask)] = (unsigned short)(s4 + jj);
          if (t1_) ssel[q0 * 256 + 256 + base1 + __popcll(m1 & lt_mask)] = (unsigned short)(s4 + jj);
          base0 += __popcll(m0); base1 += __popcll(m1);
          if (cm0 | cm1) {
            int cp0 = cb0 + __popcll(cm0 & lt_mask), cp1 = cb1 + __popcll(cm1 & lt_mask);
            if (c0_ && cp0 < 256) hrow0[cp0] = (ka[jj] << 16) | (0xFFFFu - (unsigned)(s4 + jj));
            if (c1_ && cp1 < 256) hrow0[256 + cp1] = (kb[jj] << 16) | (0xFFFFu - (unsigned)(s4 + jj));
            cb0 += __popcll(cm0); cb1 += __popcll(cm1);
          }
        }
      }
      asm volatile("s_waitcnt lgkmcnt(0)" ::: "memory");
#pragma unroll
      for (int x = 0; x < 2; ++x) {
        const int q = q0 + x;
        const unsigned* cl = hrow0 + x * 256;
        const int base = x ? base1 : base0, c = min(x ? cb1 : cb0, 256), r = x ? r1n : r0n;
        for (int i = lane; i < c; i += 64) {
          const unsigned my = cl[i];
          int rank = 0;
          for (int k = 0; k < c; ++k) rank += (cl[k] > my) ? 1 : 0;
          if (rank < r && base + rank < 256) ssel[q * 256 + base + rank] = (unsigned short)(0xFFFFu - (my & 0xFFFFu));
        }
      }
    }
    asm volatile("s_waitcnt lgkmcnt(0)" ::: "memory");
    pf_for = -1;
    if (qn < NLONG) {
      const int t0n = b * SEQ + (255 - qn) * 16;
#pragma unroll
      for (int x = 0; x < 2; ++x) {
        const int q = 2 * wids + x;
        const f16* src = proj16 + (size_t)(t0n + q) * PJ_W + ((lane < 32) ? (C_IQ + lane * 8) : C_IW);
        __builtin_amdgcn_global_load_lds((const unsigned*)src, (unsigned*)(shm + IDX_HIST + q * 1024), 16, 0, 0);
      }
      pf_for = qn;
    }
#pragma unroll 1
    for (int qq = 0; qq < 2; ++qq) {
      const int q = 2 * wids + qq, lq = l0 + q;
      unsigned short* sl = ssel + q * 256;
      f16x8 qn0, qn1;
      attn_one(qc0, qc1, proj16, qn0, qn1, p.ws + OFF_KV8, pa16, t0 + q, sl, (char*)(keys16 + (2 * wids) * KEYS_LD), lane);
      qc0 = qn0; qc1 = qn1;
    }
    __syncthreads();
  }
}

#define DL_LD 1040
template <int W>
__device__ __forceinline__ void pool_delta(const f16* up, int lf, char* dp) {
  f16x8 u[W + 7];
#pragma unroll
  for (int k = 0; k < W + 7; ++k) {
    const int rel = k - (W - 1);
    f16x8 z = {(f16)0.f, (f16)0.f, (f16)0.f, (f16)0.f, (f16)0.f, (f16)0.f, (f16)0.f, (f16)0.f};
    u[k] = (lf + rel >= 0) ? *(const f16x8*)(up + (ptrdiff_t)rel * PJ_W) : z;
  }
  float sum[8];
#pragma unroll
  for (int e = 0; e < 8; ++e) sum[e] = 0.f;
#pragma unroll
  for (int k = 0; k < W - 1; ++k)
#pragma unroll
    for (int e = 0; e < 8; ++e) sum[e] += (float)u[k][e];
#pragma unroll
  for (int i = 0; i < 8; ++i) {
    const float inv = 1.0f / (float)min(lf + i + 1, W);
    f16x8 d;
#pragma unroll
    for (int e = 0; e < 8; ++e) {
      sum[e] += (float)u[W - 1 + i][e];
      d[e] = (f16)(sum[e] * inv - (float)u[W - 1 + i][e]);
      sum[e] -= (float)u[i][e];
    }
    *(f16x8*)(dp + i * DL_LD) = d;
  }
}
__device__ __forceinline__ void p_pool(const Params& p, char* shm) {
  const f16* proj16 = (const f16*)(p.ws + OFF_B);
  const f16* wpl = (const f16*)(p.ws + OFF_WPOOL);
  f16* pa16 = (f16*)(p.ws + OFF_D);
  const int tid = opaque_tid(), wid = tid >> 6, lane = tid & 63, fr = lane & 15, fq = lane >> 4;
  for (int item = blockIdx.x; item < T_TOK / 64; item += gridDim.x) {
    const int t0 = item * 64;
    {
      const int g = wid >> 1;
      const int c = g * 128 + ((wid & 1) * 8 + (lane & 7)) * 8;
      const int tg = lane >> 3;
      const int tf = t0 + tg * 8, lf = tf & (SEQ - 1);
      const f16* up = proj16 + (size_t)tf * PJ_W + c;
      char* dp = shm + (tg * 8) * DL_LD + c * 2;
      if (g == 0) pool_delta<2>(up, lf, dp);
      else if (g == 1) pool_delta<4>(up, lf, dp);
      else if (g == 2) pool_delta<8>(up, lf, dp);
      else pool_delta<16>(up, lf, dp);
    }
    __syncthreads();
    {
      const int g = wid >> 1, eh = wid & 1;
      f32x4 acc[4][4];
#pragma unroll
      for (int m = 0; m < 4; ++m)
#pragma unroll
        for (int n = 0; n < 4; ++n) acc[m][n] = (f32x4){0.f, 0.f, 0.f, 0.f};
#pragma unroll
      for (int ks = 0; ks < 4; ++ks) {
        f16x8 A[4], B[4];
#pragma unroll
        for (int m = 0; m < 4; ++m) A[m] = *(const f16x8*)(wpl + (size_t)(g * 128 + eh * 64 + m * 16 + fr) * 128 + ks * 32 + fq * 8);
#pragma unroll
        for (int n = 0; n < 4; ++n) B[n] = *(const f16x8*)(shm + (n * 16 + fr) * DL_LD + (g * 128 + ks * 32 + fq * 8) * 2);
#pragma unroll
        for (int m = 0; m < 4; ++m)
#pragma unroll
          for (int n = 0; n < 4; ++n) acc[m][n] = __builtin_amdgcn_mfma_f32_16x16x32_f16(A[m], B[n], acc[m][n], 0, 0, 0);
      }
#pragma unroll
      for (int m = 0; m < 4; ++m) {
        const int e0 = g * 128 + eh * 64 + m * 16 + fq * 4;
        float4 sc = *(const float4*)(p.pool_scale + e0);
#pragma unroll
        for (int n = 0; n < 4; ++n) {
          f16x4 o;
          o[0] = (f16)(acc[m][n][0] * sc.x); o[1] = (f16)(acc[m][n][1] * sc.y);
          o[2] = (f16)(acc[m][n][2] * sc.z); o[3] = (f16)(acc[m][n][3] * sc.w);
          *(f16x4*)(pa16 + (size_t)(t0 + n * 16 + fr) * DM + e0) = o;
        }
      }
    }
    __syncthreads();
  }
}

#define RW_LD 2064
#define RT_LDS (2 * 36 * RW_LD)
#define RT_GB (RT_LDS + 4608)
template <int V>
__device__ __forceinline__ void p_ln1_route(const Params& p, char* shm) {
  const f16* z16 = (const f16*)(p.ws + OFF_C);
  const float* rc = (const float*)(p.ws + OFF_RC);
  char* dmy = (char*)p.out;
  f16* h1 = (V == 0) ? (f16*)(p.ws + OFF_A) : (f16*)dmy;
  int* route_e = (V == 0) ? (int*)(p.ws + OFF_ROUTE_E) : (int*)(dmy + 68000000);
  float* route_w = (V == 0) ? (float*)(p.ws + OFF_ROUTE_W) : (float*)(dmy + 69000000);
  int* counts = (V == 0) ? (int*)(p.ws + OFF_CNT) : (int*)(dmy + 70000000);
  int* lists = (V == 0) ? (int*)(p.ws + OFF_LISTS) : (int*)(dmy + 71000000);
  int* lcnt = (int*)(shm + RT_LDS);
  int* lent = lcnt + 128;
  const float* sg = (const float*)(shm + RT_GB);
  const float* sbt = sg + 1024;
  const int tid = opaque_tid(), wid = tid >> 6, lane = tid & 63, fr = lane & 15, fq = lane >> 4;
  if (tid < 128) lcnt[tid] = 0;
  {
    const f16* wsrc = (const f16*)(p.ws + OFF_WRT);
#pragma unroll
    for (int i = 0; i < 18; ++i) {
      const int c = wid + 8 * i, row = c >> 1, half = c & 1;
      __builtin_amdgcn_global_load_lds((const unsigned*)(wsrc + (size_t)row * 1024 + half * 512 + lane * 8),
                                       (unsigned*)(shm + row * RW_LD + half * 1024), 16, 0, 0);
    }
    const float* gsrc = (wid < 4) ? (p.ln1_g + wid * 256) : (p.ln1_b + (wid - 4) * 256);
    __builtin_amdgcn_global_load_lds((const unsigned*)(gsrc + lane * 4), (unsigned*)(shm + RT_GB + wid * 1024), 16, 0, 0);
  }
  const int stride = gridDim.x * 8 * 16;
  int t0 = (blockIdx.x * 8 + wid) * 16;
  f16x8 xz[32];
#define P5_LOAD(tt)                                                                  \
  {                                                                                  \
    const f16* zr_ = z16 + (size_t)((tt) + fr) * DM + fq * 8;                        \
    _Pragma("unroll") for (int ks = 0; ks < 32; ++ks) xz[ks] = *(const f16x8*)(zr_ + ks * 32); \
  }
  if (t0 < T_TOK) {
    P5_LOAD(t0);
    __builtin_amdgcn_sched_barrier(0);
    WAIT_V(32);
  } else {
    WAIT_V(0);
  }
  __builtin_amdgcn_sched_barrier(0);
  RAW_SYNC();
  while (t0 < T_TOK) {
    f32x4 acc[3];
#pragma unroll
    for (int mt = 0; mt < 3; ++mt) acc[mt] = (f32x4){0.f, 0.f, 0.f, 0.f};
    const char* wa = shm + fr * RW_LD + fq * 16;
    const char* wa2 = shm + min(32 + fr, 35) * RW_LD + fq * 16;
    float s1 = 0.f, s2 = 0.f;
#pragma unroll
    for (int ks = 0; ks < 32; ++ks) {
#pragma unroll
      for (int mt = 0; mt < 3; ++mt) {
        const char* wp = (mt < 2) ? (wa + mt * 16 * RW_LD) : wa2;
        f16x8 ah = *(const f16x8*)(wp + ks * 64), al = *(const f16x8*)(wp + 36 * RW_LD + ks * 64);
        acc[mt] = __builtin_amdgcn_mfma_f32_16x16x32_f16(ah, xz[ks], acc[mt], 0, 0, 0);
        acc[mt] = __builtin_amdgcn_mfma_f32_16x16x32_f16(al, xz[ks], acc[mt], 0, 0, 0);
      }
#pragma unroll
      for (int e = 0; e < 8; ++e) { float x = (float)xz[ks][e]; s1 += x; s2 = __builtin_fmaf(x, x, s2); }
      __builtin_amdgcn_sched_barrier(0);
    }
    s1 += __shfl_xor(s1, 16, 64); s1 += __shfl_xor(s1, 32, 64);
    s2 += __shfl_xor(s2, 16, 64); s2 += __shfl_xor(s2, 32, 64);
    const float mu = s1 * (1.0f / DM);
    const float rs = rsqrtf(fmaxf(s2 * (1.0f / DM) - mu * mu, 0.f) + 1e-5f);
#pragma unroll
    for (int mt = 0; mt < 3; ++mt) {
      const float4 c1 = *(const float4*)(rc + mt * 16 + fq * 4), c2 = *(const float4*)(rc + 48 + mt * 16 + fq * 4);
      acc[mt][0] = rs * (acc[mt][0] - mu * c1.x) + c2.x;
      acc[mt][1] = rs * (acc[mt][1] - mu * c1.y) + c2.y;
      acc[mt][2] = rs * (acc[mt][2] - mu * c1.z) + c2.z;
      acc[mt][3] = rs * (acc[mt][3] - mu * c1.w) + c2.w;
    }
    float lg[36];
#pragma unroll
    for (int o = 0; o < 36; ++o) lg[o] = __shfl(acc[o >> 4][o & 3], fr + 16 * ((o >> 2) & 3), 64);
    {
      int g = 0;
      float m = lg[0];
#pragma unroll
      for (int o = 1; o < 4; ++o) if (lg[o] > m) { m = lg[o]; g = o; }
      float se = 0.f;
#pragma unroll
      for (int o = 0; o < 4; ++o) se += __expf(lg[o] - m);
      float pg = 1.0f / se;
      float v1 = -3e38f, v2 = -3e38f;
      int i1 = 0, i2 = 0;
#pragma unroll
      for (int jx = 0; jx < 8; ++jx) {
        float x = (g == 0) ? lg[4 + jx] : (g == 1) ? lg[12 + jx] : (g == 2) ? lg[20 + jx] : lg[28 + jx];
        if (x > v1) { v2 = v1; i2 = i1; v1 = x; i1 = jx; }
        else if (x > v2) { v2 = x; i2 = jx; }
      }
      if (fq == 0) {
        const int tt = t0 + fr;
        float e2 = __expf(v2 - v1);
        float w1 = pg / (1.0f + e2), w2 = pg * e2 / (1.0f + e2);
        int ea = g * 8 + i1, eb = g * 8 + i2;
        route_e[2 * tt] = ea; route_e[2 * tt + 1] = eb;
        route_w[2 * tt] = w1; route_w[2 * tt + 1] = w2;
        int la = atomicAdd(&lcnt[ea], 1), lb = atomicAdd(&lcnt[eb], 1);
        int slot = atomicAdd(&lcnt[64], 2);
        if (slot + 1 < 512) {
          lent[2 * slot] = (ea << 16) | la; lent[2 * slot + 1] = 2 * tt;
          lent[2 * slot + 2] = (eb << 16) | lb; lent[2 * slot + 3] = 2 * tt + 1;
        }
      }
    }
    {
      f16* hr = h1 + (size_t)(t0 + fr) * DM + fq * 8;
      const float mrs = -mu * rs;
#pragma unroll
      for (int ks = 0; ks < 32; ++ks) {
        const float4 g0 = *(const float4*)(sg + ks * 32 + fq * 8), g1 = *(const float4*)(sg + ks * 32 + fq * 8 + 4);
        const float4 b0 = *(const float4*)(sbt + ks * 32 + fq * 8), b1 = *(const float4*)(sbt + ks * 32 + fq * 8 + 4);
        i32x4 xi = __builtin_bit_cast(i32x4, xz[ks]);
        asm volatile("" : "+v"(xi));
        const f16x8 xv = __builtin_bit_cast(f16x8, xi);
        f16x8 bh;
        bh[0] = (f16)__builtin_fmaf(__builtin_fmaf((float)xv[0], rs, mrs), g0.x, b0.x);
        bh[1] = (f16)__builtin_fmaf(__builtin_fmaf((float)xv[1], rs, mrs), g0.y, b0.y);
        bh[2] = (f16)__builtin_fmaf(__builtin_fmaf((float)xv[2], rs, mrs), g0.z, b0.z);
        bh[3] = (f16)__builtin_fmaf(__builtin_fmaf((float)xv[3], rs, mrs), g0.w, b0.w);
        bh[4] = (f16)__builtin_fmaf(__builtin_fmaf((float)xv[4], rs, mrs), g1.x, b1.x);
        bh[5] = (f16)__builtin_fmaf(__builtin_fmaf((float)xv[5], rs, mrs), g1.y, b1.y);
        bh[6] = (f16)__builtin_fmaf(__builtin_fmaf((float)xv[6], rs, mrs), g1.z, b1.z);
        bh[7] = (f16)__builtin_fmaf(__builtin_fmaf((float)xv[7], rs, mrs), g1.w, b1.w);
        *(f16x8*)(hr + ks * 32) = bh;
        __builtin_amdgcn_sched_barrier(0);
      }
    }
    t0 += stride;
    if (t0 < T_TOK) P5_LOAD(t0);
  }
#undef P5_LOAD
  __syncthreads();
  if (tid < 32) lcnt[32 + tid] = atomicAdd(&counts[tid * CNT_STRIDE], lcnt[tid]);
  __syncthreads();
  {
    const int n_ent = min(lcnt[64], 512);
    for (int i = tid; i < n_ent; i += 512) {
      int ev = lent[2 * i], id = lent[2 * i + 1];
      int e = ev >> 16, lp = ev & 0xffff;
      lists[(size_t)e * T_TOK + lcnt[32 + e] + lp] = id;
    }
  }
  __syncthreads();
}

__device__ __forceinline__ void p_final(const Params& p) {
  const f16* h1 = (const f16*)(p.ws + OFF_A);
  const f16* y16 = (const f16*)(p.ws + OFF_C);
  const int tid = opaque_tid(), wid = tid >> 6, lane = tid & 63;
  const int nw = gridDim.x * 8;
  int t = blockIdx.x * 8 + wid;
  f16x8 hv[2], y0[2], y1[2];
#define P7_LOAD(tt)                                                                          \
  _Pragma("unroll") for (int i = 0; i < 2; ++i) {                                            \
    hv[i] = *(const f16x8*)(h1 + (size_t)(tt) * DM + i * 512 + lane * 8);                    \
    y0[i] = *(const f16x8*)(y16 + (size_t)(2 * (tt)) * DM + i * 512 + lane * 8);             \
    y1[i] = *(const f16x8*)(y16 + (size_t)(2 * (tt) + 1) * DM + i * 512 + lane * 8);         \
  }
  if (t < T_TOK) { P7_LOAD(t); }
  for (; t < T_TOK; t += nw) {
    float v[16];
#pragma unroll
    for (int i = 0; i < 2; ++i)
#pragma unroll
      for (int e = 0; e < 8; ++e) v[i * 8 + e] = ALPHA * (float)hv[i][e] + ((float)y0[i][e] + (float)y1[i][e]);
    if (t + nw < T_TOK) { P7_LOAD(t + nw); }
    float s = 0.f;
#pragma unroll
    for (int i = 0; i < 16; ++i) s += v[i];
    float mu = wave_sum(s) * (1.0f / DM);
    float q = 0.f;
#pragma unroll
    for (int i = 0; i < 16; ++i) { v[i] -= mu; q += v[i] * v[i]; }
    float rs = rsqrtf(wave_sum(q) * (1.0f / DM) + 1e-5f);
#pragma unroll
    for (int i = 0; i < 2; ++i)
#pragma unroll
      for (int hf = 0; hf < 2; ++hf) {
        const int c = i * 512 + lane * 8 + hf * 4;
        float4 g = *(const float4*)(p.ln2_g + c), b = *(const float4*)(p.ln2_b + c);
        f32x4 o;
        o[0] = v[i * 8 + hf * 4 + 0] * rs * g.x + b.x; o[1] = v[i * 8 + hf * 4 + 1] * rs * g.y + b.y;
        o[2] = v[i * 8 + hf * 4 + 2] * rs * g.z + b.z; o[3] = v[i * 8 + hf * 4 + 3] * rs * g.w + b.w;
        *(f32x4*)(p.out + (size_t)t * DM + c) = o;
      }
  }
#undef P7_LOAD
}

#define MEGA_LDS 161408


#define XB_TMO      128
#define XB_XCNT(j)  (256  + 64 * (j))
#define XB_XSUB(j)  (1280 + 64 * (j))
#define XB_XGEN(j)  (2304 + 64 * (j))
#define XB_TOP      3328
#define XB_TOPGEN   3392
#define XCD_BAR_WORDS 3456
#define XB_SPIN_CAP (1u << 22)
#define LAS __attribute__((address_space(3)))
__device__ __forceinline__ unsigned xb_ld(unsigned* p) { return __hip_atomic_load(p, __ATOMIC_RELAXED, __HIP_MEMORY_SCOPE_AGENT); }
__device__ __forceinline__ unsigned xb_add(unsigned* p, unsigned v) { return __hip_atomic_fetch_add(p, v, __ATOMIC_RELAXED, __HIP_MEMORY_SCOPE_AGENT); }
__device__ __forceinline__ unsigned xb_xcc_id() { return (unsigned)__builtin_amdgcn_s_getreg((3 << 11) | 20) & 0xFu; }
#define XB_SPIN(cond, bar) do { unsigned _sp = 0; while (cond) { __builtin_amdgcn_s_sleep(1); \
    if ((++_sp & 255u) == 0u) { if (xb_ld(&(bar)[XB_TMO])) break; if (_sp > XB_SPIN_CAP) { atomicAdd(&(bar)[XB_TMO], 1u); break; } } } } while (0)
struct XcdBarrier { unsigned* bar; unsigned x; volatile unsigned* st; };
__device__ __forceinline__ XcdBarrier xcd_barrier_post(unsigned* bar, volatile unsigned* st) {
  XcdBarrier b; b.bar = bar; b.x = xb_xcc_id(); b.st = st;
  if (threadIdx.x == 0) (void)xb_add(&bar[XB_XCNT(b.x)], 1u);
  return b;
}
__device__ __forceinline__ void xcd_barrier_complete(unsigned* bar, unsigned x, unsigned& nloc, unsigned& nx) {
  const unsigned G = gridDim.x * gridDim.y * gridDim.z;
  unsigned sum, cnt, mine, sp = 0u;
  for (;;) {
    sum = 0u; cnt = 0u; mine = 0u;
#pragma unroll
    for (unsigned j = 0; j < 16; ++j) { const unsigned c = xb_ld(&bar[XB_XCNT(j)]); sum += c; cnt += (c > 0u) ? 1u : 0u; mine = (j == x) ? c : mine; }
    if (sum == G) break;
    __builtin_amdgcn_s_sleep(1);
    if ((++sp & 255u) == 0u) { if (xb_ld(&bar[XB_TMO])) break; if (sp > XB_SPIN_CAP) { atomicAdd(&bar[XB_TMO], 1u); break; } }
  }
  nloc = mine > 0u ? mine : 1u; nx = cnt > 0u ? cnt : 1u;
}
__device__ __forceinline__ void xcd_barrier(const XcdBarrier& b) {
  asm volatile("s_waitcnt vmcnt(0)" ::: "memory");
  __syncthreads();
  if (threadIdx.x == 0) {
    unsigned* bar = b.bar;
    __builtin_amdgcn_s_waitcnt(0);
    unsigned nloc = b.st[0], nx = b.st[1];
    if (nloc == 0u) { xcd_barrier_complete(bar, b.x, nloc, nx); b.st[0] = nloc; b.st[1] = nx; }
    const unsigned old = xb_add(&bar[XB_XSUB(b.x)], 1u);
    const unsigned gen = old / nloc;
    if (old + 1u == (gen + 1u) * nloc) {
      __builtin_amdgcn_fence(__ATOMIC_RELEASE, "agent");
      asm volatile("s_waitcnt vmcnt(0)" ::: "memory");
      const unsigned og = xb_add(&bar[XB_TOP], 1u);
      const unsigned tg = og / nx;
      if (og + 1u == (tg + 1u) * nx) xb_add(&bar[XB_TOPGEN], 1u);
      else XB_SPIN(xb_ld(&bar[XB_TOPGEN]) == tg, bar);
      __builtin_amdgcn_fence(__ATOMIC_ACQUIRE, "agent");
      xb_add(&bar[XB_XGEN(b.x)], 1u);
      asm volatile("s_waitcnt vmcnt(0)" ::: "memory");
    } else {
      XB_SPIN(xb_ld(&bar[XB_XGEN(b.x)]) == gen, bar);
      __builtin_amdgcn_fence(__ATOMIC_ACQUIRE, "agent");
      asm volatile("s_waitcnt vmcnt(0)" ::: "memory");
    }
  }
  __syncthreads();
}

#ifndef PROBE
#define PROBE 0
#endif
#define GSYNC() do { XcdBarrier xb_; xb_.bar = (unsigned*)(p.ws + OFF_BAR); xb_.x = xb_xcc_id(); xb_.st = (volatile unsigned*)(shm + MEGA_LDS); xcd_barrier(xb_); } while (0)
#define PH(n, code) do { code; if (PROBE == n) { GSYNC(); code; } } while (0)
__global__ __launch_bounds__(512) void mega(Params p) {
  __shared__ __attribute__((aligned(1024))) char shm[MEGA_LDS + 16];
  volatile unsigned* xst = (volatile unsigned*)(shm + MEGA_LDS);
  if (threadIdx.x < 4) xst[threadIdx.x] = 0u;
  __syncthreads();
  (void)xcd_barrier_post((unsigned*)(p.ws + OFF_BAR), xst);
  if (blockIdx.x == 0 && threadIdx.x < 32) ((int*)(p.ws + OFF_CNT))[threadIdx.x * CNT_STRIDE] = 0;
  PH(1, p_ln_in(p));
  PH(2, p_convert(p, shm));
  GSYNC();
  PH(3, p_inproj(p, shm));
  GSYNC();
  PH(4, p_pool(p, shm));
  PH(5, p_index<0>(p, shm));
#if PROBE >= 50 && PROBE < 60
  GSYNC();
  p_index<PROBE - 50>(p, shm);
#endif
  GSYNC();
  PH(7, p_merge(p, shm));
  GSYNC();
  PH(8, p_resid(p, shm));
  GSYNC();
  p_ln1_route<0>(p, shm);
  GSYNC();
#if PROBE == 9
  if (blockIdx.x == 0 && threadIdx.x < 32) ((int*)((char*)p.out + 70000000))[threadIdx.x * CNT_STRIDE] = 0;
  GSYNC();
  p_ln1_route<1>(p, shm);
  GSYNC();
#endif
  PH(10, p_moe_a(p, shm));
  GSYNC();
  PH(11, p_moe_b(p, shm));
  GSYNC();
  PH(12, p_final(p));
}

extern "C" void kernel_launch(void* const* d_in, const int* in_sizes, int n_in, void* d_out, int out_size, void* d_ws,
                              size_t ws_size, hipStream_t stream) {
  if (ws_size < WS_NEEDED) { fprintf(stderr, "ws too small: %zu < %zu\n", ws_size, (size_t)WS_NEEDED); return; }
  static int grid_blocks = 0;
  if (!grid_blocks) {
    int dev = 0, cus = 0, per_cu = 0;
    hipGetDevice(&dev);
    hipDeviceGetAttribute(&cus, hipDeviceAttributeMultiprocessorCount, dev);
    hipOccupancyMaxActiveBlocksPerMultiprocessor(&per_cu, mega, 512, 0);
    if (per_cu > 1) per_cu = 1;
    grid_blocks = cus * per_cu;
    fprintf(stderr, "mega: cus=%d per_cu=%d grid=%d\n", cus, per_cu, grid_blocks);
  }
  Params p{};
  const float** pp = (const float**)&p;
  for (int i = 0; i < 21; ++i) pp[i] = (const float*)d_in[i];
  p.out = (float*)d_out;
  p.ws = (char*)d_ws;
  (void)hipMemsetAsync((char*)d_ws + OFF_BAR, 0, 16384, stream);
  void* args[] = {&p};
  hipError_t e = hipLaunchCooperativeKernel((void*)mega, dim3(grid_blocks), dim3(512), args, 0, stream);
  if (e != hipSuccess) fprintf(stderr, "cooperative launch failed: %s (grid %d)\n", hipGetErrorString(e), grid_blocks);
}
```

```cpp
#include <hip/hip_runtime.h>
#include <hip/hip_fp16.h>
#include <hip/hip_cooperative_groups.h>
#include <stdint.h>
#include <stdio.h>
namespace cg = cooperative_groups;

typedef _Float16 f16;
typedef f16 f16x8 __attribute__((ext_vector_type(8)));
typedef f16 f16x4 __attribute__((ext_vector_type(4)));
typedef f16 f16x2 __attribute__((ext_vector_type(2)));
typedef float f32x4 __attribute__((ext_vector_type(4)));
typedef int i32x4 __attribute__((ext_vector_type(4)));

#define T_TOK 32768
#define DM 1024
#define SEQ 4096
#define PJ_W 1536
#define PA_W 1448
#define IN_W 3496
#define IN_WP 3584
#define C_Q 512
#define C_K 1024
#define C_V 1088
#define C_IQ 1152
#define C_IK 1408
#define C_IW 1440
#define ALPHA 1.189207115002721f
#define NEG_BIG (-1e30f)

#define SZ_A   ((size_t)T_TOK * DM * 2)
#define SZ_B   ((size_t)T_TOK * PJ_W * 2)
#define SZ_C   ((size_t)T_TOK * 2048 * 2)
#define SZ_D   ((size_t)T_TOK * DM * 2)
#define OFF_A  ((size_t)0)
#define OFF_B  (OFF_A + SZ_A)
#define OFF_C  (OFF_B + SZ_B)
#define OFF_D  (OFF_C + SZ_C)
#define OFF_W  (OFF_D + SZ_D)
#define OFF_WIN   (OFF_W)
#define OFF_WPOOL (OFF_WIN + (size_t)IN_WP * 1024 * 2)
#define OFF_WPP   (OFF_WPOOL + (size_t)4 * 128 * 128 * 2)
#define OFF_WPA   (OFF_WPP + (size_t)1024 * 512 * 2)
#define OFF_WOUT  (OFF_WPA + (size_t)1024 * 512 * 2)
#define OFF_WGU   (OFF_WOUT + (size_t)1024 * 1024 * 2)
#define OFF_WDN   (OFF_WGU + (size_t)32 * 512 * 1024 * 2)
#define OFF_MISC  (OFF_WDN + (size_t)32 * 1024 * 256 * 2)
#define OFF_ROUTE_E (OFF_MISC)
#define OFF_ROUTE_W (OFF_ROUTE_E + (size_t)T_TOK * 2 * 4)
#define OFF_COUNTS  (OFF_ROUTE_W + (size_t)T_TOK * 2 * 4)
#define OFF_LISTS   (OFF_COUNTS + 256)
#define OFF_SEL     (OFF_LISTS + (size_t)32 * T_TOK * 4)
#define OFF_CNT      (OFF_SEL + (size_t)T_TOK * 256 * 2)
#define OFF_WRT      (OFF_CNT + 4096)
#define OFF_IKC      (OFF_WRT + 2 * 36 * 1024 * 2)
#define OFF_BAR      (OFF_IKC + (size_t)T_TOK * 32 * 2)
#define OFF_RC       (OFF_BAR + 16384)
#define OFF_KV8      (OFF_RC + 4096)
#define OFF_H18      (OFF_KV8 + (size_t)T_TOK * 128)
#define OFF_STAT     (OFF_H18 + (size_t)T_TOK * 1024)
#define WS_NEEDED   (OFF_STAT + (size_t)T_TOK * 8)
#define CNT_STRIDE 32

struct Params {
  const float *x, *ln_in_g, *ln_in_b, *w_in, *b_gate, *pool_w, *pool_scale, *wpp, *wpa, *w_out, *ln1_g, *ln1_b, *w_group,
      *b_group, *w_router, *b_router, *w_gate, *w_up, *w_down, *ln2_g, *ln2_b;
  float* out;
  char* ws;
};

__device__ __forceinline__ float wave_sum(float v) {
#pragma unroll
  for (int o = 32; o > 0; o >>= 1) v += __shfl_xor(v, o, 64);
  return v;
}
__device__ __forceinline__ float wave_max(float v) {
#pragma unroll
  for (int o = 32; o > 0; o >>= 1) v = fmaxf(v, __shfl_xor(v, o, 64));
  return v;
}
__device__ __forceinline__ int wave_sum_i(int v) {
#pragma unroll
  for (int o = 32; o > 0; o >>= 1) v += __shfl_xor(v, o, 64);
  return v;
}
__device__ __forceinline__ int opaque_tid() { int t = threadIdx.x; asm volatile("" : "+v"(t)); return t; }
__device__ __forceinline__ uint2 pack8_fp8f(const float (&x)[8]) {
  float c[8];
#pragma unroll
  for (int j = 0; j < 8; ++j) c[j] = fminf(fmaxf(x[j], -448.f), 448.f);
  int p0 = __builtin_amdgcn_cvt_pk_fp8_f32(c[0], c[1], 0, false);
  p0 = __builtin_amdgcn_cvt_pk_fp8_f32(c[2], c[3], p0, true);
  int p1 = __builtin_amdgcn_cvt_pk_fp8_f32(c[4], c[5], 0, false);
  p1 = __builtin_amdgcn_cvt_pk_fp8_f32(c[6], c[7], p1, true);
  return make_uint2((unsigned)p0, (unsigned)p1);
}
__device__ __forceinline__ uint2 pack8_fp8(const f16x8& v) {
  float c[8];
#pragma unroll
  for (int j = 0; j < 8; ++j) c[j] = (float)v[j];
  return pack8_fp8f(c);
}
#define ATT_SCALE 64.0f
#define WPA_SCALE 32.0f
#define WO_SCALE 64.0f
#define MG_SCALE 32.0f
#define WIN_SCALE 64.0f
#define WIN_F8_TILE(ft) ((ft) == 2 || (ft) == 3 || (ft) >= 6)
#define WGU_SCALE 64.0f
#define WDN_SCALE 32.0f
__device__ __forceinline__ float ldf(const float* p) { return *p; }
__device__ __forceinline__ float ldf(const f16* p) { return (float)*p; }

#ifndef SKEW_P1
#define SKEW_P1 0
#endif
#define WAIT_V(n) asm volatile("s_waitcnt vmcnt(%0)" ::"n"(n) : "memory")
#define WAIT_L(n) asm volatile("s_waitcnt lgkmcnt(%0)" ::"n"(n) : "memory")
template <class T> __device__ __forceinline__ void st_nt(T* p, const T& v) { *p = v; }
__device__ __forceinline__ float gate_u8(const uint2& g, int e) { const unsigned w = (e < 4) ? g.x : g.y; return (float)((w >> (8 * (e & 3))) & 0xffu); }
#define RAW_SYNC() do { asm volatile("s_waitcnt lgkmcnt(0)" ::: "memory"); __builtin_amdgcn_s_barrier(); asm volatile("" ::: "memory"); } while (0)

__device__ __forceinline__ int lds_byte(int r, int c) {
  int ob = (r & 15) * 64 + c * 2;
  return (r >> 4) * 1024 + (ob ^ (((ob >> 9) & 1) << 5));
}
__device__ __forceinline__ void stage_rc(int b, int& R, int& C) {
  int st = b >> 10, sb = b & 1023, swz = sb ^ (((sb >> 9) & 1) << 5);
  R = st * 16 + swz / 64;
  C = (swz % 64) / 2;
}

#define TILE_B 16384
#define SLOT_B 32768
#define NSTG 2
#define GEMM_LDS 135168
#define G8_LD 272
#define EPI_LD 528

__device__ __forceinline__ void gemm_core(const f16* __restrict__ Ab, const unsigned (&pa)[NSTG], const f16* __restrict__ Bb,
                                          const unsigned (&pb)[NSTG], int nt, f32x4 (&acc)[8][4], char* shm) {
  const int tid = opaque_tid(), wid = tid >> 6, lane = tid & 63, wr = wid >> 2, wc = wid & 3, fr = lane & 15, fq = lane >> 4;
  const int nk = nt * 2;
#define SA(s_) (shm + (s_) * SLOT_B)
#define SB(s_) (shm + (s_) * SLOT_B + TILE_B)
#define GLDS_STAGE(slot, kt)                                                                                              \
  do {                                                                                                                    \
    _Pragma("unroll") for (int i = 0; i < NSTG; ++i) {                                                                   \
      __builtin_amdgcn_global_load_lds((const unsigned*)(Ab + pa[i] + (kt) * 32), (unsigned*)(SA(slot) + wid * 1024 + i * 8192), \
                                       16, 0, 0);                                                                         \
      __builtin_amdgcn_global_load_lds((const unsigned*)(Bb + pb[i] + (kt) * 32), (unsigned*)(SB(slot) + wid * 1024 + i * 8192), \
                                       16, 0, 0);                                                                         \
    }                                                                                                                     \
  } while (0)
  GLDS_STAGE(0, 0);
  GLDS_STAGE(1, 1);
  GLDS_STAGE(2, 2);
  const int aoff = lds_byte(wr * 128 + fr, fq * 8), boff = lds_byte(wc * 64 + fr, fq * 8);
  WAIT_V(8);
  __builtin_amdgcn_s_barrier();
  if (wr == 1) __builtin_amdgcn_s_barrier();
  for (int t = 0; t < nk; ++t) {
    if (t + 3 < nk) { GLDS_STAGE((t + 3) & 3, t + 3); WAIT_V(8); }
    else if (t + 2 < nk) WAIT_V(4);
    else WAIT_V(0);
    const char* sa = SA(t & 3) + aoff;
    const char* sb = SB(t & 3) + boff;
    f16x8 At[8], Bf[4];
#pragma unroll
    for (int n = 0; n < 4; ++n) Bf[n] = *(const f16x8*)(sb + n * 1024);
#pragma unroll
    for (int m = 0; m < 8; ++m) At[m] = *(const f16x8*)(sa + m * 1024);
    WAIT_L(0);
    __builtin_amdgcn_sched_barrier(0);
    __builtin_amdgcn_s_barrier();
    __builtin_amdgcn_sched_barrier(0);
#pragma unroll
    for (int m = 0; m < 8; ++m)
#pragma unroll
      for (int n = 0; n < 4; ++n) acc[m][n] = __builtin_amdgcn_mfma_f32_16x16x32_f16(At[m], Bf[n], acc[m][n], 0, 0, 0);
    __builtin_amdgcn_sched_barrier(0);
    __builtin_amdgcn_s_barrier();
    __builtin_amdgcn_sched_barrier(0);
  }
  if (wr == 0) __builtin_amdgcn_s_barrier();
  RAW_SYNC();
#undef SA
#undef SB
#undef GLDS_STAGE
}

typedef long lx2 __attribute__((ext_vector_type(2)));
__device__ __forceinline__ void gemm_core_f8(const char* __restrict__ Ab, const unsigned (&pa)[NSTG], const char* __restrict__ Bb,
                                             const unsigned (&pb)[NSTG], int nk, f32x4 (&acc)[8][4], char* shm) {
  const int tid = opaque_tid(), wid = tid >> 6, lane = tid & 63, wr = wid >> 2, wc = wid & 3, fr = lane & 15, fq = lane >> 4;
#define SA(s_) (shm + (s_) * SLOT_B)
#define SB(s_) (shm + (s_) * SLOT_B + TILE_B)
#define GLDS_STAGE(slot, kt)                                                                                              \
  do {                                                                                                                    \
    _Pragma("unroll") for (int i = 0; i < NSTG; ++i) {                                                                   \
      __builtin_amdgcn_global_load_lds((const unsigned*)(Ab + pa[i] + (kt) * 64), (unsigned*)(SA(slot) + wid * 1024 + i * 8192), \
                                       16, 0, 0);                                                                         \
      __builtin_amdgcn_global_load_lds((const unsigned*)(Bb + pb[i] + (kt) * 64), (unsigned*)(SB(slot) + wid * 1024 + i * 8192), \
                                       16, 0, 0);                                                                         \
    }                                                                                                                     \
  } while (0)
  GLDS_STAGE(0, 0);
  GLDS_STAGE(1, 1);
  GLDS_STAGE(2, 2);
  const int aoff = lds_byte(wr * 128 + fr, fq * 8), boff = lds_byte(wc * 64 + fr, fq * 8);
  WAIT_V(8);
  __builtin_amdgcn_s_barrier();
  if (wr == 1) __builtin_amdgcn_s_barrier();
  for (int t = 0; t < nk; ++t) {
    if (t + 3 < nk) { GLDS_STAGE((t + 3) & 3, t + 3); WAIT_V(8); }
    else if (t + 2 < nk) WAIT_V(4);
    else WAIT_V(0);
    const char* sa = SA(t & 3) + aoff;
    const char* sb = SB(t & 3) + boff;
    long A0[8], A1[8], B0[4], B1[4];
#pragma unroll
    for (int n = 0; n < 4; ++n) { B0[n] = *(const long*)(sb + n * 1024); B1[n] = *(const long*)(sb + n * 1024 + 8); }
#pragma unroll
    for (int m = 0; m < 8; ++m) { A0[m] = *(const long*)(sa + m * 1024); A1[m] = *(const long*)(sa + m * 1024 + 8); }
    WAIT_L(0);
    __builtin_amdgcn_sched_barrier(0);
    __builtin_amdgcn_s_barrier();
    __builtin_amdgcn_sched_barrier(0);
#pragma unroll
    for (int m = 0; m < 8; ++m)
#pragma unroll
      for (int n = 0; n < 4; ++n) acc[m][n] = __builtin_amdgcn_mfma_f32_16x16x32_fp8_fp8(A0[m], B0[n], acc[m][n], 0, 0, 0);
#pragma unroll
    for (int m = 0; m < 8; ++m)
#pragma unroll
      for (int n = 0; n < 4; ++n) acc[m][n] = __builtin_amdgcn_mfma_f32_16x16x32_fp8_fp8(A1[m], B1[n], acc[m][n], 0, 0, 0);
    __builtin_amdgcn_sched_barrier(0);
    __builtin_amdgcn_s_barrier();
    __builtin_amdgcn_sched_barrier(0);
  }
  if (wr == 0) __builtin_amdgcn_s_barrier();
  RAW_SYNC();
#undef SA
#undef SB
#undef GLDS_STAGE
}

__device__ __forceinline__ void epi_store_f16(const f32x4 (&acc)[8][4], char* shm) {
  const int tid = opaque_tid(), wid = tid >> 6, lane = tid & 63, wr = wid >> 2, wc = wid & 3, fr = lane & 15, fq = lane >> 4;
#pragma unroll
  for (int m = 0; m < 8; ++m)
#pragma unroll
    for (int n = 0; n < 4; ++n) {
      f16x4 v;
      v[0] = (f16)acc[m][n][0]; v[1] = (f16)acc[m][n][1]; v[2] = (f16)acc[m][n][2]; v[3] = (f16)acc[m][n][3];
      *(f16x4*)(shm + (wc * 64 + n * 16 + fr) * EPI_LD + (wr * 128 + m * 16 + fq * 4) * 2) = v;
    }
}

__device__ __forceinline__ void p_ln_in(const Params& p) {
  f16* h16 = (f16*)(p.ws + OFF_A);
  char* h8 = p.ws + OFF_D;
  const int tid = opaque_tid(), lane = tid & 63, wid = tid >> 6;
  const int nw = gridDim.x * 8;
  for (int t = blockIdx.x * 8 + wid; t < T_TOK; t += nw) {
    const float* xr = p.x + (size_t)t * DM;
    float4 v[4];
#pragma unroll
    for (int i = 0; i < 4; ++i) v[i] = *(const float4*)(xr + i * 256 + lane * 4);
    float s = 0.f;
#pragma unroll
    for (int i = 0; i < 4; ++i) s += v[i].x + v[i].y + v[i].z + v[i].w;
    float mu = wave_sum(s) * (1.0f / DM);
    float q = 0.f;
#pragma unroll
    for (int i = 0; i < 4; ++i) {
      v[i].x -= mu; v[i].y -= mu; v[i].z -= mu; v[i].w -= mu;
      q += v[i].x * v[i].x + v[i].y * v[i].y + v[i].z * v[i].z + v[i].w * v[i].w;
    }
    float rs = rsqrtf(wave_sum(q) * (1.0f / DM) + 1e-5f);
#pragma unroll
    for (int i = 0; i < 4; ++i) {
      float4 g = *(const float4*)(p.ln_in_g + i * 256 + lane * 4), b = *(const float4*)(p.ln_in_b + i * 256 + lane * 4);
      f16x4 o;
      o[0] = (f16)(v[i].x * rs * g.x + b.x); o[1] = (f16)(v[i].y * rs * g.y + b.y);
      o[2] = (f16)(v[i].z * rs * g.z + b.z); o[3] = (f16)(v[i].w * rs * g.w + b.w);
      *(f16x4*)(h16 + (size_t)t * DM + i * 256 + lane * 4) = o;
      {
        int pk = __builtin_amdgcn_cvt_pk_fp8_f32((float)o[0], (float)o[1], 0, false);
        pk = __builtin_amdgcn_cvt_pk_fp8_f32((float)o[2], (float)o[3], pk, true);
        *(int*)(h8 + (size_t)t * DM + i * 256 + lane * 4) = pk;
      }
    }
  }
}

template <bool FRAG = false, class RowMap>
__device__ __forceinline__ void conv_tile(const float* __restrict__ src, int ld_src, int nvalid, int k0, int n0, f16* __restrict__ dst,
                                          int ld_dst, RowMap rm, float* sT) {
  const int tid = opaque_tid();
  {
    int k = tid >> 3, n = (tid & 7) * 8;
    const float* sp = src + (size_t)(k0 + k) * ld_src + n0 + n;
#pragma unroll
    for (int j = 0; j < 8; ++j) sT[k * 65 + n + j] = (n0 + n + j < nvalid) ? sp[j] : 0.f;
  }
  __syncthreads();
  {
    int n = tid >> 3, k = (tid & 7) * 8;
    f16x8 o;
#pragma unroll
    for (int j = 0; j < 8; ++j) o[j] = (f16)sT[(k + j) * 65 + n];
    int drow = rm(n0 + n);
    if (FRAG) {
      const int kk = k0 + k;
      *(f16x8*)(dst + (size_t)((drow >> 4) * (ld_dst >> 5) + (kk >> 5)) * 512 + ((((kk >> 3) & 3) * 16) + (drow & 15)) * 8) = o;
    } else if (drow >= 0) *(f16x8*)(dst + (size_t)drow * ld_dst + k0 + k) = o;
  }
  __syncthreads();
}

template <class RowMap>
__device__ __forceinline__ void conv_tile8(const float* __restrict__ src, int ld_src, int k0, int n0, char* __restrict__ dst8, int ld_dst,
                                           RowMap rm, float scale, float* sT, int nvalid = (1 << 30)) {
  const int tid = opaque_tid();
  {
    int k = tid >> 3, n = (tid & 7) * 8;
    const float* sp = src + (size_t)(k0 + k) * ld_src + n0 + n;
#pragma unroll
    for (int j = 0; j < 8; ++j) sT[k * 65 + n + j] = (n0 + n + j < nvalid) ? sp[j] : 0.f;
  }
  __syncthreads();
  {
    int n = tid >> 3, k = (tid & 7) * 8;
    float c[8];
#pragma unroll
    for (int j = 0; j < 8; ++j) c[j] = sT[(k + j) * 65 + n] * scale;
    const int drow = rm(n0 + n);
    *(uint2*)(dst8 + (size_t)drow * ld_dst + k0 + k) = pack8_fp8f(c);
  }
  __syncthreads();
}

struct RowId { __device__ int operator()(int n) const { return n; } };
struct RowGU { int up; __device__ int operator()(int ff) const {
  int tile = ff >> 7, wr = (ff >> 6) & 1, l = ff & 63; return tile * 256 + wr * 128 + up * 64 + l; } };

__device__ __forceinline__ void p_convert(const Params& p, char* shm) {
  float* sT = (float*)shm;
  char* ws = p.ws;
  const int J0 = 16 * 56, J1 = J0 + 16, J2 = J1 + 128, J3 = J2 + 128, J4 = J3 + 256, J5 = J4 + 32 * 64, J6 = J5 + 32 * 64,
            J7 = J6 + 32 * 64;
  for (int job = blockIdx.x; job < J7; job += gridDim.x) {
    if (job < J0) {
      int kt = job / 56, nt = job % 56;
      if (WIN_F8_TILE(nt >> 2)) conv_tile8(p.w_in, IN_W, kt * 64, nt * 64, ws + OFF_WIN, 2048, RowId(), WIN_SCALE, sT, IN_W);
      else conv_tile(p.w_in, IN_W, IN_W, kt * 64, nt * 64, (f16*)(ws + OFF_WIN), 1024, RowId(), sT);
    } else if (job < J1) {
      int j = job - J0, g = j >> 2, kt = (j >> 1) & 1, nt = j & 1;
      conv_tile<true>(p.pool_w + g * 128 * 128, 128, 128, kt * 64, nt * 64, (f16*)(ws + OFF_WPOOL) + g * 128 * 128, 128, RowId(), sT);
    } else if (job < J2) {
      int j = job - J1, kt = j >> 4, nt = j & 15;
      conv_tile(p.wpp, 1024, 1024, kt * 64, nt * 64, (f16*)(ws + OFF_WPP), 512, RowId(), sT);
    } else if (job < J3) {
      int j = job - J2, kt = j >> 4, nt = j & 15;
      conv_tile8(p.wpa, 1024, kt * 64, nt * 64, ws + OFF_WPA, 512, RowId(), WPA_SCALE, sT);
    } else if (job < J4) {
      int j = job - J3, kt = j >> 4, nt = j & 15;
      conv_tile8(p.w_out, 1024, kt * 64, nt * 64, ws + OFF_WOUT, 1024, RowId(), WO_SCALE, sT);
    } else if (job < J6) {
      int up = job >= J5;
      int j = job - (up ? J5 : J4), e = j >> 6, kt = (j >> 2) & 15, nt = j & 3;
      RowGU rm; rm.up = up;
      conv_tile8((up ? p.w_up : p.w_gate) + (size_t)e * 1024 * 256, 256, kt * 64, nt * 64,
                 ws + OFF_WGU + (size_t)e * 512 * 1024, 1024, rm, WGU_SCALE, sT);
    } else {
      int j = job - J6, e = j >> 6, kt = (j >> 4) & 3, nt = j & 15;
      conv_tile8(p.w_down + (size_t)e * 256 * 1024, 1024, kt * 64, nt * 64, ws + OFF_WDN + (size_t)e * 1024 * 256, 256, RowId(), WDN_SCALE, sT);
    }
  }
  {
    f16* whi = (f16*)(ws + OFF_WRT);
    f16* wlo = whi + 36 * 1024;
    for (int i = blockIdx.x * 512 + threadIdx.x; i < 36 * 1024; i += gridDim.x * 512) {
      int o = i >> 10, k = i & 1023;
      float w = ((o < 4) ? p.w_group[k * 4 + o] : p.w_router[k * 32 + (o - 4)]) * p.ln1_g[k];
      f16 h = (f16)w;
      whi[i] = h;
      wlo[i] = (f16)(w - (float)h);
    }
  }
  if (blockIdx.x < 48) {
    float* rc = (float*)(ws + OFF_RC);
    const int o = blockIdx.x, tid = threadIdx.x;
    float a = 0.f, b = 0.f;
    if (o < 36) {
      for (int k = tid; k < 1024; k += 512) {
        float w0 = (o < 4) ? p.w_group[k * 4 + o] : p.w_router[k * 32 + (o - 4)];
        float w = w0 * p.ln1_g[k];
        f16 h = (f16)w, l = (f16)(w - (float)h);
        a += (float)h + (float)l;
        b += w0 * p.ln1_b[k];
      }
    }
    a = wave_sum(a);
    b = wave_sum(b);
    if ((tid & 63) == 0) { sT[tid >> 6] = a; sT[8 + (tid >> 6)] = b; }
    __syncthreads();
    if (tid == 0) {
      float sa = 0.f, sb = 0.f;
      for (int w = 0; w < 8; ++w) { sa += sT[w]; sb += sT[8 + w]; }
      float bias = (o < 4) ? p.b_group[o] : ((o < 36) ? p.b_router[o - 4] : 0.f);
      rc[o] = sa;
      rc[48 + o] = sb + bias;
    }
    __syncthreads();
  }
}

__device__ __forceinline__ void phase_skew(int us4) {
  const int k = (blockIdx.x >> 3) & 3;
  if (k) {
    const unsigned long long t0 = __builtin_amdgcn_s_memrealtime();
    const unsigned long long dt = (unsigned long long)(k * us4 * 25);
    while (__builtin_amdgcn_s_memrealtime() - t0 < dt) __builtin_amdgcn_s_sleep(8);
  }
}

__device__ __forceinline__ int xcd_item(int n_items, int r) {
  const int nx = 8, slots = gridDim.x >> 3;
  const int xcd = blockIdx.x & 7, slot = blockIdx.x >> 3;
  const int per = (n_items + nx - 1) / nx;
  const int local = slot + r * slots;
  if (local >= per) return -1;
  const int item = xcd * per + local;
  return (item < n_items) ? item : -2;
}

__device__ __forceinline__ void p_inproj(const Params& p, char* shm) {
  const f16* h16 = (const f16*)(p.ws + OFF_A);
  const f16* wT = (const f16*)(p.ws + OFF_WIN);
  f16* proj16 = (f16*)(p.ws + OFF_B);
  f16* gate16 = (f16*)(p.ws + OFF_C);
  f16* ikc = (f16*)(p.ws + OFF_IKC);
  char* kv8 = p.ws + OFF_KV8;
  const int tid = opaque_tid(), wid = tid >> 6, lane = tid & 63;
  int sR[NSTG], sC[NSTG];
#pragma unroll
  for (int i = 0; i < NSTG; ++i) stage_rc(wid * 1024 + i * 8192 + lane * 16, sR[i], sC[i]);
  const int NTILES = 128 * 14;
  if (SKEW_P1) phase_skew(SKEW_P1);
  for (int r = 0;; ++r) {
    int tile = xcd_item(NTILES, r);
    if (tile == -1) break;
    if (tile < 0) continue;
    int grp = tile / 56, rem = tile % 56;
    int ft = rem >> 2, tt = grp * 4 + (rem & 3);
    unsigned pa[NSTG], pb[NSTG];
    f32x4 acc[8][4];
#pragma unroll
    for (int m = 0; m < 8; ++m)
#pragma unroll
      for (int n = 0; n < 4; ++n) acc[m][n] = (f32x4){0.f, 0.f, 0.f, 0.f};
    if (WIN_F8_TILE(ft)) {
#pragma unroll
      for (int i = 0; i < NSTG; ++i) {
        pa[i] = (unsigned)((ft * 256 + sR[i]) * 2048 + sC[i] * 2);
        pb[i] = (unsigned)((tt * 256 + sR[i]) * 1024 + sC[i] * 2);
      }
      gemm_core_f8((const char*)wT, pa, p.ws + OFF_D, pb, 16, acc, shm);
      if (ft < 6) {
#pragma unroll
        for (int m = 0; m < 8; ++m)
#pragma unroll
          for (int n = 0; n < 4; ++n) acc[m][n] *= (1.0f / WIN_SCALE);
      }
    } else {
#pragma unroll
      for (int i = 0; i < NSTG; ++i) {
        pa[i] = (unsigned)((ft * 256 + sR[i]) * 1024 + sC[i]);
        pb[i] = (unsigned)((tt * 256 + sR[i]) * 1024 + sC[i]);
      }
      gemm_core(wT, pa, h16, pb, 16, acc, shm);
    }
    if (ft >= 6) {
      const int t2 = opaque_tid(), wid2 = t2 >> 6, lane2 = t2 & 63, wr2 = wid2 >> 2, wc2 = wid2 & 3, fr2 = lane2 & 15, fq2 = lane2 >> 4;
#pragma unroll
      for (int m = 0; m < 8; ++m) {
        const int fcol = ft * 256 + wr2 * 128 + m * 16 + fq2 * 4;
        float4 b4 = {0.f, 0.f, 0.f, 0.f};
        if (fcol < IN_W) b4 = *(const float4*)(p.b_gate + (fcol - PA_W));
        const float bq[4] = {-1.4426950408889634f * b4.x, -1.4426950408889634f * b4.y, -1.4426950408889634f * b4.z, -1.4426950408889634f * b4.w};
#pragma unroll
        for (int n = 0; n < 4; ++n) {
          unsigned pk = 0u;
#pragma unroll
          for (int j = 0; j < 4; ++j) {
            const float e_ = __builtin_amdgcn_exp2f(__builtin_fmaf(acc[m][n][j], -1.4426950408889634f / WIN_SCALE, bq[j]));
            pk = __builtin_amdgcn_cvt_pk_u8_f32(__builtin_amdgcn_rcpf(__builtin_fmaf(e_, 1.0f / 255.0f, 1.0f / 255.0f)), j, pk);
          }
          *(unsigned*)(shm + (wc2 * 64 + n * 16 + fr2) * G8_LD + (wr2 * 128 + m * 16 + fq2 * 4)) = pk;
        }
      }
      RAW_SYNC();
      {
        const int ch = t2 & 31, r0 = t2 >> 5;
        const int f0 = ft * 256 + ch * 8;
        if (f0 < IN_W) {
#pragma unroll 4
          for (int ps = 0; ps < 16; ++ps) {
            const int r_ = ps * 16 + r0;
            const uint2 v = *(const uint2*)(shm + r_ * G8_LD + ch * 8);
            *(uint2*)((char*)gate16 + ((size_t)tt * 256 + r_) * 2048 + (f0 - PA_W)) = v;
          }
        }
      }
      RAW_SYNC();
      continue;
    }
    epi_store_f16(acc, shm);
    RAW_SYNC();
    {
      int ch = tid & 31, r0 = tid >> 5;
      int f0 = ft * 256 + ch * 8;
      float bg[8];
      const float gsc = (ft >= 6) ? (-1.4426950408889634f / WIN_SCALE) : -1.4426950408889634f;
      if (f0 >= PA_W && f0 < IN_W) {
#pragma unroll
        for (int j = 0; j < 8; ++j) bg[j] = -1.4426950408889634f * p.b_gate[f0 - PA_W + j];
      } else {
#pragma unroll
        for (int j = 0; j < 8; ++j) bg[j] = 0.f;
      }
#pragma unroll 4
      for (int ps = 0; ps < 16; ++ps) {
        int r = ps * 16 + r0;
        f16x8 v = *(const f16x8*)(shm + r * EPI_LD + ch * 16);
        size_t tok = (size_t)tt * 256 + r;
        if (f0 < PA_W) {
          st_nt((f16x8*)(proj16 + tok * PJ_W + f0), v);
          if (f0 >= C_IK && f0 < C_IW) {
            const size_t kt_ = tok >> 4;
            const int fr_ = (int)(tok & 15), fq_ = (f0 - C_IK) >> 3;
            *(f16x8*)(ikc + kt_ * 512 + (fq_ * 16 + fr_) * 8) = v;
          }
          if (f0 >= C_K && f0 < C_IQ) {
            float c[8];
#pragma unroll
            for (int j = 0; j < 8; ++j) c[j] = fminf(fmaxf((float)v[j], -448.f), 448.f);
            int p0 = __builtin_amdgcn_cvt_pk_fp8_f32(c[0], c[1], 0, false);
            p0 = __builtin_amdgcn_cvt_pk_fp8_f32(c[2], c[3], p0, true);
            int p1 = __builtin_amdgcn_cvt_pk_fp8_f32(c[4], c[5], 0, false);
            p1 = __builtin_amdgcn_cvt_pk_fp8_f32(c[6], c[7], p1, true);
            *(uint2*)(kv8 + tok * 128 + (f0 - C_K)) = make_uint2((unsigned)p0, (unsigned)p1);
          }
        } else if (f0 < IN_W) {
          unsigned q0 = 0u, q1 = 0u;
#pragma unroll
          for (int j = 0; j < 8; ++j) {
            const float e_ = __builtin_amdgcn_exp2f(__builtin_fmaf((float)v[j], gsc, bg[j]));
            const float g = __builtin_amdgcn_rcpf(__builtin_fmaf(e_, 1.0f / 255.0f, 1.0f / 255.0f));
            if (j < 4) q0 = __builtin_amdgcn_cvt_pk_u8_f32(g, j, q0); else q1 = __builtin_amdgcn_cvt_pk_u8_f32(g, j - 4, q1);
          }
          *(uint2*)((char*)gate16 + tok * 2048 + (f0 - PA_W)) = make_uint2(q0, q1);
        }
      }
    }
    RAW_SYNC();
  }
}


__device__ __forceinline__ void zero_acc(f32x4 (&acc)[8][4]) {
#pragma unroll
  for (int m = 0; m < 8; ++m)
#pragma unroll
    for (int n = 0; n < 4; ++n) acc[m][n] = (f32x4){0.f, 0.f, 0.f, 0.f};
}

template <class RowPtr>
__device__ __forceinline__ void epi_rows_out(char* shm, RowPtr rp) {
  const int tid = opaque_tid(), ch = tid & 31, r0 = tid >> 5;
#pragma unroll 4
  for (int ps = 0; ps < 16; ++ps) {
    int r = ps * 16 + r0;
    f16x8 v = *(const f16x8*)(shm + r * EPI_LD + ch * 16);
    f16* d = rp(r);
    if (d) st_nt((f16x8*)(d + ch * 8), v);
  }
}

__device__ __forceinline__ void p_merge(const Params& p, char* shm) {
  const f16* pa16 = (const f16*)(p.ws + OFF_D);
  const f16* gate16 = (const f16*)(p.ws + OFF_C);
  const f16* wpp = (const f16*)(p.ws + OFF_WPP);
  const f16* wpa = (const f16*)(p.ws + OFF_WPA);
  f16* merged16 = (f16*)(p.ws + OFF_B);
  for (int r = 0;; ++r) {
    int tile = xcd_item(512, r);
    if (tile == -1) break;
    if (tile < 0) continue;
    int ft = tile & 3, tt = tile >> 2;
    unsigned pa[NSTG], pb[NSTG];
    {
      const int tid0 = opaque_tid(), wid0 = tid0 >> 6, lane0 = tid0 & 63;
#pragma unroll
      for (int i = 0; i < NSTG; ++i) {
        int r_, c_;
        stage_rc(wid0 * 1024 + i * 8192 + lane0 * 16, r_, c_);
        pa[i] = (unsigned)((ft * 256 + r_) * 512 + c_);
        pb[i] = (unsigned)((tt * 256 + r_) * 1024 + c_);
      }
    }
    f32x4 acc[8][4];
    zero_acc(acc);
    gemm_core(wpp, pa, pa16, pb, 8, acc, shm);
    const int tid = opaque_tid(), ch = tid & 15, r0 = tid >> 4;
    const unsigned gofs = (unsigned)(((tt * 256 + r0) * 2048) + ft * 256 + ch * 16);
    const char* gb = (const char*)gate16;
    uint4 G0[2], G1[2];
    epi_store_f16(acc, shm);
    __builtin_amdgcn_sched_barrier(0);
#pragma unroll
    for (int u = 0; u < 2; ++u) { G0[u] = *(const uint4*)(gb + (gofs + (unsigned)(u * 32 * 2048))); G1[u] = *(const uint4*)(gb + (gofs + (unsigned)(u * 32 * 2048 + 1024))); }
    RAW_SYNC();
#pragma unroll
    for (int bt = 0; bt < 4; ++bt) {
      uint4 N0[2], N1[2];
      if (bt < 3) {
#pragma unroll
        for (int u = 0; u < 2; ++u) {
          N0[u] = *(const uint4*)(gb + (gofs + (unsigned)(((bt + 1) * 2 + u) * 32 * 2048)));
          N1[u] = *(const uint4*)(gb + (gofs + (unsigned)(((bt + 1) * 2 + u) * 32 * 2048 + 1024)));
        }
      }
#pragma unroll
      for (int u = 0; u < 2; ++u) {
        const int rr = (bt * 2 + u) * 32 + r0;
#pragma unroll
        for (int hv = 0; hv < 2; ++hv) {
          const uint2 g0 = hv ? make_uint2(G0[u].z, G0[u].w) : make_uint2(G0[u].x, G0[u].y);
          const uint2 g1 = hv ? make_uint2(G1[u].z, G1[u].w) : make_uint2(G1[u].x, G1[u].y);
          f16x8 v = *(const f16x8*)(shm + rr * EPI_LD + ch * 32 + hv * 16);
          f16x8 rqh, lo8, hi8;
#pragma unroll
          for (int e = 0; e < 8; ++e) {
            rqh[e] = (f16)(gate_u8(g0, e) * __builtin_amdgcn_rcpf(fmaxf(gate_u8(g1, e), 1.0f)));
            lo8[e] = (f16)-60000.f; hi8[e] = (f16)60000.f;
          }
          const f16x8 o = __builtin_elementwise_min(__builtin_elementwise_max(v * rqh, lo8), hi8);
          *(f16x8*)(shm + rr * EPI_LD + ch * 32 + hv * 16) = o;
        }
      }
      if (bt < 3) {
#pragma unroll
        for (int u = 0; u < 2; ++u) { G0[u] = N0[u]; G1[u] = N1[u]; }
      }
    }
    RAW_SYNC();
    {
      const int wid_ = tid >> 6, lane_ = tid & 63, wr = wid_ >> 2, wc = wid_ & 3, fr = lane_ & 15, fq = lane_ >> 4;
#pragma unroll
      for (int m = 0; m < 8; ++m)
#pragma unroll
        for (int n = 0; n < 4; ++n) {
          f16x4 c = *(const f16x4*)(shm + (wc * 64 + n * 16 + fr) * EPI_LD + (wr * 128 + m * 16 + fq * 4) * 2);
          acc[m][n] = (f32x4){(float)c[0], (float)c[1], (float)c[2], (float)c[3]} * (ATT_SCALE * WPA_SCALE);
        }
    }
    RAW_SYNC();
    {
      const int tid8 = opaque_tid(), wid8 = tid8 >> 6, lane8 = tid8 & 63;
      unsigned pa8[NSTG], pb8[NSTG];
#pragma unroll
      for (int i = 0; i < NSTG; ++i) {
        int r8, c8;
        stage_rc(wid8 * 1024 + i * 8192 + lane8 * 16, r8, c8);
        pa8[i] = (unsigned)((ft * 256 + r8) * 512 + c8 * 2);
        pb8[i] = (unsigned)((tt * 256 + r8) * 2048 + 1024 + c8 * 2);
      }
      gemm_core_f8((const char*)wpa, pa8, (const char*)pa16, pb8, 8, acc, shm);
#pragma unroll
      for (int m = 0; m < 8; ++m)
#pragma unroll
        for (int n = 0; n < 4; ++n) acc[m][n] *= (MG_SCALE / (255.0f * ATT_SCALE * WPA_SCALE));
    }
    epi_store_f16(acc, shm);
    __builtin_amdgcn_sched_barrier(0);
    const int tid9 = opaque_tid(), ch9 = tid9 & 31, r09 = tid9 >> 5;
    const unsigned gofs9 = (unsigned)(((tt * 256 + r09) * 2048) + ft * 256 + ch9 * 8);
    const unsigned mofs9 = (unsigned)(((tt * 256 + r09) * 1024) + ft * 256 + ch9 * 8);
    uint2 H1[4];
#pragma unroll
    for (int u = 0; u < 4; ++u) H1[u] = *(const uint2*)(gb + (gofs9 + (unsigned)(u * 16 * 2048 + 1024)));
    RAW_SYNC();
#pragma unroll
    for (int bt = 0; bt < 4; ++bt) {
      uint2 N1[4];
      if (bt < 3) {
#pragma unroll
        for (int u = 0; u < 4; ++u) N1[u] = *(const uint2*)(gb + (gofs9 + (unsigned)(((bt + 1) * 4 + u) * 16 * 2048 + 1024)));
      }
#pragma unroll
      for (int u = 0; u < 4; ++u) {
        const int rr = (bt * 4 + u) * 16 + r09;
        f16x8 v = *(const f16x8*)(shm + rr * EPI_LD + ch9 * 16);
        float o[8];
#pragma unroll
        for (int e = 0; e < 8; ++e) o[e] = (float)v[e] * gate_u8(H1[u], e);
        *(uint2*)((char*)merged16 + (mofs9 + (unsigned)((bt * 4 + u) * 16 * 1024))) = pack8_fp8f(o);
      }
      if (bt < 3) {
#pragma unroll
        for (int u = 0; u < 4; ++u) H1[u] = N1[u];
      }
    }
    RAW_SYNC();
  }
}

__device__ __forceinline__ void p_resid(const Params& p, char* shm) {
  const f16* merged16 = (const f16*)(p.ws + OFF_B);
  const f16* h16 = (const f16*)(p.ws + OFF_A);
  const f16* wo = (const f16*)(p.ws + OFF_WOUT);
  f16* z16 = (f16*)(p.ws + OFF_C);
  const int tid = opaque_tid(), wid = tid >> 6, lane = tid & 63;
  int sR[NSTG], sC[NSTG];
#pragma unroll
  for (int i = 0; i < NSTG; ++i) stage_rc(wid * 1024 + i * 8192 + lane * 16, sR[i], sC[i]);
  const int ch = tid & 31, r0 = tid >> 5;
  for (int r = 0;; ++r) {
    int tile = xcd_item(512, r);
    if (tile == -1) break;
    if (tile < 0) continue;
    int ft = tile & 3, tt = tile >> 2;
    unsigned pa[NSTG], pb[NSTG];
#pragma unroll
    for (int i = 0; i < NSTG; ++i) {
      pa[i] = (unsigned)((ft * 256 + sR[i]) * 1024 + sC[i] * 2);
      pb[i] = (unsigned)((tt * 256 + sR[i]) * 1024 + sC[i] * 2);
    }
    {
      f32x4 acc[8][4];
      zero_acc(acc);
      gemm_core_f8((const char*)wo, pa, (const char*)merged16, pb, 16, acc, shm);
#pragma unroll
      for (int m = 0; m < 8; ++m)
#pragma unroll
        for (int n = 0; n < 4; ++n) acc[m][n] *= (1.0f / (WO_SCALE * MG_SCALE));
      epi_store_f16(acc, shm);
    }
    const unsigned oofs = (unsigned)((((tt * 256 + r0) * 1024) + ft * 256 + ch * 8) * 2);
    f16x8 H[16];
    f16x8 al8;
#pragma unroll
    for (int e = 0; e < 8; ++e) al8[e] = (f16)ALPHA;
    __builtin_amdgcn_sched_barrier(0);
#pragma unroll
    for (int u = 0; u < 16; ++u) H[u] = *(const f16x8*)((const char*)h16 + (oofs + (unsigned)(u * 16 * 2048)));
    RAW_SYNC();
#pragma unroll
    for (int u = 0; u < 16; ++u) {
      const int rr = u * 16 + r0;
      f16x8 v = *(const f16x8*)(shm + rr * EPI_LD + ch * 16);
      const f16x8 zz = __builtin_elementwise_fma(H[u], al8, v);
      *(f16x8*)((char*)z16 + (oofs + (unsigned)(u * 16 * 2048))) = zz;
    }
    RAW_SYNC();
  }
}

#define HID_ROWS 73728
#define HID_LD 272
#define MOE_TAB (GEMM_LDS + 2048)
__device__ __forceinline__ void moe_tables(const int* counts, char* shm) {
  int* tab = (int*)(shm + MOE_TAB);
  if (threadIdx.x == 0) {
    int pf = 0, pn = 0, pr = 0;
    for (int e = 0; e < 32; ++e) {
      int n = counts[e * CNT_STRIDE];
      tab[e] = pf; tab[33 + e] = pn; tab[66 + e] = pr;
      pf += min(8, (n + 255) >> 8);
      pn += (max(n - 2048, 0) + 63) >> 6;
      pr += ((n + 255) >> 8) << 8;
    }
    tab[32] = pf; tab[65] = pn; tab[98] = pr;
  }
  __syncthreads();
}
__device__ __forceinline__ void moe_find(const int* pre, int item, int& e, int& mt) {
  e = 0;
  for (int i = 1; i < 32; ++i) if (item >= pre[i]) e = i;
  mt = item - pre[e];
}

#define NSLOT_B 20480
__device__ __forceinline__ void gemm_core_narrow(const f16* __restrict__ Ab, const unsigned (&pa)[NSTG], const f16* __restrict__ Bb,
                                                 unsigned pb, int nt, const int (&ablk)[2], f32x4 (&acc)[2][4], char* shm) {
  const int tid = opaque_tid(), wid = tid >> 6, lane = tid & 63, fr = lane & 15, fq = lane >> 4;
  const int nk = nt * 2;
  const bool hasb = (wid < 4);
#define SA(s_) (shm + (s_) * NSLOT_B)
#define SB(s_) (shm + (s_) * NSLOT_B + TILE_B)
#define NSTAGE(slot, kt)                                                                                                  \
  do {                                                                                                                    \
    _Pragma("unroll") for (int i = 0; i < NSTG; ++i)                                                                     \
      __builtin_amdgcn_global_load_lds((const unsigned*)(Ab + pa[i] + (kt) * 32), (unsigned*)(SA(slot) + wid * 1024 + i * 8192), \
                                       16, 0, 0);                                                                         \
    if (hasb) __builtin_amdgcn_global_load_lds((const unsigned*)(Bb + pb + (kt) * 32), (unsigned*)(SB(slot) + wid * 1024), 16, 0, 0); \
  } while (0)
  NSTAGE(0, 0);
  NSTAGE(1, 1);
  NSTAGE(2, 2);
  const int a0 = lds_byte(ablk[0] * 16 + fr, fq * 8), a1 = lds_byte(ablk[1] * 16 + fr, fq * 8), boff = lds_byte(fr, fq * 8);
  for (int t = 0; t < nk; ++t) {
    if (hasb) { if (t + 2 < nk) WAIT_V(6); else if (t + 1 < nk) WAIT_V(3); else WAIT_V(0); }
    else      { if (t + 2 < nk) WAIT_V(4); else if (t + 1 < nk) WAIT_V(2); else WAIT_V(0); }
    __builtin_amdgcn_s_barrier();
    if (t + 3 < nk) NSTAGE((t + 3) & 3, t + 3);
    const char* sa = SA(t & 3);
    const char* sb = SB(t & 3) + boff;
    f16x8 A0 = *(const f16x8*)(sa + a0), A1 = *(const f16x8*)(sa + a1), Bf[4];
#pragma unroll
    for (int n = 0; n < 4; ++n) Bf[n] = *(const f16x8*)(sb + n * 1024);
#pragma unroll
    for (int n = 0; n < 4; ++n) acc[0][n] = __builtin_amdgcn_mfma_f32_16x16x32_f16(A0, Bf[n], acc[0][n], 0, 0, 0);
#pragma unroll
    for (int n = 0; n < 4; ++n) acc[1][n] = __builtin_amdgcn_mfma_f32_16x16x32_f16(A1, Bf[n], acc[1][n], 0, 0, 0);
    WAIT_L(0);
  }
  RAW_SYNC();
#undef SA
#undef SB
#undef NSTAGE
}

__device__ __forceinline__ void gemm_core_narrow_f8(const char* __restrict__ Ab, const unsigned (&pa)[NSTG], const char* __restrict__ Bb,
                                                    unsigned pb, int nk, const int (&ablk)[2], f32x4 (&acc)[2][4], char* shm) {
  const int tid = opaque_tid(), wid = tid >> 6, lane = tid & 63, fr = lane & 15, fq = lane >> 4;
  const bool hasb = (wid < 4);
#define SA(s_) (shm + (s_) * NSLOT_B)
#define SB(s_) (shm + (s_) * NSLOT_B + TILE_B)
#define NSTAGE(slot, kt)                                                                                                  \
  do {                                                                                                                    \
    _Pragma("unroll") for (int i = 0; i < NSTG; ++i)                                                                     \
      __builtin_amdgcn_global_load_lds((const unsigned*)(Ab + pa[i] + (kt) * 64), (unsigned*)(SA(slot) + wid * 1024 + i * 8192), \
                                       16, 0, 0);                                                                         \
    if (hasb) __builtin_amdgcn_global_load_lds((const unsigned*)(Bb + pb + (kt) * 64), (unsigned*)(SB(slot) + wid * 1024), 16, 0, 0); \
  } while (0)
  NSTAGE(0, 0);
  NSTAGE(1, 1);
  NSTAGE(2, 2);
  const int a0 = lds_byte(ablk[0] * 16 + fr, fq * 8), a1 = lds_byte(ablk[1] * 16 + fr, fq * 8), boff = lds_byte(fr, fq * 8);
  for (int t = 0; t < nk; ++t) {
    if (hasb) { if (t + 2 < nk) WAIT_V(6); else if (t + 1 < nk) WAIT_V(3); else WAIT_V(0); }
    else      { if (t + 2 < nk) WAIT_V(4); else if (t + 1 < nk) WAIT_V(2); else WAIT_V(0); }
    __builtin_amdgcn_s_barrier();
    if (t + 3 < nk) NSTAGE((t + 3) & 3, t + 3);
    const char* sa = SA(t & 3);
    const char* sb = SB(t & 3) + boff;
    lx2 A0 = *(const lx2*)(sa + a0), A1 = *(const lx2*)(sa + a1), Bf[4];
#pragma unroll
    for (int n = 0; n < 4; ++n) Bf[n] = *(const lx2*)(sb + n * 1024);
#pragma unroll
    for (int h = 0; h < 2; ++h) {
#pragma unroll
      for (int n = 0; n < 4; ++n) acc[0][n] = __builtin_amdgcn_mfma_f32_16x16x32_fp8_fp8(A0[h], Bf[n][h], acc[0][n], 0, 0, 0);
#pragma unroll
      for (int n = 0; n < 4; ++n) acc[1][n] = __builtin_amdgcn_mfma_f32_16x16x32_fp8_fp8(A1[h], Bf[n][h], acc[1][n], 0, 0, 0);
    }
    WAIT_L(0);
  }
  RAW_SYNC();
#undef SA
#undef SB
#undef NSTAGE
}

__device__ __forceinline__ void p_moe_a(const Params& p, char* shm) {
  const char* h18 = p.ws + OFF_H18;
  const char* wgu8 = p.ws + OFF_WGU;
  const int* counts = (const int*)(p.ws + OFF_CNT);
  const int* lists = (const int*)(p.ws + OFF_LISTS);
  char* hid8 = p.ws + OFF_B;
  const int* tab = (const int*)(shm + MOE_TAB);
  const int tid = opaque_tid(), wid = tid >> 6, lane = tid & 63, wr = wid >> 2, wc = wid & 3, fr = lane & 15, fq = lane >> 4;
  int sR[NSTG], sC[NSTG];
#pragma unroll
  for (int i = 0; i < NSTG; ++i) stage_rc(wid * 1024 + i * 8192 + lane * 16, sR[i], sC[i]);
  moe_tables(counts, shm);
  const int total = tab[32] * 2;
  for (int r = 0;; ++r) {
    int item = xcd_item(total, r);
    if (item == -1) break;
    if (item < 0) continue;
    int e, mt;
    moe_find(tab, item >> 1, e, mt);
    const int fh = item & 1;
    const int cnt_e = counts[e * CNT_STRIDE];
    const int rowbase = tab[66 + e];
    unsigned pa[NSTG], pb[NSTG];
    f32x4 acc[8][4];
    zero_acc(acc);
#pragma unroll
    for (int i = 0; i < NSTG; ++i) {
      pa[i] = (unsigned)((e * 512 + fh * 256 + sR[i]) * 1024 + sC[i] * 2);
      int idx = mt * 256 + sR[i];
      int tok = (idx < cnt_e) ? (lists[(size_t)e * T_TOK + idx] >> 1) : 0;
      pb[i] = (unsigned)(tok * 1024 + sC[i] * 2);
    }
    gemm_core_f8(wgu8, pa, h18, pb, 16, acc, shm);
    const int tid = opaque_tid(), wid = tid >> 6, lane = tid & 63, wr = wid >> 2, wc = wid & 3, fr = lane & 15, fq = lane >> 4;
#pragma unroll
    for (int m = 0; m < 4; ++m)
#pragma unroll
      for (int n = 0; n < 4; ++n) {
        float o[4];
#pragma unroll
        for (int j = 0; j < 4; ++j) {
          const float ag = acc[m][n][j], au = acc[m + 4][n][j];
          const float e_ = __builtin_amdgcn_exp2f(ag * (-1.4426950408889634f / WGU_SCALE));
          o[j] = fminf(fmaxf((ag * au) * __builtin_amdgcn_rcpf(__builtin_fmaf(e_, WGU_SCALE * WGU_SCALE, WGU_SCALE * WGU_SCALE)), -448.f), 448.f);
        }
        int pk = __builtin_amdgcn_cvt_pk_fp8_f32(o[0], o[1], 0, false);
        pk = __builtin_amdgcn_cvt_pk_fp8_f32(o[2], o[3], pk, true);
        *(int*)(shm + (wc * 64 + n * 16 + fr) * 144 + (wr * 64 + m * 16 + fq * 4)) = pk;
      }
    RAW_SYNC();
    {
      const int ch = tid & 7, r0 = tid >> 3;
      char* dst = hid8 + ((size_t)rowbase + mt * 256 + r0) * 256 + fh * 128 + ch * 16;
#pragma unroll
      for (int ps = 0; ps < 4; ++ps) {
        const uint4 v = *(const uint4*)(shm + (ps * 64 + r0) * 144 + ch * 16);
        *(uint4*)(dst + (size_t)ps * 64 * 256) = v;
      }
    }
    RAW_SYNC();
  }
  const int totaln = tab[65] * 2;
  for (int r = 0;; ++r) {
    int item = xcd_item(totaln, r);
    if (item == -1) break;
    if (item < 0) continue;
    int e, ntile;
    moe_find(tab + 33, item >> 1, e, ntile);
    const int fh = item & 1;
    const int cnt_e = counts[e * CNT_STRIDE];
    const int rowbase = tab[66 + e];
    const int wrn = wid >> 2, lq = wid & 3;
    const int ablk[2] = {wrn * 8 + lq, wrn * 8 + 4 + lq};
    unsigned pa[NSTG], pb = 0;
#pragma unroll
    for (int i = 0; i < NSTG; ++i) pa[i] = (unsigned)((e * 512 + fh * 256 + sR[i]) * 1024 + sC[i] * 2);
    {
      int idx = 2048 + ntile * 64 + (sR[0] & 63);
      int tok = (idx < cnt_e) ? (lists[(size_t)e * T_TOK + idx] >> 1) : 0;
      pb = (unsigned)(tok * 1024 + sC[0] * 2);
    }
    f32x4 acc[2][4];
#pragma unroll
    for (int m = 0; m < 2; ++m)
#pragma unroll
      for (int n = 0; n < 4; ++n) acc[m][n] = (f32x4){0.f, 0.f, 0.f, 0.f};
    gemm_core_narrow_f8(wgu8, pa, h18, pb, 16, ablk, acc, shm);
#pragma unroll
    for (int n = 0; n < 4; ++n) {
      float o[4];
#pragma unroll
      for (int j = 0; j < 4; ++j) {
        float g = acc[0][n][j] * (1.0f / WGU_SCALE), u = acc[1][n][j] * (1.0f / WGU_SCALE);
        o[j] = fminf(fmaxf(g * u * __builtin_amdgcn_rcpf(1.0f + __builtin_amdgcn_exp2f(-1.4426950408889634f * g)), -448.f), 448.f);
      }
      size_t row = (size_t)rowbase + 2048 + ntile * 64 + n * 16 + fr;
      int pk = __builtin_amdgcn_cvt_pk_fp8_f32(o[0], o[1], 0, false);
      pk = __builtin_amdgcn_cvt_pk_fp8_f32(o[2], o[3], pk, true);
      *(int*)(hid8 + row * 256 + fh * 128 + wrn * 64 + lq * 16 + fq * 4) = pk;
    }
  }
}

#define Y_SCALE 16.0f
__device__ __forceinline__ void p_moe_b(const Params& p, char* shm) {
  const char* wdn8 = p.ws + OFF_WDN;
  const char* hid8 = p.ws + OFF_B;
  const float* route_w = (const float*)(p.ws + OFF_ROUTE_W);
  const int* counts = (const int*)(p.ws + OFF_CNT);
  const int* lists = (const int*)(p.ws + OFF_LISTS);
  char* y8 = p.ws + OFF_A;
  int* sent = (int*)(shm + 256 * EPI_LD);
  const int* tab = (const int*)(shm + MOE_TAB);
  const int tid = opaque_tid(), wid = tid >> 6, lane = tid & 63, wc = wid & 3, fr = lane & 15, fq = lane >> 4;
  int sR[NSTG], sC[NSTG];
#pragma unroll
  for (int i = 0; i < NSTG; ++i) stage_rc(wid * 1024 + i * 8192 + lane * 16, sR[i], sC[i]);
  moe_tables(counts, shm);
  const int total = tab[32] * 4;
  for (int r = 0;; ++r) {
    int item = xcd_item(total, r);
    if (item == -1) break;
    if (item < 0) continue;
    int e, mt;
    moe_find(tab, item >> 2, e, mt);
    const int ft = item & 3;
    const int cnt_e = counts[e * CNT_STRIDE];
    const int rowbase = tab[66 + e];
    if (tid < 256) {
      int idx = mt * 256 + tid;
      sent[tid] = (idx < cnt_e) ? lists[(size_t)e * T_TOK + idx] : -1;
    }
    unsigned pa[NSTG], pb[NSTG];
    f32x4 acc[8][4];
    zero_acc(acc);
#pragma unroll
    for (int i = 0; i < NSTG; ++i) {
      pa[i] = (unsigned)((e * 1024 + ft * 256 + sR[i]) * 256 + sC[i] * 2);
      pb[i] = (unsigned)((rowbase + mt * 256 + sR[i]) * 256 + sC[i] * 2);
    }
    gemm_core_f8(wdn8, pa, hid8, pb, 4, acc, shm);
    const int tid = opaque_tid(), wid = tid >> 6, lane = tid & 63, wr = wid >> 2, wc = wid & 3, fr = lane & 15, fq = lane >> 4;
#pragma unroll
    for (int n = 0; n < 4; ++n) {
      int en = sent[wc * 64 + n * 16 + fr];
      float rw = (en >= 0) ? route_w[en] * (Y_SCALE / WDN_SCALE) : 0.f;
#pragma unroll
      for (int m = 0; m < 8; ++m) {
        float o[4];
#pragma unroll
        for (int j = 0; j < 4; ++j) o[j] = fminf(fmaxf(acc[m][n][j] * rw, -448.f), 448.f);
        int pk = __builtin_amdgcn_cvt_pk_fp8_f32(o[0], o[1], 0, false);
        pk = __builtin_amdgcn_cvt_pk_fp8_f32(o[2], o[3], pk, true);
        *(int*)(shm + (wc * 64 + n * 16 + fr) * HID_LD + (wr * 128 + m * 16 + fq * 4)) = pk;
      }
    }
    RAW_SYNC();
    {
      const int ch = tid & 15, r0 = tid >> 4;
#pragma unroll 4
      for (int ps = 0; ps < 8; ++ps) {
        const int rr = ps * 32 + r0;
        const uint4 v = *(const uint4*)(shm + rr * HID_LD + ch * 16);
        const int en = sent[rr];
        if (en >= 0) *(uint4*)(y8 + (size_t)en * 1024 + ft * 256 + ch * 16) = v;
      }
    }
    RAW_SYNC();
  }
  const int totaln = tab[65] * 4;
  for (int r = 0;; ++r) {
    int item = xcd_item(totaln, r);
    if (item == -1) break;
    if (item < 0) continue;
    int e, ntile;
    moe_find(tab + 33, item >> 2, e, ntile);
    const int ft = item & 3;
    const int cnt_e = counts[e * CNT_STRIDE];
    const int rowbase = tab[66 + e];
    if (tid < 64) {
      int idx = 2048 + ntile * 64 + tid;
      sent[tid] = (idx < cnt_e) ? lists[(size_t)e * T_TOK + idx] : -1;
    }
    const int ablk[2] = {wid * 2, wid * 2 + 1};
    unsigned pa[NSTG], pb;
#pragma unroll
    for (int i = 0; i < NSTG; ++i) pa[i] = (unsigned)((e * 1024 + ft * 256 + sR[i]) * 256 + sC[i] * 2);
    pb = (unsigned)((rowbase + 2048 + ntile * 64 + (sR[0] & 63)) * 256 + sC[0] * 2);
    f32x4 acc[2][4];
#pragma unroll
    for (int m = 0; m < 2; ++m)
#pragma unroll
      for (int n = 0; n < 4; ++n) acc[m][n] = (f32x4){0.f, 0.f, 0.f, 0.f};
    gemm_core_narrow_f8(wdn8, pa, hid8, pb, 4, ablk, acc, shm);
#pragma unroll
    for (int n = 0; n < 4; ++n) {
      int en = sent[n * 16 + fr];
      float rw = (en >= 0) ? route_w[en] * (Y_SCALE / WDN_SCALE) : 0.f;
#pragma unroll
      for (int m = 0; m < 2; ++m) {
        f16x4 v;
#pragma unroll
        for (int j = 0; j < 4; ++j) v[j] = (f16)(acc[m][n][j] * rw);
        *(f16x4*)(shm + (n * 16 + fr) * EPI_LD + (wid * 32 + m * 16 + fq * 4) * 2) = v;
      }
    }
    RAW_SYNC();
    {
      const int ch = tid & 31, r0 = tid >> 5;
#pragma unroll
      for (int ps = 0; ps < 4; ++ps) {
        int rr = ps * 16 + r0;
        f16x8 v = *(const f16x8*)(shm + rr * EPI_LD + ch * 16);
        int en = sent[rr];
        if (en >= 0) *(uint2*)(y8 + (size_t)en * 1024 + ft * 256 + ch * 8) = pack8_fp8(v);
      }
    }
    RAW_SYNC();
  }
}

__device__ __forceinline__ unsigned f2key_(float f) {
  if (f == 0.f) f = 0.f;
  unsigned u = __float_as_uint(f);
  return (u & 0x80000000u) ? ~u : (u | 0x80000000u);
}
__device__ __forceinline__ float key2f_(unsigned k) {
  return __uint_as_float((k & 0x80000000u) ? (k & 0x7fffffffu) : ~k);
}
__device__ __forceinline__ int wave_scan_incl(int v) {
  int t = v;
  t += __builtin_amdgcn_update_dpp(0, v, 0x111, 0xf, 0xf, true);
  t += __builtin_amdgcn_update_dpp(0, v, 0x112, 0xf, 0xf, true);
  t += __builtin_amdgcn_update_dpp(0, v, 0x113, 0xf, 0xf, true);
  t += __builtin_amdgcn_update_dpp(0, t, 0x114, 0xf, 0xe, true);
  t += __builtin_amdgcn_update_dpp(0, t, 0x118, 0xf, 0xc, true);
  t += __builtin_amdgcn_update_dpp(0, t, 0x142, 0xa, 0xf, true);
  t += __builtin_amdgcn_update_dpp(0, t, 0x143, 0xc, 0xf, true);
  return t;
}
__device__ __forceinline__ void find_bin(const unsigned* hrow, int need, int lane, int* out_bin, int* out_above) {
  uint4 c = *(const uint4*)(hrow + 4 * lane);
  int tot = (int)(c.x + c.y + c.z + c.w);
  const int pre = wave_scan_incl(tot);
  const int incl = __builtin_amdgcn_readlane(pre, 63) - pre + tot;
  int above = incl - tot;
  if (above < need && incl >= need) {
    int b;
    if (above + (int)c.w >= need) b = 3;
    else { above += c.w; if (above + (int)c.z >= need) b = 2;
      else { above += c.z; if (above + (int)c.y >= need) b = 1; else { above += c.y; b = 0; } } }
    *out_bin = 4 * lane + b;
    *out_above = above;
  }
}

typedef short s16x4 __attribute__((ext_vector_type(4)));
#define VROW 160
#define ATT_WAVE_LDS (64 * VROW + 512)
__device__ __forceinline__ f16x8 tr_pair(const char* a, const char* b) {
  s16x4 x = __builtin_amdgcn_ds_read_tr16_b64_v4i16((__attribute__((address_space(3))) s16x4*)(a));
  s16x4 y = __builtin_amdgcn_ds_read_tr16_b64_v4i16((__attribute__((address_space(3))) s16x4*)(b));
  typedef short s16x8 __attribute__((ext_vector_type(8)));
  s16x8 r = __builtin_shufflevector(x, y, 0, 1, 2, 3, 4, 5, 6, 7);
  return __builtin_bit_cast(f16x8, r);
}
__device__ __forceinline__ void attn_load_q(const f16* __restrict__ proj16, int t, int lane, f16x8& q0, f16x8& q1) {
  const f16* qp = proj16 + (size_t)t * PJ_W + C_Q + (lane & 7) * 64 + (lane >> 4) * 16;
  q0 = *(const f16x8*)qp;
  q1 = *(const f16x8*)(qp + 8);
}
__device__ __forceinline__ f16x8 widen8(unsigned lo, unsigned hi) {
  f16x2 a = __builtin_amdgcn_cvt_scalef32_pk_f16_fp8(lo, 1.0f, false), b = __builtin_amdgcn_cvt_scalef32_pk_f16_fp8(lo, 1.0f, true);
  f16x2 c = __builtin_amdgcn_cvt_scalef32_pk_f16_fp8(hi, 1.0f, false), d = __builtin_amdgcn_cvt_scalef32_pk_f16_fp8(hi, 1.0f, true);
  f16x8 r = {a[0], a[1], b[0], b[1], c[0], c[1], d[0], d[1]};
  return r;
}
__device__ __forceinline__ void attn_one(f16x8 bq0, f16x8 bq1, const f16* __restrict__ proj16, f16x8& nq0, f16x8& nq1,
                                         const char* __restrict__ kv8, f16* __restrict__ pa16, int t,
                                         const unsigned short* ssel, char* vimg, int lane) {
  const int fr = lane & 15, fq = lane >> 4;
  const int l = t & (SEQ - 1), b0 = t - l, cnt = min(l + 1, 256);
  f16x8 ones;
  const char* kvb = kv8 + (size_t)__builtin_amdgcn_readfirstlane(b0) * 128;
  f32x4 S[16];
  uint4 kraw[16], vraw[16];
  {
    int ki[16];
#pragma unroll
    for (int kt = 0; kt < 16; ++kt) ki[kt] = ssel[kt * 16 + (lane >> 2)];
    __builtin_amdgcn_sched_barrier(0);
#pragma unroll
    for (int kt = 0; kt < 16; ++kt) {
      const unsigned ko = (unsigned)min(ki[kt], l) * 128u + (lane & 3) * 16;
      kraw[kt] = *(const uint4*)(kvb + ko);
      vraw[kt] = *(const uint4*)(kvb + ko + 64);
    }
  }
  __builtin_amdgcn_sched_barrier(0);
  {
    const f16 qs = (f16)0.18033688011112042f;
#pragma unroll
    for (int e = 0; e < 8; ++e) {
      bq0[e] = (fr < 8) ? bq0[e] * qs : (f16)0.f;
      bq1[e] = (fr < 8) ? bq1[e] * qs : (f16)0.f;
      ones[e] = (fr == 0) ? (f16)1.f : (f16)0.f;
    }
  }
  const int bp = ((lane & 15) * 4 + (lane >> 4)) * 4;
#pragma unroll
  for (int kt = 0; kt < 16; kt += 2) {
    uint4 k0, k1;
    k0.x = __builtin_amdgcn_ds_bpermute(bp, kraw[kt].x); k0.y = __builtin_amdgcn_ds_bpermute(bp, kraw[kt].y);
    k0.z = __builtin_amdgcn_ds_bpermute(bp, kraw[kt].z); k0.w = __builtin_amdgcn_ds_bpermute(bp, kraw[kt].w);
    k1.x = __builtin_amdgcn_ds_bpermute(bp, kraw[kt + 1].x); k1.y = __builtin_amdgcn_ds_bpermute(bp, kraw[kt + 1].y);
    k1.z = __builtin_amdgcn_ds_bpermute(bp, kraw[kt + 1].z); k1.w = __builtin_amdgcn_ds_bpermute(bp, kraw[kt + 1].w);
    f32x4 z0 = {0.f, 0.f, 0.f, 0.f}, z1 = {0.f, 0.f, 0.f, 0.f};
    z0 = __builtin_amdgcn_mfma_f32_16x16x32_f16(widen8(k0.x, k0.y), bq0, z0, 0, 0, 0);
    z1 = __builtin_amdgcn_mfma_f32_16x16x32_f16(widen8(k1.x, k1.y), bq0, z1, 0, 0, 0);
    S[kt] = __builtin_amdgcn_mfma_f32_16x16x32_f16(widen8(k0.z, k0.w), bq1, z0, 0, 0, 0);
    S[kt + 1] = __builtin_amdgcn_mfma_f32_16x16x32_f16(widen8(k1.z, k1.w), bq1, z1, 0, 0, 0);
  }
  __builtin_amdgcn_sched_barrier(0);
  if (cnt < 256) {
    int cl = cnt - fq * 4;
    asm volatile("" : "+v"(cl));
#pragma unroll
    for (int kt = 0; kt < 16; ++kt)
#pragma unroll
      for (int j = 0; j < 4; ++j) S[kt][j] = (kt * 16 + j < cl) ? S[kt][j] : NEG_BIG;
  }
  attn_load_q(proj16, min(t + 1, T_TOK - 1), lane, nq0, nq1);
  __builtin_amdgcn_sched_barrier(0);
  float m = NEG_BIG;
#pragma unroll
  for (int kt = 0; kt < 16; ++kt)
#pragma unroll
    for (int j = 0; j < 4; ++j) m = fmaxf(m, S[kt][j]);
  m = fmaxf(m, __shfl_xor(m, 16, 64));
  m = fmaxf(m, __shfl_xor(m, 32, 64));
  f16x8 P[8];
#pragma unroll
  for (int c = 0; c < 8; ++c)
#pragma unroll
    for (int j = 0; j < 4; ++j) {
      P[c][j] = (f16)__builtin_amdgcn_exp2f(S[2 * c][j] - m);
      P[c][4 + j] = (f16)__builtin_amdgcn_exp2f(S[2 * c + 1][j] - m);
    }
  f32x4 O[4], Ol = {0.f, 0.f, 0.f, 0.f};
#pragma unroll
  for (int nt = 0; nt < 4; ++nt) O[nt] = (f32x4){0.f, 0.f, 0.f, 0.f};
#pragma unroll
  for (int rr = 0; rr < 4; ++rr) {
#pragma unroll
    for (int q = 0; q < 4; ++q) {
      const uint4 vr = vraw[rr * 4 + q];
      char* wp = vimg + (q * 16 + (lane >> 2)) * VROW + (lane & 3) * 32;
      *(f16x8*)wp = widen8(vr.x, vr.y);
      *(f16x8*)(wp + 16) = widen8(vr.z, vr.w);
    }
    asm volatile("" ::: "memory");
#pragma unroll
    for (int cc = 0; cc < 2; ++cc) {
      const char* ra = vimg + (cc * 32 + fq * 4 + (fr >> 2)) * VROW + (fr & 3) * 8;
#pragma unroll
      for (int nt = 0; nt < 4; ++nt) {
        f16x8 B = tr_pair(ra + nt * 32, ra + 16 * VROW + nt * 32);
        O[nt] = __builtin_amdgcn_mfma_f32_16x16x32_f16(P[rr * 2 + cc], B, O[nt], 0, 0, 0);
      }
      Ol = __builtin_amdgcn_mfma_f32_16x16x32_f16(P[rr * 2 + cc], ones, Ol, 0, 0, 0);
    }
  }
  asm volatile("s_waitcnt lgkmcnt(0)" ::: "memory");
#pragma unroll
  for (int j = 0; j < 4; ++j) {
    float ls = __shfl(Ol[j], lane & 48, 64);
    float inv = __builtin_amdgcn_rcpf(ls);
    if (fq < 2) {
      unsigned char* op = (unsigned char*)pa16 + (size_t)t * (DM * 2) + 1024 + (fq * 4 + j) * 64 + fr;
#pragma unroll
      for (int nt = 0; nt < 4; ++nt) {
        const float x = fminf(fmaxf(O[nt][j] * inv * ATT_SCALE, -448.f), 448.f);
        op[nt * 16] = (unsigned char)(__builtin_amdgcn_cvt_pk_fp8_f32(x, x, 0, false) & 0xff);
      }
    }
  }
}

__device__ __forceinline__ f32x4 score_tile(const f16x8& a, const f16x8 (&bq)[8], const f16x8& bc_hi, const f16x8& bc_lo,
                                            const float (&wq)[8]) {
  f32x4 L[8];
  f32x4 lin = __builtin_amdgcn_mfma_f32_16x16x32_f16(a, bc_lo, (f32x4){0.f, 0.f, 0.f, 0.f}, 0, 0, 0);
  lin = __builtin_amdgcn_mfma_f32_16x16x32_f16(a, bc_hi, lin, 0, 0, 0);
#pragma unroll
  for (int h = 0; h < 8; ++h) L[h] = __builtin_amdgcn_mfma_f32_16x16x32_f16(a, bq[h], (f32x4){0.f, 0.f, 0.f, 0.f}, 0, 0, 0);
  __builtin_amdgcn_sched_barrier(0);
  asm volatile("s_nop 7\n\ts_nop 7" ::: "memory");
  __builtin_amdgcn_sched_barrier(0);
  float t0 = lin[0], t1 = lin[1], t2 = lin[2], t3 = lin[3];
#pragma unroll
  for (int h = 0; h < 8; ++h) {
    asm("v_fma_f32 %0, %1, |%2|, %0" : "+v"(t0) : "v"(wq[h]), "v"(L[h][0]));
    asm("v_fma_f32 %0, %1, |%2|, %0" : "+v"(t1) : "v"(wq[h]), "v"(L[h][1]));
    asm("v_fma_f32 %0, %1, |%2|, %0" : "+v"(t2) : "v"(wq[h]), "v"(L[h][2]));
    asm("v_fma_f32 %0, %1, |%2|, %0" : "+v"(t3) : "v"(wq[h]), "v"(L[h][3]));
  }
  f32x4 s = {t0, t1, t2, t3};
  return s;
}

#define KEYS_LD 4104
#define IDX_KEYS 0
#define IDX_HIST 131584
#define IDX_SSEL (IDX_HIST + 16384)
#define IDX_CAND (IDX_SSEL + 8192)
#define IDX_MISC (IDX_CAND + 2048)
template <int V>
__device__ __forceinline__ void p_index(const Params& p, char* shm) {
  const f16* proj16 = (const f16*)(p.ws + OFF_B);
  f16* pa16 = (V == 0) ? (f16*)(p.ws + OFF_D) : (f16*)p.out;
  unsigned short* keys16 = (unsigned short*)(shm + IDX_KEYS);
  unsigned* hist = (unsigned*)(shm + IDX_HIST);
  unsigned short* ssel = (unsigned short*)(shm + IDX_SSEL);
  unsigned short* scand = (unsigned short*)(shm + IDX_CAND);
  unsigned* smm = (unsigned*)(shm + IDX_MISC);
  int* sbin = (int*)(smm + 32);
  const int tid = opaque_tid();
  const float NINF = -__builtin_huge_valf(), PINF = __builtin_huge_valf();
  unsigned* qhead = (unsigned*)(p.ws + OFF_BAR + 15360) + (blockIdx.x & 7) * 16 + ((V == 0) ? 0 : 8);
  int* qslot = (int*)(shm + IDX_MISC + 512);
  int qnext = 0;
  if (tid == 0) qnext = (int)atomicAdd(qhead, 1u);
  for (;;) {
    if (opaque_tid() == 0) *qslot = qnext;
    __syncthreads();
    const int qi = *qslot;
    if (qi >= 256) break;
    if (opaque_tid() == 0) qnext = (int)atomicAdd(qhead, 1u);
    const int idx = qi * 8 + (blockIdx.x & 7);
    const int tidr = opaque_tid();
    int lane = tidr & 63;
    asm volatile("" : "+v"(lane));
    const int wids = __builtin_amdgcn_readfirstlane(tidr >> 6);
    const int fr = lane & 15, fq = lane >> 4;
    const unsigned long long lt_mask = (1ull << lane) - 1ull;
    const int b = idx & 7, j = 255 - (idx >> 3);
    const int l0 = j * 16, t0 = b * SEQ + l0;
    if (j < 16) {
      f16x8 qc0, qc1;
      attn_load_q(proj16, t0 + 2 * wids, lane, qc0, qc1);
#pragma unroll 1
      for (int qq = 0; qq < 2; ++qq) {
        const int q = 2 * wids + qq, lq = l0 + q;
        unsigned short* sl = ssel + q * 256;
        for (int i = lane; i < 256; i += 64) sl[i] = (unsigned short)((i <= lq) ? i : 0);
        asm volatile("s_waitcnt lgkmcnt(0)" ::: "memory");
        f16x8 qn0, qn1;
        attn_one(qc0, qc1, proj16, qn0, qn1, p.ws + OFF_KV8, pa16, t0 + q, sl, (char*)(keys16 + (2 * wids) * KEYS_LD), lane);
        qc0 = qn0; qc1 = qn1;
      }
      __syncthreads();
      continue;
    }
    const int klast = (j - 1) - ((j - 1 - wids) & 7);
    const f16* kbase = (const f16*)(p.ws + OFF_IKC) + (size_t)(b * SEQ) * 32 + lane * 8;
#define NB 8
#define IK_LOAD(dst, kt0)                                                                   \
  _Pragma("unroll") for (int u = 0; u < NB; ++u) {                                          \
    int ktc = min((kt0) + 8 * u, klast);                                                    \
    dst[u] = *(const f16x8*)(kbase + ktc * 512);                                            \
  }
    f16x8 bq[8];
    float wq[8];
    f16x8 afirst[NB];
    f16x8 wv;
    f16x8 braw[8], wraw;
    {
      const f16* qrow = proj16 + (size_t)(t0 + (lane >> 2)) * PJ_W;
#pragma unroll
      for (int h = 0; h < 8; ++h) braw[h] = *(const f16x8*)(qrow + C_IQ + h * 32 + (lane & 3) * 8);
      wraw = *(const f16x8*)(qrow + C_IW);
    }
    const f16x8 ad = *(const f16x8*)(kbase + j * 512);
    IK_LOAD(afirst, wids);
    {
      const int bpq = (fr * 4 + fq) * 4, bpw = fr * 16;
#pragma unroll
      for (int h = 0; h < 8; ++h) {
        const i32x4 xi = __builtin_bit_cast(i32x4, braw[h]);
        i32x4 xo;
        xo[0] = __builtin_amdgcn_ds_bpermute(bpq, xi[0]); xo[1] = __builtin_amdgcn_ds_bpermute(bpq, xi[1]);
        xo[2] = __builtin_amdgcn_ds_bpermute(bpq, xi[2]); xo[3] = __builtin_amdgcn_ds_bpermute(bpq, xi[3]);
        bq[h] = __builtin_bit_cast(f16x8, xo);
      }
      const i32x4 wi = __builtin_bit_cast(i32x4, wraw);
      i32x4 wo;
      wo[0] = __builtin_amdgcn_ds_bpermute(bpw, wi[0]); wo[1] = __builtin_amdgcn_ds_bpermute(bpw, wi[1]);
      wo[2] = __builtin_amdgcn_ds_bpermute(bpw, wi[2]); wo[3] = __builtin_amdgcn_ds_bpermute(bpw, wi[3]);
      wv = __builtin_bit_cast(f16x8, wo);
    }
    for (int i = tidr; i < 4096; i += 512) hist[i] = 0;
    if (tidr < 16) { smm[tidr] = 0xFFFFFFFFu; smm[16 + tidr] = 0u; }
#pragma unroll
    for (int h = 0; h < 8; ++h) wq[h] = (float)wv[h];
    f16x8 bc_hi, bc_lo;
#pragma unroll
    for (int e = 0; e < 8; ++e) {
      float c = 0.f;
#pragma unroll
      for (int h = 0; h < 8; ++h) c = __builtin_fmaf(wq[h], (float)bq[h][e], c);
      f16 ch_ = (f16)c;
      bc_hi[e] = ch_;
      bc_lo[e] = (f16)(c - (float)ch_);
    }
    __syncthreads();
    {
      float mn = PINF, mx = NINF;
      f16x8 a[NB];
#pragma unroll
      for (int u = 0; u < NB; ++u) a[u] = afirst[u];
      const int astep = (j >= 32) ? (1 << 20) : 8 * NB;
      for (int kt0 = wids; kt0 < j; kt0 += astep) {
        f16x8 an[NB];
        if (j < 32) { IK_LOAD(an, kt0 + astep); }
        else {
#pragma unroll
          for (int u = 0; u < NB; ++u) an[u] = a[u];
        }
#pragma unroll
        for (int u = 0; u < NB; ++u) {
          if (kt0 + 8 * u < j) {
            f32x4 sc = score_tile(a[u], bq, bc_hi, bc_lo, wq);
            mn = fminf(fminf(mn, sc[0]), fminf(fminf(sc[1], sc[2]), sc[3]));
            mx = fmaxf(fmaxf(mx, sc[0]), fmaxf(fmaxf(sc[1], sc[2]), sc[3]));
          }
        }
#pragma unroll
        for (int u = 0; u < NB; ++u) a[u] = an[u];
      }
      if ((j & 7) == wids) {
        f32x4 sc = score_tile(ad, bq, bc_hi, bc_lo, wq);
#pragma unroll
        for (int jj = 0; jj < 4; ++jj) {
          bool ok = (fq * 4 + jj <= fr);
          mn = fminf(mn, ok ? sc[jj] : PINF);
          mx = fmaxf(mx, ok ? sc[jj] : NINF);
        }
      }
      mn = fminf(mn, __shfl_xor(mn, 16, 64)); mn = fminf(mn, __shfl_xor(mn, 32, 64));
      mx = fmaxf(mx, __shfl_xor(mx, 16, 64)); mx = fmaxf(mx, __shfl_xor(mx, 32, 64));
      if (fq == 0) {
        if (mn != PINF) atomicMin(&smm[fr], f2key_(mn));
        if (mx != NINF) atomicMax(&smm[16 + fr], f2key_(mx));
      }
    }
    __syncthreads();
    {
      float lo = key2f_(smm[fr]), hi = key2f_(smm[16 + fr]);
      if (j >= 32) { const float mg = 0.125f * (hi - lo); lo -= mg; hi += mg; }
      const float s16 = (hi > lo) ? 65536.0f / (hi - lo) : 0.f;
      const float nlo = -lo * s16;
      unsigned* hq = hist + fr * 256;
      unsigned short* kq = keys16 + fr * KEYS_LD + fq * 4;
      f16x8 a[NB];
#pragma unroll
      for (int u = 0; u < NB; ++u) a[u] = afirst[u];
      for (int kt0 = wids; kt0 < j; kt0 += 8 * NB) {
        f16x8 an[NB];
        IK_LOAD(an, kt0 + 8 * NB);
#pragma unroll
        for (int u = 0; u < NB; ++u) {
          const int kt = kt0 + 8 * u;
          if (kt < j) {
            f32x4 sc = score_tile(a[u], bq, bc_hi, bc_lo, wq);
            unsigned uu[4];
#pragma unroll
            for (int jj = 0; jj < 4; ++jj) asm("v_cvt_u32_f32 %0, %1" : "=v"(uu[jj]) : "v"(__builtin_fmaf(sc[jj], s16, nlo)));
            uint2 pk;
            asm("v_cvt_pk_u16_u32 %0, %1, %2" : "=v"(pk.x) : "v"(uu[0]), "v"(uu[1]));
            asm("v_cvt_pk_u16_u32 %0, %1, %2" : "=v"(pk.y) : "v"(uu[2]), "v"(uu[3]));
            atomicAdd(&hq[(pk.x >> 8) & 255u], 1u);
            atomicAdd(&hq[pk.x >> 24], 1u);
            atomicAdd(&hq[(pk.y >> 8) & 255u], 1u);
            atomicAdd(&hq[pk.y >> 24], 1u);
            *(uint2*)(kq + kt * 16) = pk;
          }
        }
#pragma unroll
        for (int u = 0; u < NB; ++u) a[u] = an[u];
      }
      if ((j & 7) == wids) {
        f32x4 sc = score_tile(ad, bq, bc_hi, bc_lo, wq);
        unsigned kk[4];
#pragma unroll
        for (int jj = 0; jj < 4; ++jj) {
          int k16 = min(max((int)__builtin_fmaf(sc[jj], s16, nlo), 0), 65535);
          kk[jj] = (unsigned)k16;
          if (fq * 4 + jj <= fr) atomicAdd(&hq[k16 >> 8], 1u);
        }
        uint2 pk;
        pk.x = kk[0] | (kk[1] << 16);
        pk.y = kk[2] | (kk[3] << 16);
        *(uint2*)(kq + j * 16) = pk;
      }
    }
#undef IK_LOAD
#undef NB
    __syncthreads();
    if (V == 2) continue;
    f16x8 qc0, qc1;
    attn_load_q(proj16, t0 + 2 * wids, lane, qc0, qc1);
    {
      const int q0 = 2 * wids, lq0 = l0 + q0;
      const int nmax = lq0 + 2;
      unsigned* hrow0 = hist + q0 * 256;
      const unsigned short* krow0 = keys16 + q0 * KEYS_LD;
      if (lane < 4) sbin[2 * q0 + lane] = 0;
      find_bin(hrow0, 256, lane, &sbin[2 * q0], &sbin[2 * q0 + 1]);
      find_bin(hrow0 + 256, 256, lane, &sbin[2 * q0 + 2], &sbin[2 * q0 + 3]);
      asm volatile("s_waitcnt lgkmcnt(0)" ::: "memory");
      const unsigned b1s0 = (unsigned)sbin[2 * q0], b1s1 = (unsigned)sbin[2 * q0 + 2];
      const int r0n = 256 - sbin[2 * q0 + 1], r1n = 256 - sbin[2 * q0 + 3];
      asm volatile("s_waitcnt lgkmcnt(0)" ::: "memory");
      int base0 = 0, cb0 = 0, base1 = 0, cb1 = 0;
      unsigned short* trash16 = (unsigned short*)(shm + IDX_CAND) + lane;
      unsigned* trash32 = (unsigned*)(shm + IDX_CAND + 256) + lane;
      const unsigned hi0 = b1s0 * 256u + 255u, lo0 = b1s0 * 256u, hi1 = b1s1 * 256u + 255u, lo1 = b1s1 * 256u;
      uint2 pa_ = make_uint2(0u, 0u), pb_ = make_uint2(0u, 0u);
      if (lane * 4 < nmax) { pa_ = *(const uint2*)(krow0 + lane * 4); pb_ = *(const uint2*)(krow0 + KEYS_LD + lane * 4); }
      for (int s0 = 0; s0 < nmax; s0 += 256) {
        const int s4 = s0 + lane * 4;
        const uint2 ca_ = pa_, cb_ = pb_;
        if (s4 + 256 < nmax) { pa_ = *(const uint2*)(krow0 + s4 + 256); pb_ = *(const uint2*)(krow0 + KEYS_LD + s4 + 256); }
        const unsigned ka[4] = {ca_.x & 0xffffu, ca_.x >> 16, ca_.y & 0xffffu, ca_.y >> 16};
        const unsigned kb[4] = {cb_.x & 0xffffu, cb_.x >> 16, cb_.y & 0xffffu, cb_.y >> 16};
        const int nv0 = lq0 + 1 - s4, nv1 = nv0 + 1;
        int ta[4], tb[4], ea[4], eb[4];
#pragma unroll
        for (int jj = 0; jj < 4; ++jj) {
          const bool va = jj < nv0, vb = jj < nv1;
          ta[jj] = (va && ka[jj] > hi0) ? 1 : 0;
          ea[jj] = (va && ka[jj] >= lo0 && ka[jj] <= hi0) ? 1 : 0;
          tb[jj] = (vb && kb[jj] > hi1) ? 1 : 0;
          eb[jj] = (vb && kb[jj] >= lo1 && kb[jj] <= hi1) ? 1 : 0;
        }
        const int pkt = (ta[0] + ta[1] + ta[2] + ta[3]) | ((tb[0] + tb[1] + tb[2] + tb[3]) << 16);
        const int pke = (ea[0] + ea[1] + ea[2] + ea[3]) | ((eb[0] + eb[1] + eb[2] + eb[3]) << 16);
        const int itn = wave_scan_incl(pkt);
        const int tott = __builtin_amdgcn_readlane(itn, 63);
        {
          int p0 = q0 * 256 + base0 + ((itn - pkt) & 0xffff), p1 = q0 * 256 + 256 + base1 + ((itn - pkt) >> 16);
#pragma unroll
          for (int jj = 0; jj < 4; ++jj) {
            unsigned short* d0 = ta[jj] ? (ssel + p0) : trash16;
            unsigned short* d1 = tb[jj] ? (ssel + p1) : trash16;
            *d0 = (unsigned short)(s4 + jj);
            *d1 = (unsigned short)(s4 + jj);
            p0 += ta[jj]; p1 += tb[jj];
          }
        }
        base0 += tott & 0xffff; base1 += tott >> 16;
        if (__ballot(pke != 0)) {
          const int ien = wave_scan_incl(pke);
          const int tote = __builtin_amdgcn_readlane(ien, 63);
          int c0 = cb0 + ((ien - pke) & 0xffff), c1 = cb1 + ((ien - pke) >> 16);
#pragma unroll
          for (int jj = 0; jj < 4; ++jj) {
            unsigned* d0 = (ea[jj] && c0 < 256) ? (hrow0 + c0) : trash32;
            unsigned* d1 = (eb[jj] && c1 < 256) ? (hrow0 + 256 + c1) : trash32;
            *d0 = (ka[jj] << 16) | (0xFFFFu - (unsigned)(s4 + jj));
            *d1 = (kb[jj] << 16) | (0xFFFFu - (unsigned)(s4 + jj));
            c0 += ea[jj]; c1 += eb[jj];
          }
          cb0 += tote & 0xffff; cb1 += tote >> 16;
        }
      }
      asm volatile("s_waitcnt lgkmcnt(0)" ::: "memory");
#pragma unroll
      for (int x = 0; x < 2; ++x) {
        const int q = q0 + x;
        const unsigned* cl = hrow0 + x * 256;
        const int base = x ? base1 : base0, c = min(x ? cb1 : cb0, 256), r = x ? r1n : r0n;
        if (c <= 64) {
          const unsigned my = (lane < c) ? cl[lane] : 0u;
          int rank = 0;
          for (int k = 0; k < c; ++k) rank += ((unsigned)__builtin_amdgcn_readlane((int)my, k) > my) ? 1 : 0;
          if (lane < c && rank < r && base + rank < 256) ssel[q * 256 + base + rank] = (unsigned short)(0xFFFFu - (my & 0xFFFFu));
        } else {
          for (int i = lane; i < c; i += 64) {
            const unsigned my = cl[i];
            int rank = 0;
            for (int k = 0; k < c; ++k) rank += (cl[k] > my) ? 1 : 0;
            if (rank < r && base + rank < 256) ssel[q * 256 + base + rank] = (unsigned short)(0xFFFFu - (my & 0xFFFFu));
          }
        }
      }
    }
    asm volatile("s_waitcnt lgkmcnt(0)" ::: "memory");
#pragma unroll 1
    for (int qq = 0; qq < 2; ++qq) {
      const int q = 2 * wids + qq, lq = l0 + q;
      unsigned short* sl = ssel + q * 256;
      f16x8 qn0, qn1;
      attn_one(qc0, qc1, proj16, qn0, qn1, p.ws + OFF_KV8, pa16, t0 + q, sl, (char*)(keys16 + (2 * wids) * KEYS_LD), lane);
      qc0 = qn0; qc1 = qn1;
    }
    __syncthreads();
  }
}

#define DL_LD 1040
#define POOL_OIMG 66560
template <int W>
__device__ __forceinline__ void pool_delta(const f16* up, int lf, char* dp) {
  f16x8 u[W + 7];
#pragma unroll
  for (int k = 0; k < W + 7; ++k) {
    const int rel = k - (W - 1);
    f16x8 z = {(f16)0.f, (f16)0.f, (f16)0.f, (f16)0.f, (f16)0.f, (f16)0.f, (f16)0.f, (f16)0.f};
    u[k] = (lf + rel >= 0) ? *(const f16x8*)(up + (ptrdiff_t)rel * PJ_W) : z;
  }
  float sum[8];
#pragma unroll
  for (int e = 0; e < 8; ++e) sum[e] = 0.f;
#pragma unroll
  for (int k = 0; k < W - 1; ++k)
#pragma unroll
    for (int e = 0; e < 8; ++e) sum[e] += (float)u[k][e];
#pragma unroll
  for (int i = 0; i < 8; ++i) {
    const float inv = 1.0f / (float)min(lf + i + 1, W);
    f16x8 d;
#pragma unroll
    for (int e = 0; e < 8; ++e) {
      sum[e] += (float)u[W - 1 + i][e];
      d[e] = (f16)(sum[e] * inv - (float)u[W - 1 + i][e]);
      sum[e] -= (float)u[i][e];
    }
    *(f16x8*)(dp + i * DL_LD) = d;
  }
}
__device__ __forceinline__ void p_pool(const Params& p, char* shm) {
  const f16* proj16 = (const f16*)(p.ws + OFF_B);
  const f16* wpl = (const f16*)(p.ws + OFF_WPOOL);
  f16* pa16 = (f16*)(p.ws + OFF_D);
  const int tid = opaque_tid(), wid = tid >> 6, lane = tid & 63, fr = lane & 15, fq = lane >> 4;
  for (int item = blockIdx.x; item < T_TOK / 64; item += gridDim.x) {
    const int t0 = item * 64;
    {
      const int g = wid >> 1;
      const int c = g * 128 + ((wid & 1) * 8 + (lane & 7)) * 8;
      const int tg = lane >> 3;
      const int tf = t0 + tg * 8, lf = tf & (SEQ - 1);
      const f16* up = proj16 + (size_t)tf * PJ_W + c;
      char* dp = shm + (tg * 8) * DL_LD + c * 2;
      if (g == 0) pool_delta<2>(up, lf, dp);
      else if (g == 1) pool_delta<4>(up, lf, dp);
      else if (g == 2) pool_delta<8>(up, lf, dp);
      else pool_delta<16>(up, lf, dp);
    }
    __syncthreads();
    {
      const int g = wid >> 1, eh = wid & 1;
      char* oimg = shm + POOL_OIMG;
      f32x4 acc[4][4];
#pragma unroll
      for (int m = 0; m < 4; ++m)
#pragma unroll
        for (int n = 0; n < 4; ++n) acc[m][n] = (f32x4){0.f, 0.f, 0.f, 0.f};
#pragma unroll
      for (int ks = 0; ks < 4; ++ks) {
        f16x8 A[4], B[4];
#pragma unroll
        for (int m = 0; m < 4; ++m) A[m] = *(const f16x8*)(wpl + (size_t)g * 16384 + ((eh * 4 + m) * 4 + ks) * 512 + lane * 8);
#pragma unroll
        for (int n = 0; n < 4; ++n) B[n] = *(const f16x8*)(shm + (n * 16 + fr) * DL_LD + (g * 128 + ks * 32 + fq * 8) * 2);
#pragma unroll
        for (int m = 0; m < 4; ++m)
#pragma unroll
          for (int n = 0; n < 4; ++n) acc[m][n] = __builtin_amdgcn_mfma_f32_16x16x32_f16(A[m], B[n], acc[m][n], 0, 0, 0);
      }
#pragma unroll
      for (int m = 0; m < 4; ++m) {
        const int e0 = g * 128 + eh * 64 + m * 16 + fq * 4;
        float4 sc = *(const float4*)(p.pool_scale + e0);
#pragma unroll
        for (int n = 0; n < 4; ++n) {
          f16x4 o;
          o[0] = (f16)(acc[m][n][0] * sc.x); o[1] = (f16)(acc[m][n][1] * sc.y);
          o[2] = (f16)(acc[m][n][2] * sc.z); o[3] = (f16)(acc[m][n][3] * sc.w);
          *(f16x4*)(oimg + (n * 16 + fr) * DL_LD + e0 * 2) = o;
        }
      }
    }
    __syncthreads();
    {
      const char* oimg = shm + POOL_OIMG;
#pragma unroll
      for (int ps = 0; ps < 8; ++ps) {
        const int r = ps * 8 + wid;
        f16x8 v = *(const f16x8*)(oimg + r * DL_LD + lane * 16);
        *(f16x8*)(pa16 + (size_t)(t0 + r) * DM + lane * 8) = v;
      }
    }
  }
}

#define RW_LD 2064
#define RT_LDS (2 * 36 * RW_LD)
#define RT_GB (RT_LDS + 4608)
template <int V>
__device__ __forceinline__ void p_ln1_route(const Params& p, char* shm) {
  const f16* z16 = (const f16*)(p.ws + OFF_C);
  const float* rc = (const float*)(p.ws + OFF_RC);
  char* dmy = (char*)p.out;
  float* stat = (V == 0) ? (float*)(p.ws + OFF_STAT) : (float*)(dmy + 60000000);
  int* route_e = (V == 0) ? (int*)(p.ws + OFF_ROUTE_E) : (int*)(dmy + 68000000);
  float* route_w = (V == 0) ? (float*)(p.ws + OFF_ROUTE_W) : (float*)(dmy + 69000000);
  char* h18 = (V == 0) ? (p.ws + OFF_H18) : (dmy + 100000000);
  int* counts = (V == 0) ? (int*)(p.ws + OFF_CNT) : (int*)(dmy + 70000000);
  int* lists = (V == 0) ? (int*)(p.ws + OFF_LISTS) : (int*)(dmy + 71000000);
  int* lcnt = (int*)(shm + RT_LDS);
  int* lent = lcnt + 128;
  const float* sg = (const float*)(shm + RT_GB);
  const float* sbt = sg + 1024;
  const int tid = opaque_tid(), wid = tid >> 6, lane = tid & 63, fr = lane & 15, fq = lane >> 4;
  if (tid < 128) lcnt[tid] = 0;
  {
    const f16* wsrc = (const f16*)(p.ws + OFF_WRT);
#pragma unroll
    for (int i = 0; i < 18; ++i) {
      const int c = wid + 8 * i, row = c >> 1, half = c & 1;
      __builtin_amdgcn_global_load_lds((const unsigned*)(wsrc + (size_t)row * 1024 + half * 512 + lane * 8),
                                       (unsigned*)(shm + row * RW_LD + half * 1024), 16, 0, 0);
    }
    const float* gsrc = (wid < 4) ? (p.ln1_g + wid * 256) : (p.ln1_b + (wid - 4) * 256);
    __builtin_amdgcn_global_load_lds((const unsigned*)(gsrc + lane * 4), (unsigned*)(shm + RT_GB + wid * 1024), 16, 0, 0);
  }
  const int stride = gridDim.x * 8 * 16;
  int t0 = (blockIdx.x * 8 + wid) * 16;
  f16x8 xz[32];
  const int crow = lane >> 2, cp = lane & 3;
  const int bp = ((lane & 15) * 4 + (lane >> 4)) * 4;
#define P5_LOAD(tt)                                                                  \
  {                                                                                  \
    const f16* zr_ = z16 + (size_t)((tt) + crow) * DM + cp * 8;                      \
    _Pragma("unroll") for (int ks = 0; ks < 32; ++ks) xz[ks] = *(const f16x8*)(zr_ + ks * 32); \
  }
  if (t0 < T_TOK) {
    P5_LOAD(t0);
    __builtin_amdgcn_sched_barrier(0);
    WAIT_V(32);
  } else {
    WAIT_V(0);
  }
  __builtin_amdgcn_sched_barrier(0);
  RAW_SYNC();
  while (t0 < T_TOK) {
    f32x4 acc[3];
#pragma unroll
    for (int mt = 0; mt < 3; ++mt) acc[mt] = (f32x4){0.f, 0.f, 0.f, 0.f};
    const char* wa = shm + fr * RW_LD + fq * 16;
    const char* wa2 = shm + min(32 + fr, 35) * RW_LD + fq * 16;
    float s1 = 0.f, s2 = 0.f;
#pragma unroll
    for (int ks = 0; ks < 32; ++ks) {
      f16x8 xb;
      {
        const i32x4 xi = __builtin_bit_cast(i32x4, xz[ks]);
        i32x4 xo;
        xo[0] = __builtin_amdgcn_ds_bpermute(bp, xi[0]); xo[1] = __builtin_amdgcn_ds_bpermute(bp, xi[1]);
        xo[2] = __builtin_amdgcn_ds_bpermute(bp, xi[2]); xo[3] = __builtin_amdgcn_ds_bpermute(bp, xi[3]);
        xb = __builtin_bit_cast(f16x8, xo);
      }
#pragma unroll
      for (int mt = 0; mt < 3; ++mt) {
        const char* wp = (mt < 2) ? (wa + mt * 16 * RW_LD) : wa2;
        f16x8 ah = *(const f16x8*)(wp + ks * 64), al = *(const f16x8*)(wp + 36 * RW_LD + ks * 64);
        acc[mt] = __builtin_amdgcn_mfma_f32_16x16x32_f16(ah, xb, acc[mt], 0, 0, 0);
        acc[mt] = __builtin_amdgcn_mfma_f32_16x16x32_f16(al, xb, acc[mt], 0, 0, 0);
      }
#pragma unroll
      for (int e = 0; e < 8; ++e) { float x = (float)xz[ks][e]; s1 += x; s2 = __builtin_fmaf(x, x, s2); }
      __builtin_amdgcn_sched_barrier(0);
    }
    s1 += __shfl_xor(s1, 1, 64); s1 += __shfl_xor(s1, 2, 64);
    s2 += __shfl_xor(s2, 1, 64); s2 += __shfl_xor(s2, 2, 64);
    const float mu = s1 * (1.0f / DM);
    const float rs = rsqrtf(fmaxf(s2 * (1.0f / DM) - mu * mu, 0.f) + 1e-5f);
    {
      const float mum = __shfl(mu, fr * 4, 64), rsm = __shfl(rs, fr * 4, 64);
#pragma unroll
      for (int mt = 0; mt < 3; ++mt) {
        const float4 c1 = *(const float4*)(rc + mt * 16 + fq * 4), c2 = *(const float4*)(rc + 48 + mt * 16 + fq * 4);
        acc[mt][0] = rsm * (acc[mt][0] - mum * c1.x) + c2.x;
        acc[mt][1] = rsm * (acc[mt][1] - mum * c1.y) + c2.y;
        acc[mt][2] = rsm * (acc[mt][2] - mum * c1.z) + c2.z;
        acc[mt][3] = rsm * (acc[mt][3] - mum * c1.w) + c2.w;
      }
    }
    float lg[36];
#pragma unroll
    for (int o = 0; o < 36; ++o) lg[o] = __shfl(acc[o >> 4][o & 3], fr + 16 * ((o >> 2) & 3), 64);
    {
      int g = 0;
      float m = lg[0];
#pragma unroll
      for (int o = 1; o < 4; ++o) if (lg[o] > m) { m = lg[o]; g = o; }
      float se = 0.f;
#pragma unroll
      for (int o = 0; o < 4; ++o) se += __expf(lg[o] - m);
      float pg = 1.0f / se;
      float v1 = -3e38f, v2 = -3e38f;
      int i1 = 0, i2 = 0;
#pragma unroll
      for (int jx = 0; jx < 8; ++jx) {
        float x = (g == 0) ? lg[4 + jx] : (g == 1) ? lg[12 + jx] : (g == 2) ? lg[20 + jx] : lg[28 + jx];
        if (x > v1) { v2 = v1; i2 = i1; v1 = x; i1 = jx; }
        else if (x > v2) { v2 = x; i2 = jx; }
      }
      if (fq == 0) {
        const int tt = t0 + fr;
        float e2 = __expf(v2 - v1);
        float w1 = pg / (1.0f + e2), w2 = pg * e2 / (1.0f + e2);
        int ea = g * 8 + i1, eb = g * 8 + i2;
        route_e[2 * tt] = ea; route_e[2 * tt + 1] = eb;
        route_w[2 * tt] = w1; route_w[2 * tt + 1] = w2;
        int la = atomicAdd(&lcnt[ea], 1), lb = atomicAdd(&lcnt[eb], 1);
        int slot = atomicAdd(&lcnt[64], 2);
        if (slot + 1 < 512) {
          lent[2 * slot] = (ea << 16) | la; lent[2 * slot + 1] = 2 * tt;
          lent[2 * slot + 2] = (eb << 16) | lb; lent[2 * slot + 3] = 2 * tt + 1;
        }
      }
    }
    {
      const unsigned eo = (unsigned)((t0 + crow) * DM + cp * 8);
      const float mrs = -mu * rs;
      if (cp == 0) *(float2*)(stat + (size_t)(t0 + crow) * 2) = make_float2(mu, rs);
#pragma unroll
      for (int ks = 0; ks < 32; ++ks) {
        const float4 g0 = *(const float4*)(sg + ks * 32 + cp * 8), g1 = *(const float4*)(sg + ks * 32 + cp * 8 + 4);
        const float4 b0 = *(const float4*)(sbt + ks * 32 + cp * 8), b1 = *(const float4*)(sbt + ks * 32 + cp * 8 + 4);
        i32x4 xi = __builtin_bit_cast(i32x4, xz[ks]);
        asm volatile("" : "+v"(xi));
        const f16x8 xv = __builtin_bit_cast(f16x8, xi);
        f16x8 bh;
        bh[0] = (f16)__builtin_fmaf(__builtin_fmaf((float)xv[0], rs, mrs), g0.x, b0.x);
        bh[1] = (f16)__builtin_fmaf(__builtin_fmaf((float)xv[1], rs, mrs), g0.y, b0.y);
        bh[2] = (f16)__builtin_fmaf(__builtin_fmaf((float)xv[2], rs, mrs), g0.z, b0.z);
        bh[3] = (f16)__builtin_fmaf(__builtin_fmaf((float)xv[3], rs, mrs), g0.w, b0.w);
        bh[4] = (f16)__builtin_fmaf(__builtin_fmaf((float)xv[4], rs, mrs), g1.x, b1.x);
        bh[5] = (f16)__builtin_fmaf(__builtin_fmaf((float)xv[5], rs, mrs), g1.y, b1.y);
        bh[6] = (f16)__builtin_fmaf(__builtin_fmaf((float)xv[6], rs, mrs), g1.z, b1.z);
        bh[7] = (f16)__builtin_fmaf(__builtin_fmaf((float)xv[7], rs, mrs), g1.w, b1.w);
        {
          int p0 = __builtin_amdgcn_cvt_pk_fp8_f32((float)bh[0], (float)bh[1], 0, false);
          p0 = __builtin_amdgcn_cvt_pk_fp8_f32((float)bh[2], (float)bh[3], p0, true);
          int p1 = __builtin_amdgcn_cvt_pk_fp8_f32((float)bh[4], (float)bh[5], 0, false);
          p1 = __builtin_amdgcn_cvt_pk_fp8_f32((float)bh[6], (float)bh[7], p1, true);
          *(uint2*)(h18 + ((size_t)eo + ks * 32)) = make_uint2((unsigned)p0, (unsigned)p1);
        }
        __builtin_amdgcn_sched_barrier(0);
      }
    }
    t0 += stride;
    if (t0 < T_TOK) P5_LOAD(t0);
  }
#undef P5_LOAD
  __syncthreads();
  if (tid < 32) lcnt[32 + tid] = atomicAdd(&counts[tid * CNT_STRIDE], lcnt[tid]);
  __syncthreads();
  {
    const int n_ent = min(lcnt[64], 512);
    for (int i = tid; i < n_ent; i += 512) {
      int ev = lent[2 * i], id = lent[2 * i + 1];
      int e = ev >> 16, lp = ev & 0xffff;
      lists[(size_t)e * T_TOK + lcnt[32 + e] + lp] = id;
    }
  }
  __syncthreads();
}

__device__ __forceinline__ void p_final(const Params& p) {
  const f16* z16 = (const f16*)(p.ws + OFF_C);
  const float* stat = (const float*)(p.ws + OFF_STAT);
  const char* y8 = p.ws + OFF_A;
  const int tid = opaque_tid(), wid = tid >> 6, lane = tid & 63;
  const int nw = gridDim.x * 8;
  int t = blockIdx.x * 8 + wid;
  float ag[16], ab[16];
#pragma unroll
  for (int i = 0; i < 2; ++i)
#pragma unroll
    for (int hf = 0; hf < 2; ++hf) {
      const int c = i * 512 + lane * 8 + hf * 4;
      const float4 g = *(const float4*)(p.ln1_g + c), b = *(const float4*)(p.ln1_b + c);
      ag[i * 8 + hf * 4 + 0] = ALPHA * g.x; ag[i * 8 + hf * 4 + 1] = ALPHA * g.y; ag[i * 8 + hf * 4 + 2] = ALPHA * g.z; ag[i * 8 + hf * 4 + 3] = ALPHA * g.w;
      ab[i * 8 + hf * 4 + 0] = ALPHA * b.x; ab[i * 8 + hf * 4 + 1] = ALPHA * b.y; ab[i * 8 + hf * 4 + 2] = ALPHA * b.z; ab[i * 8 + hf * 4 + 3] = ALPHA * b.w;
    }
  f16x8 zv[2];
  uint2 y0[2], y1[2];
  float2 st;
#define P7_LOAD(tt)                                                                          \
  {                                                                                          \
    _Pragma("unroll") for (int i = 0; i < 2; ++i) {                                          \
      zv[i] = *(const f16x8*)(z16 + (size_t)(tt) * DM + i * 512 + lane * 8);                 \
      y0[i] = *(const uint2*)(y8 + (size_t)(2 * (tt)) * DM + i * 512 + lane * 8);            \
      y1[i] = *(const uint2*)(y8 + (size_t)(2 * (tt) + 1) * DM + i * 512 + lane * 8);        \
    }                                                                                        \
    st = *(const float2*)(stat + (size_t)(tt) * 2);                                          \
  }
  if (t < T_TOK) { P7_LOAD(t); }
  for (; t < T_TOK; t += nw) {
    float v[16];
    const float rs1 = st.y, mrs1 = -st.x * st.y;
#pragma unroll
    for (int i = 0; i < 2; ++i) {
      typedef float f32x2_ __attribute__((ext_vector_type(2)));
      const float ys = 1.0f / Y_SCALE;
      const unsigned a_[2] = {y0[i].x, y0[i].y}, b_[2] = {y1[i].x, y1[i].y};
#pragma unroll
      for (int d = 0; d < 2; ++d) {
        const f32x2_ a0 = __builtin_amdgcn_cvt_scalef32_pk_f32_fp8(a_[d], ys, false), a1 = __builtin_amdgcn_cvt_scalef32_pk_f32_fp8(a_[d], ys, true);
        const f32x2_ b0 = __builtin_amdgcn_cvt_scalef32_pk_f32_fp8(b_[d], ys, false), b1 = __builtin_amdgcn_cvt_scalef32_pk_f32_fp8(b_[d], ys, true);
        const float yy[4] = {a0[0] + b0[0], a0[1] + b0[1], a1[0] + b1[0], a1[1] + b1[1]};
#pragma unroll
        for (int e = 0; e < 4; ++e) {
          const int k = i * 8 + d * 4 + e;
          const float xn = __builtin_fmaf((float)zv[i][d * 4 + e], rs1, mrs1);
          v[k] = __builtin_fmaf(xn, ag[k], ab[k]) + yy[e];
        }
      }
    }
    if (t + nw < T_TOK) { P7_LOAD(t + nw); }
    float s = 0.f;
#pragma unroll
    for (int i = 0; i < 16; ++i) s += v[i];
    float mu = wave_sum(s) * (1.0f / DM);
    float q = 0.f;
#pragma unroll
    for (int i = 0; i < 16; ++i) { v[i] -= mu; q += v[i] * v[i]; }
    float rs = rsqrtf(wave_sum(q) * (1.0f / DM) + 1e-5f);
#pragma unroll
    for (int i = 0; i < 2; ++i)
#pragma unroll
      for (int hf = 0; hf < 2; ++hf) {
        const int c = i * 512 + lane * 8 + hf * 4;
        float4 g = *(const float4*)(p.ln2_g + c), b = *(const float4*)(p.ln2_b + c);
        f32x4 o;
        o[0] = v[i * 8 + hf * 4 + 0] * rs * g.x + b.x; o[1] = v[i * 8 + hf * 4 + 1] * rs * g.y + b.y;
        o[2] = v[i * 8 + hf * 4 + 2] * rs * g.z + b.z; o[3] = v[i * 8 + hf * 4 + 3] * rs * g.w + b.w;
        *(f32x4*)(p.out + (size_t)t * DM + c) = o;
      }
  }
#undef P7_LOAD
}

#define MEGA_LDS 161408


#define XB_TMO      128
#define XB_XCNT(j)  (256  + 64 * (j))
#define XB_XSUB(j)  (1280 + 64 * (j))
#define XB_XGEN(j)  (2304 + 64 * (j))
#define XB_TOP      3328
#define XB_TOPGEN   3392
#define XCD_BAR_WORDS 3456
#define XB_SPIN_CAP (1u << 22)
#define LAS __attribute__((address_space(3)))
__device__ __forceinline__ unsigned xb_ld(unsigned* p) { return __hip_atomic_load(p, __ATOMIC_RELAXED, __HIP_MEMORY_SCOPE_AGENT); }
__device__ __forceinline__ unsigned xb_add(unsigned* p, unsigned v) { return __hip_atomic_fetch_add(p, v, __ATOMIC_RELAXED, __HIP_MEMORY_SCOPE_AGENT); }
__device__ __forceinline__ unsigned xb_xcc_id() { return (unsigned)__builtin_amdgcn_s_getreg((3 << 11) | 20) & 0xFu; }
#define XB_SPIN(cond, bar) do { unsigned _sp = 0; while (cond) { __builtin_amdgcn_s_sleep(1); \
    if ((++_sp & 255u) == 0u) { if (xb_ld(&(bar)[XB_TMO])) break; if (_sp > XB_SPIN_CAP) { atomicAdd(&(bar)[XB_TMO], 1u); break; } } } } while (0)
struct XcdBarrier { unsigned* bar; unsigned x; volatile unsigned* st; };
__device__ __forceinline__ XcdBarrier xcd_barrier_post(unsigned* bar, volatile unsigned* st) {
  XcdBarrier b; b.bar = bar; b.x = xb_xcc_id(); b.st = st;
  if (threadIdx.x == 0) (void)xb_add(&bar[XB_XCNT(b.x)], 1u);
  return b;
}
__device__ __forceinline__ void xcd_barrier_complete(unsigned* bar, unsigned x, unsigned& nloc, unsigned& nx) {
  const unsigned G = gridDim.x * gridDim.y * gridDim.z;
  unsigned sum, cnt, mine, sp = 0u;
  for (;;) {
    sum = 0u; cnt = 0u; mine = 0u;
#pragma unroll
    for (unsigned j = 0; j < 16; ++j) { const unsigned c = xb_ld(&bar[XB_XCNT(j)]); sum += c; cnt += (c > 0u) ? 1u : 0u; mine = (j == x) ? c : mine; }
    if (sum == G) break;
    __builtin_amdgcn_s_sleep(1);
    if ((++sp & 255u) == 0u) { if (xb_ld(&bar[XB_TMO])) break; if (sp > XB_SPIN_CAP) { atomicAdd(&bar[XB_TMO], 1u); break; } }
  }
  nloc = mine > 0u ? mine : 1u; nx = cnt > 0u ? cnt : 1u;
}
__device__ __forceinline__ void xcd_barrier(const XcdBarrier& b) {
  asm volatile("s_waitcnt vmcnt(0)" ::: "memory");
  __syncthreads();
  if (threadIdx.x == 0) {
    unsigned* bar = b.bar;
    __builtin_amdgcn_s_waitcnt(0);
    unsigned nloc = b.st[0], nx = b.st[1];
    if (nloc == 0u) { xcd_barrier_complete(bar, b.x, nloc, nx); b.st[0] = nloc; b.st[1] = nx; }
    const unsigned old = xb_add(&bar[XB_XSUB(b.x)], 1u);
    const unsigned gen = old / nloc;
    if (old + 1u == (gen + 1u) * nloc) {
      __builtin_amdgcn_fence(__ATOMIC_RELEASE, "agent");
      asm volatile("s_waitcnt vmcnt(0)" ::: "memory");
      const unsigned og = xb_add(&bar[XB_TOP], 1u);
      const unsigned tg = og / nx;
      if (og + 1u == (tg + 1u) * nx) xb_add(&bar[XB_TOPGEN], 1u);
      else XB_SPIN(xb_ld(&bar[XB_TOPGEN]) == tg, bar);
      __builtin_amdgcn_fence(__ATOMIC_ACQUIRE, "agent");
      xb_add(&bar[XB_XGEN(b.x)], 1u);
      asm volatile("s_waitcnt vmcnt(0)" ::: "memory");
    } else {
      XB_SPIN(xb_ld(&bar[XB_XGEN(b.x)]) == gen, bar);
      __builtin_amdgcn_fence(__ATOMIC_ACQUIRE, "agent");
      asm volatile("s_waitcnt vmcnt(0)" ::: "memory");
    }
  }
  __syncthreads();
}

#ifndef PROBE
#define PROBE 0
#endif
#define GSYNC() do { XcdBarrier xb_; xb_.bar = (unsigned*)(p.ws + OFF_BAR); xb_.x = xb_xcc_id(); xb_.st = (volatile unsigned*)(shm + MEGA_LDS); xcd_barrier(xb_); } while (0)
#define PH(n, code) do { code; if (PROBE == n) { GSYNC(); code; } } while (0)
__global__ __launch_bounds__(512) void mega(Params p) {
  __shared__ __attribute__((aligned(1024))) char shm[MEGA_LDS + 16];
  volatile unsigned* xst = (volatile unsigned*)(shm + MEGA_LDS);
  if (threadIdx.x < 4) xst[threadIdx.x] = 0u;
  __syncthreads();
  (void)xcd_barrier_post((unsigned*)(p.ws + OFF_BAR), xst);
  if (blockIdx.x == 0 && threadIdx.x < 32) ((int*)(p.ws + OFF_CNT))[threadIdx.x * CNT_STRIDE] = 0;
  PH(1, p_ln_in(p));
  PH(2, p_convert(p, shm));
  GSYNC();
  PH(3, p_inproj(p, shm));
  GSYNC();
  PH(4, p_pool(p, shm));
  PH(5, p_index<0>(p, shm));
#if PROBE >= 50 && PROBE < 60
  GSYNC();
  p_index<PROBE - 50>(p, shm);
#endif
  GSYNC();
  PH(7, p_merge(p, shm));
  GSYNC();
  PH(8, p_resid(p, shm));
  GSYNC();
  p_ln1_route<0>(p, shm);
  GSYNC();
#if PROBE == 9
  if (blockIdx.x == 0 && threadIdx.x < 32) ((int*)((char*)p.out + 70000000))[threadIdx.x * CNT_STRIDE] = 0;
  GSYNC();
  p_ln1_route<1>(p, shm);
  GSYNC();
#endif
  PH(10, p_moe_a(p, shm));
  GSYNC();
  PH(11, p_moe_b(p, shm));
  GSYNC();
  PH(12, p_final(p));
}

extern "C" void kernel_launch(void* const* d_in, const int* in_sizes, int n_in, void* d_out, int out_size, void* d_ws,
                              size_t ws_size, hipStream_t stream) {
  if (ws_size < WS_NEEDED) { fprintf(stderr, "ws too small: %zu < %zu\n", ws_size, (size_t)WS_NEEDED); return; }
  static int grid_blocks = 0;
  if (!grid_blocks) {
    int dev = 0, cus = 0, per_cu = 0;
    hipGetDevice(&dev);
    hipDeviceGetAttribute(&cus, hipDeviceAttributeMultiprocessorCount, dev);
    hipOccupancyMaxActiveBlocksPerMultiprocessor(&per_cu, mega, 512, 0);
    if (per_cu > 1) per_cu = 1;
    grid_blocks = cus * per_cu;
    fprintf(stderr, "mega: cus=%d per_cu=%d grid=%d\n", cus, per_cu, grid_blocks);
  }
  Params p{};
  const float** pp = (const float**)&p;
  for (int i = 0; i < 21; ++i) pp[i] = (const float*)d_in[i];
  p.out = (float*)d_out;
  p.ws = (char*)d_ws;
  (void)hipMemsetAsync((char*)d_ws + OFF_BAR, 0, 16384, stream);
  void* args[] = {&p};
  hipError_t e = hipLaunchCooperativeKernel((void*)mega, dim3(grid_blocks), dim3(512), args, 0, stream);
  if (e != hipSuccess) fprintf(stderr, "cooperative launch failed: %s (grid %d)\n", hipGetErrorString(e), grid_blocks);
}
```
